# Optimizing an MI355X kernel written in HIP

```python
import math
import jax, jax.numpy as jnp
from jax import lax
import numpy as np

D_MODEL = 1024
BATCH = 8
SEQ = 2048
DEPTH = 4

N_EVEN = (DEPTH + 1) // 2
N_ODD = DEPTH // 2
PLE_DIM = 256
EPS = 1e-6

A_HEADS = 4
A_DK = 128
A_DV = 128
A_WIDTH = A_HEADS * A_DV
A_CHUNK = 64
A_CONV = 4
B_HEADS = 8
B_DH = 64
B_WIDTH = B_HEADS * B_DH
B_LATENT = 128
IDX_HEADS = 8
IDX_DIM = 64
TOPK_MAX = 256
Q_BLOCK = 128
REL_BUCKETS = 32
REL_MAX_DIST = 128
MIX_WIDTH = A_WIDTH + B_WIDTH
IN_SIZES = (A_HEADS * A_DK, A_HEADS * A_DK, A_HEADS * A_DV, A_WIDTH, A_HEADS, A_HEADS,
            B_WIDTH, B_LATENT, IDX_HEADS * IDX_DIM, IDX_DIM, IDX_HEADS)
IN_OFFSETS = tuple(int(v) for v in np.cumsum(IN_SIZES)[:-1])
D_IN_EVEN = int(sum(IN_SIZES))
POOL_WINDOWS = (2, 4, 8, 16)
POOL_GROUP = D_MODEL // len(POOL_WINDOWS)
D_FF = 3584
N_EXPERTS = 8
TOP_K_EXPERTS = 2

kernel_name = 'hybrid_mlstm_dsa_pool_moe'


def rmsnorm(x, g):
    xf = x.astype(jnp.float32)
    y = xf * lax.rsqrt(jnp.mean(xf * xf, axis=-1, keepdims=True) + EPS)
    return (y * g.astype(jnp.float32)).astype(x.dtype)


def causal_dwconv(x, w):
    k = w.shape[0]
    return lax.conv_general_dilated(x, w[:, None, :].astype(x.dtype), window_strides=(1,),
                                    padding=[(k - 1, 0)], dimension_numbers=('NWC', 'WIO', 'NWC'),
                                    feature_group_count=x.shape[-1])


def mlstm_chunkwise(q, k, v, log_i, log_f):
    b, h, s, dk = q.shape
    dv = v.shape[-1]
    nc = s // A_CHUNK

    def to_chunks(a):
        return jnp.moveaxis(a.reshape(b, h, nc, A_CHUNK, *a.shape[3:]), 2, 0)

    causal = jnp.tril(jnp.ones((A_CHUNK, A_CHUNK), dtype=bool))

    def step(carry, inp):
        c_state, n_state, m_state = carry
        qq, kk, vv, ii, ff = inp
        bcum = jnp.cumsum(ff, axis=-1)
        dmat = bcum[..., :, None] - bcum[..., None, :] + ii[..., None, :]
        dmat = jnp.where(causal, dmat, -jnp.inf)
        inter = bcum + m_state[..., None]
        m_t = jnp.maximum(inter, jnp.max(dmat, axis=-1))
        w_intra = jnp.exp(dmat - m_t[..., None])
        w_inter = jnp.exp(inter - m_t)
        scores = jnp.einsum('bhtd,bhsd->bhts', qq, kk) * w_intra
        num = (jnp.einsum('bhts,bhsv->bhtv', scores, vv)
               + w_inter[..., None] * jnp.einsum('bhtd,bhdv->bhtv', qq, c_state))
        den = jnp.sum(scores, axis=-1) + w_inter * jnp.einsum('bhtd,bhd->bht', qq, n_state)
        h_out = num / jnp.maximum(jnp.abs(den), jnp.exp(-m_t))[..., None]
        b_last = bcum[..., -1]
        g = b_last[..., None] - bcum + ii
        m_new = jnp.maximum(b_last + m_state, jnp.max(g, axis=-1))
        decay = jnp.exp(b_last + m_state - m_new)
        wk = jnp.exp(g - m_new[..., None])
        c_new = decay[..., None, None] * c_state + jnp.einsum('bhs,bhsd,bhsv->bhdv', wk, kk, vv)
        n_new = decay[..., None] * n_state + jnp.einsum('bhs,bhsd->bhd', wk, kk)
        return (c_new, n_new, m_new), h_out

    init = (jnp.zeros((b, h, dk, dv), jnp.float32), jnp.zeros((b, h, dk), jnp.float32),
            jnp.zeros((b, h), jnp.float32))
    _, hs = lax.scan(step, init, tuple(map(to_chunks, (q, k, v, log_i, log_f))))
    return jnp.moveaxis(hs, 0, 2).reshape(b, h, s, dv)


def t5_bucket(dist):
    max_exact = REL_BUCKETS // 2
    logd = jnp.log(jnp.maximum(dist, 1).astype(jnp.float32) / max_exact)
    large = max_exact + (logd / math.log(REL_MAX_DIST / max_exact) * (REL_BUCKETS - max_exact)).astype(jnp.int32)
    large = jnp.minimum(large, REL_BUCKETS - 1)
    return jnp.where(dist < max_exact, dist, large)


def dsa_attention(q, k, c, q_idx, k_idx, w_idx, w_uv, rel_bias):
    b, s = q.shape[0], q.shape[1]
    topk = min(TOPK_MAX, s // 4)
    nb = s // Q_BLOCK
    key_pos = jnp.arange(s)
    scale = B_DH ** -0.5
    gather = jax.vmap(lambda a, i: a[i])

    def blocks(a):
        return jnp.moveaxis(a.reshape(b, nb, Q_BLOCK, *a.shape[2:]), 1, 0)

    def one_block(args):
        qb, qib, wb, t0 = args
        t = t0 + jnp.arange(Q_BLOCK)
        isc = jax.nn.relu(jnp.einsum('bqhd,bsd->bqhs', qib, k_idx).astype(jnp.float32))
        isc = jnp.einsum('bqhs,bqh->bqs', isc, wb.astype(jnp.float32))
        isc = jnp.where(key_pos[None, None, :] <= t[None, :, None], isc, -jnp.inf)
        _, idx = lax.top_k(isc, topk)
        valid = idx <= t[None, :, None]
        k_sel = gather(k, idx)
        c_sel = gather(c, idx)
        logits = jnp.einsum('bqhd,bqkd->bhqk', qb, k_sel).astype(jnp.float32) * scale
        bucket = t5_bucket(jnp.maximum(t[None, :, None] - idx, 0))
        logits = logits + jnp.moveaxis(rel_bias[bucket], -1, 1).astype(jnp.float32)
        logits = jnp.where(valid[:, None], logits, -jnp.inf)
        probs = jax.nn.softmax(logits, axis=-1).astype(c.dtype)
        o_lat = jnp.einsum('bhqk,bqkc->bqhc', probs, c_sel)
        return jnp.einsum('bqhc,hcd->bqhd', o_lat, w_uv)

    t0s = jnp.arange(nb, dtype=jnp.int32) * Q_BLOCK
    out = lax.map(one_block, (blocks(q), blocks(q_idx), blocks(w_idx), t0s))
    return jnp.moveaxis(out, 0, 1).reshape(b, s, B_WIDTH)


def even_mixer(y, w_in, b_gate, conv_w, g_h, g_q, g_k, g_kv, w_uk, w_uv, w_out, rel_bias):
    b, s, _ = y.shape
    proj = y @ w_in
    aq, ak, av, ao, ai, af, bq, bc, bqi, bki, bwi = jnp.split(proj, IN_OFFSETS, axis=-1)
    qk = jax.nn.silu(causal_dwconv(jnp.concatenate([aq, ak], axis=-1), conv_w))
    aq, ak = jnp.split(qk, 2, axis=-1)

    def heads(a, nh):
        return a.reshape(b, s, nh, -1).transpose(0, 2, 1, 3).astype(jnp.float32)

    qa = heads(aq, A_HEADS)
    ka = heads(ak, A_HEADS) * (A_DK ** -0.5)
    va = heads(av, A_HEADS)
    log_i = (ai + b_gate[:A_HEADS]).astype(jnp.float32).transpose(0, 2, 1)
    log_f = jax.nn.log_sigmoid((af + b_gate[A_HEADS:]).astype(jnp.float32)).transpose(0, 2, 1)
    h_a = mlstm_chunkwise(qa, ka, va, log_i, log_f)
    h_a = rmsnorm(h_a, g_h.reshape(A_HEADS, 1, A_DV))
    h_a = h_a.transpose(0, 2, 1, 3).reshape(b, s, A_WIDTH).astype(y.dtype) * jax.nn.sigmoid(ao)
    qb = rmsnorm(bq.reshape(b, s, B_HEADS, B_DH), g_q)
    lat = rmsnorm(bc, g_kv)
    kb = rmsnorm(lat @ w_uk, g_k)
    h_b = dsa_attention(qb, kb, lat, bqi.reshape(b, s, IDX_HEADS, IDX_DIM), bki, bwi, w_uv, rel_bias)
    return jnp.concatenate([h_a, h_b], axis=-1) @ w_out


def pool_mixer(y, w_pool, scale):
    b, s, d = y.shape
    yf = y.astype(jnp.float32)
    cs0 = jnp.pad(jnp.cumsum(yf, axis=1), ((0, 0), (1, 0), (0, 0)))
    pos = jnp.arange(1, s + 1, dtype=jnp.float32)[None, :, None]
    outs = []
    for g, win in enumerate(POOL_WINDOWS):
        sl = slice(g * POOL_GROUP, (g + 1) * POOL_GROUP)
        c = cs0[:, :, sl]
        lower = jnp.pad(c, ((0, 0), (win - 1, 0), (0, 0)))[:, :s]
        mean = (c[:, 1:] - lower) / jnp.minimum(pos, win)
        pooled = (mean - yf[:, :, sl]).astype(y.dtype)
        outs.append(pooled @ w_pool[g])
    return jnp.concatenate(outs, axis=-1) * scale


def swiglu(y, wg, wu, wd):
    return (jax.nn.silu(y @ wg) * (y @ wu)) @ wd


def moe(y, w_router, b_router, wg, wu, wd):
    logits = (y @ w_router).astype(jnp.float32) + b_router.astype(jnp.float32)
    top_v, top_i = lax.top_k(logits, TOP_K_EXPERTS)
    gates = jax.nn.softmax(top_v, axis=-1)
    combine = jnp.sum(jax.nn.one_hot(top_i, N_EXPERTS, dtype=jnp.float32) * gates[..., None], axis=-2)
    out = jnp.zeros_like(y)
    for e in range(N_EXPERTS):
        out = out + combine[..., e:e + 1].astype(y.dtype) * swiglu(y, wg[e], wu[e], wd[e])
    return out


def setup_inputs(seed: int = 0) -> dict:
    key = jax.random.key(seed)
    ks = iter(jax.random.split(key, 40))

    def nrm(shape, scale):
        return jax.random.normal(next(ks), shape, jnp.float32) * scale

    def gain(shape):
        return 1.0 + nrm(shape, 0.1)

    return {
        'x': nrm((BATCH, SEQ, D_MODEL), 1.0),
        'p': nrm((DEPTH, BATCH, SEQ, PLE_DIM), 1.0),
        'norm_mix': gain((DEPTH, D_MODEL)),
        'norm_ffn': gain((DEPTH, D_MODEL)),
        'w_in_e': nrm((N_EVEN, D_MODEL, D_IN_EVEN), D_MODEL ** -0.5),
        'b_gate_e': jnp.concatenate([nrm((N_EVEN, A_HEADS), 0.1), 3.0 + nrm((N_EVEN, A_HEADS), 0.5)], axis=-1),
        'conv_a': nrm((N_EVEN, A_CONV, 2 * A_HEADS * A_DK), A_CONV ** -0.5),
        'norm_h_a': gain((N_EVEN, A_WIDTH)),
        'norm_q_b': gain((N_EVEN, B_DH)),
        'norm_k_b': gain((N_EVEN, B_DH)),
        'norm_kv_b': gain((N_EVEN, B_LATENT)),
        'w_uk_b': nrm((N_EVEN, B_LATENT, B_DH), B_LATENT ** -0.5),
        'w_uv_b': nrm((N_EVEN, B_HEADS, B_LATENT, B_DH), B_LATENT ** -0.5),
        'w_out_e': nrm((N_EVEN, MIX_WIDTH, D_MODEL), MIX_WIDTH ** -0.5),
        'rel_bias': nrm((REL_BUCKETS, B_HEADS), 0.5),
        'w_pool': nrm((N_ODD, len(POOL_WINDOWS), POOL_GROUP, POOL_GROUP), POOL_GROUP ** -0.5),
        'scale_pool': gain((N_ODD, D_MODEL)),
        'w_gate_d': nrm((N_EVEN, D_MODEL, D_FF), D_MODEL ** -0.5),
        'w_up_d': nrm((N_EVEN, D_MODEL, D_FF), D_MODEL ** -0.5),
        'w_down_d': nrm((N_EVEN, D_FF, D_MODEL), D_FF ** -0.5),
        'w_router': nrm((N_ODD, D_MODEL, N_EXPERTS), D_MODEL ** -0.5),
        'b_router': nrm((N_ODD, N_EXPERTS), 0.01),
        'w_gate_m': nrm((N_ODD, N_EXPERTS, D_MODEL, D_FF), D_MODEL ** -0.5),
        'w_up_m': nrm((N_ODD, N_EXPERTS, D_MODEL, D_FF), D_MODEL ** -0.5),
        'w_down_m': nrm((N_ODD, N_EXPERTS, D_FF, D_MODEL), D_FF ** -0.5),
        'w_ple': nrm((DEPTH, PLE_DIM, D_MODEL), PLE_DIM ** -0.5),
        'w_ple_gate': nrm((DEPTH, D_MODEL, D_MODEL), D_MODEL ** -0.5),
        'norm_ple': gain((DEPTH, D_MODEL)),
    }


def reference(x, p, norm_mix, norm_ffn, w_in_e, b_gate_e, conv_a, norm_h_a, norm_q_b, norm_k_b,
              norm_kv_b, w_uk_b, w_uv_b, w_out_e, rel_bias, w_pool, scale_pool, w_gate_d, w_up_d,
              w_down_d, w_router, b_router, w_gate_m, w_up_m, w_down_m, w_ple, w_ple_gate, norm_ple):
    h = x
    for i in range(DEPTH):
        y = rmsnorm(h, norm_mix[i])
        if i % 2 == 0:
            e = i // 2
            h = h + even_mixer(y, w_in_e[e], b_gate_e[e], conv_a[e], norm_h_a[e], norm_q_b[e],
                               norm_k_b[e], norm_kv_b[e], w_uk_b[e], w_uv_b[e], w_out_e[e], rel_bias)
            y = rmsnorm(h, norm_ffn[i])
            h = h + swiglu(y, w_gate_d[e], w_up_d[e], w_down_d[e])
        else:
            o = i // 2
            h = h + pool_mixer(y, w_pool[o], scale_pool[o])
            y = rmsnorm(h, norm_ffn[i])
            h = h + moe(y, w_router[o], b_router[o], w_gate_m[o], w_up_m[o], w_down_m[o])
        gate = jax.nn.sigmoid(rmsnorm(h, norm_ple[i]) @ w_ple_gate[i])
        h = h + (p[i] @ w_ple[i]) * gate
    return h
```

```cpp
#include <hip/hip_runtime.h>
#include <cstdio>
#include <cstdint>
#ifndef MK_ONE_LAUNCH
#define MK_ONE_LAUNCH 0
#endif
namespace pg8 {
#define PG8_LAS __attribute__((address_space(3)))
typedef unsigned short bf16_t;
typedef short bf16x8 __attribute__((ext_vector_type(8)));
typedef float f32x4 __attribute__((ext_vector_type(4)));
typedef unsigned u32x4 __attribute__((ext_vector_type(4)));
constexpr int BM = 256, BK = 64, HALF = 128, HTB = HALF * BK * 2  , STAGE_BYTES = 8 * HTB, NXCD = 8, WGM = 8;

__host__ __device__ __forceinline__ int lds_byte(int r, int c) { const int st = (r >> 4) * 2 + (c >> 5), rr = r & 15, cc = c & 31, ob = rr * 64 + cc * 2; return st * 1024 + (ob ^ (((ob >> 9) & 1) << 5)); }
__host__ __device__ __forceinline__ void stage_rc(int b, int& R, int& C) { const int st = b / 1024, sb = b % 1024, swz = sb ^ (((sb >> 9) & 1) << 5); R = (st >> 1) * 16 + swz / 64; C = (st & 1) * 32 + (swz % 64) / 2; }
__host__ __device__ __forceinline__ int perm32(int rho) { const int n = rho >> 4, i = rho & 15; return 8 * (i >> 2) + 4 * n + (i & 3); }

struct Unit { int pm, pn; };
struct Gemm { const bf16_t* A; const bf16_t* Bt; int M, N, K; };

struct StaticOrder {
    int nM, nN, nwg, G, c;
    __host__ __device__ void init(int M, int N, int G_, int c_) { nM = M / BM; nN = N / BM; nwg = nM * nN; G = G_; c = c_; }
    __host__ __device__ bool next(int i, Unit& u) const {
        const long L = (long)i * G + c; if (L >= nwg) return false;
        int wgid = (int)L; { const int q = nwg / NXCD, r = nwg % NXCD, xcd = wgid % NXCD, off = wgid / NXCD; wgid = (xcd < r ? xcd * (q + 1) : r * (q + 1) + (xcd - r) * q) + off; }
        const int nig = WGM * nN, gid = wgid / nig, fm = gid * WGM, gsz = (nM - fm) < WGM ? (nM - fm) : WGM;
        u.pm = fm + ((wgid % nig) % gsz); u.pn = (wgid % nig) / gsz; return true;
    }
    __device__ __forceinline__ void a_ready(const Unit&) const {}
    __device__ __forceinline__ void done(const Unit&) const {}
};
__device__ __forceinline__ unsigned cvt_pk_bf16(float lo, float hi) { unsigned r; asm volatile("v_cvt_pk_bf16_f32 %0, %1, %2" : "=v"(r) : "v"(lo), "v"(hi)); return r; }
typedef float f32x2 __attribute__((ext_vector_type(2)));
constexpr float RMS_EPS = 1e-6f;
__device__ __forceinline__ float fsigmoid(float x) { return __builtin_amdgcn_rcpf(1.0f + __builtin_amdgcn_exp2f(-1.44269504f * x)); }
__device__ __forceinline__ f32x4 sig4(f32x4 v) { f32x4 o; o.x = fsigmoid(v.x); o.y = fsigmoid(v.y); o.z = fsigmoid(v.z); o.w = fsigmoid(v.w); return o; }
__device__ __forceinline__ u32x4 pack8(f32x4 v0, f32x4 v1) { u32x4 w; w.x = cvt_pk_bf16(v0[0], v0[1]); w.y = cvt_pk_bf16(v0[2], v0[3]); w.z = cvt_pk_bf16(v1[0], v1[1]); w.w = cvt_pk_bf16(v1[2], v1[3]); return w; }
__device__ __forceinline__ void unpack8(u32x4 w, f32x4& a, f32x4& b) {
    a.x = __uint_as_float(w.x << 16); a.y = __uint_as_float(w.x & 0xffff0000u); a.z = __uint_as_float(w.y << 16); a.w = __uint_as_float(w.y & 0xffff0000u);
    b.x = __uint_as_float(w.z << 16); b.y = __uint_as_float(w.z & 0xffff0000u); b.z = __uint_as_float(w.w << 16); b.w = __uint_as_float(w.w & 0xffff0000u); }
__device__ __forceinline__ void load_rstd(const float* stats, int rowb, int fr, int fq, float (&rs)[2][4]) {
    float mine[2];
#pragma unroll
    for (int ai = 0; ai < 2; ++ai) { const f32x4* p = (const f32x4*)(stats + (size_t)(rowb + ai * HALF + fq * 16) * 16); const f32x4 a = p[0], b = p[1], c = p[2], d = p[3];
        const float s = (((a.x + a.y) + (a.z + a.w)) + ((b.x + b.y) + (b.z + b.w))) + (((c.x + c.y) + (c.z + c.w)) + ((d.x + d.y) + (d.z + d.w)));
        mine[ai] = rsqrtf(s * (1.0f / 1024.0f) + RMS_EPS); }
#pragma unroll
    for (int ai = 0; ai < 2; ++ai)
#pragma unroll
        for (int m = 0; m < 4; ++m) rs[ai][m] = __shfl(mine[ai], fr + 16 * m);
}
struct EpiIn {
    static constexpr bool PERM = true, AFTER_DRAIN = false;
    const float* stats; bf16_t* QK; float* MISC;
    __device__ __forceinline__ void operator()(const f32x4 (&acc)[2][2][4][2], const Unit& u, int wr, int wc, int fr, int fq) const {
        const int rowb = u.pm * BM + wr * 64 + fr, cl = wc * 32 + 8 * fq, pn = u.pn;
        float rs[2][4]; load_rstd(stats, rowb, fr, fq, rs);
        if (pn < 12) {
            bf16_t* base; int ld, colt; bool sig = false;
            if (pn < 4) { base = QK; ld = 1024; colt = pn * 256; }
            else { const int t = (pn - 4) >> 1; base = QK + (size_t)16777216 + (size_t)t * 8388608; ld = 512; colt = ((pn - 4) & 1) * 256; sig = (t == 1); }
#pragma unroll
            for (int ai = 0; ai < 2; ++ai)
#pragma unroll
                for (int m = 0; m < 4; ++m) { const float r = rs[ai][m]; bf16_t* rp = base + (size_t)(rowb + ai * HALF + m * 16) * ld + colt + cl;
#pragma unroll
                    for (int bj = 0; bj < 2; ++bj) { f32x4 v0 = acc[ai][bj][m][0] * r, v1 = acc[ai][bj][m][1] * r; if (sig) { v0 = sig4(v0); v1 = sig4(v1); }
                        *(u32x4*)(rp + bj * HALF) = pack8(v0, v1); }
                    asm volatile("" ::: "memory"); }
        } else {
#pragma unroll
            for (int ai = 0; ai < 2; ++ai)
#pragma unroll
                for (int m = 0; m < 4; ++m) { const float r = rs[ai][m]; float* rp = MISC + (size_t)(rowb + ai * HALF + m * 16) * 256 + cl;
#pragma unroll
                    for (int bj = 0; bj < 2; ++bj)
#pragma unroll
                        for (int n = 0; n < 2; ++n) *(f32x4*)(rp + bj * HALF + 4 * n) = acc[ai][bj][m][n] * r;
                    asm volatile("" ::: "memory"); }
        }
    }
};
template <int MODE> struct EpiResid {
    static constexpr bool PERM = true, AFTER_DRAIN = false;
    float* H; bf16_t* HBo; float* statsW; const float* statsR; const bf16_t* E; const float* scale;
    __device__ __forceinline__ void operator()(const f32x4 (&acc)[2][2][4][2], const Unit& u, int wr, int wc, int fr, int fq) const {
        int pm = u.pm; const int pn = u.pn; if (MODE == 1) pm -= 64 * pn;
        const int rowb = pm * BM + wr * 64 + fr, colb = pn * BM + wc * 32 + 8 * fq;
        float rs[2][4]; if (MODE == 2) load_rstd(statsR, rowb, fr, fq, rs);
        f32x4 sc[2][2];
        if (MODE == 1) {
#pragma unroll
            for (int bj = 0; bj < 2; ++bj)
#pragma unroll
                for (int n = 0; n < 2; ++n) sc[bj][n] = *(const f32x4*)(scale + colb + bj * HALF + 4 * n); }
#pragma unroll
        for (int ai = 0; ai < 2; ++ai)
#pragma unroll
            for (int m = 0; m < 4; ++m) { const size_t off = (size_t)(rowb + ai * HALF + m * 16) * 1024 + colb; float ssq = 0.f;
#pragma unroll
                for (int bj = 0; bj < 2; ++bj) { float* hp = H + off + bj * HALF; f32x4 h0 = ((const f32x4*)hp)[0], h1 = ((const f32x4*)hp)[1];
                    f32x4 v0 = acc[ai][bj][m][0], v1 = acc[ai][bj][m][1];
                    if (MODE == 1) { v0 = v0 * sc[bj][0]; v1 = v1 * sc[bj][1]; }
                    if (MODE == 2) { const u32x4 ew = *(const u32x4*)(E + off + bj * HALF); f32x4 e0, e1; unpack8(ew, e0, e1); const float r = rs[ai][m]; v0 = e0 * sig4(v0 * r); v1 = e1 * sig4(v1 * r); }
                    h0 = h0 + v0; h1 = h1 + v1; ((f32x4*)hp)[0] = h0; ((f32x4*)hp)[1] = h1;
                    ssq += ((h0.x * h0.x + h0.y * h0.y) + (h0.z * h0.z + h0.w * h0.w)) + ((h1.x * h1.x + h1.y * h1.y) + (h1.z * h1.z + h1.w * h1.w));
                    *(u32x4*)(HBo + off + bj * HALF) = pack8(h0, h1); }
                ssq += __shfl_xor(ssq, 16); ssq += __shfl_xor(ssq, 32);
                if (fq == 0) statsW[(size_t)(rowb + ai * HALF + m * 16) * 16 + pn * 4 + wc] = ssq;
                asm volatile("" ::: "memory"); }
    }
};
template <bool MOE> struct EpiGLU {
    static constexpr bool PERM = true, AFTER_DRAIN = false;
    const float* stats; const float* rowr; bf16_t* ACT;
    __device__ __forceinline__ void operator()(const f32x4 (&acc)[2][2][4][2], const Unit& u, int wr, int wc, int fr, int fq) const {
        const int rowb = u.pm * BM + wr * 64 + fr, jt = MOE ? (u.pn % 28) : u.pn;
        float rs[2][4];
        if (MOE) {
#pragma unroll
            for (int ai = 0; ai < 2; ++ai)
#pragma unroll
                for (int m = 0; m < 4; ++m) rs[ai][m] = rowr[rowb + ai * HALF + m * 16];
        } else load_rstd(stats, rowb, fr, fq, rs);
#pragma unroll
        for (int ai = 0; ai < 2; ++ai)
#pragma unroll
            for (int m = 0; m < 4; ++m) { const float r = rs[ai][m]; bf16_t* rp = ACT + (size_t)(rowb + ai * HALF + m * 16) * 3584 + jt * 128 + wc * 32 + 8 * fq;
                const f32x4 g0 = acc[ai][0][m][0] * r, g1 = acc[ai][0][m][1] * r, u0 = acc[ai][1][m][0] * r, u1 = acc[ai][1][m][1] * r;
                *(u32x4*)rp = pack8(g0 * sig4(g0) * u0, g1 * sig4(g1) * u1);
                asm volatile("" ::: "memory"); }
    }
};
struct EpiScatter {
    static constexpr bool PERM = true, AFTER_DRAIN = false;
    const int* rowts; const float* rowg; bf16_t *D0, *D1;
    __device__ __forceinline__ void operator()(const f32x4 (&acc)[2][2][4][2], const Unit& u, int wr, int wc, int fr, int fq) const {
        const int rowb = u.pm * BM + wr * 64 + fr, jt = u.pn & 3;
#pragma unroll
        for (int ai = 0; ai < 2; ++ai)
#pragma unroll
            for (int m = 0; m < 4; ++m) { const int row = rowb + ai * HALF + m * 16; const int ts = rowts[row];
                if (ts >= 0) { const float g = rowg[row]; bf16_t* dp = ((ts & 1) ? D1 : D0) + (size_t)(ts >> 1) * 1024 + jt * 256 + wc * 32 + 8 * fq;
#pragma unroll
                    for (int bj = 0; bj < 2; ++bj) *(u32x4*)(dp + bj * HALF) = pack8(acc[ai][bj][m][0] * g, acc[ai][bj][m][1] * g); }
                asm volatile("" ::: "memory"); }
    }
};
struct EpiStore {
    static constexpr bool PERM = true, AFTER_DRAIN = false;
    bf16_t* O; int ldc;
    __device__ __forceinline__ void operator()(const f32x4 (&acc)[2][2][4][2], const Unit& u, int wr, int wc, int fr, int fq) const {
        const int rowb = u.pm * BM + wr * 64 + fr, colb = u.pn * BM + wc * 32 + 8 * fq;
#pragma unroll
        for (int ai = 0; ai < 2; ++ai)
#pragma unroll
            for (int m = 0; m < 4; ++m) { bf16_t* rp = O + (size_t)(rowb + ai * HALF + m * 16) * ldc + colb;
#pragma unroll
                for (int bj = 0; bj < 2; ++bj) *(u32x4*)(rp + bj * HALF) = pack8(acc[ai][bj][m][0], acc[ai][bj][m][1]); }
    }
};
struct PoolOrder {
    int G, c;
    __device__ __forceinline__ bool next(int i, Unit& u) const { const int L = i * G + c; if (L >= 256) return false; const int g = L & 3; u.pm = g * 64 + (L >> 2); u.pn = g; return true; }
    __device__ __forceinline__ void a_ready(const Unit&) const {}
    __device__ __forceinline__ void done(const Unit&) const {}
};
struct MoeOrder {
    const int* tileE; int ntiles, ncol, G, c;
    __device__ __forceinline__ bool next(int i, Unit& u) const { const int L = i * G + c; if (L >= ntiles * ncol) return false; const int rt = L / ncol, j = L - rt * ncol;
        u.pm = rt; u.pn = __builtin_amdgcn_readfirstlane(tileE[rt]) * ncol + j; return true; }
    __device__ __forceinline__ void a_ready(const Unit&) const {}
    __device__ __forceinline__ void done(const Unit&) const {}
};
template <class Epi, class Sched, bool ALIGN_EPI = false, bool SP2 = false>
__device__ __forceinline__ void gemm_phase(PG8_LAS unsigned char* lds, const Gemm g, const Sched& S, const Epi& E) {
    const int tid = threadIdx.x, wid = __builtin_amdgcn_readfirstlane(tid >> 6), lane = tid & 63, wr = wid >> 2, wc = wid & 3, fr = lane & 15, fq = lane >> 4;
    const int K = g.K, nt = K / BK;
    unsigned voffA[2], voffB[2];
#pragma unroll
    for (int i = 0; i < 2; ++i) { int R, C; stage_rc(tid * 16 + i * 8192, R, C); const int Rb = Epi::PERM ? ((R & ~31) + perm32(R & 31)) : R;
        voffA[i] = (unsigned)(R * K + C) * 2u; voffB[i] = (unsigned)(Rb * K + C) * 2u; }
    const size_t kstep = (size_t)(BK * 2);
    const size_t hstep = (size_t)HALF * K * 2;
    const size_t tstep = 2 * hstep;
    const unsigned ldsw = (unsigned)wid * 1024u;
    const int aoff = lds_byte(wr * 64 + fr, fq * 8), boff = lds_byte(wc * 32 + fr, fq * 8);
#define PG8_SA(b, h) (((b) * 2 + (h)) * HTB)
#define PG8_SB(b, h) ((4 + (b) * 2 + (h)) * HTB)
#define PG8_STAGE(bufoff, gbase, voff) do { _Pragma("unroll") for (int _i = 0; _i < 2; ++_i) \
        __builtin_amdgcn_global_load_lds((const unsigned*)((const char*)(gbase) + (voff)[_i]), (PG8_LAS unsigned*)(lds + (bufoff) + ldsw + _i * 8192), 16, 0, 0); } while (0)
#define PG8_LDA(dst, b, h) do { _Pragma("unroll") for (int m = 0; m < 4; ++m) _Pragma("unroll") for (int k = 0; k < 2; ++k) dst[m][k] = *(const PG8_LAS bf16x8*)(lds + PG8_SA(b, h) + aoff + m * 2048 + k * 1024); } while (0)
#define PG8_LDB(dst, b, h) do { _Pragma("unroll") for (int n = 0; n < 2; ++n) _Pragma("unroll") for (int k = 0; k < 2; ++k) dst[n][k] = *(const PG8_LAS bf16x8*)(lds + PG8_SB(b, h) + boff + n * 2048 + k * 1024); } while (0)
#define PG8_MMA(ai, bj, At, Bt) do { __builtin_amdgcn_s_setprio(1); _Pragma("unroll") for (int m = 0; m < 4; ++m) _Pragma("unroll") for (int n = 0; n < 2; ++n) _Pragma("unroll") for (int k = 0; k < 2; ++k) \
        acc[ai][bj][m][n] = __builtin_amdgcn_mfma_f32_16x16x32_bf16(Bt[n][k], At[m][k], acc[ai][bj][m][n], 0, 0, 0); __builtin_amdgcn_s_setprio(0); } while (0)
#define PG8_WAIT_V(n) asm volatile("s_waitcnt vmcnt(" #n ")" ::: "memory")
#define PG8_WAIT_L(n) asm volatile("s_waitcnt lgkmcnt(" #n ")" ::: "memory")
#define PG8_BAR __builtin_amdgcn_s_barrier()
#define PG8_SCHED __builtin_amdgcn_sched_barrier(0)
    Unit cur, nxt; int ui = 0;
    if (!S.next(0, cur)) return;
    f32x4 acc[2][2][4][2];
#pragma unroll
    for (int a = 0; a < 2; ++a)
#pragma unroll
        for (int b = 0; b < 2; ++b)
#pragma unroll
            for (int m = 0; m < 4; ++m)
#pragma unroll
                for (int n = 0; n < 2; ++n) acc[a][b][m][n] = (f32x4){0.f, 0.f, 0.f, 0.f};
    bf16x8 At[4][2], B0[2][2], B1[2][2];
    const char* cA = (const char*)g.A + (size_t)cur.pm * tstep; const char* cB = (const char*)g.Bt + (size_t)cur.pn * tstep;
    S.a_ready(cur);
    if constexpr (SP2) {
        PG8_STAGE(PG8_SB(0, 0), cB, voffB); PG8_STAGE(PG8_SB(0, 1), cB + hstep, voffB); PG8_STAGE(PG8_SA(0, 0), cA, voffA); PG8_STAGE(PG8_SA(0, 1), cA + hstep, voffA);
        if (wr == 1) PG8_BAR;
        PG8_WAIT_V(2); PG8_BAR;
        PG8_STAGE(PG8_SB(1, 0), cB + kstep, voffB); PG8_STAGE(PG8_SA(1, 0), cA + kstep, voffA); PG8_STAGE(PG8_SB(1, 1), cB + hstep + kstep, voffB);
        PG8_WAIT_V(6); PG8_BAR;
    } else {
        PG8_STAGE(PG8_SB(0, 0), cB, voffB); PG8_STAGE(PG8_SA(0, 0), cA, voffA); PG8_STAGE(PG8_SB(0, 1), cB + hstep, voffB); PG8_STAGE(PG8_SA(0, 1), cA + hstep, voffA);
        if (wr == 1) PG8_BAR;
        PG8_WAIT_V(4); PG8_BAR;
        PG8_STAGE(PG8_SB(1, 0), cB + kstep, voffB); PG8_STAGE(PG8_SA(1, 0), cA + kstep, voffA); PG8_STAGE(PG8_SB(1, 1), cB + hstep + kstep, voffB);
        PG8_WAIT_V(6); PG8_BAR;
    }
    for (;;) {
        const bool has_next = S.next(ui + 1, nxt);
        const char* nA = has_next ? (const char*)g.A + (size_t)nxt.pm * tstep : cA; const char* nB = has_next ? (const char*)g.Bt + (size_t)nxt.pn * tstep : cB;
        for (int t = 0; t < nt; t += 2) {
            const bool last = (t == nt - 2);
            const char* a1 = cA + (size_t)(t + 1) * kstep;
            const char* a2 = last ? nA : cA + (size_t)(t + 2) * kstep; const char* b2 = last ? nB : cB + (size_t)(t + 2) * kstep;
            const char* a3 = a2 + kstep; const char* b3 = b2 + kstep;
            if (last && has_next) S.a_ready(nxt);
            if constexpr (SP2) {
            PG8_LDB(B0, 0, 0); PG8_LDB(B1, 0, 1); PG8_SCHED; PG8_LDA(At, 0, 0); PG8_STAGE(PG8_SA(1, 1), a1 + hstep, voffA);
            PG8_WAIT_V(8); PG8_WAIT_L(0); PG8_BAR; PG8_MMA(0, 0, At, B0); PG8_MMA(0, 1, At, B1); PG8_BAR; PG8_SCHED;
            PG8_LDA(At, 0, 1); PG8_STAGE(PG8_SB(0, 0), b2, voffB); PG8_STAGE(PG8_SB(0, 1), b2 + hstep, voffB); PG8_STAGE(PG8_SA(0, 0), a2, voffA);
            PG8_WAIT_V(8); PG8_WAIT_L(0); PG8_BAR; PG8_MMA(1, 0, At, B0); PG8_MMA(1, 1, At, B1); PG8_BAR; PG8_SCHED;
            PG8_LDB(B0, 1, 0); PG8_LDB(B1, 1, 1); PG8_SCHED; PG8_LDA(At, 1, 0); PG8_STAGE(PG8_SA(0, 1), a2 + hstep, voffA);
            PG8_WAIT_V(8); PG8_WAIT_L(0); PG8_BAR; PG8_MMA(0, 0, At, B0); PG8_MMA(0, 1, At, B1); PG8_BAR; PG8_SCHED;
            PG8_LDA(At, 1, 1); PG8_STAGE(PG8_SB(1, 0), b3, voffB); PG8_STAGE(PG8_SB(1, 1), b3 + hstep, voffB); PG8_STAGE(PG8_SA(1, 0), a3, voffA);
            PG8_WAIT_V(8); PG8_WAIT_L(0); PG8_BAR; PG8_MMA(1, 0, At, B0); PG8_MMA(1, 1, At, B1); PG8_BAR; PG8_SCHED;
            } else {
            PG8_LDB(B0, 0, 0); PG8_SCHED; PG8_LDA(At, 0, 0); PG8_STAGE(PG8_SA(1, 1), a1 + hstep, voffA);
            PG8_WAIT_L(8); PG8_BAR; PG8_WAIT_L(0); PG8_MMA(0, 0, At, B0); PG8_BAR; PG8_SCHED;
            PG8_LDB(B1, 0, 1); PG8_STAGE(PG8_SB(0, 0), b2, voffB);
            PG8_BAR; PG8_WAIT_L(0); PG8_MMA(0, 1, At, B1); PG8_BAR;
            PG8_LDA(At, 0, 1); PG8_STAGE(PG8_SA(0, 0), a2, voffA);
            PG8_BAR; PG8_WAIT_L(0); PG8_MMA(1, 0, At, B0); PG8_BAR; PG8_SCHED;
            PG8_STAGE(PG8_SB(0, 1), b2 + hstep, voffB);
            PG8_WAIT_V(6); PG8_BAR; PG8_MMA(1, 1, At, B1); PG8_BAR;
            PG8_LDB(B0, 1, 0); PG8_SCHED; PG8_LDA(At, 1, 0); PG8_STAGE(PG8_SA(0, 1), a2 + hstep, voffA);
            PG8_WAIT_L(8); PG8_BAR; PG8_WAIT_L(0); PG8_MMA(0, 0, At, B0); PG8_BAR; PG8_SCHED;
            PG8_LDB(B1, 1, 1); PG8_STAGE(PG8_SB(1, 0), b3, voffB);
            PG8_BAR; PG8_WAIT_L(0); PG8_MMA(0, 1, At, B1); PG8_BAR;
            PG8_LDA(At, 1, 1); PG8_STAGE(PG8_SA(1, 0), a3, voffA);
            PG8_BAR; PG8_WAIT_L(0); PG8_MMA(1, 0, At, B0); PG8_BAR; PG8_SCHED;
            PG8_STAGE(PG8_SB(1, 1), b3 + hstep, voffB);
            PG8_WAIT_V(6); PG8_BAR; PG8_MMA(1, 1, At, B1); PG8_BAR;
            }
        }
        if constexpr (ALIGN_EPI) { if (wr == 0) PG8_BAR; }
        if constexpr (!Epi::AFTER_DRAIN) { E(acc, cur, wr, wc, fr, fq); S.done(cur); }
        if (!has_next) break;
#pragma unroll
        for (int a = 0; a < 2; ++a)
#pragma unroll
            for (int b = 0; b < 2; ++b)
#pragma unroll
                for (int m = 0; m < 4; ++m)
#pragma unroll
                    for (int n = 0; n < 2; ++n) acc[a][b][m][n] = (f32x4){0.f, 0.f, 0.f, 0.f};
        cur = nxt; cA = nA; cB = nB; ++ui;
        if constexpr (ALIGN_EPI) { if (wr == 1) PG8_BAR; }
    }
    PG8_WAIT_V(0);
    if constexpr (!ALIGN_EPI) { if (wr == 0) PG8_BAR; }
    PG8_BAR;
    if constexpr (Epi::AFTER_DRAIN) { E.fused(acc, cur, wr, wc, fr, fq, lds, wid, lane); S.done(cur); }
#undef PG8_SA
#undef PG8_SB
#undef PG8_STAGE
#undef PG8_LDA
#undef PG8_LDB
#undef PG8_MMA
#undef PG8_WAIT_V
#undef PG8_WAIT_L
#undef PG8_BAR
#undef PG8_SCHED
}
}
constexpr int NWAVES = 8;
constexpr int BATCH = 8, SEQ = 2048, DM = 1024, M = BATCH * SEQ, DFF = 3584, NEXP = 8, PLED = 256, NINP = 3328, NCHUNK = 32;
constexpr float LOG2E = 1.4426950408889634f;
constexpr size_t MiB = 1u << 20;
constexpr size_t WS_CTL = 0, CTL_ZERO_BYTES = 1 * MiB;
constexpr size_t WS_SMALL = 1 * MiB;
constexpr size_t WS_W_IN = 2 * MiB, WS_W_OUT = 15 * MiB, WS_W_GU = 19 * MiB, WS_W_DN = 47 * MiB, WS_W_PG = 61 * MiB, WS_W_PL = 69 * MiB, WS_W_POOL = 71 * MiB;
constexpr size_t WS_W_MGU = 72 * MiB, WS_W_MDN = 184 * MiB;
constexpr size_t WS_HB0 = 240 * MiB, WS_HB1 = 272 * MiB, WS_STATS = 304 * MiB, WS_PB = 306 * MiB, WS_E = 338 * MiB;
constexpr size_t WS_OVL = 370 * MiB;
constexpr size_t WS_QK = WS_OVL, WS_VB = WS_OVL + 32 * MiB, WS_OG = WS_OVL + 48 * MiB, WS_BQ = WS_OVL + 64 * MiB, WS_BQI = WS_OVL + 80 * MiB, WS_MISC = WS_OVL + 96 * MiB, WS_MIX = WS_OVL + 112 * MiB;
constexpr size_t WS_KB = WS_OVL + 144 * MiB, WS_KIB = WS_OVL + 146 * MiB, WS_VT = WS_OVL + 148 * MiB, WS_MASK = WS_OVL + 164 * MiB, WS_CHS = WS_OVL + 168 * MiB;
constexpr size_t WS_ISC = WS_OVL + 169 * MiB, WS_U = WS_OVL + 297 * MiB, WS_CB = WS_OVL + 369 * MiB, WS_ACT = WS_ISC;
constexpr size_t WS_POOLED = WS_OVL, WS_YG = WS_OVL + 32 * MiB, WS_ACTM = WS_OVL + 100 * MiB, WS_D0 = WS_OVL + 338 * MiB, WS_D1 = WS_OVL + 370 * MiB, WS_ROUTE = WS_OVL + 402 * MiB;
constexpr size_t WS_END = WS_OVL + 406 * MiB;
constexpr int MAXROWS = 34816;
constexpr size_t RT_TOKE = 0, RT_TOKG = 65536, RT_TOKR = 196608, RT_CNT = 262144, RT_ROWTS = 270336, RT_ROWG = 409600, RT_ROWR = 548864, RT_TILEE = 688128, RT_NT = 688128 + 1024;
constexpr int CW_BAR = 4096;
constexpr int RING_BYTES = 131072, LDSCTL_OFF = RING_BYTES, MISC_OFF = LDSCTL_OFF + 320, LDS_BYTES = 147456;

#define GAS __attribute__((address_space(1)))
#define LAS __attribute__((address_space(3)))
typedef unsigned short bf16;
typedef unsigned v4u __attribute__((ext_vector_type(4)));
typedef unsigned v2u __attribute__((ext_vector_type(2)));
typedef float f32x4 __attribute__((ext_vector_type(4)));
typedef float f32x2 __attribute__((ext_vector_type(2)));
typedef short bf16x8 __attribute__((ext_vector_type(8)));
#define LDS_WAIT() asm volatile("s_waitcnt lgkmcnt(0)" ::: "memory")
__device__ __forceinline__ unsigned f2bf(float f) { unsigned u = __builtin_bit_cast(unsigned, f); return (u + 0x7fffu + ((u >> 16) & 1u)) >> 16; }
__device__ __forceinline__ unsigned pk2(float lo, float hi) { return f2bf(lo) | (f2bf(hi) << 16); }
__device__ __forceinline__ float bflo(unsigned w) { return __uint_as_float(w << 16); }
__device__ __forceinline__ float bfhi(unsigned w) { return __uint_as_float(w & 0xffff0000u); }
__device__ __forceinline__ float bf2f(bf16 b) { return __uint_as_float(((unsigned)b) << 16); }
__device__ __forceinline__ float wave_sum(float v) {
#pragma unroll
    for (int o = 1; o < 64; o <<= 1) v += __shfl_xor(v, o);
    return v;
}
__device__ __forceinline__ float wave_max(float v) {
#pragma unroll
    for (int o = 1; o < 64; o <<= 1) v = fmaxf(v, __shfl_xor(v, o));
    return v;
}
__device__ __forceinline__ float fsig(float x) { return 1.0f / (1.0f + __expf(-x)); }
#define MFMA16(a, b, c) __builtin_amdgcn_mfma_f32_16x16x32_bf16((a), (b), (c), 0, 0, 0)
#define XB_TMO      128
#define XB_XCNT(j)  (256  + 64 * (j))
#define XB_XSUB(j)  (1280 + 64 * (j))
#define XB_XGEN(j)  (2304 + 64 * (j))
#define XB_TOP      3328
#define XB_TOPGEN   3392
#define XCD_BAR_WORDS 3456
#define XB_SPIN_CAP (1u << 18)

__device__ __forceinline__ unsigned xb_ld(unsigned* p)              { return __hip_atomic_load(p, __ATOMIC_RELAXED, __HIP_MEMORY_SCOPE_AGENT); }
__device__ __forceinline__ unsigned xb_add(unsigned* p, unsigned v) { return __hip_atomic_fetch_add(p, v, __ATOMIC_RELAXED, __HIP_MEMORY_SCOPE_AGENT); }
__device__ __forceinline__ unsigned xb_xcc_id() { return (unsigned)__builtin_amdgcn_s_getreg((3 << 11) | 20) & 0xFu; }
#define XB_SPIN(cond, bar) do { unsigned _sp = 0; while (cond) { __builtin_amdgcn_s_sleep(1); \
    if ((++_sp & 255u) == 0u) { if (xb_ld(&(bar)[XB_TMO])) break; if (_sp > XB_SPIN_CAP) { atomicAdd(&(bar)[XB_TMO], 1u); break; } } } } while (0)

struct XcdBarrier {
    unsigned* bar; unsigned x;
    volatile LAS unsigned* st;
};

__device__ __forceinline__ XcdBarrier xcd_barrier_post(unsigned* bar, volatile LAS unsigned* st) {
    XcdBarrier b; b.bar = bar; b.x = xb_xcc_id(); b.st = st;
    if (threadIdx.x == 0) (void)xb_add(&bar[XB_XCNT(b.x)], 1u);
    return b;
}
__device__ __forceinline__ void xcd_barrier_complete(unsigned* bar, unsigned x, unsigned& nloc, unsigned& nx) {
    const unsigned G = gridDim.x * gridDim.y * gridDim.z;
    unsigned sum, cnt, mine, sp = 0u;
    for (;;) {
        sum = 0u; cnt = 0u; mine = 0u;
#pragma unroll
        for (unsigned j = 0; j < 16; ++j) { const unsigned c = xb_ld(&bar[XB_XCNT(j)]); sum += c; cnt += (c > 0u) ? 1u : 0u; mine = (j == x) ? c : mine; }
        if (sum == G) break;
        __builtin_amdgcn_s_sleep(1);
        if ((++sp & 255u) == 0u) { if (xb_ld(&bar[XB_TMO])) break; if (sp > XB_SPIN_CAP) { atomicAdd(&bar[XB_TMO], 1u); break; } }
    }
    nloc = mine > 0u ? mine : 1u; nx = cnt > 0u ? cnt : 1u;
}

__device__ __forceinline__ void xcd_barrier(const XcdBarrier& b) {
    asm volatile("s_waitcnt vmcnt(0)" ::: "memory");
    __syncthreads();
    if (threadIdx.x == 0) {
        unsigned* bar = b.bar;
        __builtin_amdgcn_s_waitcnt(0);
        unsigned nloc = b.st[0], nx = b.st[1];
        if (nloc == 0u) { xcd_barrier_complete(bar, b.x, nloc, nx); b.st[0] = nloc; b.st[1] = nx; }
        const unsigned old = xb_add(&bar[XB_XSUB(b.x)], 1u);
        const unsigned gen = old / nloc;
        if (old + 1u == (gen + 1u) * nloc) {
            __builtin_amdgcn_fence(__ATOMIC_RELEASE, "agent");
            asm volatile("s_waitcnt vmcnt(0)" ::: "memory");
            const unsigned og = xb_add(&bar[XB_TOP], 1u);
            const unsigned tg = og / nx;
            if (og + 1u == (tg + 1u) * nx) xb_add(&bar[XB_TOPGEN], 1u);
            else XB_SPIN(xb_ld(&bar[XB_TOPGEN]) == tg, bar);
            __builtin_amdgcn_fence(__ATOMIC_ACQUIRE, "agent");
            xb_add(&bar[XB_XGEN(b.x)], 1u);
            asm volatile("s_waitcnt vmcnt(0)" ::: "memory");
        } else {
            XB_SPIN(xb_ld(&bar[XB_XGEN(b.x)]) == gen, bar);
            __builtin_amdgcn_fence(__ATOMIC_ACQUIRE, "agent");
            asm volatile("s_waitcnt vmcnt(0)" ::: "memory");
        }
    }
    __syncthreads();
}
struct Args { const float* in[28]; float* out; unsigned char* ws; int ph_lo, ph_hi; };
struct Frame {
    LAS unsigned char* lds; unsigned char* gl;
    volatile LAS unsigned* MISCW;
    int tid, lane, wave, G, bid, gw, NGW;
    float* out; unsigned char* ws;
};
#define INP(k) (args.in[k])
#define IN_X 0
#define IN_P 1
#define IN_NORM_MIX 2
#define IN_NORM_FFN 3
#define IN_W_IN 4
#define IN_B_GATE 5
#define IN_CONV 6
#define IN_NORM_H 7
#define IN_NORM_Q 8
#define IN_NORM_K 9
#define IN_NORM_KV 10
#define IN_W_UK 11
#define IN_W_UV 12
#define IN_W_OUT 13
#define IN_REL_BIAS 14
#define IN_W_POOL 15
#define IN_SCALE_POOL 16
#define IN_W_GATE_D 17
#define IN_W_UP_D 18
#define IN_W_DOWN_D 19
#define IN_W_ROUTER 20
#define IN_B_ROUTER 21
#define IN_W_GATE_M 22
#define IN_W_UP_M 23
#define IN_W_DOWN_M 24
#define IN_W_PLE 25
#define IN_W_PLE_GATE 26
#define IN_NORM_PLE 27

template <int MODE> __device__ __forceinline__ int dst_row(int n) {
    if (MODE == 0) return n;
    if (MODE == 1) return ((n >> 7) << 8) + (n & 127);
    if (MODE == 2) return ((n >> 7) << 8) + 128 + (n & 127);
    if (n < 2048) return n;
    if (n < 2052) return 3264 + (n - 2048);
    if (n < 2056) return 3268 + (n - 2052);
    if (n < 2568) return 2048 + (n - 2056);
    if (n < 2696) return 3072 + (n - 2568);
    if (n < 3208) return 2560 + (n - 2696);
    if (n < 3272) return 3200 + (n - 3208);
    return 3272 + (n - 3272);
}
template <int MODE> __device__ __forceinline__ void conv_mat(Frame& F, const float* W, int K, int N, bf16* WT, const float* gain, int wi, int nw) {
    LAS float* scr = (LAS float*)(F.lds + F.wave * 16384);
    const int nblk = (N + 31) >> 5, nitems = (K >> 6) * nblk, lane = F.lane;
    for (int it = wi; it < nitems; it += nw) {
        const int kb = it / nblk, nb = it - kb * nblk, k0 = 64 * kb, n0 = 32 * nb, nn = n0 + (lane & 31); const bool okn = nn < N;
#pragma unroll 8
        for (int i = 0; i < 32; ++i) { const int kk = 2 * i + (lane >> 5); float v = okn ? W[(size_t)(k0 + kk) * N + nn] : 0.f; if (gain) v *= gain[k0 + kk]; scr[kk * 33 + (lane & 31)] = v; }
        LDS_WAIT(); asm volatile("" ::: "memory");
        const int c = lane & 7;
#pragma unroll
        for (int j = 0; j < 4; ++j) { const int n = (lane >> 3) + 8 * j; const LAS float* s = scr + (8 * c) * 33 + n;
            v4u o; o.x = pk2(s[0 * 33], s[1 * 33]); o.y = pk2(s[2 * 33], s[3 * 33]); o.z = pk2(s[4 * 33], s[5 * 33]); o.w = pk2(s[6 * 33], s[7 * 33]);
            if (n0 + n < N) *(v4u*)(WT + (size_t)dst_row<MODE>(n0 + n) * K + k0 + 8 * c) = o; }
        LDS_WAIT(); asm volatile("" ::: "memory");
    }
}
__device__ __forceinline__ void conv_moe(Frame& F, const Args& args, int o) {
    bf16* mgu = (bf16*)(F.ws + WS_W_MGU); bf16* mdn = (bf16*)(F.ws + WS_W_MDN);
    const float* gain = INP(IN_NORM_FFN) + (2 * o + 1) * DM;
    for (int e = 0; e < NEXP; ++e) {
        const size_t wo = ((size_t)o * NEXP + e) * DM * DFF;
        conv_mat<1>(F, INP(IN_W_GATE_M) + wo, DM, DFF, mgu + (size_t)e * 7168 * 1024, gain, F.gw, F.NGW);
        conv_mat<2>(F, INP(IN_W_UP_M) + wo, DM, DFF, mgu + (size_t)e * 7168 * 1024, gain, F.gw, F.NGW);
        conv_mat<0>(F, INP(IN_W_DOWN_M) + wo, DFF, DM, mdn + (size_t)e * 1024 * 3584, nullptr, F.gw, F.NGW);
    }
}
__device__ __forceinline__ void p0_prologue(Frame& F, const Args& args) {
    unsigned char* ws = F.ws;
    for (int e = 0; e < 2; ++e) {
        conv_mat<3>(F, INP(IN_W_IN) + (size_t)e * DM * 3280, DM, 3280, (bf16*)(ws + WS_W_IN) + (size_t)e * NINP * DM, INP(IN_NORM_MIX) + (2 * e) * DM, F.gw, F.NGW);
        conv_mat<0>(F, INP(IN_W_OUT) + (size_t)e * DM * DM, DM, DM, (bf16*)(ws + WS_W_OUT) + (size_t)e * DM * DM, nullptr, F.gw, F.NGW);
        conv_mat<1>(F, INP(IN_W_GATE_D) + (size_t)e * DM * DFF, DM, DFF, (bf16*)(ws + WS_W_GU) + (size_t)e * 7168 * DM, INP(IN_NORM_FFN) + (2 * e) * DM, F.gw, F.NGW);
        conv_mat<2>(F, INP(IN_W_UP_D) + (size_t)e * DM * DFF, DM, DFF, (bf16*)(ws + WS_W_GU) + (size_t)e * 7168 * DM, INP(IN_NORM_FFN) + (2 * e) * DM, F.gw, F.NGW);
        conv_mat<0>(F, INP(IN_W_DOWN_D) + (size_t)e * DFF * DM, DFF, DM, (bf16*)(ws + WS_W_DN) + (size_t)e * DM * DFF, nullptr, F.gw, F.NGW);
        conv_mat<0>(F, INP(IN_W_UK) + (size_t)e * 128 * 64, 128, 64, (bf16*)(ws + WS_SMALL + 8192) + (size_t)e * 64 * 128, nullptr, F.gw, F.NGW);
        for (int h = 0; h < 8; ++h)
            conv_mat<0>(F, INP(IN_W_UV) + ((size_t)e * 8 + h) * 128 * 64, 128, 64, (bf16*)(ws + WS_SMALL + 65536) + ((size_t)e * 512 + h * 64) * 128, nullptr, F.gw, F.NGW);
        for (int g = 0; g < 4; ++g)
            conv_mat<0>(F, INP(IN_W_POOL) + ((size_t)e * 4 + g) * 256 * 256, 256, 256, (bf16*)(ws + WS_W_POOL) + ((size_t)e * 4 + g) * 256 * 256, nullptr, F.gw, F.NGW);
    }
    for (int i = 0; i < 4; ++i) {
        conv_mat<0>(F, INP(IN_W_PLE_GATE) + (size_t)i * DM * DM, DM, DM, (bf16*)(ws + WS_W_PG) + (size_t)i * DM * DM, INP(IN_NORM_PLE) + i * DM, F.gw, F.NGW);
        conv_mat<0>(F, INP(IN_W_PLE) + (size_t)i * PLED * DM, PLED, DM, (bf16*)(ws + WS_W_PL) + (size_t)i * DM * PLED, nullptr, F.gw, F.NGW);
    }
    conv_moe(F, args, 0);
    const int gt = F.bid * 512 + F.tid, NT = F.G * 512;
    for (int i = gt; i < 2 * 48 * DM / 8; i += NT) { const int e = i / (48 * DM / 8), r = i - e * (48 * DM / 8); *(v4u*)((bf16*)(ws + WS_W_IN) + ((size_t)e * NINP + 3280) * DM + (size_t)r * 8) = (v4u){0u, 0u, 0u, 0u}; }
    if (F.bid == 0) for (int t = F.tid; t < 1024; t += 512) { const int hh = t >> 7, d = t & 127; int bk = d;
        if (d >= 16) { bk = 16 + (d >= 19) + (d >= 21) + (d >= 24) + (d >= 27) + (d >= 31) + (d >= 35) + (d >= 40) + (d >= 46) + (d >= 52) + (d >= 59) + (d >= 67) + (d >= 77) + (d >= 87) + (d >= 99) + (d >= 113); }
        ((float*)(ws + WS_SMALL))[t] = INP(IN_REL_BIAS)[bk * 8 + hh] * LOG2E; }
    { const f32x4* src = (const f32x4*)INP(IN_P); v4u* dst = (v4u*)(ws + WS_PB);
      for (int i = gt; i < 4 * M * PLED / 8; i += NT) { const f32x4 a = src[2 * i], b = src[2 * i + 1]; v4u o; o.x = pk2(a.x, a.y); o.y = pk2(a.z, a.w); o.z = pk2(b.x, b.y); o.w = pk2(b.z, b.w); dst[i] = o; } }
    { const float* x = INP(IN_X); bf16* hb = (bf16*)(ws + WS_HB0); float* st = (float*)(ws + WS_STATS);
      for (int m = F.gw; m < M; m += F.NGW) { const f32x4* xr = (const f32x4*)(x + (size_t)m * DM) + F.lane; f32x4* orow = (f32x4*)(F.out + (size_t)m * DM) + F.lane; f32x4 v[4]; float s = 0.f;
#pragma unroll
          for (int j = 0; j < 4; ++j) { v[j] = xr[64 * j]; orow[64 * j] = v[j]; s += (v[j].x * v[j].x + v[j].y * v[j].y) + (v[j].z * v[j].z + v[j].w * v[j].w); }
          s = wave_sum(s);
          v2u* o8 = (v2u*)(hb + (size_t)m * DM) + F.lane;
#pragma unroll
          for (int j = 0; j < 4; ++j) { v2u w; w.x = pk2(v[j].x, v[j].y); w.y = pk2(v[j].z, v[j].w); o8[64 * j] = w; }
          if (F.lane < 16) st[(size_t)m * 16 + F.lane] = (F.lane == 0) ? s : 0.f; } }
}

struct EvenPtrs {
    const bf16 *QK, *VB, *OG, *BQ, *BQI; const float* MISC; bf16 *MIX, *KB, *KIB, *VT; unsigned* MASK; float* CHS; float* MST; float* ISC; float* U; bf16* CB;
    const float *bgate, *conv, *gh, *gq, *gk, *gkv; const bf16 *WukT, *WuvT; const float* bt;
};
__device__ __forceinline__ void conv8(const bf16* QK, const float* cw, int rowb, int tpos, int ch, float (&o)[8]) {
#pragma unroll
    for (int j = 0; j < 8; ++j) o[j] = 0.f;
#pragma unroll
    for (int tap = 0; tap < 4; ++tap) { const int tp = tpos - 3 + tap;
        if (tp >= 0) { const v4u w = *(const v4u*)(QK + (size_t)(rowb + tp) * 1024 + ch); const f32x4 c0 = *(const f32x4*)(cw + tap * 1024 + ch), c1 = *(const f32x4*)(cw + tap * 1024 + ch + 4);
            o[0] += bflo(w.x) * c0.x; o[1] += bfhi(w.x) * c0.y; o[2] += bflo(w.y) * c0.z; o[3] += bfhi(w.y) * c0.w;
            o[4] += bflo(w.z) * c1.x; o[5] += bfhi(w.z) * c1.y; o[6] += bflo(w.w) * c1.z; o[7] += bfhi(w.w) * c1.w; } }
#pragma unroll
    for (int j = 0; j < 8; ++j) o[j] = o[j] * fsig(o[j]);
}
__device__ __forceinline__ void chunk_gates(const EvenPtrs& P, int row, int hh, int lane, float& li, float& bc) {
    const float ai = P.MISC[(size_t)row * 256 + 192 + hh], af = P.MISC[(size_t)row * 256 + 196 + hh];
    li = ai + P.bgate[hh]; const float x = af + P.bgate[4 + hh]; const float lf = fminf(x, 0.f) - log1pf(__expf(-fabsf(x)));
    bc = lf;
#pragma unroll
    for (int o = 1; o < 64; o <<= 1) { const float t = __shfl_up(bc, o); if (lane >= o) bc += t; }
}
__device__ __forceinline__ void mlstm_a(Frame& F, const EvenPtrs& P) {
    bf16* KT = (bf16*)F.gl; bf16* VwT = (bf16*)(F.gl + 18432); float* wv = (float*)(F.gl + 18432 + 20736);
    const int tid = F.tid, lane = F.lane, w = F.wave, fr = lane & 15, fq = lane >> 4;
    for (int unit = F.bid; unit < BATCH * 4 * NCHUNK; unit += F.G) {
        const int b = unit >> 7, hh = (unit >> 5) & 3, c = unit & 31, rowb = b * SEQ, t0 = c * 64;
        if (w == 0) { float li, bc; chunk_gates(P, rowb + t0 + lane, hh, lane, li, bc); const float blast = __shfl(bc, 63), g = blast - bc + li, gmax = wave_max(g);
            wv[lane] = __expf(g - gmax); if (lane == 0) { P.CHS[unit * 2] = blast; P.CHS[unit * 2 + 1] = gmax; } }
        __syncthreads();
        { const int s = tid & 63, dg = tid >> 6; const float ws_ = wv[s];
#pragma unroll
          for (int half = 0; half < 2; ++half) { float o[8]; conv8(P.QK, P.conv, rowb, t0 + s, 512 + hh * 128 + dg * 16 + half * 8, o);
#pragma unroll
              for (int j = 0; j < 8; ++j) KT[(dg * 16 + half * 8 + j) * 72 + s] = (bf16)f2bf(o[j] * 0.08838834764831845f);
              const v4u vw = *(const v4u*)(P.VB + (size_t)(rowb + t0 + s) * 512 + hh * 128 + dg * 16 + half * 8); const int v0 = dg * 16 + half * 8;
              VwT[(v0 + 0) * 72 + s] = (bf16)f2bf(bflo(vw.x) * ws_); VwT[(v0 + 1) * 72 + s] = (bf16)f2bf(bfhi(vw.x) * ws_); VwT[(v0 + 2) * 72 + s] = (bf16)f2bf(bflo(vw.y) * ws_); VwT[(v0 + 3) * 72 + s] = (bf16)f2bf(bfhi(vw.y) * ws_);
              VwT[(v0 + 4) * 72 + s] = (bf16)f2bf(bflo(vw.z) * ws_); VwT[(v0 + 5) * 72 + s] = (bf16)f2bf(bfhi(vw.z) * ws_); VwT[(v0 + 6) * 72 + s] = (bf16)f2bf(bflo(vw.w) * ws_); VwT[(v0 + 7) * 72 + s] = (bf16)f2bf(bfhi(vw.w) * ws_); }
          if (tid < 64) VwT[128 * 72 + tid] = (bf16)f2bf(ws_);
          for (int i = tid; i < 15 * 64; i += 512) VwT[(129 + (i >> 6)) * 72 + (i & 63)] = 0; }
        __syncthreads();
        { bf16x8 bfr[2]; f32x4 acc[9];
#pragma unroll
          for (int ks = 0; ks < 2; ++ks) bfr[ks] = *(const bf16x8*)(KT + (16 * w + fr) * 72 + 8 * fq + 32 * ks);
#pragma unroll
          for (int rt = 0; rt < 9; ++rt) { acc[rt] = (f32x4){0.f, 0.f, 0.f, 0.f};
#pragma unroll
              for (int ks = 0; ks < 2; ++ks) { const bf16x8 a = *(const bf16x8*)(VwT + (16 * rt + fr) * 72 + 8 * fq + 32 * ks); acc[rt] = MFMA16(a, bfr[ks], acc[rt]); } }
          float* Uo = P.U + (size_t)unit * 144 * 128 + 16 * w + fr;
#pragma unroll
          for (int rt = 0; rt < 9; ++rt)
#pragma unroll
              for (int r = 0; r < 4; ++r) Uo[(size_t)(16 * rt + 4 * fq + r) * 128] = acc[rt][r]; }
        __syncthreads();
    }
}
__device__ __forceinline__ void mlstm_b(Frame& F, const EvenPtrs& P) {
    const int gt = F.bid * 512 + F.tid, NT = F.G * 512;
    for (int e = gt; e < BATCH * 4 * 144 * 128; e += NT) {
        const int d = e & 127, v = (e >> 7) % 144, bh = e / (144 * 128);
        float C = 0.f, m = 0.f;
        for (int c = 0; c < NCHUNK; ++c) { const int unit = bh * 32 + c; const size_t idx = ((size_t)unit * 144 + v) * 128 + d;
            P.CB[idx] = (bf16)f2bf(v < 129 ? C : 0.f);
            if (v == 0 && d == 0) P.MST[unit] = m;
            const float blast = P.CHS[unit * 2], gmax = P.CHS[unit * 2 + 1], mn = fmaxf(blast + m, gmax);
            const float u = (v < 129) ? P.U[idx] : 0.f;
            C = __expf(blast + m - mn) * C + __expf(gmax - mn) * u; m = mn; }
    }
}
__device__ __forceinline__ void mlstm_c(Frame& F, const EvenPtrs& P) {
    bf16* Qs = (bf16*)F.gl; bf16* Ks = (bf16*)(F.gl + 17408); bf16* VTa = (bf16*)(F.gl + 34816); bf16* Ps = (bf16*)(F.gl + 55552);
    float* av = (float*)(F.gl + 64768); float* pmv = av + 64; float* bcv = av + 128;
    const int tid = F.tid, lane = F.lane, w = F.wave, fr = lane & 15, fq = lane >> 4;
    for (int unit = F.bid; unit < BATCH * 4 * NCHUNK; unit += F.G) {
        const int b = unit >> 7, hh = (unit >> 5) & 3, c = unit & 31, rowb = b * SEQ, t0 = c * 64;
        const float mc = P.MST[unit];
        if (w == 0) { float li, bc; chunk_gates(P, rowb + t0 + lane, hh, lane, li, bc); const float a = li - bc; float p = a;
#pragma unroll
            for (int o = 1; o < 64; o <<= 1) { const float t = __shfl_up(p, o); if (lane >= o) p = fmaxf(p, t); }
            av[lane] = a; pmv[lane] = fmaxf(p, mc); bcv[lane] = bc; }
        { const int s = tid & 63, dg = tid >> 6;
#pragma unroll
          for (int half = 0; half < 2; ++half) { float o[8]; const int dd = dg * 16 + half * 8;
              conv8(P.QK, P.conv, rowb, t0 + s, hh * 128 + dd, o);
              { v4u q; q.x = pk2(o[0], o[1]); q.y = pk2(o[2], o[3]); q.z = pk2(o[4], o[5]); q.w = pk2(o[6], o[7]); *(v4u*)(Qs + s * 136 + dd) = q; }
              conv8(P.QK, P.conv, rowb, t0 + s, 512 + hh * 128 + dd, o);
              { const float sc = 0.08838834764831845f; v4u q; q.x = pk2(o[0] * sc, o[1] * sc); q.y = pk2(o[2] * sc, o[3] * sc); q.z = pk2(o[4] * sc, o[5] * sc); q.w = pk2(o[6] * sc, o[7] * sc); *(v4u*)(Ks + s * 136 + dd) = q; }
              const v4u vw = *(const v4u*)(P.VB + (size_t)(rowb + t0 + s) * 512 + hh * 128 + dd);
              VTa[(dd + 0) * 72 + s] = (bf16)(vw.x & 0xffffu); VTa[(dd + 1) * 72 + s] = (bf16)(vw.x >> 16); VTa[(dd + 2) * 72 + s] = (bf16)(vw.y & 0xffffu); VTa[(dd + 3) * 72 + s] = (bf16)(vw.y >> 16);
              VTa[(dd + 4) * 72 + s] = (bf16)(vw.z & 0xffffu); VTa[(dd + 5) * 72 + s] = (bf16)(vw.z >> 16); VTa[(dd + 6) * 72 + s] = (bf16)(vw.w & 0xffffu); VTa[(dd + 7) * 72 + s] = (bf16)(vw.w >> 16); }
          if (tid < 64) VTa[128 * 72 + tid] = (bf16)0x3f80u;
          for (int i = tid; i < 15 * 64; i += 512) VTa[(129 + (i >> 6)) * 72 + (i & 63)] = 0; }
        __syncthreads();
        { const int rt = w >> 1;
#pragma unroll
          for (int c2 = 0; c2 < 2; ++c2) { const int ct = 2 * (w & 1) + c2; f32x4 acc = (f32x4){0.f, 0.f, 0.f, 0.f};
#pragma unroll
              for (int ks = 0; ks < 4; ++ks) { const bf16x8 a = *(const bf16x8*)(Qs + (16 * rt + fr) * 136 + 8 * fq + 32 * ks), bb = *(const bf16x8*)(Ks + (16 * ct + fr) * 136 + 8 * fq + 32 * ks); acc = MFMA16(a, bb, acc); }
              const int s = 16 * ct + fr; const float as = av[s];
#pragma unroll
              for (int r = 0; r < 4; ++r) { const int t = 16 * rt + 4 * fq + r; const float p = (s <= t) ? acc[r] * __expf(as - pmv[t]) : 0.f; Ps[t * 72 + s] = (bf16)f2bf(p); } } }
        __syncthreads();
        if (w < 4) { const int rt = w; f32x4 ni[9], ne[9];
#pragma unroll
            for (int ct = 0; ct < 9; ++ct) { ni[ct] = (f32x4){0.f, 0.f, 0.f, 0.f}; ne[ct] = (f32x4){0.f, 0.f, 0.f, 0.f};
#pragma unroll
                for (int ks = 0; ks < 2; ++ks) { const bf16x8 a = *(const bf16x8*)(Ps + (16 * rt + fr) * 72 + 8 * fq + 32 * ks), bb = *(const bf16x8*)(VTa + (16 * ct + fr) * 72 + 8 * fq + 32 * ks); ni[ct] = MFMA16(a, bb, ni[ct]); }
#pragma unroll
                for (int ks = 0; ks < 4; ++ks) { const bf16x8 a = *(const bf16x8*)(Qs + (16 * rt + fr) * 136 + 8 * fq + 32 * ks), bb = *(const bf16x8*)(P.CB + ((size_t)unit * 144 + 16 * ct + fr) * 128 + 8 * fq + 32 * ks); ne[ct] = MFMA16(a, bb, ne[ct]); } }
            float rinv[4], ss[4];
#pragma unroll
            for (int r = 0; r < 4; ++r) { const int t = 16 * rt + 4 * fq + r; const float pm = pmv[t], wi = __expf(mc - pm);
#pragma unroll
                for (int ct = 0; ct < 9; ++ct) ni[ct][r] += wi * ne[ct][r];
                const float den = __shfl(ni[8][r], lane & 48), fl = __expf(-(bcv[t] + pm)); rinv[r] = 1.0f / fmaxf(fabsf(den), fl); float q = 0.f;
#pragma unroll
                for (int ct = 0; ct < 8; ++ct) { ni[ct][r] *= rinv[r]; q += ni[ct][r] * ni[ct][r]; }
                q += __shfl_xor(q, 1); q += __shfl_xor(q, 2); q += __shfl_xor(q, 4); q += __shfl_xor(q, 8); ss[r] = rsqrtf(q * (1.0f / 128.0f) + 1e-6f); }
#pragma unroll
            for (int ct = 0; ct < 8; ++ct) { const int col = hh * 128 + 16 * ct + fr; const float g = P.gh[col];
#pragma unroll
                for (int r = 0; r < 4; ++r) { const size_t row = (size_t)(rowb + t0 + 16 * rt + 4 * fq + r); P.MIX[row * 1024 + col] = (bf16)f2bf(ni[ct][r] * ss[r] * g * bf2f(P.OG[row * 512 + col])); } } }
        __syncthreads();
    }
}
__device__ __forceinline__ void dsa_prep(Frame& F, const EvenPtrs& P) {
    bf16* LAT = (bf16*)F.gl;
    const int lane = F.lane, w = F.wave, fr = lane & 15, fq = lane >> 4;
    for (int tile = F.bid; tile < M / 64; tile += F.G) {
        const int row0 = tile * 64, b = row0 >> 11, s0 = row0 & 2047;
        for (int i = 0; i < 8; ++i) { const int tok = w * 8 + i; const size_t row = (size_t)(row0 + tok);
            const f32x2 x = *(const f32x2*)(P.MISC + row * 256 + 2 * lane); const float ss = wave_sum(x.x * x.x + x.y * x.y), r = rsqrtf(ss * (1.0f / 128.0f) + 1e-6f);
            const f32x2 g = *(const f32x2*)(P.gkv + 2 * lane);
            *(unsigned*)(LAT + tok * 136 + 2 * lane) = pk2(x.x * r * g.x, x.y * r * g.y);
            P.KIB[row * 64 + lane] = (bf16)f2bf(P.MISC[row * 256 + 128 + lane]); }
        __syncthreads();
        if (w < 4) { const int rt = w; f32x4 acc[4]; float q[4] = {0.f, 0.f, 0.f, 0.f};
#pragma unroll
            for (int ct = 0; ct < 4; ++ct) { acc[ct] = (f32x4){0.f, 0.f, 0.f, 0.f};
#pragma unroll
                for (int ks = 0; ks < 4; ++ks) { const bf16x8 a = *(const bf16x8*)(LAT + (16 * rt + fr) * 136 + 8 * fq + 32 * ks), bb = *(const bf16x8*)(P.WukT + (16 * ct + fr) * 128 + 8 * fq + 32 * ks); acc[ct] = MFMA16(a, bb, acc[ct]); }
#pragma unroll
                for (int r = 0; r < 4; ++r) q[r] += acc[ct][r] * acc[ct][r]; }
#pragma unroll
            for (int r = 0; r < 4; ++r) { float s = q[r]; s += __shfl_xor(s, 1); s += __shfl_xor(s, 2); s += __shfl_xor(s, 4); s += __shfl_xor(s, 8); q[r] = rsqrtf(s * (1.0f / 64.0f) + 1e-6f); }
#pragma unroll
            for (int ct = 0; ct < 4; ++ct) { const float g = P.gk[16 * ct + fr];
#pragma unroll
                for (int r = 0; r < 4; ++r) P.KB[(size_t)(row0 + 16 * rt + 4 * fq + r) * 64 + 16 * ct + fr] = (bf16)f2bf(acc[ct][r] * q[r] * g); } }
        for (int i = 0; i < 4; ++i) { const int rt = w + 8 * i;
#pragma unroll
            for (int ct = 0; ct < 4; ++ct) { f32x4 acc = (f32x4){0.f, 0.f, 0.f, 0.f};
#pragma unroll
                for (int ks = 0; ks < 4; ++ks) { const bf16x8 a = *(const bf16x8*)(P.WuvT + (size_t)(16 * rt + fr) * 128 + 8 * fq + 32 * ks), bb = *(const bf16x8*)(LAT + (16 * ct + fr) * 136 + 8 * fq + 32 * ks); acc = MFMA16(a, bb, acc); }
#pragma unroll
                for (int r = 0; r < 4; ++r) { const int hd = 16 * rt + 4 * fq + r; P.VT[((size_t)(b * 8 + (hd >> 6)) * 64 + (hd & 63)) * 2048 + s0 + 16 * ct + fr] = (bf16)f2bf(acc[r]); } } }
        __syncthreads();
    }
}
__device__ __forceinline__ void dsa_index(Frame& F, const EvenPtrs& P) {
    const int lane = F.lane, fr = lane & 15, fq = lane >> 4;
    for (int uid = F.gw; uid < BATCH * 576; uid += F.NGW) {
        const int b = uid / 576, rr0 = uid - b * 576; int gq = 0;
        while (gq < 7 && 8 * (gq + 1) * (gq + 2) <= rr0) ++gq;
        const int rr = rr0 - 8 * gq * (gq + 1), qt = gq * 16 + rr / (gq + 1), kc = rr % (gq + 1);
        const int t0 = qt * 16; int nkt = ((t0 + 15 - kc * 256) >> 4) + 1; if (nkt > 16) nkt = 16;
        const size_t rowq = (size_t)b * SEQ + t0 + fr;
        bf16x8 qf[8][2]; float wq[8];
#pragma unroll
        for (int hh = 0; hh < 8; ++hh)
#pragma unroll
            for (int ks = 0; ks < 2; ++ks) qf[hh][ks] = *(const bf16x8*)(P.BQI + rowq * 512 + hh * 64 + 32 * ks + 8 * fq);
        { const f32x4 w0 = *(const f32x4*)(P.MISC + rowq * 256 + 200), w1 = *(const f32x4*)(P.MISC + rowq * 256 + 204); wq[0] = w0.x; wq[1] = w0.y; wq[2] = w0.z; wq[3] = w0.w; wq[4] = w1.x; wq[5] = w1.y; wq[6] = w1.z; wq[7] = w1.w; }
        for (int kt = 0; kt < nkt; ++kt) { const int sk = kc * 256 + kt * 16; const size_t rowk = (size_t)b * SEQ + sk + fr;
            const bf16x8 a0 = *(const bf16x8*)(P.KIB + rowk * 64 + 8 * fq), a1 = *(const bf16x8*)(P.KIB + rowk * 64 + 32 + 8 * fq);
            f32x4 sc = (f32x4){0.f, 0.f, 0.f, 0.f};
#pragma unroll
            for (int hh = 0; hh < 8; ++hh) { f32x4 acc = MFMA16(a0, qf[hh][0], ((f32x4){0.f, 0.f, 0.f, 0.f})); acc = MFMA16(a1, qf[hh][1], acc);
                sc.x += wq[hh] * fmaxf(acc.x, 0.f); sc.y += wq[hh] * fmaxf(acc.y, 0.f); sc.z += wq[hh] * fmaxf(acc.z, 0.f); sc.w += wq[hh] * fmaxf(acc.w, 0.f); }
            *(f32x4*)(P.ISC + rowq * 2048 + sk + 4 * fq) = sc; }
    }
}
__device__ __forceinline__ unsigned fkey(float f) { const unsigned u = __float_as_uint(f); return (u & 0x80000000u) ? ~u : (u | 0x80000000u); }
__device__ __forceinline__ void dsa_select(Frame& F, const EvenPtrs& P) {
    const int lane = F.lane;
    for (int k = 0; k < BATCH; ++k) {
        const int gwid = F.gw & 2047; if (F.gw >= 2048) break;
        const int t = (k & 1) ? 2047 - gwid : gwid; const size_t row = (size_t)k * SEQ + t; const int n = t + 1, nj = (n + 63) >> 6;
        unsigned long long* mo = (unsigned long long*)(P.MASK + row * 64);
        if (n <= 256) {
#pragma unroll
            for (int j = 0; j < 32; ++j) { const unsigned long long m = __ballot(64 * j + lane <= t); if (lane == 0) mo[j] = m; }
            continue; }
        unsigned key[32];
#pragma unroll
        for (int j = 0; j < 32; ++j) { key[j] = 0u; if (j < nj) { const int s = 64 * j + lane; const float x = P.ISC[row * 2048 + s]; key[j] = (s <= t) ? fkey(x) : 0u; } }
        unsigned T = 0u;
        for (int bit = 31; bit >= 0; --bit) { const unsigned cand = T | (1u << bit); int cnt = 0;
#pragma unroll
            for (int j = 0; j < 32; ++j) if (j < nj) cnt += __popcll(__ballot(key[j] >= cand));
            if (cnt >= 256) T = cand; }
        int cgt = 0;
#pragma unroll
        for (int j = 0; j < 32; ++j) if (j < nj) cgt += __popcll(__ballot(key[j] > T));
        const int need = 256 - cgt; int run = 0; const unsigned long long lt = (lane == 0) ? 0ull : (~0ull >> (64 - lane));
#pragma unroll
        for (int j = 0; j < 32; ++j) { unsigned long long m = 0ull;
            if (j < nj) { const unsigned long long eq = __ballot(key[j] == T); const int before = run + __popcll(eq & lt); const bool sel = (key[j] > T) || (key[j] == T && before < need); m = __ballot(sel); run += __popcll(eq); }
            if (lane == 0) mo[j] = m; }
    }
}
__device__ __forceinline__ void dsa_attn(Frame& F, const EvenPtrs& P) {
    const int lane = F.lane, fr = lane & 15, fq = lane >> 4;
    for (int uid = F.gw; uid < 8192; uid += F.NGW) {
        const int k4 = uid >> 11, gwid = uid & 2047, bh = gwid >> 5, qsel = gwid & 31, b = bh >> 3, hh = bh & 7;
        const int qt = (k4 == 0) ? qsel : (k4 == 1) ? 63 - qsel : (k4 == 2) ? 64 + qsel : 127 - qsel;
        const int t0 = qt * 16, t = t0 + fr; const size_t rowq = (size_t)b * SEQ + t;
        bf16x8 qf[2];
        { const v4u w0 = *(const v4u*)(P.BQ + rowq * 512 + hh * 64 + 8 * fq), w1 = *(const v4u*)(P.BQ + rowq * 512 + hh * 64 + 32 + 8 * fq);
          float x[16] = {bflo(w0.x), bfhi(w0.x), bflo(w0.y), bfhi(w0.y), bflo(w0.z), bfhi(w0.z), bflo(w0.w), bfhi(w0.w), bflo(w1.x), bfhi(w1.x), bflo(w1.y), bfhi(w1.y), bflo(w1.z), bfhi(w1.z), bflo(w1.w), bfhi(w1.w)};
          float ss = 0.f;
#pragma unroll
          for (int j = 0; j < 16; ++j) ss += x[j] * x[j];
          ss += __shfl_xor(ss, 16); ss += __shfl_xor(ss, 32);
          const float r = rsqrtf(ss * (1.0f / 64.0f) + 1e-6f) * (0.125f * LOG2E);
          const f32x4 g0 = *(const f32x4*)(P.gq + 8 * fq), g1 = *(const f32x4*)(P.gq + 8 * fq + 4), g2 = *(const f32x4*)(P.gq + 32 + 8 * fq), g3 = *(const f32x4*)(P.gq + 32 + 8 * fq + 4);
          v4u q0, q1; q0.x = pk2(x[0] * r * g0.x, x[1] * r * g0.y); q0.y = pk2(x[2] * r * g0.z, x[3] * r * g0.w); q0.z = pk2(x[4] * r * g1.x, x[5] * r * g1.y); q0.w = pk2(x[6] * r * g1.z, x[7] * r * g1.w);
          q1.x = pk2(x[8] * r * g2.x, x[9] * r * g2.y); q1.y = pk2(x[10] * r * g2.z, x[11] * r * g2.w); q1.z = pk2(x[12] * r * g3.x, x[13] * r * g3.y); q1.w = pk2(x[14] * r * g3.z, x[15] * r * g3.w);
          qf[0] = __builtin_bit_cast(bf16x8, q0); qf[1] = __builtin_bit_cast(bf16x8, q1); }
        f32x4 o[4]; o[0] = o[1] = o[2] = o[3] = (f32x4){0.f, 0.f, 0.f, 0.f};
        float mrun = -INFINITY, lrun = 0.f;
        const unsigned* mrow = P.MASK + rowq * 64; const float* btab = P.bt + hh * 128;
        const bf16* vbase = P.VT + ((size_t)(b * 8 + hh) * 64) * 2048;
        const int ntile = ((t0 + 15) >> 5) + 1;
        for (int kt = 0; kt < ntile; ++kt) { const int s0 = kt * 32; const unsigned mw = mrow[kt];
            float p[8];
#pragma unroll
            for (int st = 0; st < 2; ++st) { const size_t rowk = (size_t)b * SEQ + s0 + 16 * st + fr;
                const bf16x8 a0 = *(const bf16x8*)(P.KB + rowk * 64 + 8 * fq), a1 = *(const bf16x8*)(P.KB + rowk * 64 + 32 + 8 * fq);
                f32x4 acc = MFMA16(a0, qf[0], ((f32x4){0.f, 0.f, 0.f, 0.f})); acc = MFMA16(a1, qf[1], acc);
#pragma unroll
                for (int r = 0; r < 4; ++r) { const int kl = 16 * st + 4 * fq + r; int dist = t - (s0 + kl); dist = dist < 0 ? 0 : (dist > 127 ? 127 : dist);
                    p[4 * st + r] = ((mw >> kl) & 1u) ? acc[r] + btab[dist] : -INFINITY; } }
            float mx = fmaxf(fmaxf(fmaxf(p[0], p[1]), fmaxf(p[2], p[3])), fmaxf(fmaxf(p[4], p[5]), fmaxf(p[6], p[7])));
            mx = fmaxf(mx, __shfl_xor(mx, 16)); mx = fmaxf(mx, __shfl_xor(mx, 32));
            const float mnew = fmaxf(mrun, mx); float alpha = 1.f, psum = 0.f;
            if (mnew == -INFINITY) {
#pragma unroll
                for (int j = 0; j < 8; ++j) p[j] = 0.f;
            } else { alpha = __builtin_amdgcn_exp2f(mrun - mnew);
#pragma unroll
                for (int j = 0; j < 8; ++j) { p[j] = __builtin_amdgcn_exp2f(p[j] - mnew); psum += p[j]; } }
            mrun = mnew; lrun = lrun * alpha + psum;
            v4u pw; pw.x = pk2(p[0], p[1]); pw.y = pk2(p[2], p[3]); pw.z = pk2(p[4], p[5]); pw.w = pk2(p[6], p[7]); const bf16x8 pf = __builtin_bit_cast(bf16x8, pw);
#pragma unroll
            for (int dt = 0; dt < 4; ++dt) { const bf16* vp = vbase + (size_t)(16 * dt + fr) * 2048 + s0 + 4 * fq; const v2u lo = *(const v2u*)vp, hi = *(const v2u*)(vp + 16);
                v4u vv; vv.x = lo.x; vv.y = lo.y; vv.z = hi.x; vv.w = hi.y; o[dt] = o[dt] * alpha; o[dt] = MFMA16(__builtin_bit_cast(bf16x8, vv), pf, o[dt]); } }
        lrun += __shfl_xor(lrun, 16); lrun += __shfl_xor(lrun, 32); const float linv = 1.0f / lrun;
#pragma unroll
        for (int dt = 0; dt < 4; ++dt) { v2u w; w.x = pk2(o[dt].x * linv, o[dt].y * linv); w.y = pk2(o[dt].z * linv, o[dt].w * linv); *(v2u*)(P.MIX + rowq * 1024 + 512 + hh * 64 + 16 * dt + 4 * fq) = w; }
    }
}
__device__ __forceinline__ void pool_prep(Frame& F, const float* stats, const float* gmix, bf16* POOLED) {
    float* rl = (float*)F.gl;
    for (int tile = F.bid; tile < M / 64; tile += F.G) {
        const int row0 = tile * 64, tpos0 = row0 & 2047;
        if (F.tid < 79) { const int row = row0 - 15 + F.tid; float r = 0.f;
            if (tpos0 - 15 + F.tid >= 0) { const f32x4* p = (const f32x4*)(stats + (size_t)row * 16); const f32x4 a = p[0], b = p[1], c = p[2], d = p[3];
                const float s = (((a.x + a.y) + (a.z + a.w)) + ((b.x + b.y) + (b.z + b.w))) + (((c.x + c.y) + (c.z + c.w)) + ((d.x + d.y) + (d.z + d.w))); r = rsqrtf(s * (1.0f / 1024.0f) + 1e-6f); }
            rl[F.tid] = r; }
        __syncthreads();
        for (int it = F.tid; it < 64 * 128; it += 512) { const int tok = it >> 7, c0 = (it & 127) * 8, g = c0 >> 8, win = 2 << g, tpos = tpos0 + tok; const int n = (tpos + 1 < win) ? tpos + 1 : win;
            float acc[8] = {0.f, 0.f, 0.f, 0.f, 0.f, 0.f, 0.f, 0.f}, y0[8];
            for (int j = 0; j < n; ++j) { const float* hp = F.out + (size_t)(row0 + tok - j) * DM + c0; const f32x4 a = *(const f32x4*)hp, b = *(const f32x4*)(hp + 4); const float r = rl[15 + tok - j];
                const float v[8] = {a.x * r, a.y * r, a.z * r, a.w * r, b.x * r, b.y * r, b.z * r, b.w * r};
#pragma unroll
                for (int q = 0; q < 8; ++q) { acc[q] += v[q]; if (j == 0) y0[q] = v[q]; } }
            const float inv = 1.0f / (float)n; const f32x4 g0 = *(const f32x4*)(gmix + c0), g1 = *(const f32x4*)(gmix + c0 + 4);
            v4u o; o.x = pk2((acc[0] * inv - y0[0]) * g0.x, (acc[1] * inv - y0[1]) * g0.y); o.y = pk2((acc[2] * inv - y0[2]) * g0.z, (acc[3] * inv - y0[3]) * g0.w);
            o.z = pk2((acc[4] * inv - y0[4]) * g1.x, (acc[5] * inv - y0[5]) * g1.y); o.w = pk2((acc[6] * inv - y0[6]) * g1.z, (acc[7] * inv - y0[7]) * g1.w);
            *(v4u*)(POOLED + ((size_t)g * M + row0 + tok) * 256 + (c0 & 255)) = o; }
        __syncthreads();
    }
}
struct RoutePtrs { int* TOKE; float* TOKG; float* TOKR; int* CNT; int* ROWTS; float* ROWG; float* ROWR; int* TILEE; int* NT; };
__device__ __forceinline__ RoutePtrs route_ptrs(unsigned char* ws) { unsigned char* r = ws + WS_ROUTE; RoutePtrs p;
    p.TOKE = (int*)(r + RT_TOKE); p.TOKG = (float*)(r + RT_TOKG); p.TOKR = (float*)(r + RT_TOKR); p.CNT = (int*)(r + RT_CNT); p.ROWTS = (int*)(r + RT_ROWTS); p.ROWG = (float*)(r + RT_ROWG); p.ROWR = (float*)(r + RT_ROWR);
    p.TILEE = (int*)(r + RT_TILEE); p.NT = (int*)(r + RT_NT); return p; }
__device__ __forceinline__ void moe_route(Frame& F, const RoutePtrs& R, const float* gffn, const float* wr, const float* br) {
    int* cnt = (int*)F.gl;
    for (int tile = F.bid; tile < M / 64; tile += F.G) {
        if (F.tid < 8) cnt[F.tid] = 0;
        __syncthreads();
        for (int i = 0; i < 8; ++i) { const int row = tile * 64 + F.wave * 8 + i; const f32x4* hr = (const f32x4*)(F.out + (size_t)row * DM) + F.lane; f32x4 v[4]; float ss = 0.f;
#pragma unroll
            for (int j = 0; j < 4; ++j) { v[j] = hr[64 * j]; ss += (v[j].x * v[j].x + v[j].y * v[j].y) + (v[j].z * v[j].z + v[j].w * v[j].w); }
            ss = wave_sum(ss); const float r = rsqrtf(ss * (1.0f / 1024.0f) + 1e-6f);
            float lg[8] = {0.f, 0.f, 0.f, 0.f, 0.f, 0.f, 0.f, 0.f};
#pragma unroll
            for (int j = 0; j < 4; ++j) { const int c0 = 4 * F.lane + 256 * j; const f32x4 g = *(const f32x4*)(gffn + c0); const float y[4] = {v[j].x * r * g.x, v[j].y * r * g.y, v[j].z * r * g.z, v[j].w * r * g.w};
#pragma unroll
                for (int q = 0; q < 4; ++q) { const f32x4 w0 = *(const f32x4*)(wr + (size_t)(c0 + q) * 8), w1 = *(const f32x4*)(wr + (size_t)(c0 + q) * 8 + 4);
                    lg[0] += y[q] * w0.x; lg[1] += y[q] * w0.y; lg[2] += y[q] * w0.z; lg[3] += y[q] * w0.w; lg[4] += y[q] * w1.x; lg[5] += y[q] * w1.y; lg[6] += y[q] * w1.z; lg[7] += y[q] * w1.w; } }
#pragma unroll
            for (int e = 0; e < 8; ++e) lg[e] = wave_sum(lg[e]) + br[e];
            int e1 = 0; float v1 = lg[0];
#pragma unroll
            for (int e = 1; e < 8; ++e) if (lg[e] > v1) { v1 = lg[e]; e1 = e; }
            int e2 = -1; float v2 = -INFINITY;
#pragma unroll
            for (int e = 0; e < 8; ++e) if (e != e1 && lg[e] > v2) { v2 = lg[e]; e2 = e; }
            const float ex = __expf(v2 - v1), g1 = 1.0f / (1.0f + ex), g2 = ex * g1;
            if (F.lane == 0) { R.TOKE[row] = e1 | (e2 << 8); R.TOKG[row * 2] = g1; R.TOKG[row * 2 + 1] = g2; R.TOKR[row] = r; atomicAdd(&cnt[e1], 1); atomicAdd(&cnt[e2], 1); } }
        __syncthreads();
        if (F.tid < 8) R.CNT[tile * 8 + F.tid] = cnt[F.tid];
        __syncthreads();
    }
}
__device__ __forceinline__ void moe_scatter(Frame& F, const RoutePtrs& R, const bf16* HB, bf16* YG) {
    int* sm = (int*)F.gl;
    for (int tile = F.bid; tile < M / 64; tile += F.G) {
        if (F.tid < 16) sm[F.tid] = 0;
        __syncthreads();
        for (int i = F.tid; i < (M / 64) * 8; i += 512) { const int v = R.CNT[i]; atomicAdd(&sm[i & 7], v); if ((i >> 3) < tile) atomicAdd(&sm[8 + (i & 7)], v); }
        __syncthreads();
        if (F.tid == 0) { int base = 0; for (int e = 0; e < 8; ++e) { sm[16 + e] = base; base += (sm[e] + 255) & ~255; } sm[24] = base >> 8; }
        __syncthreads();
        if (F.wave == 0) { const int row = tile * 64 + F.lane, te = R.TOKE[row], e1 = te & 255, e2 = te >> 8; int p1 = 0, p2 = 0; const unsigned long long lt = (F.lane == 0) ? 0ull : (~0ull >> (64 - F.lane));
#pragma unroll
            for (int e = 0; e < 8; ++e) { const unsigned long long m1 = __ballot(e1 == e), m2 = __ballot(e2 == e); const int rk = __popcll(m1 & lt) + __popcll(m2 & lt), bs = sm[16 + e] + sm[8 + e];
                if (e1 == e) p1 = bs + rk; if (e2 == e) p2 = bs + rk; }
            const float r = R.TOKR[row]; R.ROWTS[p1] = row * 2; R.ROWTS[p2] = row * 2 + 1; R.ROWG[p1] = R.TOKG[row * 2]; R.ROWG[p2] = R.TOKG[row * 2 + 1]; R.ROWR[p1] = r; R.ROWR[p2] = r;
            sm[32 + 2 * F.lane] = p1; sm[33 + 2 * F.lane] = p2; }
        __syncthreads();
        for (int i = 0; i < 16; ++i) { const int cp = F.wave * 16 + i, tok = cp >> 1, pos = sm[32 + cp]; const v4u* src = (const v4u*)(HB + (size_t)(tile * 64 + tok) * DM); v4u* dst = (v4u*)(YG + (size_t)pos * DM);
            dst[F.lane] = src[F.lane]; dst[64 + F.lane] = src[64 + F.lane]; }
        if (tile == 0) {
            for (int e = 0; e < 8; ++e) { const int lo = sm[16 + e] + sm[e], hi = sm[16 + e] + ((sm[e] + 255) & ~255);
                for (int p = lo + F.tid; p < hi; p += 512) { R.ROWTS[p] = -1; R.ROWG[p] = 0.f; R.ROWR[p] = 0.f; }
                for (int t2 = (sm[16 + e] >> 8) + F.tid; t2 < (hi >> 8); t2 += 512) R.TILEE[t2] = e; }
            if (F.tid == 0) R.NT[0] = sm[24]; }
        __syncthreads();
    }
}
__device__ __forceinline__ void moe_combine(Frame& F, const bf16* D0, const bf16* D1, bf16* HB, float* stats) {
    for (int m = F.gw; m < M; m += F.NGW) { f32x4* hr = (f32x4*)(F.out + (size_t)m * DM) + F.lane; const v2u* a = (const v2u*)(D0 + (size_t)m * DM) + F.lane; const v2u* b = (const v2u*)(D1 + (size_t)m * DM) + F.lane;
        v2u* o8 = (v2u*)(HB + (size_t)m * DM) + F.lane; float s = 0.f;
#pragma unroll
        for (int j = 0; j < 4; ++j) { f32x4 v = hr[64 * j]; const v2u x = a[64 * j], y = b[64 * j];
            v.x += bflo(x.x) + bflo(y.x); v.y += bfhi(x.x) + bfhi(y.x); v.z += bflo(x.y) + bflo(y.y); v.w += bfhi(x.y) + bfhi(y.y);
            hr[64 * j] = v; s += (v.x * v.x + v.y * v.y) + (v.z * v.z + v.w * v.w); v2u w; w.x = pk2(v.x, v.y); w.y = pk2(v.z, v.w); o8[64 * j] = w; }
        s = wave_sum(s);
        if (F.lane < 16) stats[(size_t)m * 16 + F.lane] = (F.lane == 0) ? s : 0.f; }
}
constexpr int N_PHASES = 35;
static_assert(WS_VB == WS_QK + 32 * MiB && WS_OG == WS_VB + 16 * MiB && WS_BQ == WS_OG + 16 * MiB && WS_BQI == WS_BQ + 16 * MiB, "EpiIn address arithmetic");
#ifndef PHASE_SEL
#define PHASE_SEL -1
#endif
#define PHEN(r) (PHASE_SEL < 0 || PHASE_SEL == (r))
#define IN(k) (lo <= (k) && (k) < hi)
#define SEAM(k) do { if ((k) + 1 < hi) { XcdBarrier b2_ = bar; asm volatile("" : "+s"(b2_.bar)); xcd_barrier(b2_); } } while (0)
#define HBSEL(i) ((bf16*)(ws + ((i) ? WS_HB1 : WS_HB0)))
#define STSEL(i) ((float*)(ws + WS_STATS + ((i) ? MiB : (size_t)0)))
template <int lp> __device__ __forceinline__ void layer_pair(Frame& F, const Args& args, const XcdBarrier& bar, const int lo, const int hi, LAS unsigned char* ring, const int K256) {
    unsigned char* ws = F.ws; bf16* Eb = (bf16*)(ws + WS_E);
        const int pb = 1 + 17 * lp;
        int hbi = 0, si = 0;
        if (PHEN(0) && IN(pb + 0)) { if (lp == 1) conv_moe(F, args, 1); SEAM(pb + 0); }
        {
            const int e = lp, li = 2 * lp;
            EvenPtrs P;
            P.QK = (const bf16*)(ws + WS_QK); P.VB = (const bf16*)(ws + WS_VB); P.OG = (const bf16*)(ws + WS_OG); P.BQ = (const bf16*)(ws + WS_BQ); P.BQI = (const bf16*)(ws + WS_BQI); P.MISC = (const float*)(ws + WS_MISC);
            P.MIX = (bf16*)(ws + WS_MIX); P.KB = (bf16*)(ws + WS_KB); P.KIB = (bf16*)(ws + WS_KIB); P.VT = (bf16*)(ws + WS_VT); P.MASK = (unsigned*)(ws + WS_MASK); P.CHS = (float*)(ws + WS_CHS); P.MST = (float*)(ws + WS_CHS + 65536);
            P.ISC = (float*)(ws + WS_ISC); P.U = (float*)(ws + WS_U); P.CB = (bf16*)(ws + WS_CB);
            P.bgate = INP(IN_B_GATE) + e * 8; P.conv = INP(IN_CONV) + e * 4 * 1024; P.gh = INP(IN_NORM_H) + e * 512; P.gq = INP(IN_NORM_Q) + e * 64; P.gk = INP(IN_NORM_K) + e * 64; P.gkv = INP(IN_NORM_KV) + e * 128;
            P.WukT = (const bf16*)(ws + WS_SMALL + 8192) + (size_t)e * 64 * 128; P.WuvT = (const bf16*)(ws + WS_SMALL + 65536) + (size_t)e * 512 * 128; P.bt = (const float*)(ws + WS_SMALL);
            if (PHEN(1) && IN(pb + 1)) {
                pg8::Gemm g{HBSEL(hbi), (const bf16*)(ws + WS_W_IN) + (size_t)e * NINP * DM, M, NINP, DM}; pg8::StaticOrder S; S.init(M, NINP, F.G, F.bid);
                pg8::EpiIn E{STSEL(si), (bf16*)(ws + WS_QK), (float*)(ws + WS_MISC)};
                pg8::gemm_phase<pg8::EpiIn, pg8::StaticOrder, true, true>(ring, g, S, E);
                SEAM(pb + 1); }
            if (PHEN(2) && IN(pb + 2)) { mlstm_a(F, P); dsa_prep(F, P); dsa_index(F, P); SEAM(pb + 2); }
            if (PHEN(3) && IN(pb + 3)) { mlstm_b(F, P); dsa_select(F, P); SEAM(pb + 3); }
            if (PHEN(4) && IN(pb + 4)) { mlstm_c(F, P); dsa_attn(F, P); SEAM(pb + 4); }
            if (PHEN(5) && IN(pb + 5)) {
                { pg8::Gemm g{(const bf16*)(ws + WS_MIX), (const bf16*)(ws + WS_W_OUT) + (size_t)e * DM * DM, M, DM, DM}; pg8::StaticOrder S; S.init(M, DM, F.G, F.bid);
                  pg8::EpiResid<0> E{F.out, HBSEL(hbi), STSEL(si ^ 1), nullptr, nullptr, nullptr};
                  pg8::gemm_phase<pg8::EpiResid<0>, pg8::StaticOrder, true, true>(ring, g, S, E); }
                { pg8::Gemm g{(const bf16*)(ws + WS_PB) + (size_t)li * M * PLED, (const bf16*)(ws + WS_W_PL) + (size_t)li * DM * PLED, M, DM, K256}; pg8::StaticOrder S; S.init(M, DM, F.G, F.bid);
                  pg8::EpiStore E{Eb, DM};
                  pg8::gemm_phase<pg8::EpiStore, pg8::StaticOrder, true, true>(ring, g, S, E); }
                SEAM(pb + 5); }
            si ^= 1;
            if (PHEN(6) && IN(pb + 6)) {
                pg8::Gemm g{HBSEL(hbi), (const bf16*)(ws + WS_W_GU) + (size_t)e * 7168 * DM, M, 7168, DM}; pg8::StaticOrder S; S.init(M, 7168, F.G, F.bid);
                pg8::EpiGLU<false> E{STSEL(si), nullptr, (bf16*)(ws + WS_ACT)};
                pg8::gemm_phase<pg8::EpiGLU<false>, pg8::StaticOrder, true, true>(ring, g, S, E);
                SEAM(pb + 6); }
            if (PHEN(7) && IN(pb + 7)) {
                pg8::Gemm g{(const bf16*)(ws + WS_ACT), (const bf16*)(ws + WS_W_DN) + (size_t)e * DM * DFF, M, DM, DFF}; pg8::StaticOrder S; S.init(M, DM, F.G, F.bid);
                pg8::EpiResid<0> E{F.out, HBSEL(hbi), STSEL(si ^ 1), nullptr, nullptr, nullptr};
                pg8::gemm_phase<pg8::EpiResid<0>, pg8::StaticOrder, true, true>(ring, g, S, E);
                SEAM(pb + 7); }
            si ^= 1;
            if (PHEN(8) && IN(pb + 8)) {
                pg8::Gemm g{HBSEL(hbi), (const bf16*)(ws + WS_W_PG) + (size_t)li * DM * DM, M, DM, DM}; pg8::StaticOrder S; S.init(M, DM, F.G, F.bid);
                pg8::EpiResid<2> E{F.out, HBSEL(hbi ^ 1), STSEL(si ^ 1), STSEL(si), Eb, nullptr};
                pg8::gemm_phase<pg8::EpiResid<2>, pg8::StaticOrder, true, true>(ring, g, S, E);
                SEAM(pb + 8); }
            si ^= 1; hbi ^= 1;
        }
        {
            const int o = lp, li = 2 * lp + 1;
            const RoutePtrs R = route_ptrs(ws);
            if (PHEN(9) && IN(pb + 9)) {
                pool_prep(F, STSEL(si), INP(IN_NORM_MIX) + li * DM, (bf16*)(ws + WS_POOLED));
                { pg8::Gemm g{(const bf16*)(ws + WS_PB) + (size_t)li * M * PLED, (const bf16*)(ws + WS_W_PL) + (size_t)li * DM * PLED, M, DM, K256}; pg8::StaticOrder S; S.init(M, DM, F.G, F.bid);
                  pg8::EpiStore E{Eb, DM};
                  pg8::gemm_phase<pg8::EpiStore, pg8::StaticOrder, true, true>(ring, g, S, E); }
                SEAM(pb + 9); }
            if (PHEN(10) && IN(pb + 10)) {
                pg8::Gemm g{(const bf16*)(ws + WS_POOLED), (const bf16*)(ws + WS_W_POOL) + (size_t)o * 4 * 256 * 256, 4 * M, 1024, K256}; pg8::PoolOrder S{F.G, F.bid};
                pg8::EpiResid<1> E{F.out, HBSEL(hbi), STSEL(si ^ 1), nullptr, nullptr, INP(IN_SCALE_POOL) + o * DM};
                pg8::gemm_phase<pg8::EpiResid<1>, pg8::PoolOrder, true, true>(ring, g, S, E);
                SEAM(pb + 10); }
            si ^= 1;
            if (PHEN(11) && IN(pb + 11)) { moe_route(F, R, INP(IN_NORM_FFN) + li * DM, INP(IN_W_ROUTER) + (size_t)o * DM * 8, INP(IN_B_ROUTER) + o * 8); SEAM(pb + 11); }
            if (PHEN(12) && IN(pb + 12)) { moe_scatter(F, R, HBSEL(hbi), (bf16*)(ws + WS_YG)); SEAM(pb + 12); }
            if (PHEN(13) && IN(pb + 13)) {
                const int nt = __builtin_amdgcn_readfirstlane(R.NT[0]);
                pg8::Gemm g{(const bf16*)(ws + WS_YG), (const bf16*)(ws + WS_W_MGU), MAXROWS, 8 * 7168, DM}; pg8::MoeOrder S{R.TILEE, nt, 28, F.G, F.bid};
                pg8::EpiGLU<true> E{nullptr, R.ROWR, (bf16*)(ws + WS_ACTM)};
                pg8::gemm_phase<pg8::EpiGLU<true>, pg8::MoeOrder, true, true>(ring, g, S, E);
                SEAM(pb + 13); }
            if (PHEN(14) && IN(pb + 14)) {
                const int nt = __builtin_amdgcn_readfirstlane(R.NT[0]);
                pg8::Gemm g{(const bf16*)(ws + WS_ACTM), (const bf16*)(ws + WS_W_MDN), MAXROWS, 8 * 1024, DFF}; pg8::MoeOrder S{R.TILEE, nt, 4, F.G, F.bid};
                pg8::EpiScatter E{R.ROWTS, R.ROWG, (bf16*)(ws + WS_D0), (bf16*)(ws + WS_D1)};
                pg8::gemm_phase<pg8::EpiScatter, pg8::MoeOrder, true, true>(ring, g, S, E);
                SEAM(pb + 14); }
            if (PHEN(15) && IN(pb + 15)) { moe_combine(F, (const bf16*)(ws + WS_D0), (const bf16*)(ws + WS_D1), HBSEL(hbi), STSEL(si ^ 1)); SEAM(pb + 15); }
            si ^= 1;
            if (PHEN(16) && IN(pb + 16)) {
                pg8::Gemm g{HBSEL(hbi), (const bf16*)(ws + WS_W_PG) + (size_t)li * DM * DM, M, DM, DM}; pg8::StaticOrder S; S.init(M, DM, F.G, F.bid);
                pg8::EpiResid<2> E{F.out, HBSEL(hbi ^ 1), STSEL(si ^ 1), STSEL(si), Eb, nullptr};
                pg8::gemm_phase<pg8::EpiResid<2>, pg8::StaticOrder, true, true>(ring, g, S, E);
                SEAM(pb + 16); }
            si ^= 1; hbi ^= 1;
        }

}
__global__ void __launch_bounds__(NWAVES * 64, 2) fwd(Args args) {
    extern __shared__ __attribute__((aligned(16))) unsigned char lds[];
    Frame F;
    F.lds = (LAS unsigned char*)lds; F.gl = lds; F.MISCW = (volatile LAS unsigned*)(F.lds + MISC_OFF);
    F.tid = threadIdx.x; F.lane = F.tid & 63; F.wave = __builtin_amdgcn_readfirstlane(F.tid >> 6); F.G = gridDim.x; F.bid = blockIdx.x; F.gw = F.bid * NWAVES + F.wave; F.NGW = F.G * NWAVES;
    F.out = args.out; F.ws = args.ws;
    unsigned char* ws = args.ws;
    for (int u = F.tid; u < (LDS_BYTES - LDSCTL_OFF) / 4; u += NWAVES * 64) ((LAS unsigned*)(F.lds + LDSCTL_OFF))[u] = 0u;
    __syncthreads();
    XcdBarrier bar = xcd_barrier_post((unsigned*)(ws + WS_CTL) + CW_BAR, F.MISCW + 8);
    const int lo = args.ph_lo, hi = args.ph_hi;
    LAS unsigned char* ring = F.lds;
    int K256 = 256; asm volatile("" : "+s"(K256));

    if (PHEN(100) && IN(0)) { p0_prologue(F, args); SEAM(0); }

    layer_pair<0>(F, args, bar, lo, hi, ring, K256);
    layer_pair<1>(F, args, bar, lo, hi, ring, K256);
#undef IN
#undef SEAM
}

extern "C" void kernel_launch(void* const* d_in, const int* in_sizes, int n_in, void* d_out, int out_size, void* d_ws, size_t ws_size, hipStream_t stream) {
    static int grid = 0;
    if (grid == 0) {
        if (n_in != 28 || in_sizes[0] != M * DM || out_size != M * DM || ws_size < WS_END) { fprintf(stderr, "kernel_launch: unexpected shapes (n_in %d, in0 %d, out %d, ws %zu < %zu); nothing launched\n", n_in, n_in > 0 ? in_sizes[0] : -1, out_size, ws_size, (size_t)WS_END); grid = -1; return; }
        int dev = 0, cus = 0, per_cu = 0;
        if (hipGetDevice(&dev) != hipSuccess || hipDeviceGetAttribute(&cus, hipDeviceAttributeMultiprocessorCount, dev) != hipSuccess) { grid = -1; return; }
        if (hipFuncSetAttribute((const void*)fwd, hipFuncAttributeMaxDynamicSharedMemorySize, LDS_BYTES) != hipSuccess) { fprintf(stderr, "kernel_launch: hipFuncSetAttribute failed\n"); grid = -1; return; }
        if (hipOccupancyMaxActiveBlocksPerMultiprocessor(&per_cu, (const void*)fwd, NWAVES * 64, LDS_BYTES) != hipSuccess || per_cu < 1) fprintf(stderr, "kernel_launch: occupancy query reports %d workgroups per CU\n", per_cu);
        (void)hipGetLastError();
        grid = cus;
    }
    if (grid < 0) return;
    if (hipMemsetAsync((char*)d_ws + WS_CTL, 0, CTL_ZERO_BYTES, stream) != hipSuccess) return;
    Args a{};
    for (int i = 0; i < 28; ++i) a.in[i] = (const float*)d_in[i];
    a.out = (float*)d_out; a.ws = (unsigned char*)d_ws;
#if MK_ONE_LAUNCH
    a.ph_lo = 0; a.ph_hi = N_PHASES;
    hipLaunchKernelGGL(fwd, dim3(grid), dim3(NWAVES * 64), LDS_BYTES, stream, a);
#else
    for (int ph = 0; ph < N_PHASES; ++ph) { if (ph == 1) continue; a.ph_lo = ph; a.ph_hi = ph + 1;
        hipLaunchKernelGGL(fwd, dim3(grid), dim3(NWAVES * 64), LDS_BYTES, stream, a); }
#endif
}
```

```cpp
#include <hip/hip_runtime.h>
#include <cstdio>
#include <cstdint>
#ifndef MK_ONE_LAUNCH
#define MK_ONE_LAUNCH 1
#endif
namespace pg8 {
#define PG8_LAS __attribute__((address_space(3)))
typedef unsigned short bf16_t;
typedef short bf16x8 __attribute__((ext_vector_type(8)));
typedef float f32x4 __attribute__((ext_vector_type(4)));
typedef unsigned u32x4 __attribute__((ext_vector_type(4)));
constexpr int BM = 256, BK = 64, HALF = 128, HTB = HALF * BK * 2  , STAGE_BYTES = 8 * HTB, NXCD = 8, WGM = 8;

__host__ __device__ __forceinline__ int lds_byte(int r, int c) { const int st = (r >> 4) * 2 + (c >> 5), rr = r & 15, cc = c & 31, ob = rr * 64 + cc * 2; return st * 1024 + (ob ^ (((ob >> 9) & 1) << 5)); }
__host__ __device__ __forceinline__ void stage_rc(int b, int& R, int& C) { const int st = b / 1024, sb = b % 1024, swz = sb ^ (((sb >> 9) & 1) << 5); R = (st >> 1) * 16 + swz / 64; C = (st & 1) * 32 + (swz % 64) / 2; }
__host__ __device__ __forceinline__ int perm32(int rho) { const int n = rho >> 4, i = rho & 15; return 8 * (i >> 2) + 4 * n + (i & 3); }

struct Unit { int pm, pn; };
struct Gemm { const bf16_t* A; const bf16_t* Bt; int M, N, K; };

struct StaticOrder {
    int nM, nN, nwg, G, c;
    __host__ __device__ void init(int M, int N, int G_, int c_) { nM = M / BM; nN = N / BM; nwg = nM * nN; G = G_; c = c_; }
    __host__ __device__ bool next(int i, Unit& u) const {
        const long L = (long)i * G + c; if (L >= nwg) return false;
        int wgid = (int)L; { const int q = nwg / NXCD, r = nwg % NXCD, xcd = wgid % NXCD, off = wgid / NXCD; wgid = (xcd < r ? xcd * (q + 1) : r * (q + 1) + (xcd - r) * q) + off; }
        const int nig = WGM * nN, gid = wgid / nig, fm = gid * WGM, gsz = (nM - fm) < WGM ? (nM - fm) : WGM;
        u.pm = fm + ((wgid % nig) % gsz); u.pn = (wgid % nig) / gsz; return true;
    }
    __device__ __forceinline__ void a_ready(const Unit&) const {}
    __device__ __forceinline__ void done(const Unit&) const {}
};
__device__ __forceinline__ unsigned cvt_pk_bf16(float lo, float hi) { unsigned r; asm volatile("v_cvt_pk_bf16_f32 %0, %1, %2" : "=v"(r) : "v"(lo), "v"(hi)); return r; }
typedef float f32x2 __attribute__((ext_vector_type(2)));
constexpr float RMS_EPS = 1e-6f;
__device__ __forceinline__ float fsigmoid(float x) { return __builtin_amdgcn_rcpf(1.0f + __builtin_amdgcn_exp2f(-1.44269504f * x)); }
__device__ __forceinline__ f32x4 sig4(f32x4 v) { f32x4 o; o.x = fsigmoid(v.x); o.y = fsigmoid(v.y); o.z = fsigmoid(v.z); o.w = fsigmoid(v.w); return o; }
__device__ __forceinline__ u32x4 pack8(f32x4 v0, f32x4 v1) { u32x4 w; w.x = cvt_pk_bf16(v0[0], v0[1]); w.y = cvt_pk_bf16(v0[2], v0[3]); w.z = cvt_pk_bf16(v1[0], v1[1]); w.w = cvt_pk_bf16(v1[2], v1[3]); return w; }
__device__ __forceinline__ void unpack8(u32x4 w, f32x4& a, f32x4& b) {
    a.x = __uint_as_float(w.x << 16); a.y = __uint_as_float(w.x & 0xffff0000u); a.z = __uint_as_float(w.y << 16); a.w = __uint_as_float(w.y & 0xffff0000u);
    b.x = __uint_as_float(w.z << 16); b.y = __uint_as_float(w.z & 0xffff0000u); b.z = __uint_as_float(w.w << 16); b.w = __uint_as_float(w.w & 0xffff0000u); }
__device__ __forceinline__ void load_rstd(const float* stats, int rowb, int fr, int fq, float (&rs)[2][4]) {
    float mine[2];
#pragma unroll
    for (int ai = 0; ai < 2; ++ai) { const f32x4* p = (const f32x4*)(stats + (size_t)(rowb + ai * HALF + fq * 16) * 16); const f32x4 a = p[0], b = p[1], c = p[2], d = p[3];
        const float s = (((a.x + a.y) + (a.z + a.w)) + ((b.x + b.y) + (b.z + b.w))) + (((c.x + c.y) + (c.z + c.w)) + ((d.x + d.y) + (d.z + d.w)));
        mine[ai] = rsqrtf(s * (1.0f / 1024.0f) + RMS_EPS); }
#pragma unroll
    for (int ai = 0; ai < 2; ++ai)
#pragma unroll
        for (int m = 0; m < 4; ++m) rs[ai][m] = __shfl(mine[ai], fr + 16 * m);
}
struct EpiIn {
    static constexpr bool PERM = true, AFTER_DRAIN = false;
    const float* stats; bf16_t* QK; float* MISC; bf16_t* KIB;
    __device__ __forceinline__ void operator()(const f32x4 (&acc)[2][2][4][2], const Unit& u, int wr, int wc, int fr, int fq) const {
        const int rowb = u.pm * BM + wr * 64 + fr, cl = wc * 32 + 8 * fq, pn = u.pn;
        float rs[2][4]; load_rstd(stats, rowb, fr, fq, rs);
        if (pn < 12) {
            bf16_t* base; int ld, colt; bool sig = false;
            if (pn < 4) { base = QK; ld = 1024; colt = pn * 256; }
            else { const int t = (pn - 4) >> 1; base = QK + (size_t)16777216 + (size_t)t * 8388608; ld = 512; colt = ((pn - 4) & 1) * 256; sig = (t == 1); }
#pragma unroll
            for (int ai = 0; ai < 2; ++ai)
#pragma unroll
                for (int m = 0; m < 4; ++m) { const float r = rs[ai][m]; bf16_t* rp = base + (size_t)(rowb + ai * HALF + m * 16) * ld + colt + cl;
#pragma unroll
                    for (int bj = 0; bj < 2; ++bj) { f32x4 v0 = acc[ai][bj][m][0] * r, v1 = acc[ai][bj][m][1] * r; if (sig) { v0 = sig4(v0); v1 = sig4(v1); }
                        *(u32x4*)(rp + bj * HALF) = pack8(v0, v1); }
                    asm volatile("" ::: "memory"); }
        } else {
#pragma unroll
            for (int ai = 0; ai < 2; ++ai)
#pragma unroll
                for (int m = 0; m < 4; ++m) { const float r = rs[ai][m]; float* rp = MISC + (size_t)(rowb + ai * HALF + m * 16) * 256 + cl;
#pragma unroll
                    for (int bj = 0; bj < 2; ++bj)
#pragma unroll
                        for (int n = 0; n < 2; ++n) *(f32x4*)(rp + bj * HALF + 4 * n) = acc[ai][bj][m][n] * r;
                    if (wc < 2) *(u32x4*)(KIB + (size_t)(rowb + ai * HALF + m * 16) * 64 + cl) = pack8(acc[ai][1][m][0] * r, acc[ai][1][m][1] * r);
                    asm volatile("" ::: "memory"); }
        }
    }
};
template <int MODE> struct EpiResid {
    static constexpr bool PERM = true, AFTER_DRAIN = false;
    float* H; bf16_t* HBo; float* statsW; const float* statsR; const bf16_t* E; const float* scale;
    __device__ __forceinline__ void operator()(const f32x4 (&acc)[2][2][4][2], const Unit& u, int wr, int wc, int fr, int fq) const {
        int pm = u.pm; const int pn = u.pn; if (MODE == 1) pm -= 64 * pn;
        const int rowb = pm * BM + wr * 64 + fr, colb = pn * BM + wc * 32 + 8 * fq;
        float rs[2][4]; if (MODE == 2) load_rstd(statsR, rowb, fr, fq, rs);
        f32x4 sc[2][2];
        if (MODE == 1) {
#pragma unroll
            for (int bj = 0; bj < 2; ++bj)
#pragma unroll
                for (int n = 0; n < 2; ++n) sc[bj][n] = *(const f32x4*)(scale + colb + bj * HALF + 4 * n); }
#pragma unroll
        for (int ai = 0; ai < 2; ++ai)
#pragma unroll
            for (int m = 0; m < 4; ++m) { const size_t off = (size_t)(rowb + ai * HALF + m * 16) * 1024 + colb; float ssq = 0.f;
#pragma unroll
                for (int bj = 0; bj < 2; ++bj) { float* hp = H + off + bj * HALF; f32x4 h0 = ((const f32x4*)hp)[0], h1 = ((const f32x4*)hp)[1];
                    f32x4 v0 = acc[ai][bj][m][0], v1 = acc[ai][bj][m][1];
                    if (MODE == 1) { v0 = v0 * sc[bj][0]; v1 = v1 * sc[bj][1]; }
                    if (MODE == 2) { const u32x4 ew = *(const u32x4*)(E + off + bj * HALF); f32x4 e0, e1; unpack8(ew, e0, e1); const float r = rs[ai][m]; v0 = e0 * sig4(v0 * r); v1 = e1 * sig4(v1 * r); }
                    h0 = h0 + v0; h1 = h1 + v1; ((f32x4*)hp)[0] = h0; ((f32x4*)hp)[1] = h1;
                    ssq += ((h0.x * h0.x + h0.y * h0.y) + (h0.z * h0.z + h0.w * h0.w)) + ((h1.x * h1.x + h1.y * h1.y) + (h1.z * h1.z + h1.w * h1.w));
                    *(u32x4*)(HBo + off + bj * HALF) = pack8(h0, h1); }
                ssq += __shfl_xor(ssq, 16); ssq += __shfl_xor(ssq, 32);
                if (fq == 0) statsW[(size_t)(rowb + ai * HALF + m * 16) * 16 + pn * 4 + wc] = ssq;
                asm volatile("" ::: "memory"); }
    }
};
template <bool MOE> struct EpiGLU {
    static constexpr bool PERM = true, AFTER_DRAIN = false;
    const float* stats; const float* rowr; bf16_t* ACT;
    __device__ __forceinline__ void operator()(const f32x4 (&acc)[2][2][4][2], const Unit& u, int wr, int wc, int fr, int fq) const {
        const int rowb = u.pm * BM + wr * 64 + fr, jt = MOE ? (u.pn % 28) : u.pn;
        float rs[2][4];
        if (MOE) {
#pragma unroll
            for (int ai = 0; ai < 2; ++ai)
#pragma unroll
                for (int m = 0; m < 4; ++m) rs[ai][m] = rowr[rowb + ai * HALF + m * 16];
        } else load_rstd(stats, rowb, fr, fq, rs);
#pragma unroll
        for (int ai = 0; ai < 2; ++ai)
#pragma unroll
            for (int m = 0; m < 4; ++m) { const float r = rs[ai][m]; bf16_t* rp = ACT + (size_t)(rowb + ai * HALF + m * 16) * 3584 + jt * 128 + wc * 32 + 8 * fq;
                const f32x4 g0 = acc[ai][0][m][0] * r, g1 = acc[ai][0][m][1] * r, u0 = acc[ai][1][m][0] * r, u1 = acc[ai][1][m][1] * r;
                *(u32x4*)rp = pack8(g0 * sig4(g0) * u0, g1 * sig4(g1) * u1);
                asm volatile("" ::: "memory"); }
    }
};
struct EpiScatter {
    static constexpr bool PERM = true, AFTER_DRAIN = false;
    const int* rowts; const float* rowg; bf16_t *D0, *D1;
    __device__ __forceinline__ void operator()(const f32x4 (&acc)[2][2][4][2], const Unit& u, int wr, int wc, int fr, int fq) const {
        const int rowb = u.pm * BM + wr * 64 + fr, jt = u.pn & 3;
#pragma unroll
        for (int ai = 0; ai < 2; ++ai)
#pragma unroll
            for (int m = 0; m < 4; ++m) { const int row = rowb + ai * HALF + m * 16; const int ts = rowts[row];
                if (ts >= 0) { const float g = rowg[row]; bf16_t* dp = ((ts & 1) ? D1 : D0) + (size_t)(ts >> 1) * 1024 + jt * 256 + wc * 32 + 8 * fq;
#pragma unroll
                    for (int bj = 0; bj < 2; ++bj) *(u32x4*)(dp + bj * HALF) = pack8(acc[ai][bj][m][0] * g, acc[ai][bj][m][1] * g); }
                asm volatile("" ::: "memory"); }
    }
};
struct EpiStore {
    static constexpr bool PERM = true, AFTER_DRAIN = false;
    bf16_t* O; int ldc;
    __device__ __forceinline__ void operator()(const f32x4 (&acc)[2][2][4][2], const Unit& u, int wr, int wc, int fr, int fq) const {
        const int rowb = u.pm * BM + wr * 64 + fr, colb = u.pn * BM + wc * 32 + 8 * fq;
#pragma unroll
        for (int ai = 0; ai < 2; ++ai)
#pragma unroll
            for (int m = 0; m < 4; ++m) { bf16_t* rp = O + (size_t)(rowb + ai * HALF + m * 16) * ldc + colb;
#pragma unroll
                for (int bj = 0; bj < 2; ++bj) *(u32x4*)(rp + bj * HALF) = pack8(acc[ai][bj][m][0], acc[ai][bj][m][1]); }
    }
};
struct PoolOrder {
    int G, c;
    __device__ __forceinline__ bool next(int i, Unit& u) const { const int L = i * G + c; if (L >= 256) return false; const int g = L & 3; u.pm = g * 64 + (L >> 2); u.pn = g; return true; }
    __device__ __forceinline__ void a_ready(const Unit&) const {}
    __device__ __forceinline__ void done(const Unit&) const {}
};
struct MoeOrder {
    const int* tileE; int ntiles, ncol, G, c;
    __device__ __forceinline__ bool next(int i, Unit& u) const { const int L = i * G + c; if (L >= ntiles * ncol) return false; const int rt = L / ncol, j = L - rt * ncol;
        u.pm = rt; u.pn = __builtin_amdgcn_readfirstlane(tileE[rt]) * ncol + j; return true; }
    __device__ __forceinline__ void a_ready(const Unit&) const {}
    __device__ __forceinline__ void done(const Unit&) const {}
};
template <class Epi, class Sched, bool ALIGN_EPI = false, bool SP2 = false>
__device__ __forceinline__ void gemm_phase(PG8_LAS unsigned char* lds, const Gemm g, const Sched& S, const Epi& E) {
    const int tid = threadIdx.x, wid = __builtin_amdgcn_readfirstlane(tid >> 6), lane = tid & 63, wr = wid >> 2, wc = wid & 3, fr = lane & 15, fq = lane >> 4;
    const int K = g.K, nt = K / BK;
    unsigned voffA[2], voffB[2];
#pragma unroll
    for (int i = 0; i < 2; ++i) { int R, C; stage_rc(tid * 16 + i * 8192, R, C); const int Rb = Epi::PERM ? ((R & ~31) + perm32(R & 31)) : R;
        voffA[i] = (unsigned)(R * K + C) * 2u; voffB[i] = (unsigned)(Rb * K + C) * 2u; }
    const size_t kstep = (size_t)(BK * 2);
    const size_t hstep = (size_t)HALF * K * 2;
    const size_t tstep = 2 * hstep;
    const unsigned ldsw = (unsigned)wid * 1024u;
    const int aoff = lds_byte(wr * 64 + fr, fq * 8), boff = lds_byte(wc * 32 + fr, fq * 8);
#define PG8_SA(b, h) (((b) * 2 + (h)) * HTB)
#define PG8_SB(b, h) ((4 + (b) * 2 + (h)) * HTB)
#define PG8_STAGE(bufoff, gbase, voff) do { _Pragma("unroll") for (int _i = 0; _i < 2; ++_i) \
        __builtin_amdgcn_global_load_lds((const unsigned*)((const char*)(gbase) + (voff)[_i]), (PG8_LAS unsigned*)(lds + (bufoff) + ldsw + _i * 8192), 16, 0, 0); } while (0)
#define PG8_LDA(dst, b, h) do { _Pragma("unroll") for (int m = 0; m < 4; ++m) _Pragma("unroll") for (int k = 0; k < 2; ++k) dst[m][k] = *(const PG8_LAS bf16x8*)(lds + PG8_SA(b, h) + aoff + m * 2048 + k * 1024); } while (0)
#define PG8_LDB(dst, b, h) do { _Pragma("unroll") for (int n = 0; n < 2; ++n) _Pragma("unroll") for (int k = 0; k < 2; ++k) dst[n][k] = *(const PG8_LAS bf16x8*)(lds + PG8_SB(b, h) + boff + n * 2048 + k * 1024); } while (0)
#define PG8_MMA(ai, bj, At, Bt) do { __builtin_amdgcn_s_setprio(1); _Pragma("unroll") for (int m = 0; m < 4; ++m) _Pragma("unroll") for (int n = 0; n < 2; ++n) _Pragma("unroll") for (int k = 0; k < 2; ++k) \
        acc[ai][bj][m][n] = __builtin_amdgcn_mfma_f32_16x16x32_bf16(Bt[n][k], At[m][k], acc[ai][bj][m][n], 0, 0, 0); __builtin_amdgcn_s_setprio(0); } while (0)
#define PG8_WAIT_V(n) asm volatile("s_waitcnt vmcnt(" #n ")" ::: "memory")
#define PG8_WAIT_L(n) asm volatile("s_waitcnt lgkmcnt(" #n ")" ::: "memory")
#define PG8_BAR __builtin_amdgcn_s_barrier()
#define PG8_SCHED __builtin_amdgcn_sched_barrier(0)
    Unit cur, nxt; int ui = 0;
    if (!S.next(0, cur)) return;
    f32x4 acc[2][2][4][2];
#pragma unroll
    for (int a = 0; a < 2; ++a)
#pragma unroll
        for (int b = 0; b < 2; ++b)
#pragma unroll
            for (int m = 0; m < 4; ++m)
#pragma unroll
                for (int n = 0; n < 2; ++n) acc[a][b][m][n] = (f32x4){0.f, 0.f, 0.f, 0.f};
    bf16x8 At[4][2], B0[2][2], B1[2][2];
    const char* cA = (const char*)g.A + (size_t)cur.pm * tstep; const char* cB = (const char*)g.Bt + (size_t)cur.pn * tstep;
    S.a_ready(cur);
    if constexpr (SP2) {
        PG8_STAGE(PG8_SB(0, 0), cB, voffB); PG8_STAGE(PG8_SB(0, 1), cB + hstep, voffB); PG8_STAGE(PG8_SA(0, 0), cA, voffA); PG8_STAGE(PG8_SA(0, 1), cA + hstep, voffA);
        if (wr == 1) PG8_BAR;
        PG8_WAIT_V(2); PG8_BAR;
        PG8_STAGE(PG8_SB(1, 0), cB + kstep, voffB); PG8_STAGE(PG8_SA(1, 0), cA + kstep, voffA); PG8_STAGE(PG8_SB(1, 1), cB + hstep + kstep, voffB);
        PG8_WAIT_V(6); PG8_BAR;
    } else {
        PG8_STAGE(PG8_SB(0, 0), cB, voffB); PG8_STAGE(PG8_SA(0, 0), cA, voffA); PG8_STAGE(PG8_SB(0, 1), cB + hstep, voffB); PG8_STAGE(PG8_SA(0, 1), cA + hstep, voffA);
        if (wr == 1) PG8_BAR;
        PG8_WAIT_V(4); PG8_BAR;
        PG8_STAGE(PG8_SB(1, 0), cB + kstep, voffB); PG8_STAGE(PG8_SA(1, 0), cA + kstep, voffA); PG8_STAGE(PG8_SB(1, 1), cB + hstep + kstep, voffB);
        PG8_WAIT_V(6); PG8_BAR;
    }
    for (;;) {
        const bool has_next = S.next(ui + 1, nxt);
        const char* nA = has_next ? (const char*)g.A + (size_t)nxt.pm * tstep : cA; const char* nB = has_next ? (const char*)g.Bt + (size_t)nxt.pn * tstep : cB;
        for (int t = 0; t < nt; t += 2) {
            const bool last = (t == nt - 2);
            const char* a1 = cA + (size_t)(t + 1) * kstep;
            const char* a2 = last ? nA : cA + (size_t)(t + 2) * kstep; const char* b2 = last ? nB : cB + (size_t)(t + 2) * kstep;
            const char* a3 = a2 + kstep; const char* b3 = b2 + kstep;
            if (last && has_next) S.a_ready(nxt);
            if constexpr (SP2) {
            PG8_LDB(B0, 0, 0); PG8_LDB(B1, 0, 1); PG8_SCHED; PG8_LDA(At, 0, 0); PG8_STAGE(PG8_SA(1, 1), a1 + hstep, voffA);
            PG8_WAIT_V(8); PG8_WAIT_L(0); PG8_BAR; PG8_MMA(0, 0, At, B0); PG8_MMA(0, 1, At, B1); PG8_BAR; PG8_SCHED;
            PG8_LDA(At, 0, 1); PG8_STAGE(PG8_SB(0, 0), b2, voffB); PG8_STAGE(PG8_SB(0, 1), b2 + hstep, voffB); PG8_STAGE(PG8_SA(0, 0), a2, voffA);
            PG8_WAIT_V(8); PG8_WAIT_L(0); PG8_BAR; PG8_MMA(1, 0, At, B0); PG8_MMA(1, 1, At, B1); PG8_BAR; PG8_SCHED;
            PG8_LDB(B0, 1, 0); PG8_LDB(B1, 1, 1); PG8_SCHED; PG8_LDA(At, 1, 0); PG8_STAGE(PG8_SA(0, 1), a2 + hstep, voffA);
            PG8_WAIT_V(8); PG8_WAIT_L(0); PG8_BAR; PG8_MMA(0, 0, At, B0); PG8_MMA(0, 1, At, B1); PG8_BAR; PG8_SCHED;
            PG8_LDA(At, 1, 1); PG8_STAGE(PG8_SB(1, 0), b3, voffB); PG8_STAGE(PG8_SB(1, 1), b3 + hstep, voffB); PG8_STAGE(PG8_SA(1, 0), a3, voffA);
            PG8_WAIT_V(8); PG8_WAIT_L(0); PG8_BAR; PG8_MMA(1, 0, At, B0); PG8_MMA(1, 1, At, B1); PG8_BAR; PG8_SCHED;
            } else {
            PG8_LDB(B0, 0, 0); PG8_SCHED; PG8_LDA(At, 0, 0); PG8_STAGE(PG8_SA(1, 1), a1 + hstep, voffA);
            PG8_WAIT_L(8); PG8_BAR; PG8_WAIT_L(0); PG8_MMA(0, 0, At, B0); PG8_BAR; PG8_SCHED;
            PG8_LDB(B1, 0, 1); PG8_STAGE(PG8_SB(0, 0), b2, voffB);
            PG8_BAR; PG8_WAIT_L(0); PG8_MMA(0, 1, At, B1); PG8_BAR;
            PG8_LDA(At, 0, 1); PG8_STAGE(PG8_SA(0, 0), a2, voffA);
            PG8_BAR; PG8_WAIT_L(0); PG8_MMA(1, 0, At, B0); PG8_BAR; PG8_SCHED;
            PG8_STAGE(PG8_SB(0, 1), b2 + hstep, voffB);
            PG8_WAIT_V(6); PG8_BAR; PG8_MMA(1, 1, At, B1); PG8_BAR;
            PG8_LDB(B0, 1, 0); PG8_SCHED; PG8_LDA(At, 1, 0); PG8_STAGE(PG8_SA(0, 1), a2 + hstep, voffA);
            PG8_WAIT_L(8); PG8_BAR; PG8_WAIT_L(0); PG8_MMA(0, 0, At, B0); PG8_BAR; PG8_SCHED;
            PG8_LDB(B1, 1, 1); PG8_STAGE(PG8_SB(1, 0), b3, voffB);
            PG8_BAR; PG8_WAIT_L(0); PG8_MMA(0, 1, At, B1); PG8_BAR;
            PG8_LDA(At, 1, 1); PG8_STAGE(PG8_SA(1, 0), a3, voffA);
            PG8_BAR; PG8_WAIT_L(0); PG8_MMA(1, 0, At, B0); PG8_BAR; PG8_SCHED;
            PG8_STAGE(PG8_SB(1, 1), b3 + hstep, voffB);
            PG8_WAIT_V(6); PG8_BAR; PG8_MMA(1, 1, At, B1); PG8_BAR;
            }
        }
        if constexpr (ALIGN_EPI) { if (wr == 0) PG8_BAR; }
        if constexpr (!Epi::AFTER_DRAIN) { E(acc, cur, wr, wc, fr, fq); S.done(cur); }
        if (!has_next) break;
#pragma unroll
        for (int a = 0; a < 2; ++a)
#pragma unroll
            for (int b = 0; b < 2; ++b)
#pragma unroll
                for (int m = 0; m < 4; ++m)
#pragma unroll
                    for (int n = 0; n < 2; ++n) acc[a][b][m][n] = (f32x4){0.f, 0.f, 0.f, 0.f};
        cur = nxt; cA = nA; cB = nB; ++ui;
        if constexpr (ALIGN_EPI) { if (wr == 1) PG8_BAR; }
    }
    PG8_WAIT_V(0);
    if constexpr (!ALIGN_EPI) { if (wr == 0) PG8_BAR; }
    PG8_BAR;
    if constexpr (Epi::AFTER_DRAIN) { E.fused(acc, cur, wr, wc, fr, fq, lds, wid, lane); S.done(cur); }
#undef PG8_SA
#undef PG8_SB
#undef PG8_STAGE
#undef PG8_LDA
#undef PG8_LDB
#undef PG8_MMA
#undef PG8_WAIT_V
#undef PG8_WAIT_L
#undef PG8_BAR
#undef PG8_SCHED
}
}
constexpr int NWAVES = 8;
constexpr int BATCH = 8, SEQ = 2048, DM = 1024, M = BATCH * SEQ, DFF = 3584, NEXP = 8, PLED = 256, NINP = 3328, NCHUNK = 32;
constexpr float LOG2E = 1.4426950408889634f;
constexpr size_t MiB = 1u << 20;
constexpr size_t WS_CTL = 0, CTL_ZERO_BYTES = 1 * MiB;
constexpr size_t WS_SMALL = 1 * MiB;
constexpr size_t WS_W_IN = 2 * MiB, WS_W_OUT = 15 * MiB, WS_W_GU = 19 * MiB, WS_W_DN = 47 * MiB, WS_W_PG = 61 * MiB, WS_W_PL = 69 * MiB, WS_W_POOL = 71 * MiB;
constexpr size_t WS_W_MGU = 72 * MiB, WS_W_MDN = 184 * MiB;
constexpr size_t WS_HB0 = 240 * MiB, WS_HB1 = 272 * MiB, WS_STATS = 304 * MiB, WS_PB = 306 * MiB, WS_E = 338 * MiB;
constexpr size_t WS_OVL = 370 * MiB;
constexpr size_t WS_QK = WS_OVL, WS_VB = WS_OVL + 32 * MiB, WS_OG = WS_OVL + 48 * MiB, WS_BQ = WS_OVL + 64 * MiB, WS_BQI = WS_OVL + 80 * MiB, WS_MISC = WS_OVL + 96 * MiB, WS_MIX = WS_OVL + 112 * MiB;
constexpr size_t WS_KB = WS_OVL + 144 * MiB, WS_KIB = WS_OVL + 146 * MiB, WS_VT = WS_OVL + 148 * MiB, WS_MASK = WS_OVL + 164 * MiB, WS_CHS = WS_OVL + 168 * MiB;
constexpr size_t WS_ISC = WS_OVL + 169 * MiB, WS_U = WS_OVL + 297 * MiB, WS_CB = WS_OVL + 369 * MiB, WS_ACT = WS_ISC;
constexpr size_t WS_POOLED = WS_OVL, WS_YG = WS_OVL + 32 * MiB, WS_ACTM = WS_OVL + 100 * MiB, WS_D0 = WS_OVL + 338 * MiB, WS_D1 = WS_OVL + 370 * MiB, WS_ROUTE = WS_OVL + 402 * MiB;
constexpr size_t WS_END = WS_OVL + 406 * MiB;
constexpr int MAXROWS = 34816;
constexpr size_t RT_TOKE = 0, RT_TOKG = 65536, RT_TOKR = 196608, RT_CNT = 262144, RT_ROWTS = 270336, RT_ROWG = 409600, RT_ROWR = 548864, RT_TILEE = 688128, RT_NT = 688128 + 1024;
constexpr int CW_BAR = 4096;
constexpr int RING_BYTES = 131072, LDSCTL_OFF = RING_BYTES, MISC_OFF = LDSCTL_OFF + 320, LDS_BYTES = 147456;

#define GAS __attribute__((address_space(1)))
#define LAS __attribute__((address_space(3)))
typedef unsigned short bf16;
typedef unsigned v4u __attribute__((ext_vector_type(4)));
typedef unsigned v2u __attribute__((ext_vector_type(2)));
typedef float f32x4 __attribute__((ext_vector_type(4)));
typedef float f32x2 __attribute__((ext_vector_type(2)));
typedef short bf16x8 __attribute__((ext_vector_type(8)));
#define LDS_WAIT() asm volatile("s_waitcnt lgkmcnt(0)" ::: "memory")
__device__ __forceinline__ unsigned f2bf(float f) { unsigned u = __builtin_bit_cast(unsigned, f); return (u + 0x7fffu + ((u >> 16) & 1u)) >> 16; }
__device__ __forceinline__ unsigned pk2(float lo, float hi) { return f2bf(lo) | (f2bf(hi) << 16); }
__device__ __forceinline__ float bflo(unsigned w) { return __uint_as_float(w << 16); }
__device__ __forceinline__ float bfhi(unsigned w) { return __uint_as_float(w & 0xffff0000u); }
__device__ __forceinline__ float bf2f(bf16 b) { return __uint_as_float(((unsigned)b) << 16); }
__device__ __forceinline__ float wave_sum(float v) {
#pragma unroll
    for (int o = 1; o < 64; o <<= 1) v += __shfl_xor(v, o);
    return v;
}
__device__ __forceinline__ float wave_max(float v) {
#pragma unroll
    for (int o = 1; o < 64; o <<= 1) v = fmaxf(v, __shfl_xor(v, o));
    return v;
}
__device__ __forceinline__ float fsig(float x) { return 1.0f / (1.0f + __expf(-x)); }
#define MFMA16(a, b, c) __builtin_amdgcn_mfma_f32_16x16x32_bf16((a), (b), (c), 0, 0, 0)
#define XB_TMO      128
#define XB_XCNT(j)  (256  + 64 * (j))
#define XB_XSUB(j)  (1280 + 64 * (j))
#define XB_XGEN(j)  (2304 + 64 * (j))
#define XB_TOP      3328
#define XB_TOPGEN   3392
#define XCD_BAR_WORDS 3456
#define XB_SPIN_CAP (1u << 18)

__device__ __forceinline__ unsigned xb_ld(unsigned* p)              { return __hip_atomic_load(p, __ATOMIC_RELAXED, __HIP_MEMORY_SCOPE_AGENT); }
__device__ __forceinline__ unsigned xb_add(unsigned* p, unsigned v) { return __hip_atomic_fetch_add(p, v, __ATOMIC_RELAXED, __HIP_MEMORY_SCOPE_AGENT); }
__device__ __forceinline__ unsigned xb_xcc_id() { return (unsigned)__builtin_amdgcn_s_getreg((3 << 11) | 20) & 0xFu; }
#define XB_SPIN(cond, bar) do { unsigned _sp = 0; while (cond) { __builtin_amdgcn_s_sleep(1); \
    if ((++_sp & 255u) == 0u) { if (xb_ld(&(bar)[XB_TMO])) break; if (_sp > XB_SPIN_CAP) { atomicAdd(&(bar)[XB_TMO], 1u); break; } } } } while (0)

struct XcdBarrier {
    unsigned* bar; unsigned x;
    volatile LAS unsigned* st;
};

__device__ __forceinline__ XcdBarrier xcd_barrier_post(unsigned* bar, volatile LAS unsigned* st) {
    XcdBarrier b; b.bar = bar; b.x = xb_xcc_id(); b.st = st;
    if (threadIdx.x == 0) (void)xb_add(&bar[XB_XCNT(b.x)], 1u);
    return b;
}
__device__ __forceinline__ void xcd_barrier_complete(unsigned* bar, unsigned x, unsigned& nloc, unsigned& nx) {
    const unsigned G = gridDim.x * gridDim.y * gridDim.z;
    unsigned sum, cnt, mine, sp = 0u;
    for (;;) {
        sum = 0u; cnt = 0u; mine = 0u;
#pragma unroll
        for (unsigned j = 0; j < 16; ++j) { const unsigned c = xb_ld(&bar[XB_XCNT(j)]); sum += c; cnt += (c > 0u) ? 1u : 0u; mine = (j == x) ? c : mine; }
        if (sum == G) break;
        __builtin_amdgcn_s_sleep(1);
        if ((++sp & 255u) == 0u) { if (xb_ld(&bar[XB_TMO])) break; if (sp > XB_SPIN_CAP) { atomicAdd(&bar[XB_TMO], 1u); break; } }
    }
    nloc = mine > 0u ? mine : 1u; nx = cnt > 0u ? cnt : 1u;
}

__device__ __forceinline__ void xcd_barrier(const XcdBarrier& b) {
    asm volatile("s_waitcnt vmcnt(0)" ::: "memory");
    __syncthreads();
    if (threadIdx.x == 0) {
        unsigned* bar = b.bar;
        __builtin_amdgcn_s_waitcnt(0);
        unsigned nloc = b.st[0], nx = b.st[1];
        if (nloc == 0u) { xcd_barrier_complete(bar, b.x, nloc, nx); b.st[0] = nloc; b.st[1] = nx; }
        const unsigned old = xb_add(&bar[XB_XSUB(b.x)], 1u);
        const unsigned gen = old / nloc;
        if (old + 1u == (gen + 1u) * nloc) {
            __builtin_amdgcn_fence(__ATOMIC_RELEASE, "agent");
            asm volatile("s_waitcnt vmcnt(0)" ::: "memory");
            const unsigned og = xb_add(&bar[XB_TOP], 1u);
            const unsigned tg = og / nx;
            if (og + 1u == (tg + 1u) * nx) xb_add(&bar[XB_TOPGEN], 1u);
            else XB_SPIN(xb_ld(&bar[XB_TOPGEN]) == tg, bar);
            __builtin_amdgcn_fence(__ATOMIC_ACQUIRE, "agent");
            xb_add(&bar[XB_XGEN(b.x)], 1u);
            asm volatile("s_waitcnt vmcnt(0)" ::: "memory");
        } else {
            XB_SPIN(xb_ld(&bar[XB_XGEN(b.x)]) == gen, bar);
            __builtin_amdgcn_fence(__ATOMIC_ACQUIRE, "agent");
            asm volatile("s_waitcnt vmcnt(0)" ::: "memory");
        }
    }
    __syncthreads();
}
struct Args { const float* in[28]; float* out; unsigned char* ws; int ph_lo, ph_hi; };
struct Frame {
    LAS unsigned char* lds; unsigned char* gl;
    volatile LAS unsigned* MISCW;
    int tid, lane, wave, G, bid, gw, NGW;
    float* out; unsigned char* ws;
};
#define INP(k) (args.in[k])
#define IN_X 0
#define IN_P 1
#define IN_NORM_MIX 2
#define IN_NORM_FFN 3
#define IN_W_IN 4
#define IN_B_GATE 5
#define IN_CONV 6
#define IN_NORM_H 7
#define IN_NORM_Q 8
#define IN_NORM_K 9
#define IN_NORM_KV 10
#define IN_W_UK 11
#define IN_W_UV 12
#define IN_W_OUT 13
#define IN_REL_BIAS 14
#define IN_W_POOL 15
#define IN_SCALE_POOL 16
#define IN_W_GATE_D 17
#define IN_W_UP_D 18
#define IN_W_DOWN_D 19
#define IN_W_ROUTER 20
#define IN_B_ROUTER 21
#define IN_W_GATE_M 22
#define IN_W_UP_M 23
#define IN_W_DOWN_M 24
#define IN_W_PLE 25
#define IN_W_PLE_GATE 26
#define IN_NORM_PLE 27

template <int MODE> __device__ __forceinline__ int dst_row(int n) {
    if (MODE == 0) return n;
    if (MODE == 1) return ((n >> 7) << 8) + (n & 127);
    if (MODE == 2) return ((n >> 7) << 8) + 128 + (n & 127);
    if (n < 2048) return n;
    if (n < 2052) return 3264 + (n - 2048);
    if (n < 2056) return 3268 + (n - 2052);
    if (n < 2568) return 2048 + (n - 2056);
    if (n < 2696) return 3072 + (n - 2568);
    if (n < 3208) return 2560 + (n - 2696);
    if (n < 3272) return 3200 + (n - 3208);
    return 3272 + (n - 3272);
}
template <int MODE> __device__ __forceinline__ void conv_mat(Frame& F, const float* W, int K, int N, bf16* WT, const float* gain, int wi, int nw) {
    LAS float* scr = (LAS float*)(F.lds + F.wave * 16384);
    const int nblk = (N + 31) >> 5, nitems = (K >> 6) * nblk, lane = F.lane;
    for (int it = wi; it < nitems; it += nw) {
        const int kb = it / nblk, nb = it - kb * nblk, k0 = 64 * kb, n0 = 32 * nb, nn = n0 + (lane & 31); const bool okn = nn < N;
#pragma unroll 8
        for (int i = 0; i < 32; ++i) { const int kk = 2 * i + (lane >> 5); float v = okn ? W[(size_t)(k0 + kk) * N + nn] : 0.f; if (gain) v *= gain[k0 + kk]; scr[kk * 33 + (lane & 31)] = v; }
        LDS_WAIT(); asm volatile("" ::: "memory");
        const int c = lane & 7;
#pragma unroll
        for (int j = 0; j < 4; ++j) { const int n = (lane >> 3) + 8 * j; const LAS float* s = scr + (8 * c) * 33 + n;
            v4u o; o.x = pk2(s[0 * 33], s[1 * 33]); o.y = pk2(s[2 * 33], s[3 * 33]); o.z = pk2(s[4 * 33], s[5 * 33]); o.w = pk2(s[6 * 33], s[7 * 33]);
            if (n0 + n < N) *(v4u*)(WT + (size_t)dst_row<MODE>(n0 + n) * K + k0 + 8 * c) = o; }
        LDS_WAIT(); asm volatile("" ::: "memory");
    }
}
__device__ __forceinline__ void conv_moe(Frame& F, const Args& args, int o) {
    bf16* mgu = (bf16*)(F.ws + WS_W_MGU); bf16* mdn = (bf16*)(F.ws + WS_W_MDN);
    const float* gain = INP(IN_NORM_FFN) + (2 * o + 1) * DM;
    for (int e = 0; e < NEXP; ++e) {
        const size_t wo = ((size_t)o * NEXP + e) * DM * DFF;
        conv_mat<1>(F, INP(IN_W_GATE_M) + wo, DM, DFF, mgu + (size_t)e * 7168 * 1024, gain, F.gw, F.NGW);
        conv_mat<2>(F, INP(IN_W_UP_M) + wo, DM, DFF, mgu + (size_t)e * 7168 * 1024, gain, F.gw, F.NGW);
        conv_mat<0>(F, INP(IN_W_DOWN_M) + wo, DFF, DM, mdn + (size_t)e * 1024 * 3584, nullptr, F.gw, F.NGW);
    }
}
__device__ __forceinline__ void p0_prologue(Frame& F, const Args& args) {
    unsigned char* ws = F.ws;
    for (int e = 0; e < 2; ++e) {
        conv_mat<3>(F, INP(IN_W_IN) + (size_t)e * DM * 3280, DM, 3280, (bf16*)(ws + WS_W_IN) + (size_t)e * NINP * DM, INP(IN_NORM_MIX) + (2 * e) * DM, F.gw, F.NGW);
        conv_mat<0>(F, INP(IN_W_OUT) + (size_t)e * DM * DM, DM, DM, (bf16*)(ws + WS_W_OUT) + (size_t)e * DM * DM, nullptr, F.gw, F.NGW);
        conv_mat<1>(F, INP(IN_W_GATE_D) + (size_t)e * DM * DFF, DM, DFF, (bf16*)(ws + WS_W_GU) + (size_t)e * 7168 * DM, INP(IN_NORM_FFN) + (2 * e) * DM, F.gw, F.NGW);
        conv_mat<2>(F, INP(IN_W_UP_D) + (size_t)e * DM * DFF, DM, DFF, (bf16*)(ws + WS_W_GU) + (size_t)e * 7168 * DM, INP(IN_NORM_FFN) + (2 * e) * DM, F.gw, F.NGW);
        conv_mat<0>(F, INP(IN_W_DOWN_D) + (size_t)e * DFF * DM, DFF, DM, (bf16*)(ws + WS_W_DN) + (size_t)e * DM * DFF, nullptr, F.gw, F.NGW);
        conv_mat<0>(F, INP(IN_W_UK) + (size_t)e * 128 * 64, 128, 64, (bf16*)(ws + WS_SMALL + 8192) + (size_t)e * 64 * 128, nullptr, F.gw, F.NGW);
        for (int h = 0; h < 8; ++h)
            conv_mat<0>(F, INP(IN_W_UV) + ((size_t)e * 8 + h) * 128 * 64, 128, 64, (bf16*)(ws + WS_SMALL + 65536) + ((size_t)e * 512 + h * 64) * 128, nullptr, F.gw, F.NGW);
        for (int g = 0; g < 4; ++g)
            conv_mat<0>(F, INP(IN_W_POOL) + ((size_t)e * 4 + g) * 256 * 256, 256, 256, (bf16*)(ws + WS_W_POOL) + ((size_t)e * 4 + g) * 256 * 256, nullptr, F.gw, F.NGW);
    }
    for (int i = 0; i < 4; ++i) {
        conv_mat<0>(F, INP(IN_W_PLE_GATE) + (size_t)i * DM * DM, DM, DM, (bf16*)(ws + WS_W_PG) + (size_t)i * DM * DM, INP(IN_NORM_PLE) + i * DM, F.gw, F.NGW);
        conv_mat<0>(F, INP(IN_W_PLE) + (size_t)i * PLED * DM, PLED, DM, (bf16*)(ws + WS_W_PL) + (size_t)i * DM * PLED, nullptr, F.gw, F.NGW);
    }
    conv_moe(F, args, 0);
    const int gt = F.bid * 512 + F.tid, NT = F.G * 512;
    for (int i = gt; i < 2 * 48 * DM / 8; i += NT) { const int e = i / (48 * DM / 8), r = i - e * (48 * DM / 8); *(v4u*)((bf16*)(ws + WS_W_IN) + ((size_t)e * NINP + 3280) * DM + (size_t)r * 8) = (v4u){0u, 0u, 0u, 0u}; }
    if (F.bid == 0) for (int t = F.tid; t < 1024; t += 512) { const int hh = t >> 7, d = t & 127; int bk = d;
        if (d >= 16) { bk = 16 + (d >= 19) + (d >= 21) + (d >= 24) + (d >= 27) + (d >= 31) + (d >= 35) + (d >= 40) + (d >= 46) + (d >= 52) + (d >= 59) + (d >= 67) + (d >= 77) + (d >= 87) + (d >= 99) + (d >= 113); }
        ((float*)(ws + WS_SMALL))[t] = INP(IN_REL_BIAS)[bk * 8 + hh] * LOG2E; }
    { const f32x4* src = (const f32x4*)INP(IN_P); v4u* dst = (v4u*)(ws + WS_PB);
      for (int i = gt; i < 4 * M * PLED / 8; i += NT) { const f32x4 a = src[2 * i], b = src[2 * i + 1]; v4u o; o.x = pk2(a.x, a.y); o.y = pk2(a.z, a.w); o.z = pk2(b.x, b.y); o.w = pk2(b.z, b.w); dst[i] = o; } }
    { const float* x = INP(IN_X); bf16* hb = (bf16*)(ws + WS_HB0); float* st = (float*)(ws + WS_STATS);
      for (int m = F.gw; m < M; m += F.NGW) { const f32x4* xr = (const f32x4*)(x + (size_t)m * DM) + F.lane; f32x4* orow = (f32x4*)(F.out + (size_t)m * DM) + F.lane; f32x4 v[4]; float s = 0.f;
#pragma unroll
          for (int j = 0; j < 4; ++j) { v[j] = xr[64 * j]; orow[64 * j] = v[j]; s += (v[j].x * v[j].x + v[j].y * v[j].y) + (v[j].z * v[j].z + v[j].w * v[j].w); }
          s = wave_sum(s);
          v2u* o8 = (v2u*)(hb + (size_t)m * DM) + F.lane;
#pragma unroll
          for (int j = 0; j < 4; ++j) { v2u w; w.x = pk2(v[j].x, v[j].y); w.y = pk2(v[j].z, v[j].w); o8[64 * j] = w; }
          if (F.lane < 16) st[(size_t)m * 16 + F.lane] = (F.lane == 0) ? s : 0.f; } }
}

struct EvenPtrs {
    const bf16 *QK, *VB, *OG, *BQ, *BQI; const float* MISC; bf16 *MIX, *KB, *KIB, *VT; unsigned* MASK; float* CHS; float* MST; float* ISC; float* U; bf16* CB;
    const float *bgate, *conv, *gh, *gq, *gk, *gkv; const bf16 *WukT, *WuvT; const float* bt;
};
__device__ __forceinline__ void conv8(const bf16* QK, const float* cw, int rowb, int tpos, int ch, float (&o)[8]) {
#pragma unroll
    for (int j = 0; j < 8; ++j) o[j] = 0.f;
#pragma unroll
    for (int tap = 0; tap < 4; ++tap) { const int tp = tpos - 3 + tap;
        if (tp >= 0) { const v4u w = *(const v4u*)(QK + (size_t)(rowb + tp) * 1024 + ch); const f32x4 c0 = *(const f32x4*)(cw + tap * 1024 + ch), c1 = *(const f32x4*)(cw + tap * 1024 + ch + 4);
            o[0] += bflo(w.x) * c0.x; o[1] += bfhi(w.x) * c0.y; o[2] += bflo(w.y) * c0.z; o[3] += bfhi(w.y) * c0.w;
            o[4] += bflo(w.z) * c1.x; o[5] += bfhi(w.z) * c1.y; o[6] += bflo(w.w) * c1.z; o[7] += bfhi(w.w) * c1.w; } }
#pragma unroll
    for (int j = 0; j < 8; ++j) o[j] = o[j] * fsig(o[j]);
}
__device__ __forceinline__ void chunk_gates(const EvenPtrs& P, int row, int hh, int lane, float& li, float& bc) {
    const float ai = P.MISC[(size_t)row * 256 + 192 + hh], af = P.MISC[(size_t)row * 256 + 196 + hh];
    li = ai + P.bgate[hh]; const float x = af + P.bgate[4 + hh]; const float lf = fminf(x, 0.f) - log1pf(__expf(-fabsf(x)));
    bc = lf;
#pragma unroll
    for (int o = 1; o < 64; o <<= 1) { const float t = __shfl_up(bc, o); if (lane >= o) bc += t; }
}
__device__ __forceinline__ void mlstm_a(Frame& F, const EvenPtrs& P) {
    bf16* KT = (bf16*)F.gl; bf16* VwT = (bf16*)(F.gl + 18432); float* wv = (float*)(F.gl + 18432 + 20736);
    const int tid = F.tid, lane = F.lane, w = F.wave, fr = lane & 15, fq = lane >> 4;
    for (int unit = F.bid; unit < BATCH * 4 * NCHUNK; unit += F.G) {
        const int b = unit >> 7, hh = (unit >> 5) & 3, c = unit & 31, rowb = b * SEQ, t0 = c * 64;
        if (w == 0) { float li, bc; chunk_gates(P, rowb + t0 + lane, hh, lane, li, bc); const float blast = __shfl(bc, 63), g = blast - bc + li, gmax = wave_max(g);
            wv[lane] = __expf(g - gmax); if (lane == 0) { P.CHS[unit * 2] = blast; P.CHS[unit * 2 + 1] = gmax; } }
        __syncthreads();
        { const int s = tid & 63, dg = tid >> 6; const float ws_ = wv[s];
#pragma unroll
          for (int half = 0; half < 2; ++half) { float o[8]; conv8(P.QK, P.conv, rowb, t0 + s, 512 + hh * 128 + dg * 16 + half * 8, o);
#pragma unroll
              for (int j = 0; j < 8; ++j) KT[(dg * 16 + half * 8 + j) * 72 + s] = (bf16)f2bf(o[j] * 0.08838834764831845f);
              const v4u vw = *(const v4u*)(P.VB + (size_t)(rowb + t0 + s) * 512 + hh * 128 + dg * 16 + half * 8); const int v0 = dg * 16 + half * 8;
              VwT[(v0 + 0) * 72 + s] = (bf16)f2bf(bflo(vw.x) * ws_); VwT[(v0 + 1) * 72 + s] = (bf16)f2bf(bfhi(vw.x) * ws_); VwT[(v0 + 2) * 72 + s] = (bf16)f2bf(bflo(vw.y) * ws_); VwT[(v0 + 3) * 72 + s] = (bf16)f2bf(bfhi(vw.y) * ws_);
              VwT[(v0 + 4) * 72 + s] = (bf16)f2bf(bflo(vw.z) * ws_); VwT[(v0 + 5) * 72 + s] = (bf16)f2bf(bfhi(vw.z) * ws_); VwT[(v0 + 6) * 72 + s] = (bf16)f2bf(bflo(vw.w) * ws_); VwT[(v0 + 7) * 72 + s] = (bf16)f2bf(bfhi(vw.w) * ws_); }
          if (tid < 64) VwT[128 * 72 + tid] = (bf16)f2bf(ws_);
          for (int i = tid; i < 15 * 64; i += 512) VwT[(129 + (i >> 6)) * 72 + (i & 63)] = 0; }
        __syncthreads();
        { bf16x8 bfr[2]; f32x4 acc[9];
#pragma unroll
          for (int ks = 0; ks < 2; ++ks) bfr[ks] = *(const bf16x8*)(KT + (16 * w + fr) * 72 + 8 * fq + 32 * ks);
#pragma unroll
          for (int rt = 0; rt < 9; ++rt) { acc[rt] = (f32x4){0.f, 0.f, 0.f, 0.f};
#pragma unroll
              for (int ks = 0; ks < 2; ++ks) { const bf16x8 a = *(const bf16x8*)(VwT + (16 * rt + fr) * 72 + 8 * fq + 32 * ks); acc[rt] = MFMA16(a, bfr[ks], acc[rt]); } }
          float* Uo = P.U + (size_t)unit * 144 * 128 + 16 * w + fr;
#pragma unroll
          for (int rt = 0; rt < 9; ++rt)
#pragma unroll
              for (int r = 0; r < 4; ++r) Uo[(size_t)(16 * rt + 4 * fq + r) * 128] = acc[rt][r]; }
        __syncthreads();
    }
}
__device__ __forceinline__ void mlstm_b(Frame& F, const EvenPtrs& P) {
    const int gt = F.bid * 512 + F.tid, NT = F.G * 512;
    for (int e = gt; e < BATCH * 4 * 144 * 128; e += NT) {
        const int d = e & 127, v = (e >> 7) % 144, bh = e / (144 * 128);
        float C = 0.f, m = 0.f;
        for (int c = 0; c < NCHUNK; ++c) { const int unit = bh * 32 + c; const size_t idx = ((size_t)unit * 144 + v) * 128 + d;
            P.CB[idx] = (bf16)f2bf(v < 129 ? C : 0.f);
            if (v == 0 && d == 0) P.MST[unit] = m;
            const float blast = P.CHS[unit * 2], gmax = P.CHS[unit * 2 + 1], mn = fmaxf(blast + m, gmax);
            const float u = (v < 129) ? P.U[idx] : 0.f;
            C = __expf(blast + m - mn) * C + __expf(gmax - mn) * u; m = mn; }
    }
}
__device__ __forceinline__ void mlstm_c(Frame& F, const EvenPtrs& P) {
    bf16* Qs = (bf16*)F.gl; bf16* Ks = (bf16*)(F.gl + 17408); bf16* VTa = (bf16*)(F.gl + 34816); bf16* Ps = (bf16*)(F.gl + 55552);
    float* av = (float*)(F.gl + 64768); float* pmv = av + 64; float* bcv = av + 128;
    const int tid = F.tid, lane = F.lane, w = F.wave, fr = lane & 15, fq = lane >> 4;
    for (int unit = F.bid; unit < BATCH * 4 * NCHUNK; unit += F.G) {
        const int b = unit >> 7, hh = (unit >> 5) & 3, c = unit & 31, rowb = b * SEQ, t0 = c * 64;
        const float mc = P.MST[unit];
        if (w == 0) { float li, bc; chunk_gates(P, rowb + t0 + lane, hh, lane, li, bc); const float a = li - bc; float p = a;
#pragma unroll
            for (int o = 1; o < 64; o <<= 1) { const float t = __shfl_up(p, o); if (lane >= o) p = fmaxf(p, t); }
            av[lane] = a; pmv[lane] = fmaxf(p, mc); bcv[lane] = bc; }
        { const int s = tid & 63, dg = tid >> 6;
#pragma unroll
          for (int half = 0; half < 2; ++half) { float o[8]; const int dd = dg * 16 + half * 8;
              conv8(P.QK, P.conv, rowb, t0 + s, hh * 128 + dd, o);
              { v4u q; q.x = pk2(o[0], o[1]); q.y = pk2(o[2], o[3]); q.z = pk2(o[4], o[5]); q.w = pk2(o[6], o[7]); *(v4u*)(Qs + s * 136 + dd) = q; }
              conv8(P.QK, P.conv, rowb, t0 + s, 512 + hh * 128 + dd, o);
              { const float sc = 0.08838834764831845f; v4u q; q.x = pk2(o[0] * sc, o[1] * sc); q.y = pk2(o[2] * sc, o[3] * sc); q.z = pk2(o[4] * sc, o[5] * sc); q.w = pk2(o[6] * sc, o[7] * sc); *(v4u*)(Ks + s * 136 + dd) = q; }
              const v4u vw = *(const v4u*)(P.VB + (size_t)(rowb + t0 + s) * 512 + hh * 128 + dd);
              VTa[(dd + 0) * 72 + s] = (bf16)(vw.x & 0xffffu); VTa[(dd + 1) * 72 + s] = (bf16)(vw.x >> 16); VTa[(dd + 2) * 72 + s] = (bf16)(vw.y & 0xffffu); VTa[(dd + 3) * 72 + s] = (bf16)(vw.y >> 16);
              VTa[(dd + 4) * 72 + s] = (bf16)(vw.z & 0xffffu); VTa[(dd + 5) * 72 + s] = (bf16)(vw.z >> 16); VTa[(dd + 6) * 72 + s] = (bf16)(vw.w & 0xffffu); VTa[(dd + 7) * 72 + s] = (bf16)(vw.w >> 16); }
          if (tid < 64) VTa[128 * 72 + tid] = (bf16)0x3f80u;
          for (int i = tid; i < 15 * 64; i += 512) VTa[(129 + (i >> 6)) * 72 + (i & 63)] = 0; }
        __syncthreads();
        { const int rt = w >> 1;
#pragma unroll
          for (int c2 = 0; c2 < 2; ++c2) { const int ct = 2 * (w & 1) + c2; f32x4 acc = (f32x4){0.f, 0.f, 0.f, 0.f};
#pragma unroll
              for (int ks = 0; ks < 4; ++ks) { const bf16x8 a = *(const bf16x8*)(Qs + (16 * rt + fr) * 136 + 8 * fq + 32 * ks), bb = *(const bf16x8*)(Ks + (16 * ct + fr) * 136 + 8 * fq + 32 * ks); acc = MFMA16(a, bb, acc); }
              const int s = 16 * ct + fr; const float as = av[s];
#pragma unroll
              for (int r = 0; r < 4; ++r) { const int t = 16 * rt + 4 * fq + r; const float p = (s <= t) ? acc[r] * __expf(as - pmv[t]) : 0.f; Ps[t * 72 + s] = (bf16)f2bf(p); } } }
        __syncthreads();
        if (w < 4) { const int rt = w; f32x4 ni[9], ne[9];
#pragma unroll
            for (int ct = 0; ct < 9; ++ct) { ni[ct] = (f32x4){0.f, 0.f, 0.f, 0.f}; ne[ct] = (f32x4){0.f, 0.f, 0.f, 0.f};
#pragma unroll
                for (int ks = 0; ks < 2; ++ks) { const bf16x8 a = *(const bf16x8*)(Ps + (16 * rt + fr) * 72 + 8 * fq + 32 * ks), bb = *(const bf16x8*)(VTa + (16 * ct + fr) * 72 + 8 * fq + 32 * ks); ni[ct] = MFMA16(a, bb, ni[ct]); }
#pragma unroll
                for (int ks = 0; ks < 4; ++ks) { const bf16x8 a = *(const bf16x8*)(Qs + (16 * rt + fr) * 136 + 8 * fq + 32 * ks), bb = *(const bf16x8*)(P.CB + ((size_t)unit * 144 + 16 * ct + fr) * 128 + 8 * fq + 32 * ks); ne[ct] = MFMA16(a, bb, ne[ct]); } }
            float rinv[4], ss[4];
#pragma unroll
            for (int r = 0; r < 4; ++r) { const int t = 16 * rt + 4 * fq + r; const float pm = pmv[t], wi = __expf(mc - pm);
#pragma unroll
                for (int ct = 0; ct < 9; ++ct) ni[ct][r] += wi * ne[ct][r];
                const float den = __shfl(ni[8][r], lane & 48), fl = __expf(-(bcv[t] + pm)); rinv[r] = 1.0f / fmaxf(fabsf(den), fl); float q = 0.f;
#pragma unroll
                for (int ct = 0; ct < 8; ++ct) { ni[ct][r] *= rinv[r]; q += ni[ct][r] * ni[ct][r]; }
                q += __shfl_xor(q, 1); q += __shfl_xor(q, 2); q += __shfl_xor(q, 4); q += __shfl_xor(q, 8); ss[r] = rsqrtf(q * (1.0f / 128.0f) + 1e-6f); }
#pragma unroll
            for (int ct = 0; ct < 8; ++ct) { const int col = hh * 128 + 16 * ct + fr; const float g = P.gh[col];
#pragma unroll
                for (int r = 0; r < 4; ++r) { const size_t row = (size_t)(rowb + t0 + 16 * rt + 4 * fq + r); P.MIX[row * 1024 + col] = (bf16)f2bf(ni[ct][r] * ss[r] * g * bf2f(P.OG[row * 512 + col])); } } }
        __syncthreads();
    }
}
__device__ __forceinline__ void dsa_prep(Frame& F, const EvenPtrs& P) {
    bf16* LAT = (bf16*)F.gl;
    const int lane = F.lane, w = F.wave, fr = lane & 15, fq = lane >> 4;
    for (int tile = F.bid; tile < M / 64; tile += F.G) {
        const int row0 = tile * 64, b = row0 >> 11, s0 = row0 & 2047;
        for (int i = 0; i < 8; ++i) { const int tok = w * 8 + i; const size_t row = (size_t)(row0 + tok);
            const f32x2 x = *(const f32x2*)(P.MISC + row * 256 + 2 * lane); const float ss = wave_sum(x.x * x.x + x.y * x.y), r = rsqrtf(ss * (1.0f / 128.0f) + 1e-6f);
            const f32x2 g = *(const f32x2*)(P.gkv + 2 * lane);
            *(unsigned*)(LAT + tok * 136 + 2 * lane) = pk2(x.x * r * g.x, x.y * r * g.y);
            }
        __syncthreads();
        if (w < 4) { const int rt = w; f32x4 acc[4]; float q[4] = {0.f, 0.f, 0.f, 0.f};
#pragma unroll
            for (int ct = 0; ct < 4; ++ct) { acc[ct] = (f32x4){0.f, 0.f, 0.f, 0.f};
#pragma unroll
                for (int ks = 0; ks < 4; ++ks) { const bf16x8 a = *(const bf16x8*)(LAT + (16 * rt + fr) * 136 + 8 * fq + 32 * ks), bb = *(const bf16x8*)(P.WukT + (16 * ct + fr) * 128 + 8 * fq + 32 * ks); acc[ct] = MFMA16(a, bb, acc[ct]); }
#pragma unroll
                for (int r = 0; r < 4; ++r) q[r] += acc[ct][r] * acc[ct][r]; }
#pragma unroll
            for (int r = 0; r < 4; ++r) { float s = q[r]; s += __shfl_xor(s, 1); s += __shfl_xor(s, 2); s += __shfl_xor(s, 4); s += __shfl_xor(s, 8); q[r] = rsqrtf(s * (1.0f / 64.0f) + 1e-6f); }
#pragma unroll
            for (int ct = 0; ct < 4; ++ct) { const float g = P.gk[16 * ct + fr];
#pragma unroll
                for (int r = 0; r < 4; ++r) P.KB[(size_t)(row0 + 16 * rt + 4 * fq + r) * 64 + 16 * ct + fr] = (bf16)f2bf(acc[ct][r] * q[r] * g); } }
        for (int i = 0; i < 4; ++i) { const int rt = w + 8 * i;
#pragma unroll
            for (int ct = 0; ct < 4; ++ct) { f32x4 acc = (f32x4){0.f, 0.f, 0.f, 0.f};
#pragma unroll
                for (int ks = 0; ks < 4; ++ks) { const bf16x8 a = *(const bf16x8*)(P.WuvT + (size_t)(16 * rt + fr) * 128 + 8 * fq + 32 * ks), bb = *(const bf16x8*)(LAT + (16 * ct + fr) * 136 + 8 * fq + 32 * ks); acc = MFMA16(a, bb, acc); }
#pragma unroll
                for (int r = 0; r < 4; ++r) { const int hd = 16 * rt + 4 * fq + r; P.VT[((size_t)(b * 8 + (hd >> 6)) * 64 + (hd & 63)) * 2048 + s0 + 16 * ct + fr] = (bf16)f2bf(acc[r]); } } }
        __syncthreads();
    }
}
__device__ __forceinline__ void dsa_index(Frame& F, const EvenPtrs& P) {
    const int lane = F.lane, fr = lane & 15, fq = lane >> 4;
    for (int uid = F.gw; uid < BATCH * 576; uid += F.NGW) {
        const int b = uid / 576, rr0 = uid - b * 576; int gq = 0;
        while (gq < 7 && 8 * (gq + 1) * (gq + 2) <= rr0) ++gq;
        const int rr = rr0 - 8 * gq * (gq + 1), qt = gq * 16 + rr / (gq + 1), kc = rr % (gq + 1);
        const int t0 = qt * 16; int nkt = ((t0 + 15 - kc * 256) >> 4) + 1; if (nkt > 16) nkt = 16;
        const size_t rowq = (size_t)b * SEQ + t0 + fr;
        bf16x8 qf[8][2]; float wq[8];
#pragma unroll
        for (int hh = 0; hh < 8; ++hh)
#pragma unroll
            for (int ks = 0; ks < 2; ++ks) qf[hh][ks] = *(const bf16x8*)(P.BQI + rowq * 512 + hh * 64 + 32 * ks + 8 * fq);
        { const f32x4 w0 = *(const f32x4*)(P.MISC + rowq * 256 + 200), w1 = *(const f32x4*)(P.MISC + rowq * 256 + 204); wq[0] = w0.x; wq[1] = w0.y; wq[2] = w0.z; wq[3] = w0.w; wq[4] = w1.x; wq[5] = w1.y; wq[6] = w1.z; wq[7] = w1.w; }
        for (int kt = 0; kt < nkt; ++kt) { const int sk = kc * 256 + kt * 16; const size_t rowk = (size_t)b * SEQ + sk + fr;
            const bf16x8 a0 = *(const bf16x8*)(P.KIB + rowk * 64 + 8 * fq), a1 = *(const bf16x8*)(P.KIB + rowk * 64 + 32 + 8 * fq);
            f32x4 sc = (f32x4){0.f, 0.f, 0.f, 0.f};
#pragma unroll
            for (int hh = 0; hh < 8; ++hh) { f32x4 acc = MFMA16(a0, qf[hh][0], ((f32x4){0.f, 0.f, 0.f, 0.f})); acc = MFMA16(a1, qf[hh][1], acc);
                sc.x += wq[hh] * fmaxf(acc.x, 0.f); sc.y += wq[hh] * fmaxf(acc.y, 0.f); sc.z += wq[hh] * fmaxf(acc.z, 0.f); sc.w += wq[hh] * fmaxf(acc.w, 0.f); }
            *(f32x4*)(P.ISC + rowq * 2048 + sk + 4 * fq) = sc; }
    }
}
__device__ __forceinline__ unsigned fkey(float f) { const unsigned u = __float_as_uint(f); return (u & 0x80000000u) ? ~u : (u | 0x80000000u); }
__device__ __forceinline__ void dsa_select(Frame& F, const EvenPtrs& P) {
    const int lane = F.lane;
    for (int k = 0; k < BATCH; ++k) {
        const int gwid = F.gw & 2047; if (F.gw >= 2048) break;
        const int t = (k & 1) ? 2047 - gwid : gwid; const size_t row = (size_t)k * SEQ + t; const int n = t + 1, nj = (n + 63) >> 6;
        unsigned long long* mo = (unsigned long long*)(P.MASK + row * 64);
        if (n <= 256) {
#pragma unroll
            for (int j = 0; j < 32; ++j) { const unsigned long long m = __ballot(64 * j + lane <= t); if (lane == 0) mo[j] = m; }
            continue; }
        unsigned key[32];
#pragma unroll
        for (int j = 0; j < 32; ++j) { key[j] = 0u; if (j < nj) { const int s = 64 * j + lane; const float x = P.ISC[row * 2048 + s]; key[j] = (s <= t) ? fkey(x) : 0u; } }
        unsigned T = 0u;
        for (int bit = 31; bit >= 0; --bit) { const unsigned cand = T | (1u << bit); int cnt = 0;
#pragma unroll
            for (int j = 0; j < 32; ++j) if (j < nj) cnt += __popcll(__ballot(key[j] >= cand));
            if (cnt >= 256) T = cand; }
        int cgt = 0;
#pragma unroll
        for (int j = 0; j < 32; ++j) if (j < nj) cgt += __popcll(__ballot(key[j] > T));
        const int need = 256 - cgt; int run = 0; const unsigned long long lt = (lane == 0) ? 0ull : (~0ull >> (64 - lane));
#pragma unroll
        for (int j = 0; j < 32; ++j) { unsigned long long m = 0ull;
            if (j < nj) { const unsigned long long eq = __ballot(key[j] == T); const int before = run + __popcll(eq & lt); const bool sel = (key[j] > T) || (key[j] == T && before < need); m = __ballot(sel); run += __popcll(eq); }
            if (lane == 0) mo[j] = m; }
    }
}
__device__ __forceinline__ void dsa_attn(Frame& F, const EvenPtrs& P) {
    const int lane = F.lane, fr = lane & 15, fq = lane >> 4;
    for (int uid = F.gw; uid < 8192; uid += F.NGW) {
        const int k4 = uid >> 11, gwid = uid & 2047, bh = gwid >> 5, qsel = gwid & 31, b = bh >> 3, hh = bh & 7;
        const int qt = (k4 == 0) ? qsel : (k4 == 1) ? 63 - qsel : (k4 == 2) ? 64 + qsel : 127 - qsel;
        const int t0 = qt * 16, t = t0 + fr; const size_t rowq = (size_t)b * SEQ + t;
        bf16x8 qf[2];
        { const v4u w0 = *(const v4u*)(P.BQ + rowq * 512 + hh * 64 + 8 * fq), w1 = *(const v4u*)(P.BQ + rowq * 512 + hh * 64 + 32 + 8 * fq);
          float x[16] = {bflo(w0.x), bfhi(w0.x), bflo(w0.y), bfhi(w0.y), bflo(w0.z), bfhi(w0.z), bflo(w0.w), bfhi(w0.w), bflo(w1.x), bfhi(w1.x), bflo(w1.y), bfhi(w1.y), bflo(w1.z), bfhi(w1.z), bflo(w1.w), bfhi(w1.w)};
          float ss = 0.f;
#pragma unroll
          for (int j = 0; j < 16; ++j) ss += x[j] * x[j];
          ss += __shfl_xor(ss, 16); ss += __shfl_xor(ss, 32);
          const float r = rsqrtf(ss * (1.0f / 64.0f) + 1e-6f) * (0.125f * LOG2E);
          const f32x4 g0 = *(const f32x4*)(P.gq + 8 * fq), g1 = *(const f32x4*)(P.gq + 8 * fq + 4), g2 = *(const f32x4*)(P.gq + 32 + 8 * fq), g3 = *(const f32x4*)(P.gq + 32 + 8 * fq + 4);
          v4u q0, q1; q0.x = pk2(x[0] * r * g0.x, x[1] * r * g0.y); q0.y = pk2(x[2] * r * g0.z, x[3] * r * g0.w); q0.z = pk2(x[4] * r * g1.x, x[5] * r * g1.y); q0.w = pk2(x[6] * r * g1.z, x[7] * r * g1.w);
          q1.x = pk2(x[8] * r * g2.x, x[9] * r * g2.y); q1.y = pk2(x[10] * r * g2.z, x[11] * r * g2.w); q1.z = pk2(x[12] * r * g3.x, x[13] * r * g3.y); q1.w = pk2(x[14] * r * g3.z, x[15] * r * g3.w);
          qf[0] = __builtin_bit_cast(bf16x8, q0); qf[1] = __builtin_bit_cast(bf16x8, q1); }
        f32x4 o[4]; o[0] = o[1] = o[2] = o[3] = (f32x4){0.f, 0.f, 0.f, 0.f};
        float mrun = -INFINITY, lrun = 0.f;
        const unsigned* mrow = P.MASK + rowq * 64; const float* btab = P.bt + hh * 128;
        const bf16* vbase = P.VT + ((size_t)(b * 8 + hh) * 64) * 2048;
        const int ntile = ((t0 + 15) >> 5) + 1;
        for (int kt = 0; kt < ntile; ++kt) { const int s0 = kt * 32; const unsigned mw = mrow[kt];
            float p[8];
#pragma unroll
            for (int st = 0; st < 2; ++st) { const size_t rowk = (size_t)b * SEQ + s0 + 16 * st + fr;
                const bf16x8 a0 = *(const bf16x8*)(P.KB + rowk * 64 + 8 * fq), a1 = *(const bf16x8*)(P.KB + rowk * 64 + 32 + 8 * fq);
                f32x4 acc = MFMA16(a0, qf[0], ((f32x4){0.f, 0.f, 0.f, 0.f})); acc = MFMA16(a1, qf[1], acc);
#pragma unroll
                for (int r = 0; r < 4; ++r) { const int kl = 16 * st + 4 * fq + r; int dist = t - (s0 + kl); dist = dist < 0 ? 0 : (dist > 127 ? 127 : dist);
                    p[4 * st + r] = ((mw >> kl) & 1u) ? acc[r] + btab[dist] : -INFINITY; } }
            float mx = fmaxf(fmaxf(fmaxf(p[0], p[1]), fmaxf(p[2], p[3])), fmaxf(fmaxf(p[4], p[5]), fmaxf(p[6], p[7])));
            mx = fmaxf(mx, __shfl_xor(mx, 16)); mx = fmaxf(mx, __shfl_xor(mx, 32));
            const float mnew = fmaxf(mrun, mx); float alpha = 1.f, psum = 0.f;
            if (mnew == -INFINITY) {
#pragma unroll
                for (int j = 0; j < 8; ++j) p[j] = 0.f;
            } else { alpha = __builtin_amdgcn_exp2f(mrun - mnew);
#pragma unroll
                for (int j = 0; j < 8; ++j) { p[j] = __builtin_amdgcn_exp2f(p[j] - mnew); psum += p[j]; } }
            mrun = mnew; lrun = lrun * alpha + psum;
            v4u pw; pw.x = pk2(p[0], p[1]); pw.y = pk2(p[2], p[3]); pw.z = pk2(p[4], p[5]); pw.w = pk2(p[6], p[7]); const bf16x8 pf = __builtin_bit_cast(bf16x8, pw);
#pragma unroll
            for (int dt = 0; dt < 4; ++dt) { const bf16* vp = vbase + (size_t)(16 * dt + fr) * 2048 + s0 + 4 * fq; const v2u lo = *(const v2u*)vp, hi = *(const v2u*)(vp + 16);
                v4u vv; vv.x = lo.x; vv.y = lo.y; vv.z = hi.x; vv.w = hi.y; o[dt] = o[dt] * alpha; o[dt] = MFMA16(__builtin_bit_cast(bf16x8, vv), pf, o[dt]); } }
        lrun += __shfl_xor(lrun, 16); lrun += __shfl_xor(lrun, 32); const float linv = 1.0f / lrun;
#pragma unroll
        for (int dt = 0; dt < 4; ++dt) { v2u w; w.x = pk2(o[dt].x * linv, o[dt].y * linv); w.y = pk2(o[dt].z * linv, o[dt].w * linv); *(v2u*)(P.MIX + rowq * 1024 + 512 + hh * 64 + 16 * dt + 4 * fq) = w; }
    }
}
__device__ __forceinline__ void pool_prep(Frame& F, const float* stats, const float* gmix, bf16* POOLED) {
    float* rl = (float*)F.gl;
    for (int tile = F.bid; tile < M / 64; tile += F.G) {
        const int row0 = tile * 64, tpos0 = row0 & 2047;
        if (F.tid < 79) { const int row = row0 - 15 + F.tid; float r = 0.f;
            if (tpos0 - 15 + F.tid >= 0) { const f32x4* p = (const f32x4*)(stats + (size_t)row * 16); const f32x4 a = p[0], b = p[1], c = p[2], d = p[3];
                const float s = (((a.x + a.y) + (a.z + a.w)) + ((b.x + b.y) + (b.z + b.w))) + (((c.x + c.y) + (c.z + c.w)) + ((d.x + d.y) + (d.z + d.w))); r = rsqrtf(s * (1.0f / 1024.0f) + 1e-6f); }
            rl[F.tid] = r; }
        __syncthreads();
        for (int it = F.tid; it < 64 * 128; it += 512) { const int tok = it >> 7, c0 = (it & 127) * 8, g = c0 >> 8, win = 2 << g, tpos = tpos0 + tok; const int n = (tpos + 1 < win) ? tpos + 1 : win;
            float acc[8] = {0.f, 0.f, 0.f, 0.f, 0.f, 0.f, 0.f, 0.f}, y0[8];
            for (int j = 0; j < n; ++j) { const float* hp = F.out + (size_t)(row0 + tok - j) * DM + c0; const f32x4 a = *(const f32x4*)hp, b = *(const f32x4*)(hp + 4); const float r = rl[15 + tok - j];
                const float v[8] = {a.x * r, a.y * r, a.z * r, a.w * r, b.x * r, b.y * r, b.z * r, b.w * r};
#pragma unroll
                for (int q = 0; q < 8; ++q) { acc[q] += v[q]; if (j == 0) y0[q] = v[q]; } }
            const float inv = 1.0f / (float)n; const f32x4 g0 = *(const f32x4*)(gmix + c0), g1 = *(const f32x4*)(gmix + c0 + 4);
            v4u o; o.x = pk2((acc[0] * inv - y0[0]) * g0.x, (acc[1] * inv - y0[1]) * g0.y); o.y = pk2((acc[2] * inv - y0[2]) * g0.z, (acc[3] * inv - y0[3]) * g0.w);
            o.z = pk2((acc[4] * inv - y0[4]) * g1.x, (acc[5] * inv - y0[5]) * g1.y); o.w = pk2((acc[6] * inv - y0[6]) * g1.z, (acc[7] * inv - y0[7]) * g1.w);
            *(v4u*)(POOLED + ((size_t)g * M + row0 + tok) * 256 + (c0 & 255)) = o; }
        __syncthreads();
    }
}
struct RoutePtrs { int* TOKE; float* TOKG; float* TOKR; int* CNT; int* ROWTS; float* ROWG; float* ROWR; int* TILEE; int* NT; };
__device__ __forceinline__ RoutePtrs route_ptrs(unsigned char* ws) { unsigned char* r = ws + WS_ROUTE; RoutePtrs p;
    p.TOKE = (int*)(r + RT_TOKE); p.TOKG = (float*)(r + RT_TOKG); p.TOKR = (float*)(r + RT_TOKR); p.CNT = (int*)(r + RT_CNT); p.ROWTS = (int*)(r + RT_ROWTS); p.ROWG = (float*)(r + RT_ROWG); p.ROWR = (float*)(r + RT_ROWR);
    p.TILEE = (int*)(r + RT_TILEE); p.NT = (int*)(r + RT_NT); return p; }
__device__ __forceinline__ void moe_route(Frame& F, const RoutePtrs& R, const float* gffn, const float* wr, const float* br) {
    int* cnt = (int*)F.gl;
    for (int tile = F.bid; tile < M / 64; tile += F.G) {
        if (F.tid < 8) cnt[F.tid] = 0;
        __syncthreads();
        for (int i = 0; i < 8; ++i) { const int row = tile * 64 + F.wave * 8 + i; const f32x4* hr = (const f32x4*)(F.out + (size_t)row * DM) + F.lane; f32x4 v[4]; float ss = 0.f;
#pragma unroll
            for (int j = 0; j < 4; ++j) { v[j] = hr[64 * j]; ss += (v[j].x * v[j].x + v[j].y * v[j].y) + (v[j].z * v[j].z + v[j].w * v[j].w); }
            ss = wave_sum(ss); const float r = rsqrtf(ss * (1.0f / 1024.0f) + 1e-6f);
            float lg[8] = {0.f, 0.f, 0.f, 0.f, 0.f, 0.f, 0.f, 0.f};
#pragma unroll
            for (int j = 0; j < 4; ++j) { const int c0 = 4 * F.lane + 256 * j; const f32x4 g = *(const f32x4*)(gffn + c0); const float y[4] = {v[j].x * r * g.x, v[j].y * r * g.y, v[j].z * r * g.z, v[j].w * r * g.w};
#pragma unroll
                for (int q = 0; q < 4; ++q) { const f32x4 w0 = *(const f32x4*)(wr + (size_t)(c0 + q) * 8), w1 = *(const f32x4*)(wr + (size_t)(c0 + q) * 8 + 4);
                    lg[0] += y[q] * w0.x; lg[1] += y[q] * w0.y; lg[2] += y[q] * w0.z; lg[3] += y[q] * w0.w; lg[4] += y[q] * w1.x; lg[5] += y[q] * w1.y; lg[6] += y[q] * w1.z; lg[7] += y[q] * w1.w; } }
#pragma unroll
            for (int e = 0; e < 8; ++e) lg[e] = wave_sum(lg[e]) + br[e];
            int e1 = 0; float v1 = lg[0];
#pragma unroll
            for (int e = 1; e < 8; ++e) if (lg[e] > v1) { v1 = lg[e]; e1 = e; }
            int e2 = -1; float v2 = -INFINITY;
#pragma unroll
            for (int e = 0; e < 8; ++e) if (e != e1 && lg[e] > v2) { v2 = lg[e]; e2 = e; }
            const float ex = __expf(v2 - v1), g1 = 1.0f / (1.0f + ex), g2 = ex * g1;
            if (F.lane == 0) { R.TOKE[row] = e1 | (e2 << 8); R.TOKG[row * 2] = g1; R.TOKG[row * 2 + 1] = g2; R.TOKR[row] = r; atomicAdd(&cnt[e1], 1); atomicAdd(&cnt[e2], 1); } }
        __syncthreads();
        if (F.tid < 8) R.CNT[tile * 8 + F.tid] = cnt[F.tid];
        __syncthreads();
    }
}
__device__ __forceinline__ void moe_scatter(Frame& F, const RoutePtrs& R, const bf16* HB, bf16* YG) {
    int* sm = (int*)F.gl;
    for (int tile = F.bid; tile < M / 64; tile += F.G) {
        if (F.tid < 16) sm[F.tid] = 0;
        __syncthreads();
        for (int i = F.tid; i < (M / 64) * 8; i += 512) { const int v = R.CNT[i]; atomicAdd(&sm[i & 7], v); if ((i >> 3) < tile) atomicAdd(&sm[8 + (i & 7)], v); }
        __syncthreads();
        if (F.tid == 0) { int base = 0; for (int e = 0; e < 8; ++e) { sm[16 + e] = base; base += (sm[e] + 255) & ~255; } sm[24] = base >> 8; }
        __syncthreads();
        if (F.wave == 0) { const int row = tile * 64 + F.lane, te = R.TOKE[row], e1 = te & 255, e2 = te >> 8; int p1 = 0, p2 = 0; const unsigned long long lt = (F.lane == 0) ? 0ull : (~0ull >> (64 - F.lane));
#pragma unroll
            for (int e = 0; e < 8; ++e) { const unsigned long long m1 = __ballot(e1 == e), m2 = __ballot(e2 == e); const int rk = __popcll(m1 & lt) + __popcll(m2 & lt), bs = sm[16 + e] + sm[8 + e];
                if (e1 == e) p1 = bs + rk; if (e2 == e) p2 = bs + rk; }
            const float r = R.TOKR[row]; R.ROWTS[p1] = row * 2; R.ROWTS[p2] = row * 2 + 1; R.ROWG[p1] = R.TOKG[row * 2]; R.ROWG[p2] = R.TOKG[row * 2 + 1]; R.ROWR[p1] = r; R.ROWR[p2] = r;
            sm[32 + 2 * F.lane] = p1; sm[33 + 2 * F.lane] = p2; }
        __syncthreads();
        for (int i = 0; i < 16; ++i) { const int cp = F.wave * 16 + i, tok = cp >> 1, pos = sm[32 + cp]; const v4u* src = (const v4u*)(HB + (size_t)(tile * 64 + tok) * DM); v4u* dst = (v4u*)(YG + (size_t)pos * DM);
            dst[F.lane] = src[F.lane]; dst[64 + F.lane] = src[64 + F.lane]; }
        if (tile == 0) {
            for (int e = 0; e < 8; ++e) { const int lo = sm[16 + e] + sm[e], hi = sm[16 + e] + ((sm[e] + 255) & ~255);
                for (int p = lo + F.tid; p < hi; p += 512) { R.ROWTS[p] = -1; R.ROWG[p] = 0.f; R.ROWR[p] = 0.f; }
                for (int t2 = (sm[16 + e] >> 8) + F.tid; t2 < (hi >> 8); t2 += 512) R.TILEE[t2] = e; }
            if (F.tid == 0) R.NT[0] = sm[24]; }
        __syncthreads();
    }
}
__device__ __forceinline__ void moe_combine(Frame& F, const bf16* D0, const bf16* D1, bf16* HB, float* stats) {
    for (int m = F.gw; m < M; m += F.NGW) { f32x4* hr = (f32x4*)(F.out + (size_t)m * DM) + F.lane; const v2u* a = (const v2u*)(D0 + (size_t)m * DM) + F.lane; const v2u* b = (const v2u*)(D1 + (size_t)m * DM) + F.lane;
        v2u* o8 = (v2u*)(HB + (size_t)m * DM) + F.lane; float s = 0.f;
#pragma unroll
        for (int j = 0; j < 4; ++j) { f32x4 v = hr[64 * j]; const v2u x = a[64 * j], y = b[64 * j];
            v.x += bflo(x.x) + bflo(y.x); v.y += bfhi(x.x) + bfhi(y.x); v.z += bflo(x.y) + bflo(y.y); v.w += bfhi(x.y) + bfhi(y.y);
            hr[64 * j] = v; s += (v.x * v.x + v.y * v.y) + (v.z * v.z + v.w * v.w); v2u w; w.x = pk2(v.x, v.y); w.y = pk2(v.z, v.w); o8[64 * j] = w; }
        s = wave_sum(s);
        if (F.lane < 16) stats[(size_t)m * 16 + F.lane] = (F.lane == 0) ? s : 0.f; }
}
constexpr int N_PHASES = 35;
static_assert(WS_VB == WS_QK + 32 * MiB && WS_OG == WS_VB + 16 * MiB && WS_BQ == WS_OG + 16 * MiB && WS_BQI == WS_BQ + 16 * MiB, "EpiIn address arithmetic");
#ifndef PHASE_SEL
#define PHASE_SEL -1
#endif
#define PHEN(r) (PHASE_SEL < 0 || PHASE_SEL == (r))
#define IN(k) (lo <= (k) && (k) < hi)
#define SEAM(k) do { if ((k) + 1 < hi) { XcdBarrier b2_ = bar; asm volatile("" : "+s"(b2_.bar)); xcd_barrier(b2_); } } while (0)
#define HBSEL(i) ((bf16*)(ws + ((i) ? WS_HB1 : WS_HB0)))
#define STSEL(i) ((float*)(ws + WS_STATS + ((i) ? MiB : (size_t)0)))
template <int lp> __device__ __forceinline__ void layer_pair(Frame& F, const Args& args, const XcdBarrier& bar, const int lo, const int hi, LAS unsigned char* ring, const int K256) {
    unsigned char* ws = F.ws; bf16* Eb = (bf16*)(ws + WS_E);
        const int pb = 1 + 17 * lp;
        int hbi = 0, si = 0;
        if (PHEN(0) && IN(pb + 0)) { if (lp == 1) conv_moe(F, args, 1); SEAM(pb + 0); }
        {
            const int e = lp, li = 2 * lp;
            EvenPtrs P;
            P.QK = (const bf16*)(ws + WS_QK); P.VB = (const bf16*)(ws + WS_VB); P.OG = (const bf16*)(ws + WS_OG); P.BQ = (const bf16*)(ws + WS_BQ); P.BQI = (const bf16*)(ws + WS_BQI); P.MISC = (const float*)(ws + WS_MISC);
            P.MIX = (bf16*)(ws + WS_MIX); P.KB = (bf16*)(ws + WS_KB); P.KIB = (bf16*)(ws + WS_KIB); P.VT = (bf16*)(ws + WS_VT); P.MASK = (unsigned*)(ws + WS_MASK); P.CHS = (float*)(ws + WS_CHS); P.MST = (float*)(ws + WS_CHS + 65536);
            P.ISC = (float*)(ws + WS_ISC); P.U = (float*)(ws + WS_U); P.CB = (bf16*)(ws + WS_CB);
            P.bgate = INP(IN_B_GATE) + e * 8; P.conv = INP(IN_CONV) + e * 4 * 1024; P.gh = INP(IN_NORM_H) + e * 512; P.gq = INP(IN_NORM_Q) + e * 64; P.gk = INP(IN_NORM_K) + e * 64; P.gkv = INP(IN_NORM_KV) + e * 128;
            P.WukT = (const bf16*)(ws + WS_SMALL + 8192) + (size_t)e * 64 * 128; P.WuvT = (const bf16*)(ws + WS_SMALL + 65536) + (size_t)e * 512 * 128; P.bt = (const float*)(ws + WS_SMALL);
            if (PHEN(1) && IN(pb + 1)) {
                pg8::Gemm g{HBSEL(hbi), (const bf16*)(ws + WS_W_IN) + (size_t)e * NINP * DM, M, NINP, DM}; pg8::StaticOrder S; S.init(M, NINP, F.G, F.bid);
                pg8::EpiIn E{STSEL(si), (bf16*)(ws + WS_QK), (float*)(ws + WS_MISC), (bf16*)(ws + WS_KIB)};
                pg8::gemm_phase<pg8::EpiIn, pg8::StaticOrder, true, true>(ring, g, S, E);
                SEAM(pb + 1); }
            if (PHEN(2) && IN(pb + 2)) { mlstm_a(F, P); dsa_prep(F, P); dsa_index(F, P); SEAM(pb + 2); }
            if (PHEN(3) && IN(pb + 3)) { mlstm_b(F, P); dsa_select(F, P); SEAM(pb + 3); }
            if (PHEN(4) && IN(pb + 4)) { mlstm_c(F, P); dsa_attn(F, P); SEAM(pb + 4); }
            if (PHEN(5) && IN(pb + 5)) {
                { pg8::Gemm g{(const bf16*)(ws + WS_MIX), (const bf16*)(ws + WS_W_OUT) + (size_t)e * DM * DM, M, DM, DM}; pg8::StaticOrder S; S.init(M, DM, F.G, F.bid);
                  pg8::EpiResid<0> E{F.out, HBSEL(hbi), STSEL(si ^ 1), nullptr, nullptr, nullptr};
                  pg8::gemm_phase<pg8::EpiResid<0>, pg8::StaticOrder, true, true>(ring, g, S, E); }
                { pg8::Gemm g{(const bf16*)(ws + WS_PB) + (size_t)li * M * PLED, (const bf16*)(ws + WS_W_PL) + (size_t)li * DM * PLED, M, DM, K256}; pg8::StaticOrder S; S.init(M, DM, F.G, F.bid);
                  pg8::EpiStore E{Eb, DM};
                  pg8::gemm_phase<pg8::EpiStore, pg8::StaticOrder, true, true>(ring, g, S, E); }
                SEAM(pb + 5); }
            si ^= 1;
            if (PHEN(6) && IN(pb + 6)) {
                pg8::Gemm g{HBSEL(hbi), (const bf16*)(ws + WS_W_GU) + (size_t)e * 7168 * DM, M, 7168, DM}; pg8::StaticOrder S; S.init(M, 7168, F.G, F.bid);
                pg8::EpiGLU<false> E{STSEL(si), nullptr, (bf16*)(ws + WS_ACT)};
                pg8::gemm_phase<pg8::EpiGLU<false>, pg8::StaticOrder, true, true>(ring, g, S, E);
                SEAM(pb + 6); }
            if (PHEN(7) && IN(pb + 7)) {
                pg8::Gemm g{(const bf16*)(ws + WS_ACT), (const bf16*)(ws + WS_W_DN) + (size_t)e * DM * DFF, M, DM, DFF}; pg8::StaticOrder S; S.init(M, DM, F.G, F.bid);
                pg8::EpiResid<0> E{F.out, HBSEL(hbi), STSEL(si ^ 1), nullptr, nullptr, nullptr};
                pg8::gemm_phase<pg8::EpiResid<0>, pg8::StaticOrder, true, true>(ring, g, S, E);
                SEAM(pb + 7); }
            si ^= 1;
            if (PHEN(8) && IN(pb + 8)) {
                pg8::Gemm g{HBSEL(hbi), (const bf16*)(ws + WS_W_PG) + (size_t)li * DM * DM, M, DM, DM}; pg8::StaticOrder S; S.init(M, DM, F.G, F.bid);
                pg8::EpiResid<2> E{F.out, HBSEL(hbi ^ 1), STSEL(si ^ 1), STSEL(si), Eb, nullptr};
                pg8::gemm_phase<pg8::EpiResid<2>, pg8::StaticOrder, true, true>(ring, g, S, E);
                SEAM(pb + 8); }
            si ^= 1; hbi ^= 1;
        }
        {
            const int o = lp, li = 2 * lp + 1;
            const RoutePtrs R = route_ptrs(ws);
            if (PHEN(9) && IN(pb + 9)) {
                pool_prep(F, STSEL(si), INP(IN_NORM_MIX) + li * DM, (bf16*)(ws + WS_POOLED));
                { pg8::Gemm g{(const bf16*)(ws + WS_PB) + (size_t)li * M * PLED, (const bf16*)(ws + WS_W_PL) + (size_t)li * DM * PLED, M, DM, K256}; pg8::StaticOrder S; S.init(M, DM, F.G, F.bid);
                  pg8::EpiStore E{Eb, DM};
                  pg8::gemm_phase<pg8::EpiStore, pg8::StaticOrder, true, true>(ring, g, S, E); }
                SEAM(pb + 9); }
            if (PHEN(10) && IN(pb + 10)) {
                pg8::Gemm g{(const bf16*)(ws + WS_POOLED), (const bf16*)(ws + WS_W_POOL) + (size_t)o * 4 * 256 * 256, 4 * M, 1024, K256}; pg8::PoolOrder S{F.G, F.bid};
                pg8::EpiResid<1> E{F.out, HBSEL(hbi), STSEL(si ^ 1), nullptr, nullptr, INP(IN_SCALE_POOL) + o * DM};
                pg8::gemm_phase<pg8::EpiResid<1>, pg8::PoolOrder, true, true>(ring, g, S, E);
                SEAM(pb + 10); }
            si ^= 1;
            if (PHEN(11) && IN(pb + 11)) { moe_route(F, R, INP(IN_NORM_FFN) + li * DM, INP(IN_W_ROUTER) + (size_t)o * DM * 8, INP(IN_B_ROUTER) + o * 8); SEAM(pb + 11); }
            if (PHEN(12) && IN(pb + 12)) { moe_scatter(F, R, HBSEL(hbi), (bf16*)(ws + WS_YG)); SEAM(pb + 12); }
            if (PHEN(13) && IN(pb + 13)) {
                const int nt = __builtin_amdgcn_readfirstlane(R.NT[0]);
                pg8::Gemm g{(const bf16*)(ws + WS_YG), (const bf16*)(ws + WS_W_MGU), MAXROWS, 8 * 7168, DM}; pg8::MoeOrder S{R.TILEE, nt, 28, F.G, F.bid};
                pg8::EpiGLU<true> E{nullptr, R.ROWR, (bf16*)(ws + WS_ACTM)};
                pg8::gemm_phase<pg8::EpiGLU<true>, pg8::MoeOrder, true, true>(ring, g, S, E);
                SEAM(pb + 13); }
            if (PHEN(14) && IN(pb + 14)) {
                const int nt = __builtin_amdgcn_readfirstlane(R.NT[0]);
                pg8::Gemm g{(const bf16*)(ws + WS_ACTM), (const bf16*)(ws + WS_W_MDN), MAXROWS, 8 * 1024, DFF}; pg8::MoeOrder S{R.TILEE, nt, 4, F.G, F.bid};
                pg8::EpiScatter E{R.ROWTS, R.ROWG, (bf16*)(ws + WS_D0), (bf16*)(ws + WS_D1)};
                pg8::gemm_phase<pg8::EpiScatter, pg8::MoeOrder, true, true>(ring, g, S, E);
                SEAM(pb + 14); }
            if (PHEN(15) && IN(pb + 15)) { moe_combine(F, (const bf16*)(ws + WS_D0), (const bf16*)(ws + WS_D1), HBSEL(hbi), STSEL(si ^ 1)); SEAM(pb + 15); }
            si ^= 1;
            if (PHEN(16) && IN(pb + 16)) {
                pg8::Gemm g{HBSEL(hbi), (const bf16*)(ws + WS_W_PG) + (size_t)li * DM * DM, M, DM, DM}; pg8::StaticOrder S; S.init(M, DM, F.G, F.bid);
                pg8::EpiResid<2> E{F.out, HBSEL(hbi ^ 1), STSEL(si ^ 1), STSEL(si), Eb, nullptr};
                pg8::gemm_phase<pg8::EpiResid<2>, pg8::StaticOrder, true, true>(ring, g, S, E);
                SEAM(pb + 16); }
            si ^= 1; hbi ^= 1;
        }

}
__global__ void __launch_bounds__(NWAVES * 64, 2) fwd(Args args) {
    extern __shared__ __attribute__((aligned(16))) unsigned char lds[];
    Frame F;
    F.lds = (LAS unsigned char*)lds; F.gl = lds; F.MISCW = (volatile LAS unsigned*)(F.lds + MISC_OFF);
    F.tid = threadIdx.x; F.lane = F.tid & 63; F.wave = __builtin_amdgcn_readfirstlane(F.tid >> 6); F.G = gridDim.x; F.bid = blockIdx.x; F.gw = F.bid * NWAVES + F.wave; F.NGW = F.G * NWAVES;
    F.out = args.out; F.ws = args.ws;
    unsigned char* ws = args.ws;
    for (int u = F.tid; u < (LDS_BYTES - LDSCTL_OFF) / 4; u += NWAVES * 64) ((LAS unsigned*)(F.lds + LDSCTL_OFF))[u] = 0u;
    __syncthreads();
    XcdBarrier bar = xcd_barrier_post((unsigned*)(ws + WS_CTL) + CW_BAR, F.MISCW + 8);
    const int lo = args.ph_lo, hi = args.ph_hi;
    LAS unsigned char* ring = F.lds;
    int K256 = 256; asm volatile("" : "+s"(K256));

    if (PHEN(100) && IN(0)) { p0_prologue(F, args); SEAM(0); }

    layer_pair<0>(F, args, bar, lo, hi, ring, K256);
    layer_pair<1>(F, args, bar, lo, hi, ring, K256);
#undef IN
#undef SEAM
}

extern "C" void kernel_launch(void* const* d_in, const int* in_sizes, int n_in, void* d_out, int out_size, void* d_ws, size_t ws_size, hipStream_t stream) {
    static int grid = 0;
    if (grid == 0) {
        if (n_in != 28 || in_sizes[0] != M * DM || out_size != M * DM || ws_size < WS_END) { fprintf(stderr, "kernel_launch: unexpected shapes (n_in %d, in0 %d, out %d, ws %zu < %zu); nothing launched\n", n_in, n_in > 0 ? in_sizes[0] : -1, out_size, ws_size, (size_t)WS_END); grid = -1; return; }
        int dev = 0, cus = 0, per_cu = 0;
        if (hipGetDevice(&dev) != hipSuccess || hipDeviceGetAttribute(&cus, hipDeviceAttributeMultiprocessorCount, dev) != hipSuccess) { grid = -1; return; }
        if (hipFuncSetAttribute((const void*)fwd, hipFuncAttributeMaxDynamicSharedMemorySize, LDS_BYTES) != hipSuccess) { fprintf(stderr, "kernel_launch: hipFuncSetAttribute failed\n"); grid = -1; return; }
        if (hipOccupancyMaxActiveBlocksPerMultiprocessor(&per_cu, (const void*)fwd, NWAVES * 64, LDS_BYTES) != hipSuccess || per_cu < 1) fprintf(stderr, "kernel_launch: occupancy query reports %d workgroups per CU\n", per_cu);
        (void)hipGetLastError();
        grid = cus;
    }
    if (grid < 0) return;
    if (hipMemsetAsync((char*)d_ws + WS_CTL, 0, CTL_ZERO_BYTES, stream) != hipSuccess) return;
    Args a{};
    for (int i = 0; i < 28; ++i) a.in[i] = (const float*)d_in[i];
    a.out = (float*)d_out; a.ws = (unsigned char*)d_ws;
#if MK_ONE_LAUNCH
    a.ph_lo = 0; a.ph_hi = N_PHASES;
    hipLaunchKernelGGL(fwd, dim3(grid), dim3(NWAVES * 64), LDS_BYTES, stream, a);
#else
    for (int ph = 0; ph < N_PHASES; ++ph) { if (ph == 1) continue; a.ph_lo = ph; a.ph_hi = ph + 1;
        hipLaunchKernelGGL(fwd, dim3(grid), dim3(NWAVES * 64), LDS_BYTES, stream, a); }
#endif
}
```

```cpp
#include <hip/hip_runtime.h>
#include <cstdio>
#include <cstdint>
#ifndef MK_ONE_LAUNCH
#define MK_ONE_LAUNCH 1
#endif
namespace pg8 {
#define PG8_LAS __attribute__((address_space(3)))
typedef unsigned short bf16_t;
typedef short bf16x8 __attribute__((ext_vector_type(8)));
typedef float f32x4 __attribute__((ext_vector_type(4)));
typedef unsigned u32x4 __attribute__((ext_vector_type(4)));
constexpr int BM = 256, BK = 64, HALF = 128, HTB = HALF * BK * 2  , STAGE_BYTES = 8 * HTB, NXCD = 8, WGM = 8;

__host__ __device__ __forceinline__ int lds_byte(int r, int c) { const int st = (r >> 4) * 2 + (c >> 5), rr = r & 15, cc = c & 31, ob = rr * 64 + cc * 2; return st * 1024 + (ob ^ (((ob >> 9) & 1) << 5)); }
__host__ __device__ __forceinline__ void stage_rc(int b, int& R, int& C) { const int st = b / 1024, sb = b % 1024, swz = sb ^ (((sb >> 9) & 1) << 5); R = (st >> 1) * 16 + swz / 64; C = (st & 1) * 32 + (swz % 64) / 2; }
__host__ __device__ __forceinline__ int perm32(int rho) { const int n = rho >> 4, i = rho & 15; return 8 * (i >> 2) + 4 * n + (i & 3); }

struct Unit { int pm, pn; };
struct Gemm { const bf16_t* A; const bf16_t* Bt; int M, N, K; };

struct StaticOrder {
    int nM, nN, nwg, G, c;
    __host__ __device__ void init(int M, int N, int G_, int c_) { nM = M / BM; nN = N / BM; nwg = nM * nN; G = G_; c = c_; }
    __host__ __device__ bool next(int i, Unit& u) const {
        const long L = (long)i * G + c; if (L >= nwg) return false;
        int wgid = (int)L; { const int q = nwg / NXCD, r = nwg % NXCD, xcd = wgid % NXCD, off = wgid / NXCD; wgid = (xcd < r ? xcd * (q + 1) : r * (q + 1) + (xcd - r) * q) + off; }
        const int nig = WGM * nN, gid = wgid / nig, fm = gid * WGM, gsz = (nM - fm) < WGM ? (nM - fm) : WGM;
        u.pm = fm + ((wgid % nig) % gsz); u.pn = (wgid % nig) / gsz; return true;
    }
    __device__ __forceinline__ void a_ready(const Unit&) const {}
    __device__ __forceinline__ void done(const Unit&) const {}
};
__device__ __forceinline__ unsigned cvt_pk_bf16(float lo, float hi) { unsigned r; asm volatile("v_cvt_pk_bf16_f32 %0, %1, %2" : "=v"(r) : "v"(lo), "v"(hi)); return r; }
typedef float f32x2 __attribute__((ext_vector_type(2)));
constexpr float RMS_EPS = 1e-6f;
__device__ __forceinline__ float fsigmoid(float x) { return __builtin_amdgcn_rcpf(1.0f + __builtin_amdgcn_exp2f(-1.44269504f * x)); }
__device__ __forceinline__ f32x4 sig4(f32x4 v) { f32x4 o; o.x = fsigmoid(v.x); o.y = fsigmoid(v.y); o.z = fsigmoid(v.z); o.w = fsigmoid(v.w); return o; }
__device__ __forceinline__ u32x4 pack8(f32x4 v0, f32x4 v1) { u32x4 w; w.x = cvt_pk_bf16(v0[0], v0[1]); w.y = cvt_pk_bf16(v0[2], v0[3]); w.z = cvt_pk_bf16(v1[0], v1[1]); w.w = cvt_pk_bf16(v1[2], v1[3]); return w; }
__device__ __forceinline__ void unpack8(u32x4 w, f32x4& a, f32x4& b) {
    a.x = __uint_as_float(w.x << 16); a.y = __uint_as_float(w.x & 0xffff0000u); a.z = __uint_as_float(w.y << 16); a.w = __uint_as_float(w.y & 0xffff0000u);
    b.x = __uint_as_float(w.z << 16); b.y = __uint_as_float(w.z & 0xffff0000u); b.z = __uint_as_float(w.w << 16); b.w = __uint_as_float(w.w & 0xffff0000u); }
__device__ __forceinline__ void load_rstd(const float* stats, int rowb, int fr, int fq, float (&rs)[2][4]) {
    float mine[2];
#pragma unroll
    for (int ai = 0; ai < 2; ++ai) { const f32x4* p = (const f32x4*)(stats + (size_t)(rowb + ai * HALF + fq * 16) * 16); const f32x4 a = p[0], b = p[1], c = p[2], d = p[3];
        const float s = (((a.x + a.y) + (a.z + a.w)) + ((b.x + b.y) + (b.z + b.w))) + (((c.x + c.y) + (c.z + c.w)) + ((d.x + d.y) + (d.z + d.w)));
        mine[ai] = rsqrtf(s * (1.0f / 1024.0f) + RMS_EPS); }
#pragma unroll
    for (int ai = 0; ai < 2; ++ai)
#pragma unroll
        for (int m = 0; m < 4; ++m) rs[ai][m] = __shfl(mine[ai], fr + 16 * m);
}
struct EpiIn {
    static constexpr bool PERM = true, AFTER_DRAIN = false;
    const float* stats; bf16_t* QK; float* MISC; bf16_t* KIB;
    __device__ __forceinline__ void operator()(const f32x4 (&acc)[2][2][4][2], const Unit& u, int wr, int wc, int fr, int fq) const {
        const int rowb = u.pm * BM + wr * 64 + fr, cl = wc * 32 + 8 * fq, pn = u.pn;
        float rs[2][4]; load_rstd(stats, rowb, fr, fq, rs);
        if (pn < 12) {
            bf16_t* base; int ld, colt; bool sig = false;
            if (pn < 4) { base = QK; ld = 1024; colt = pn * 256; }
            else { const int t = (pn - 4) >> 1; base = QK + (size_t)16777216 + (size_t)t * 8388608; ld = 512; colt = ((pn - 4) & 1) * 256; sig = (t == 1); }
#pragma unroll
            for (int ai = 0; ai < 2; ++ai)
#pragma unroll
                for (int m = 0; m < 4; ++m) { const float r = rs[ai][m]; bf16_t* rp = base + (size_t)(rowb + ai * HALF + m * 16) * ld + colt + cl;
#pragma unroll
                    for (int bj = 0; bj < 2; ++bj) { f32x4 v0 = acc[ai][bj][m][0] * r, v1 = acc[ai][bj][m][1] * r; if (sig) { v0 = sig4(v0); v1 = sig4(v1); }
                        *(u32x4*)(rp + bj * HALF) = pack8(v0, v1); }
                    asm volatile("" ::: "memory"); }
        } else {
#pragma unroll
            for (int ai = 0; ai < 2; ++ai)
#pragma unroll
                for (int m = 0; m < 4; ++m) { const float r = rs[ai][m]; float* rp = MISC + (size_t)(rowb + ai * HALF + m * 16) * 256 + cl;
#pragma unroll
                    for (int bj = 0; bj < 2; ++bj)
#pragma unroll
                        for (int n = 0; n < 2; ++n) *(f32x4*)(rp + bj * HALF + 4 * n) = acc[ai][bj][m][n] * r;
                    if (wc < 2) *(u32x4*)(KIB + (size_t)(rowb + ai * HALF + m * 16) * 64 + cl) = pack8(acc[ai][1][m][0] * r, acc[ai][1][m][1] * r);
                    asm volatile("" ::: "memory"); }
        }
    }
};
template <int MODE> struct EpiResid {
    static constexpr bool PERM = true, AFTER_DRAIN = false;
    float* H; bf16_t* HBo; float* statsW; const float* statsR; const bf16_t* E; const float* scale;
    __device__ __forceinline__ void operator()(const f32x4 (&acc)[2][2][4][2], const Unit& u, int wr, int wc, int fr, int fq) const {
        int pm = u.pm; const int pn = u.pn; if (MODE == 1) pm -= 64 * pn;
        const int rowb = pm * BM + wr * 64 + fr, colb = pn * BM + wc * 32 + 8 * fq;
        float rs[2][4]; if (MODE == 2) load_rstd(statsR, rowb, fr, fq, rs);
        f32x4 sc[2][2];
        if (MODE == 1) {
#pragma unroll
            for (int bj = 0; bj < 2; ++bj)
#pragma unroll
                for (int n = 0; n < 2; ++n) sc[bj][n] = *(const f32x4*)(scale + colb + bj * HALF + 4 * n); }
#pragma unroll
        for (int ai = 0; ai < 2; ++ai)
#pragma unroll
            for (int m = 0; m < 4; ++m) { const size_t off = (size_t)(rowb + ai * HALF + m * 16) * 1024 + colb; float ssq = 0.f;
#pragma unroll
                for (int bj = 0; bj < 2; ++bj) { float* hp = H + off + bj * HALF; f32x4 h0 = ((const f32x4*)hp)[0], h1 = ((const f32x4*)hp)[1];
                    f32x4 v0 = acc[ai][bj][m][0], v1 = acc[ai][bj][m][1];
                    if (MODE == 1) { v0 = v0 * sc[bj][0]; v1 = v1 * sc[bj][1]; }
                    if (MODE == 2) { const u32x4 ew = *(const u32x4*)(E + off + bj * HALF); f32x4 e0, e1; unpack8(ew, e0, e1); const float r = rs[ai][m]; v0 = e0 * sig4(v0 * r); v1 = e1 * sig4(v1 * r); }
                    h0 = h0 + v0; h1 = h1 + v1; ((f32x4*)hp)[0] = h0; ((f32x4*)hp)[1] = h1;
                    ssq += ((h0.x * h0.x + h0.y * h0.y) + (h0.z * h0.z + h0.w * h0.w)) + ((h1.x * h1.x + h1.y * h1.y) + (h1.z * h1.z + h1.w * h1.w));
                    *(u32x4*)(HBo + off + bj * HALF) = pack8(h0, h1); }
                ssq += __shfl_xor(ssq, 16); ssq += __shfl_xor(ssq, 32);
                if (fq == 0) statsW[(size_t)(rowb + ai * HALF + m * 16) * 16 + pn * 4 + wc] = ssq;
                asm volatile("" ::: "memory"); }
    }
};
template <bool MOE> struct EpiGLU {
    static constexpr bool PERM = true, AFTER_DRAIN = false;
    const float* stats; const float* rowr; bf16_t* ACT;
    __device__ __forceinline__ void operator()(const f32x4 (&acc)[2][2][4][2], const Unit& u, int wr, int wc, int fr, int fq) const {
        const int rowb = u.pm * BM + wr * 64 + fr, jt = MOE ? (u.pn % 28) : u.pn;
        float rs[2][4];
        if (MOE) {
#pragma unroll
            for (int ai = 0; ai < 2; ++ai)
#pragma unroll
                for (int m = 0; m < 4; ++m) rs[ai][m] = rowr[rowb + ai * HALF + m * 16];
        } else load_rstd(stats, rowb, fr, fq, rs);
#pragma unroll
        for (int ai = 0; ai < 2; ++ai)
#pragma unroll
            for (int m = 0; m < 4; ++m) { const float r = rs[ai][m]; bf16_t* rp = ACT + (size_t)(rowb + ai * HALF + m * 16) * 3584 + jt * 128 + wc * 32 + 8 * fq;
                const f32x4 g0 = acc[ai][0][m][0] * r, g1 = acc[ai][0][m][1] * r, u0 = acc[ai][1][m][0] * r, u1 = acc[ai][1][m][1] * r;
                *(u32x4*)rp = pack8(g0 * sig4(g0) * u0, g1 * sig4(g1) * u1);
                asm volatile("" ::: "memory"); }
    }
};
struct EpiScatter {
    static constexpr bool PERM = true, AFTER_DRAIN = false;
    const int* rowts; const float* rowg; bf16_t *D0, *D1;
    __device__ __forceinline__ void operator()(const f32x4 (&acc)[2][2][4][2], const Unit& u, int wr, int wc, int fr, int fq) const {
        const int rowb = u.pm * BM + wr * 64 + fr, jt = u.pn & 3;
#pragma unroll
        for (int ai = 0; ai < 2; ++ai)
#pragma unroll
            for (int m = 0; m < 4; ++m) { const int row = rowb + ai * HALF + m * 16; const int ts = rowts[row];
                if (ts >= 0) { const float g = rowg[row]; bf16_t* dp = ((ts & 1) ? D1 : D0) + (size_t)(ts >> 1) * 1024 + jt * 256 + wc * 32 + 8 * fq;
#pragma unroll
                    for (int bj = 0; bj < 2; ++bj) *(u32x4*)(dp + bj * HALF) = pack8(acc[ai][bj][m][0] * g, acc[ai][bj][m][1] * g); }
                asm volatile("" ::: "memory"); }
    }
};
struct EpiStore {
    static constexpr bool PERM = true, AFTER_DRAIN = false;
    bf16_t* O; int ldc;
    __device__ __forceinline__ void operator()(const f32x4 (&acc)[2][2][4][2], const Unit& u, int wr, int wc, int fr, int fq) const {
        const int rowb = u.pm * BM + wr * 64 + fr, colb = u.pn * BM + wc * 32 + 8 * fq;
#pragma unroll
        for (int ai = 0; ai < 2; ++ai)
#pragma unroll
            for (int m = 0; m < 4; ++m) { bf16_t* rp = O + (size_t)(rowb + ai * HALF + m * 16) * ldc + colb;
#pragma unroll
                for (int bj = 0; bj < 2; ++bj) *(u32x4*)(rp + bj * HALF) = pack8(acc[ai][bj][m][0], acc[ai][bj][m][1]); }
    }
};
struct PoolOrder {
    int G, c;
    __device__ __forceinline__ bool next(int i, Unit& u) const { const int L = i * G + c; if (L >= 256) return false; const int g = L & 3; u.pm = g * 64 + (L >> 2); u.pn = g; return true; }
    __device__ __forceinline__ void a_ready(const Unit&) const {}
    __device__ __forceinline__ void done(const Unit&) const {}
};
struct MoeOrder {
    const int* tileE; int ntiles, ncol, G, c;
    __device__ __forceinline__ bool next(int i, Unit& u) const { const int L = i * G + c; if (L >= ntiles * ncol) return false; const int rt = L / ncol, j = L - rt * ncol;
        u.pm = rt; u.pn = __builtin_amdgcn_readfirstlane(tileE[rt]) * ncol + j; return true; }
    __device__ __forceinline__ void a_ready(const Unit&) const {}
    __device__ __forceinline__ void done(const Unit&) const {}
};
template <class Epi, class Sched, bool ALIGN_EPI = false, bool SP2 = false>
__device__ __forceinline__ void gemm_phase(PG8_LAS unsigned char* lds, const Gemm g, const Sched& S, const Epi& E) {
    const int tid = threadIdx.x, wid = __builtin_amdgcn_readfirstlane(tid >> 6), lane = tid & 63, wr = wid >> 2, wc = wid & 3, fr = lane & 15, fq = lane >> 4;
    const int K = g.K, nt = K / BK;
    unsigned voffA[2], voffB[2];
#pragma unroll
    for (int i = 0; i < 2; ++i) { int R, C; stage_rc(tid * 16 + i * 8192, R, C); const int Rb = Epi::PERM ? ((R & ~31) + perm32(R & 31)) : R;
        voffA[i] = (unsigned)(R * K + C) * 2u; voffB[i] = (unsigned)(Rb * K + C) * 2u; }
    const size_t kstep = (size_t)(BK * 2);
    const size_t hstep = (size_t)HALF * K * 2;
    const size_t tstep = 2 * hstep;
    const unsigned ldsw = (unsigned)wid * 1024u;
    const int aoff = lds_byte(wr * 64 + fr, fq * 8), boff = lds_byte(wc * 32 + fr, fq * 8);
#define PG8_SA(b, h) (((b) * 2 + (h)) * HTB)
#define PG8_SB(b, h) ((4 + (b) * 2 + (h)) * HTB)
#define PG8_STAGE(bufoff, gbase, voff) do { _Pragma("unroll") for (int _i = 0; _i < 2; ++_i) \
        __builtin_amdgcn_global_load_lds((const unsigned*)((const char*)(gbase) + (voff)[_i]), (PG8_LAS unsigned*)(lds + (bufoff) + ldsw + _i * 8192), 16, 0, 0); } while (0)
#define PG8_LDA(dst, b, h) do { _Pragma("unroll") for (int m = 0; m < 4; ++m) _Pragma("unroll") for (int k = 0; k < 2; ++k) dst[m][k] = *(const PG8_LAS bf16x8*)(lds + PG8_SA(b, h) + aoff + m * 2048 + k * 1024); } while (0)
#define PG8_LDB(dst, b, h) do { _Pragma("unroll") for (int n = 0; n < 2; ++n) _Pragma("unroll") for (int k = 0; k < 2; ++k) dst[n][k] = *(const PG8_LAS bf16x8*)(lds + PG8_SB(b, h) + boff + n * 2048 + k * 1024); } while (0)
#define PG8_MMA(ai, bj, At, Bt) do { __builtin_amdgcn_s_setprio(1); _Pragma("unroll") for (int m = 0; m < 4; ++m) _Pragma("unroll") for (int n = 0; n < 2; ++n) _Pragma("unroll") for (int k = 0; k < 2; ++k) \
        acc[ai][bj][m][n] = __builtin_amdgcn_mfma_f32_16x16x32_bf16(Bt[n][k], At[m][k], acc[ai][bj][m][n], 0, 0, 0); __builtin_amdgcn_s_setprio(0); } while (0)
#define PG8_WAIT_V(n) asm volatile("s_waitcnt vmcnt(" #n ")" ::: "memory")
#define PG8_WAIT_L(n) asm volatile("s_waitcnt lgkmcnt(" #n ")" ::: "memory")
#define PG8_BAR __builtin_amdgcn_s_barrier()
#define PG8_SCHED __builtin_amdgcn_sched_barrier(0)
    Unit cur, nxt; int ui = 0;
    if (!S.next(0, cur)) return;
    f32x4 acc[2][2][4][2];
#pragma unroll
    for (int a = 0; a < 2; ++a)
#pragma unroll
        for (int b = 0; b < 2; ++b)
#pragma unroll
            for (int m = 0; m < 4; ++m)
#pragma unroll
                for (int n = 0; n < 2; ++n) acc[a][b][m][n] = (f32x4){0.f, 0.f, 0.f, 0.f};
    bf16x8 At[4][2], B0[2][2], B1[2][2];
    const char* cA = (const char*)g.A + (size_t)cur.pm * tstep; const char* cB = (const char*)g.Bt + (size_t)cur.pn * tstep;
    S.a_ready(cur);
    if constexpr (SP2) {
        PG8_STAGE(PG8_SB(0, 0), cB, voffB); PG8_STAGE(PG8_SB(0, 1), cB + hstep, voffB); PG8_STAGE(PG8_SA(0, 0), cA, voffA); PG8_STAGE(PG8_SA(0, 1), cA + hstep, voffA);
        if (wr == 1) PG8_BAR;
        PG8_WAIT_V(2); PG8_BAR;
        PG8_STAGE(PG8_SB(1, 0), cB + kstep, voffB); PG8_STAGE(PG8_SA(1, 0), cA + kstep, voffA); PG8_STAGE(PG8_SB(1, 1), cB + hstep + kstep, voffB);
        PG8_WAIT_V(6); PG8_BAR;
    } else {
        PG8_STAGE(PG8_SB(0, 0), cB, voffB); PG8_STAGE(PG8_SA(0, 0), cA, voffA); PG8_STAGE(PG8_SB(0, 1), cB + hstep, voffB); PG8_STAGE(PG8_SA(0, 1), cA + hstep, voffA);
        if (wr == 1) PG8_BAR;
        PG8_WAIT_V(4); PG8_BAR;
        PG8_STAGE(PG8_SB(1, 0), cB + kstep, voffB); PG8_STAGE(PG8_SA(1, 0), cA + kstep, voffA); PG8_STAGE(PG8_SB(1, 1), cB + hstep + kstep, voffB);
        PG8_WAIT_V(6); PG8_BAR;
    }
    for (;;) {
        const bool has_next = S.next(ui + 1, nxt);
        const char* nA = has_next ? (const char*)g.A + (size_t)nxt.pm * tstep : cA; const char* nB = has_next ? (const char*)g.Bt + (size_t)nxt.pn * tstep : cB;
        for (int t = 0; t < nt; t += 2) {
            const bool last = (t == nt - 2);
            const char* a1 = cA + (size_t)(t + 1) * kstep;
            const char* a2 = last ? nA : cA + (size_t)(t + 2) * kstep; const char* b2 = last ? nB : cB + (size_t)(t + 2) * kstep;
            const char* a3 = a2 + kstep; const char* b3 = b2 + kstep;
            if (last && has_next) S.a_ready(nxt);
            if constexpr (SP2) {
            PG8_LDB(B0, 0, 0); PG8_LDB(B1, 0, 1); PG8_SCHED; PG8_LDA(At, 0, 0); PG8_STAGE(PG8_SA(1, 1), a1 + hstep, voffA);
            PG8_WAIT_V(8); PG8_WAIT_L(0); PG8_BAR; PG8_MMA(0, 0, At, B0); PG8_MMA(0, 1, At, B1); PG8_BAR; PG8_SCHED;
            PG8_LDA(At, 0, 1); PG8_STAGE(PG8_SB(0, 0), b2, voffB); PG8_STAGE(PG8_SB(0, 1), b2 + hstep, voffB); PG8_STAGE(PG8_SA(0, 0), a2, voffA);
            PG8_WAIT_V(8); PG8_WAIT_L(0); PG8_BAR; PG8_MMA(1, 0, At, B0); PG8_MMA(1, 1, At, B1); PG8_BAR; PG8_SCHED;
            PG8_LDB(B0, 1, 0); PG8_LDB(B1, 1, 1); PG8_SCHED; PG8_LDA(At, 1, 0); PG8_STAGE(PG8_SA(0, 1), a2 + hstep, voffA);
            PG8_WAIT_V(8); PG8_WAIT_L(0); PG8_BAR; PG8_MMA(0, 0, At, B0); PG8_MMA(0, 1, At, B1); PG8_BAR; PG8_SCHED;
            PG8_LDA(At, 1, 1); PG8_STAGE(PG8_SB(1, 0), b3, voffB); PG8_STAGE(PG8_SB(1, 1), b3 + hstep, voffB); PG8_STAGE(PG8_SA(1, 0), a3, voffA);
            PG8_WAIT_V(8); PG8_WAIT_L(0); PG8_BAR; PG8_MMA(1, 0, At, B0); PG8_MMA(1, 1, At, B1); PG8_BAR; PG8_SCHED;
            } else {
            PG8_LDB(B0, 0, 0); PG8_SCHED; PG8_LDA(At, 0, 0); PG8_STAGE(PG8_SA(1, 1), a1 + hstep, voffA);
            PG8_WAIT_L(8); PG8_BAR; PG8_WAIT_L(0); PG8_MMA(0, 0, At, B0); PG8_BAR; PG8_SCHED;
            PG8_LDB(B1, 0, 1); PG8_STAGE(PG8_SB(0, 0), b2, voffB);
            PG8_BAR; PG8_WAIT_L(0); PG8_MMA(0, 1, At, B1); PG8_BAR;
            PG8_LDA(At, 0, 1); PG8_STAGE(PG8_SA(0, 0), a2, voffA);
            PG8_BAR; PG8_WAIT_L(0); PG8_MMA(1, 0, At, B0); PG8_BAR; PG8_SCHED;
            PG8_STAGE(PG8_SB(0, 1), b2 + hstep, voffB);
            PG8_WAIT_V(6); PG8_BAR; PG8_MMA(1, 1, At, B1); PG8_BAR;
            PG8_LDB(B0, 1, 0); PG8_SCHED; PG8_LDA(At, 1, 0); PG8_STAGE(PG8_SA(0, 1), a2 + hstep, voffA);
            PG8_WAIT_L(8); PG8_BAR; PG8_WAIT_L(0); PG8_MMA(0, 0, At, B0); PG8_BAR; PG8_SCHED;
            PG8_LDB(B1, 1, 1); PG8_STAGE(PG8_SB(1, 0), b3, voffB);
            PG8_BAR; PG8_WAIT_L(0); PG8_MMA(0, 1, At, B1); PG8_BAR;
            PG8_LDA(At, 1, 1); PG8_STAGE(PG8_SA(1, 0), a3, voffA);
            PG8_BAR; PG8_WAIT_L(0); PG8_MMA(1, 0, At, B0); PG8_BAR; PG8_SCHED;
            PG8_STAGE(PG8_SB(1, 1), b3 + hstep, voffB);
            PG8_WAIT_V(6); PG8_BAR; PG8_MMA(1, 1, At, B1); PG8_BAR;
            }
        }
        if constexpr (ALIGN_EPI) { if (wr == 0) PG8_BAR; }
        if constexpr (!Epi::AFTER_DRAIN) { E(acc, cur, wr, wc, fr, fq); S.done(cur); }
        if (!has_next) break;
#pragma unroll
        for (int a = 0; a < 2; ++a)
#pragma unroll
            for (int b = 0; b < 2; ++b)
#pragma unroll
                for (int m = 0; m < 4; ++m)
#pragma unroll
                    for (int n = 0; n < 2; ++n) acc[a][b][m][n] = (f32x4){0.f, 0.f, 0.f, 0.f};
        cur = nxt; cA = nA; cB = nB; ++ui;
        if constexpr (ALIGN_EPI) { if (wr == 1) PG8_BAR; }
    }
    PG8_WAIT_V(0);
    if constexpr (!ALIGN_EPI) { if (wr == 0) PG8_BAR; }
    PG8_BAR;
    if constexpr (Epi::AFTER_DRAIN) { E.fused(acc, cur, wr, wc, fr, fq, lds, wid, lane); S.done(cur); }
#undef PG8_SA
#undef PG8_SB
#undef PG8_STAGE
#undef PG8_LDA
#undef PG8_LDB
#undef PG8_MMA
#undef PG8_WAIT_V
#undef PG8_WAIT_L
#undef PG8_BAR
#undef PG8_SCHED
}
}
constexpr int NWAVES = 8;
constexpr int BATCH = 8, SEQ = 2048, DM = 1024, M = BATCH * SEQ, DFF = 3584, NEXP = 8, PLED = 256, NINP = 3328, NCHUNK = 32;
constexpr float LOG2E = 1.4426950408889634f;
constexpr size_t MiB = 1u << 20;
constexpr size_t WS_CTL = 0, CTL_ZERO_BYTES = 1 * MiB;
constexpr size_t WS_SMALL = 1 * MiB;
constexpr size_t WS_W_IN = 2 * MiB, WS_W_OUT = 15 * MiB, WS_W_GU = 19 * MiB, WS_W_DN = 47 * MiB, WS_W_PG = 61 * MiB, WS_W_PL = 69 * MiB, WS_W_POOL = 71 * MiB;
constexpr size_t WS_W_MGU = 72 * MiB, WS_W_MDN = 184 * MiB;
constexpr size_t WS_HB0 = 240 * MiB, WS_HB1 = 272 * MiB, WS_STATS = 304 * MiB, WS_PB = 306 * MiB, WS_E = 338 * MiB;
constexpr size_t WS_OVL = 370 * MiB;
constexpr size_t WS_QK = WS_OVL, WS_VB = WS_OVL + 32 * MiB, WS_OG = WS_OVL + 48 * MiB, WS_BQ = WS_OVL + 64 * MiB, WS_BQI = WS_OVL + 80 * MiB, WS_MISC = WS_OVL + 96 * MiB, WS_MIX = WS_OVL + 112 * MiB;
constexpr size_t WS_KB = WS_OVL + 144 * MiB, WS_KIB = WS_OVL + 146 * MiB, WS_VT = WS_OVL + 148 * MiB, WS_MASK = WS_OVL + 164 * MiB, WS_CHS = WS_OVL + 168 * MiB;
constexpr size_t WS_ISC = WS_OVL + 169 * MiB, WS_U = WS_OVL + 297 * MiB, WS_CB = WS_OVL + 369 * MiB, WS_QKC = WS_OVL + 406 * MiB, WS_ACT = WS_ISC;
constexpr size_t WS_POOLED = WS_OVL, WS_YG = WS_OVL + 32 * MiB, WS_ACTM = WS_OVL + 100 * MiB, WS_D0 = WS_OVL + 338 * MiB, WS_D1 = WS_OVL + 370 * MiB, WS_ROUTE = WS_OVL + 402 * MiB;
constexpr size_t WS_END = WS_OVL + 438 * MiB;
constexpr int MAXROWS = 34816;
constexpr size_t RT_TOKE = 0, RT_TOKG = 65536, RT_TOKR = 196608, RT_CNT = 262144, RT_ROWTS = 270336, RT_ROWG = 409600, RT_ROWR = 548864, RT_TILEE = 688128, RT_NT = 688128 + 1024;
constexpr int CW_BAR = 4096;
constexpr int RING_BYTES = 131072, LDSCTL_OFF = RING_BYTES, MISC_OFF = LDSCTL_OFF + 320, LDS_BYTES = 147456;

#define GAS __attribute__((address_space(1)))
#define LAS __attribute__((address_space(3)))
typedef unsigned short bf16;
typedef unsigned v4u __attribute__((ext_vector_type(4)));
typedef unsigned v2u __attribute__((ext_vector_type(2)));
typedef float f32x4 __attribute__((ext_vector_type(4)));
typedef float f32x2 __attribute__((ext_vector_type(2)));
typedef short bf16x8 __attribute__((ext_vector_type(8)));
#define LDS_WAIT() asm volatile("s_waitcnt lgkmcnt(0)" ::: "memory")
__device__ __forceinline__ unsigned f2bf(float f) { unsigned u = __builtin_bit_cast(unsigned, f); return (u + 0x7fffu + ((u >> 16) & 1u)) >> 16; }
__device__ __forceinline__ unsigned pk2(float lo, float hi) { return f2bf(lo) | (f2bf(hi) << 16); }
__device__ __forceinline__ float bflo(unsigned w) { return __uint_as_float(w << 16); }
__device__ __forceinline__ float bfhi(unsigned w) { return __uint_as_float(w & 0xffff0000u); }
__device__ __forceinline__ float bf2f(bf16 b) { return __uint_as_float(((unsigned)b) << 16); }
__device__ __forceinline__ float wave_sum(float v) {
#pragma unroll
    for (int o = 1; o < 64; o <<= 1) v += __shfl_xor(v, o);
    return v;
}
__device__ __forceinline__ float wave_max(float v) {
#pragma unroll
    for (int o = 1; o < 64; o <<= 1) v = fmaxf(v, __shfl_xor(v, o));
    return v;
}
__device__ __forceinline__ float fsig(float x) { return 1.0f / (1.0f + __expf(-x)); }
#define MFMA16(a, b, c) __builtin_amdgcn_mfma_f32_16x16x32_bf16((a), (b), (c), 0, 0, 0)
#define XB_TMO      128
#define XB_XCNT(j)  (256  + 64 * (j))
#define XB_XSUB(j)  (1280 + 64 * (j))
#define XB_XGEN(j)  (2304 + 64 * (j))
#define XB_TOP      3328
#define XB_TOPGEN   3392
#define XCD_BAR_WORDS 3456
#define XB_SPIN_CAP (1u << 18)

__device__ __forceinline__ unsigned xb_ld(unsigned* p)              { return __hip_atomic_load(p, __ATOMIC_RELAXED, __HIP_MEMORY_SCOPE_AGENT); }
__device__ __forceinline__ unsigned xb_add(unsigned* p, unsigned v) { return __hip_atomic_fetch_add(p, v, __ATOMIC_RELAXED, __HIP_MEMORY_SCOPE_AGENT); }
__device__ __forceinline__ unsigned xb_xcc_id() { return (unsigned)__builtin_amdgcn_s_getreg((3 << 11) | 20) & 0xFu; }
#define XB_SPIN(cond, bar) do { unsigned _sp = 0; while (cond) { __builtin_amdgcn_s_sleep(1); \
    if ((++_sp & 255u) == 0u) { if (xb_ld(&(bar)[XB_TMO])) break; if (_sp > XB_SPIN_CAP) { atomicAdd(&(bar)[XB_TMO], 1u); break; } } } } while (0)

struct XcdBarrier {
    unsigned* bar; unsigned x;
    volatile LAS unsigned* st;
};

__device__ __forceinline__ XcdBarrier xcd_barrier_post(unsigned* bar, volatile LAS unsigned* st) {
    XcdBarrier b; b.bar = bar; b.x = xb_xcc_id(); b.st = st;
    if (threadIdx.x == 0) (void)xb_add(&bar[XB_XCNT(b.x)], 1u);
    return b;
}
__device__ __forceinline__ void xcd_barrier_complete(unsigned* bar, unsigned x, unsigned& nloc, unsigned& nx) {
    const unsigned G = gridDim.x * gridDim.y * gridDim.z;
    unsigned sum, cnt, mine, sp = 0u;
    for (;;) {
        sum = 0u; cnt = 0u; mine = 0u;
#pragma unroll
        for (unsigned j = 0; j < 16; ++j) { const unsigned c = xb_ld(&bar[XB_XCNT(j)]); sum += c; cnt += (c > 0u) ? 1u : 0u; mine = (j == x) ? c : mine; }
        if (sum == G) break;
        __builtin_amdgcn_s_sleep(1);
        if ((++sp & 255u) == 0u) { if (xb_ld(&bar[XB_TMO])) break; if (sp > XB_SPIN_CAP) { atomicAdd(&bar[XB_TMO], 1u); break; } }
    }
    nloc = mine > 0u ? mine : 1u; nx = cnt > 0u ? cnt : 1u;
}

__device__ __forceinline__ void xcd_barrier(const XcdBarrier& b) {
    asm volatile("s_waitcnt vmcnt(0)" ::: "memory");
    __syncthreads();
    if (threadIdx.x == 0) {
        unsigned* bar = b.bar;
        __builtin_amdgcn_s_waitcnt(0);
        unsigned nloc = b.st[0], nx = b.st[1];
        if (nloc == 0u) { xcd_barrier_complete(bar, b.x, nloc, nx); b.st[0] = nloc; b.st[1] = nx; }
        const unsigned old = xb_add(&bar[XB_XSUB(b.x)], 1u);
        const unsigned gen = old / nloc;
        if (old + 1u == (gen + 1u) * nloc) {
            __builtin_amdgcn_fence(__ATOMIC_RELEASE, "agent");
            asm volatile("s_waitcnt vmcnt(0)" ::: "memory");
            const unsigned og = xb_add(&bar[XB_TOP], 1u);
            const unsigned tg = og / nx;
            if (og + 1u == (tg + 1u) * nx) xb_add(&bar[XB_TOPGEN], 1u);
            else XB_SPIN(xb_ld(&bar[XB_TOPGEN]) == tg, bar);
            __builtin_amdgcn_fence(__ATOMIC_ACQUIRE, "agent");
            xb_add(&bar[XB_XGEN(b.x)], 1u);
            asm volatile("s_waitcnt vmcnt(0)" ::: "memory");
        } else {
            XB_SPIN(xb_ld(&bar[XB_XGEN(b.x)]) == gen, bar);
            __builtin_amdgcn_fence(__ATOMIC_ACQUIRE, "agent");
            asm volatile("s_waitcnt vmcnt(0)" ::: "memory");
        }
    }
    __syncthreads();
}
struct Args { const float* in[28]; float* out; unsigned char* ws; int ph_lo, ph_hi; };
struct Frame {
    LAS unsigned char* lds; unsigned char* gl;
    volatile LAS unsigned* MISCW;
    int tid, lane, wave, G, bid, gw, NGW;
    float* out; unsigned char* ws;
    unsigned long long tacc, tprev;
};
#define INP(k) (args.in[k])
#define IN_X 0
#define IN_P 1
#define IN_NORM_MIX 2
#define IN_NORM_FFN 3
#define IN_W_IN 4
#define IN_B_GATE 5
#define IN_CONV 6
#define IN_NORM_H 7
#define IN_NORM_Q 8
#define IN_NORM_K 9
#define IN_NORM_KV 10
#define IN_W_UK 11
#define IN_W_UV 12
#define IN_W_OUT 13
#define IN_REL_BIAS 14
#define IN_W_POOL 15
#define IN_SCALE_POOL 16
#define IN_W_GATE_D 17
#define IN_W_UP_D 18
#define IN_W_DOWN_D 19
#define IN_W_ROUTER 20
#define IN_B_ROUTER 21
#define IN_W_GATE_M 22
#define IN_W_UP_M 23
#define IN_W_DOWN_M 24
#define IN_W_PLE 25
#define IN_W_PLE_GATE 26
#define IN_NORM_PLE 27

template <int MODE> __device__ __forceinline__ int dst_row(int n) {
    if (MODE == 0) return n;
    if (MODE == 1) return ((n >> 7) << 8) + (n & 127);
    if (MODE == 2) return ((n >> 7) << 8) + 128 + (n & 127);
    if (n < 2048) return n;
    if (n < 2052) return 3264 + (n - 2048);
    if (n < 2056) return 3268 + (n - 2052);
    if (n < 2568) return 2048 + (n - 2056);
    if (n < 2696) return 3072 + (n - 2568);
    if (n < 3208) return 2560 + (n - 2696);
    if (n < 3272) return 3200 + (n - 3208);
    return 3272 + (n - 3272);
}
template <int MODE> __device__ __forceinline__ void conv_mat(Frame& F, const float* W, int K, int N, bf16* WT, const float* gain, int wi, int nw) {
    LAS float* scr = (LAS float*)(F.lds + F.wave * 16384);
    const int nblk = (N + 31) >> 5, nitems = (K >> 6) * nblk, lane = F.lane, r = lane >> 3, c4 = lane & 7;
    for (int it = wi; it < nitems; it += nw) {
        const int kb = it / nblk, nb = it - kb * nblk, k0 = 64 * kb, n0 = 32 * nb, nn = n0 + 4 * c4; const bool okn = nn < N;
        f32x4 v[8];
#pragma unroll
        for (int i = 0; i < 8; ++i) v[i] = okn ? *(const f32x4*)(W + (size_t)(k0 + 8 * i + r) * N + nn) : (f32x4){0.f, 0.f, 0.f, 0.f};
        if (gain) {
#pragma unroll
            for (int i = 0; i < 8; ++i) v[i] = v[i] * gain[k0 + 8 * i + r]; }
#pragma unroll
        for (int i = 0; i < 8; ++i) { LAS float* d = scr + (8 * i + r) * 33 + 4 * c4; d[0] = v[i].x; d[1] = v[i].y; d[2] = v[i].z; d[3] = v[i].w; }
        LDS_WAIT(); asm volatile("" ::: "memory");
        const int c = lane & 7;
#pragma unroll
        for (int j = 0; j < 4; ++j) { const int n = (lane >> 3) + 8 * j; const LAS float* s = scr + (8 * c) * 33 + n;
            v4u o; o.x = pk2(s[0 * 33], s[1 * 33]); o.y = pk2(s[2 * 33], s[3 * 33]); o.z = pk2(s[4 * 33], s[5 * 33]); o.w = pk2(s[6 * 33], s[7 * 33]);
            if (n0 + n < N) *(v4u*)(WT + (size_t)dst_row<MODE>(n0 + n) * K + k0 + 8 * c) = o; }
        LDS_WAIT(); asm volatile("" ::: "memory");
    }
}
__device__ __forceinline__ void conv_moe(Frame& F, const Args& args, int o) {
    bf16* mgu = (bf16*)(F.ws + WS_W_MGU); bf16* mdn = (bf16*)(F.ws + WS_W_MDN);
    const float* gain = INP(IN_NORM_FFN) + (2 * o + 1) * DM;
    for (int e = 0; e < NEXP; ++e) {
        const size_t wo = ((size_t)o * NEXP + e) * DM * DFF;
        conv_mat<1>(F, INP(IN_W_GATE_M) + wo, DM, DFF, mgu + (size_t)e * 7168 * 1024, gain, F.gw, F.NGW);
        conv_mat<2>(F, INP(IN_W_UP_M) + wo, DM, DFF, mgu + (size_t)e * 7168 * 1024, gain, F.gw, F.NGW);
        conv_mat<0>(F, INP(IN_W_DOWN_M) + wo, DFF, DM, mdn + (size_t)e * 1024 * 3584, nullptr, F.gw, F.NGW);
    }
}
__device__ __forceinline__ void p0_prologue(Frame& F, const Args& args) {
    unsigned char* ws = F.ws;
    for (int e = 0; e < 2; ++e) {
        conv_mat<3>(F, INP(IN_W_IN) + (size_t)e * DM * 3280, DM, 3280, (bf16*)(ws + WS_W_IN) + (size_t)e * NINP * DM, INP(IN_NORM_MIX) + (2 * e) * DM, F.gw, F.NGW);
        conv_mat<0>(F, INP(IN_W_OUT) + (size_t)e * DM * DM, DM, DM, (bf16*)(ws + WS_W_OUT) + (size_t)e * DM * DM, nullptr, F.gw, F.NGW);
        conv_mat<1>(F, INP(IN_W_GATE_D) + (size_t)e * DM * DFF, DM, DFF, (bf16*)(ws + WS_W_GU) + (size_t)e * 7168 * DM, INP(IN_NORM_FFN) + (2 * e) * DM, F.gw, F.NGW);
        conv_mat<2>(F, INP(IN_W_UP_D) + (size_t)e * DM * DFF, DM, DFF, (bf16*)(ws + WS_W_GU) + (size_t)e * 7168 * DM, INP(IN_NORM_FFN) + (2 * e) * DM, F.gw, F.NGW);
        conv_mat<0>(F, INP(IN_W_DOWN_D) + (size_t)e * DFF * DM, DFF, DM, (bf16*)(ws + WS_W_DN) + (size_t)e * DM * DFF, nullptr, F.gw, F.NGW);
        conv_mat<0>(F, INP(IN_W_UK) + (size_t)e * 128 * 64, 128, 64, (bf16*)(ws + WS_SMALL + 8192) + (size_t)e * 64 * 128, nullptr, F.gw, F.NGW);
        for (int h = 0; h < 8; ++h)
            conv_mat<0>(F, INP(IN_W_UV) + ((size_t)e * 8 + h) * 128 * 64, 128, 64, (bf16*)(ws + WS_SMALL + 65536) + ((size_t)e * 512 + h * 64) * 128, nullptr, F.gw, F.NGW);
        for (int g = 0; g < 4; ++g)
            conv_mat<0>(F, INP(IN_W_POOL) + ((size_t)e * 4 + g) * 256 * 256, 256, 256, (bf16*)(ws + WS_W_POOL) + ((size_t)e * 4 + g) * 256 * 256, nullptr, F.gw, F.NGW);
    }
    for (int i = 0; i < 4; ++i) {
        conv_mat<0>(F, INP(IN_W_PLE_GATE) + (size_t)i * DM * DM, DM, DM, (bf16*)(ws + WS_W_PG) + (size_t)i * DM * DM, INP(IN_NORM_PLE) + i * DM, F.gw, F.NGW);
        conv_mat<0>(F, INP(IN_W_PLE) + (size_t)i * PLED * DM, PLED, DM, (bf16*)(ws + WS_W_PL) + (size_t)i * DM * PLED, nullptr, F.gw, F.NGW);
    }
    conv_moe(F, args, 0);
    const int gt = F.bid * 512 + F.tid, NT = F.G * 512;
    for (int i = gt; i < 2 * 48 * DM / 8; i += NT) { const int e = i / (48 * DM / 8), r = i - e * (48 * DM / 8); *(v4u*)((bf16*)(ws + WS_W_IN) + ((size_t)e * NINP + 3280) * DM + (size_t)r * 8) = (v4u){0u, 0u, 0u, 0u}; }
    if (F.bid == 0) for (int t = F.tid; t < 1024; t += 512) { const int hh = t >> 7, d = t & 127; int bk = d;
        if (d >= 16) { bk = 16 + (d >= 19) + (d >= 21) + (d >= 24) + (d >= 27) + (d >= 31) + (d >= 35) + (d >= 40) + (d >= 46) + (d >= 52) + (d >= 59) + (d >= 67) + (d >= 77) + (d >= 87) + (d >= 99) + (d >= 113); }
        ((float*)(ws + WS_SMALL))[t] = INP(IN_REL_BIAS)[bk * 8 + hh] * LOG2E; }
    { const f32x4* src = (const f32x4*)INP(IN_P); v4u* dst = (v4u*)(ws + WS_PB);
      for (int i = gt; i < 4 * M * PLED / 8; i += NT) { const f32x4 a = src[2 * i], b = src[2 * i + 1]; v4u o; o.x = pk2(a.x, a.y); o.y = pk2(a.z, a.w); o.z = pk2(b.x, b.y); o.w = pk2(b.z, b.w); dst[i] = o; } }
    { const float* x = INP(IN_X); bf16* hb = (bf16*)(ws + WS_HB0); float* st = (float*)(ws + WS_STATS);
      for (int m = F.gw; m < M; m += F.NGW) { const f32x4* xr = (const f32x4*)(x + (size_t)m * DM) + F.lane; f32x4* orow = (f32x4*)(F.out + (size_t)m * DM) + F.lane; f32x4 v[4]; float s = 0.f;
#pragma unroll
          for (int j = 0; j < 4; ++j) { v[j] = xr[64 * j]; orow[64 * j] = v[j]; s += (v[j].x * v[j].x + v[j].y * v[j].y) + (v[j].z * v[j].z + v[j].w * v[j].w); }
          s = wave_sum(s);
          v2u* o8 = (v2u*)(hb + (size_t)m * DM) + F.lane;
#pragma unroll
          for (int j = 0; j < 4; ++j) { v2u w; w.x = pk2(v[j].x, v[j].y); w.y = pk2(v[j].z, v[j].w); o8[64 * j] = w; }
          if (F.lane < 16) st[(size_t)m * 16 + F.lane] = (F.lane == 0) ? s : 0.f; } }
}

struct EvenPtrs {
    const bf16 *QK, *VB, *OG, *BQ, *BQI; const float* MISC; bf16 *MIX, *KB, *KIB, *VT, *QKC; unsigned* MASK; float* CHS; float* MST; float* ISC; float* U; bf16* CB;
    const float *bgate, *conv, *gh, *gq, *gk, *gkv; const bf16 *WukT, *WuvT; const float* bt;
};
__device__ __forceinline__ void conv8(const bf16* QK, const float* cw, int rowb, int tpos, int ch, float (&o)[8]) {
#pragma unroll
    for (int j = 0; j < 8; ++j) o[j] = 0.f;
#pragma unroll
    for (int tap = 0; tap < 4; ++tap) { const int tp = tpos - 3 + tap;
        if (tp >= 0) { const v4u w = *(const v4u*)(QK + (size_t)(rowb + tp) * 1024 + ch); const f32x4 c0 = *(const f32x4*)(cw + tap * 1024 + ch), c1 = *(const f32x4*)(cw + tap * 1024 + ch + 4);
            o[0] += bflo(w.x) * c0.x; o[1] += bfhi(w.x) * c0.y; o[2] += bflo(w.y) * c0.z; o[3] += bfhi(w.y) * c0.w;
            o[4] += bflo(w.z) * c1.x; o[5] += bfhi(w.z) * c1.y; o[6] += bflo(w.w) * c1.z; o[7] += bfhi(w.w) * c1.w; } }
#pragma unroll
    for (int j = 0; j < 8; ++j) o[j] = o[j] * fsig(o[j]);
}
__device__ __forceinline__ void chunk_gates(const EvenPtrs& P, int row, int hh, int lane, float& li, float& bc) {
    const float ai = P.MISC[(size_t)row * 256 + 192 + hh], af = P.MISC[(size_t)row * 256 + 196 + hh];
    li = ai + P.bgate[hh]; const float x = af + P.bgate[4 + hh]; const float lf = fminf(x, 0.f) - log1pf(__expf(-fabsf(x)));
    bc = lf;
#pragma unroll
    for (int o = 1; o < 64; o <<= 1) { const float t = __shfl_up(bc, o); if (lane >= o) bc += t; }
}
__device__ __forceinline__ void mlstm_a(Frame& F, const EvenPtrs& P) {
    bf16* KT = (bf16*)F.gl; bf16* VwT = (bf16*)(F.gl + 18432); float* wv = (float*)(F.gl + 18432 + 20736);
    const int tid = F.tid, lane = F.lane, w = F.wave, fr = lane & 15, fq = lane >> 4;
    for (int unit = F.bid; unit < BATCH * 4 * NCHUNK; unit += F.G) {
        const int b = unit >> 7, hh = (unit >> 5) & 3, c = unit & 31, rowb = b * SEQ, t0 = c * 64;
        if (w == 0) { float li, bc; chunk_gates(P, rowb + t0 + lane, hh, lane, li, bc); const float blast = __shfl(bc, 63), g = blast - bc + li, gmax = wave_max(g);
            wv[lane] = __expf(g - gmax); if (lane == 0) { P.CHS[unit * 2] = blast; P.CHS[unit * 2 + 1] = gmax; } }
        { const int cg = tid & 31, s0 = (tid >> 5) * 4, ch = (cg < 16 ? 0 : 512 - 128) + hh * 128 + cg * 8;
          float cw[4][8];
#pragma unroll
          for (int tap = 0; tap < 4; ++tap) { const f32x4 c0 = *(const f32x4*)(P.conv + tap * 1024 + ch), c1 = *(const f32x4*)(P.conv + tap * 1024 + ch + 4);
              cw[tap][0] = c0.x; cw[tap][1] = c0.y; cw[tap][2] = c0.z; cw[tap][3] = c0.w; cw[tap][4] = c1.x; cw[tap][5] = c1.y; cw[tap][6] = c1.z; cw[tap][7] = c1.w; }
          v4u xin[7];
#pragma unroll
          for (int i = 0; i < 7; ++i) { const int tp = t0 + s0 - 3 + i; xin[i] = (tp >= 0) ? *(const v4u*)(P.QK + (size_t)(rowb + tp) * 1024 + ch) : (v4u){0u, 0u, 0u, 0u}; }
          float o[4][8];
#pragma unroll
          for (int r = 0; r < 4; ++r) {
#pragma unroll
              for (int j = 0; j < 8; ++j) o[r][j] = 0.f;
#pragma unroll
              for (int tap = 0; tap < 4; ++tap) { const v4u xw = xin[r + tap];
                  o[r][0] += bflo(xw.x) * cw[tap][0]; o[r][1] += bfhi(xw.x) * cw[tap][1]; o[r][2] += bflo(xw.y) * cw[tap][2]; o[r][3] += bfhi(xw.y) * cw[tap][3];
                  o[r][4] += bflo(xw.z) * cw[tap][4]; o[r][5] += bfhi(xw.z) * cw[tap][5]; o[r][6] += bflo(xw.w) * cw[tap][6]; o[r][7] += bfhi(xw.w) * cw[tap][7]; }
              const float sc = (cg < 16) ? 1.0f : 0.08838834764831845f;
#pragma unroll
              for (int j = 0; j < 8; ++j) o[r][j] = o[r][j] * fsig(o[r][j]) * sc;
              v4u q; q.x = pk2(o[r][0], o[r][1]); q.y = pk2(o[r][2], o[r][3]); q.z = pk2(o[r][4], o[r][5]); q.w = pk2(o[r][6], o[r][7]);
              *(v4u*)(P.QKC + (size_t)(rowb + t0 + s0 + r) * 1024 + ch) = q; }
          if (cg >= 16) { const int d0 = (cg - 16) * 8;
#pragma unroll
              for (int j = 0; j < 8; ++j) { v2u pk; pk.x = pk2(o[0][j], o[1][j]); pk.y = pk2(o[2][j], o[3][j]); *(v2u*)(KT + (d0 + j) * 72 + s0) = pk; } } }
        __syncthreads();
        if (tid < 256) { const int vg = tid & 15, s0 = (tid >> 4) * 4; v4u vw[4]; float ws4[4];
#pragma unroll
            for (int r = 0; r < 4; ++r) { vw[r] = *(const v4u*)(P.VB + (size_t)(rowb + t0 + s0 + r) * 512 + hh * 128 + vg * 8); ws4[r] = wv[s0 + r]; }
#pragma unroll
            for (int j = 0; j < 4; ++j) { const unsigned w0 = j == 0 ? vw[0].x : j == 1 ? vw[0].y : j == 2 ? vw[0].z : vw[0].w, w1 = j == 0 ? vw[1].x : j == 1 ? vw[1].y : j == 2 ? vw[1].z : vw[1].w,
                                                    w2 = j == 0 ? vw[2].x : j == 1 ? vw[2].y : j == 2 ? vw[2].z : vw[2].w, w3 = j == 0 ? vw[3].x : j == 1 ? vw[3].y : j == 2 ? vw[3].z : vw[3].w;
                v2u lo, hi; lo.x = pk2(bflo(w0) * ws4[0], bflo(w1) * ws4[1]); lo.y = pk2(bflo(w2) * ws4[2], bflo(w3) * ws4[3]); hi.x = pk2(bfhi(w0) * ws4[0], bfhi(w1) * ws4[1]); hi.y = pk2(bfhi(w2) * ws4[2], bfhi(w3) * ws4[3]);
                *(v2u*)(VwT + (vg * 8 + 2 * j) * 72 + s0) = lo; *(v2u*)(VwT + (vg * 8 + 2 * j + 1) * 72 + s0) = hi; } }
        else if (tid < 320) VwT[128 * 72 + (tid - 256)] = (bf16)f2bf(wv[tid - 256]);
        else for (int i = tid - 320; i < 15 * 64; i += 192) VwT[(129 + (i >> 6)) * 72 + (i & 63)] = 0;
        __syncthreads();
        { bf16x8 bfr[2]; f32x4 acc[9];
#pragma unroll
          for (int ks = 0; ks < 2; ++ks) bfr[ks] = *(const bf16x8*)(KT + (16 * w + fr) * 72 + 8 * fq + 32 * ks);
#pragma unroll
          for (int rt = 0; rt < 9; ++rt) { acc[rt] = (f32x4){0.f, 0.f, 0.f, 0.f};
#pragma unroll
              for (int ks = 0; ks < 2; ++ks) { const bf16x8 a = *(const bf16x8*)(VwT + (16 * rt + fr) * 72 + 8 * fq + 32 * ks); acc[rt] = MFMA16(a, bfr[ks], acc[rt]); } }
          float* Uo = P.U + (size_t)unit * 144 * 128 + 16 * w + fr;
#pragma unroll
          for (int rt = 0; rt < 9; ++rt)
#pragma unroll
              for (int r = 0; r < 4; ++r) Uo[(size_t)(16 * rt + 4 * fq + r) * 128] = acc[rt][r]; }
        __syncthreads();
    }
}
__device__ __forceinline__ void mlstm_b(Frame& F, const EvenPtrs& P) {
    const int gt = F.bid * 512 + F.tid, NT = F.G * 512;
    for (int e = gt; e < BATCH * 4 * 129 * 128; e += NT) {
        const int d = e & 127, v = (e >> 7) % 129, bh = e / (129 * 128);
        float u[NCHUNK];
#pragma unroll
        for (int c = 0; c < NCHUNK; ++c) u[c] = P.U[((size_t)(bh * 32 + c) * 144 + v) * 128 + d];
        float C = 0.f, m = 0.f;
#pragma unroll
        for (int c = 0; c < NCHUNK; ++c) { const int unit = bh * 32 + c; const size_t idx = ((size_t)unit * 144 + v) * 128 + d;
            P.CB[idx] = (bf16)f2bf(C);
            if (v == 0 && d == 0) P.MST[unit] = m;
            const float blast = P.CHS[unit * 2], gmax = P.CHS[unit * 2 + 1], mn = fmaxf(blast + m, gmax);
            C = __expf(blast + m - mn) * C + __expf(gmax - mn) * u[c]; m = mn; }
    }
    for (int e = gt; e < BATCH * 4 * NCHUNK * 15 * 128; e += NT) { const int d = e & 127, r = (e >> 7) % 15, unit = e / (15 * 128); P.CB[((size_t)unit * 144 + 129 + r) * 128 + d] = 0; }
}
__device__ __forceinline__ void mlstm_c(Frame& F, const EvenPtrs& P) {
    bf16* Qs = (bf16*)F.gl; bf16* Ks = (bf16*)(F.gl + 17408); bf16* VTa = (bf16*)(F.gl + 34816); bf16* Ps = (bf16*)(F.gl + 55552);
    float* av = (float*)(F.gl + 64768); float* pmv = av + 64; float* bcv = av + 128; float* ssb = av + 192;
    const int tid = F.tid, lane = F.lane, w = F.wave, fr = lane & 15, fq = lane >> 4;
    for (int unit = F.bid; unit < BATCH * 4 * NCHUNK; unit += F.G) {
        const int b = unit >> 7, hh = (unit >> 5) & 3, c = unit & 31, rowb = b * SEQ, t0 = c * 64;
        const float mc = P.MST[unit];
        if (w == 0) { float li, bc; chunk_gates(P, rowb + t0 + lane, hh, lane, li, bc); const float a = li - bc; float p = a;
#pragma unroll
            for (int o = 1; o < 64; o <<= 1) { const float tt = __shfl_up(p, o); if (lane >= o) p = fmaxf(p, tt); }
            av[lane] = a; pmv[lane] = fmaxf(p, mc); bcv[lane] = bc; }
        {
#pragma unroll
          for (int i = 0; i < 2; ++i) { const int idx = tid + 512 * i, s = idx >> 4, ch = (idx & 15) * 8;
              *(v4u*)(Qs + s * 136 + ch) = *(const v4u*)(P.QKC + (size_t)(rowb + t0 + s) * 1024 + hh * 128 + ch);
              *(v4u*)(Ks + s * 136 + ch) = *(const v4u*)(P.QKC + (size_t)(rowb + t0 + s) * 1024 + 512 + hh * 128 + ch); }
          if (tid < 256) { const int vg = tid & 15, s0 = (tid >> 4) * 4; v4u vw[4];
#pragma unroll
              for (int r = 0; r < 4; ++r) vw[r] = *(const v4u*)(P.VB + (size_t)(rowb + t0 + s0 + r) * 512 + hh * 128 + vg * 8);
#pragma unroll
              for (int j = 0; j < 4; ++j) { const unsigned w0 = j == 0 ? vw[0].x : j == 1 ? vw[0].y : j == 2 ? vw[0].z : vw[0].w, w1 = j == 0 ? vw[1].x : j == 1 ? vw[1].y : j == 2 ? vw[1].z : vw[1].w,
                                                      w2 = j == 0 ? vw[2].x : j == 1 ? vw[2].y : j == 2 ? vw[2].z : vw[2].w, w3 = j == 0 ? vw[3].x : j == 1 ? vw[3].y : j == 2 ? vw[3].z : vw[3].w;
                  v2u lo, hi; lo.x = (w0 & 0xffffu) | (w1 << 16); lo.y = (w2 & 0xffffu) | (w3 << 16); hi.x = (w0 >> 16) | (w1 & 0xffff0000u); hi.y = (w2 >> 16) | (w3 & 0xffff0000u);
                  *(v2u*)(VTa + (vg * 8 + 2 * j) * 72 + s0) = lo; *(v2u*)(VTa + (vg * 8 + 2 * j + 1) * 72 + s0) = hi; } }
          else if (tid < 320) VTa[128 * 72 + (tid - 256)] = (bf16)0x3f80u;
          else for (int i = tid - 320; i < 15 * 64; i += 192) VTa[(129 + (i >> 6)) * 72 + (i & 63)] = 0; }
        __syncthreads();
        { const int rt = w >> 1;
#pragma unroll
          for (int c2 = 0; c2 < 2; ++c2) { const int ct = 2 * (w & 1) + c2; f32x4 acc = (f32x4){0.f, 0.f, 0.f, 0.f};
#pragma unroll
              for (int ks = 0; ks < 4; ++ks) { const bf16x8 a = *(const bf16x8*)(Qs + (16 * rt + fr) * 136 + 8 * fq + 32 * ks), bb = *(const bf16x8*)(Ks + (16 * ct + fr) * 136 + 8 * fq + 32 * ks); acc = MFMA16(a, bb, acc); }
              const int s = 16 * ct + fr; const float as = av[s];
#pragma unroll
              for (int r = 0; r < 4; ++r) { const int t = 16 * rt + 4 * fq + r; const float p = (s <= t) ? acc[r] * __expf(as - pmv[t]) : 0.f; Ps[t * 72 + s] = (bf16)f2bf(p); } } }
        __syncthreads();
        { const int tt = w & 3, hf = w >> 2, t = 16 * tt + fr; f32x4 ni[5], ne[5];
#pragma unroll
          for (int i = 0; i < 5; ++i) { const int vt = (i < 4) ? 4 * hf + i : 8; ni[i] = (f32x4){0.f, 0.f, 0.f, 0.f}; ne[i] = (f32x4){0.f, 0.f, 0.f, 0.f};
#pragma unroll
              for (int ks = 0; ks < 2; ++ks) { const bf16x8 a = *(const bf16x8*)(VTa + (16 * vt + fr) * 72 + 8 * fq + 32 * ks), bb = *(const bf16x8*)(Ps + (16 * tt + fr) * 72 + 8 * fq + 32 * ks); ni[i] = MFMA16(a, bb, ni[i]); }
#pragma unroll
              for (int ks = 0; ks < 4; ++ks) { const bf16x8 a = *(const bf16x8*)(P.CB + ((size_t)unit * 144 + 16 * vt + fr) * 128 + 8 * fq + 32 * ks), bb = *(const bf16x8*)(Qs + (16 * tt + fr) * 136 + 8 * fq + 32 * ks); ne[i] = MFMA16(a, bb, ne[i]); } }
          const float pm = pmv[t], wi = __expf(mc - pm), fl = __expf(-(bcv[t] + pm));
#pragma unroll
          for (int i = 0; i < 5; ++i) ni[i] = ni[i] + ne[i] * wi;
          const float den = __shfl(ni[4].x, fr), rinv = 1.0f / fmaxf(fabsf(den), fl); float q = 0.f;
#pragma unroll
          for (int i = 0; i < 4; ++i) { ni[i] = ni[i] * rinv; q += (ni[i].x * ni[i].x + ni[i].y * ni[i].y) + (ni[i].z * ni[i].z + ni[i].w * ni[i].w); }
          q += __shfl_xor(q, 16); q += __shfl_xor(q, 32);
          if (fq == 0) ssb[w * 16 + fr] = q;
          __syncthreads();
          const float rs = rsqrtf((q + ssb[(w ^ 4) * 16 + fr]) * (1.0f / 128.0f) + 1e-6f);
          const size_t row = (size_t)(rowb + t0 + t);
#pragma unroll
          for (int i = 0; i < 4; ++i) { const int col = hh * 128 + 16 * (4 * hf + i) + 4 * fq; const f32x4 g = *(const f32x4*)(P.gh + col); const v2u og = *(const v2u*)(P.OG + row * 512 + col);
              v2u o; o.x = pk2(ni[i].x * rs * g.x * bflo(og.x), ni[i].y * rs * g.y * bfhi(og.x)); o.y = pk2(ni[i].z * rs * g.z * bflo(og.y), ni[i].w * rs * g.w * bfhi(og.y));
              *(v2u*)(P.MIX + row * 1024 + col) = o; } }
        __syncthreads();
    }
}
__device__ __forceinline__ void dsa_prep(Frame& F, const EvenPtrs& P) {
    bf16* LAT = (bf16*)F.gl;
    const int lane = F.lane, w = F.wave, fr = lane & 15, fq = lane >> 4;
    for (int tile = F.bid; tile < M / 64; tile += F.G) {
        const int row0 = tile * 64, b = row0 >> 11, s0 = row0 & 2047;
        for (int i = 0; i < 8; ++i) { const int tok = w * 8 + i; const size_t row = (size_t)(row0 + tok);
            const f32x2 x = *(const f32x2*)(P.MISC + row * 256 + 2 * lane); const float ss = wave_sum(x.x * x.x + x.y * x.y), r = rsqrtf(ss * (1.0f / 128.0f) + 1e-6f);
            const f32x2 g = *(const f32x2*)(P.gkv + 2 * lane);
            *(unsigned*)(LAT + tok * 136 + 2 * lane) = pk2(x.x * r * g.x, x.y * r * g.y);
            }
        __syncthreads();
        if (w < 4) { const int rt = w; f32x4 acc[4]; float q[4] = {0.f, 0.f, 0.f, 0.f};
#pragma unroll
            for (int ct = 0; ct < 4; ++ct) { acc[ct] = (f32x4){0.f, 0.f, 0.f, 0.f};
#pragma unroll
                for (int ks = 0; ks < 4; ++ks) { const bf16x8 a = *(const bf16x8*)(LAT + (16 * rt + fr) * 136 + 8 * fq + 32 * ks), bb = *(const bf16x8*)(P.WukT + (16 * ct + fr) * 128 + 8 * fq + 32 * ks); acc[ct] = MFMA16(a, bb, acc[ct]); }
#pragma unroll
                for (int r = 0; r < 4; ++r) q[r] += acc[ct][r] * acc[ct][r]; }
#pragma unroll
            for (int r = 0; r < 4; ++r) { float s = q[r]; s += __shfl_xor(s, 1); s += __shfl_xor(s, 2); s += __shfl_xor(s, 4); s += __shfl_xor(s, 8); q[r] = rsqrtf(s * (1.0f / 64.0f) + 1e-6f); }
#pragma unroll
            for (int ct = 0; ct < 4; ++ct) { const float g = P.gk[16 * ct + fr];
#pragma unroll
                for (int r = 0; r < 4; ++r) P.KB[(size_t)(row0 + 16 * rt + 4 * fq + r) * 64 + 16 * ct + fr] = (bf16)f2bf(acc[ct][r] * q[r] * g); } }
        for (int i = 0; i < 4; ++i) { const int rt = w + 8 * i;
#pragma unroll
            for (int ct = 0; ct < 4; ++ct) { f32x4 acc = (f32x4){0.f, 0.f, 0.f, 0.f};
#pragma unroll
                for (int ks = 0; ks < 4; ++ks) { const bf16x8 a = *(const bf16x8*)(P.WuvT + (size_t)(16 * rt + fr) * 128 + 8 * fq + 32 * ks), bb = *(const bf16x8*)(LAT + (16 * ct + fr) * 136 + 8 * fq + 32 * ks); acc = MFMA16(a, bb, acc); }
#pragma unroll
                for (int r = 0; r < 4; ++r) { const int hd = 16 * rt + 4 * fq + r; P.VT[((size_t)(b * 8 + (hd >> 6)) * 64 + (hd & 63)) * 2048 + s0 + 16 * ct + fr] = (bf16)f2bf(acc[r]); } } }
        __syncthreads();
    }
}
__device__ __forceinline__ void dsa_index(Frame& F, const EvenPtrs& P) {
    const int lane = F.lane, fr = lane & 15, fq = lane >> 4;
    for (int uid = F.gw; uid < BATCH * 576; uid += F.NGW) {
        const int b = uid / 576, rr0 = uid - b * 576; int gq = 0;
        while (gq < 7 && 8 * (gq + 1) * (gq + 2) <= rr0) ++gq;
        const int rr = rr0 - 8 * gq * (gq + 1), qt = gq * 16 + rr / (gq + 1), kc = rr % (gq + 1);
        const int t0 = qt * 16; int nkt = ((t0 + 15 - kc * 256) >> 4) + 1; if (nkt > 16) nkt = 16;
        const size_t rowq = (size_t)b * SEQ + t0 + fr;
        bf16x8 qf[8][2]; float wq[8];
#pragma unroll
        for (int hh = 0; hh < 8; ++hh)
#pragma unroll
            for (int ks = 0; ks < 2; ++ks) qf[hh][ks] = *(const bf16x8*)(P.BQI + rowq * 512 + hh * 64 + 32 * ks + 8 * fq);
        { const f32x4 w0 = *(const f32x4*)(P.MISC + rowq * 256 + 200), w1 = *(const f32x4*)(P.MISC + rowq * 256 + 204); wq[0] = w0.x; wq[1] = w0.y; wq[2] = w0.z; wq[3] = w0.w; wq[4] = w1.x; wq[5] = w1.y; wq[6] = w1.z; wq[7] = w1.w; }
        for (int kt = 0; kt < nkt; ++kt) { const int sk = kc * 256 + kt * 16; const size_t rowk = (size_t)b * SEQ + sk + fr;
            const bf16x8 a0 = *(const bf16x8*)(P.KIB + rowk * 64 + 8 * fq), a1 = *(const bf16x8*)(P.KIB + rowk * 64 + 32 + 8 * fq);
            f32x4 sc = (f32x4){0.f, 0.f, 0.f, 0.f};
#pragma unroll
            for (int hh = 0; hh < 8; ++hh) { f32x4 acc = MFMA16(a0, qf[hh][0], ((f32x4){0.f, 0.f, 0.f, 0.f})); acc = MFMA16(a1, qf[hh][1], acc);
                sc.x += wq[hh] * fmaxf(acc.x, 0.f); sc.y += wq[hh] * fmaxf(acc.y, 0.f); sc.z += wq[hh] * fmaxf(acc.z, 0.f); sc.w += wq[hh] * fmaxf(acc.w, 0.f); }
            *(f32x4*)(P.ISC + rowq * 2048 + sk + 4 * fq) = sc; }
    }
}
__device__ __forceinline__ unsigned fkey(float f) { const unsigned u = __float_as_uint(f); return (u & 0x80000000u) ? ~u : (u | 0x80000000u); }
template <int NJ> __device__ __forceinline__ void select_row(const float* isc, unsigned long long* mo, int t, int lane) {
    unsigned key[NJ];
#pragma unroll
    for (int j = 0; j < NJ; ++j) { const int s = 64 * j + lane; const float x = (s <= t) ? isc[s] : 0.f; key[j] = (s <= t) ? fkey(x) : 0u; }
    unsigned T = 0u;
    for (int bit = 31; bit >= 0; --bit) { const unsigned cand = T | (1u << bit); int cnt = 0;
#pragma unroll
        for (int j = 0; j < NJ; ++j) cnt += __popcll(__ballot(key[j] >= cand));
        if (cnt >= 256) T = cand; }
    int cgt = 0;
#pragma unroll
    for (int j = 0; j < NJ; ++j) cgt += __popcll(__ballot(key[j] > T));
    const int need = 256 - cgt; int run = 0; const unsigned long long lt = (lane == 0) ? 0ull : (~0ull >> (64 - lane));
#pragma unroll
    for (int j = 0; j < 32; ++j) { unsigned long long m = 0ull;
        if (j < NJ) { const unsigned long long eq = __ballot(key[j] == T); const int before = run + __popcll(eq & lt); const bool sel = (key[j] > T) || (key[j] == T && before < need); m = __ballot(sel); run += __popcll(eq); }
        if (lane == 0) mo[j] = m; }
}
template <int NJ> __device__ __forceinline__ void select_hist(const float* isc, unsigned long long* mo, int t, int lane, LAS unsigned* hist  , LAS float* cand  ) {
    float x[NJ]; int bn[NJ];
    float mn = INFINITY, mxv = -INFINITY;
#pragma unroll
    for (int j = 0; j < NJ; ++j) { const int s = 64 * j + lane; const bool v = s <= t; x[j] = v ? isc[s] : 0.f; mn = fminf(mn, v ? x[j] : INFINITY); mxv = fmaxf(mxv, v ? x[j] : -INFINITY); }
    mn = -wave_max(-mn); mxv = wave_max(mxv);
    const float range = mxv - mn; const bool ok = (range > 0.f) && (range < 3.0e38f);
    const float scale = ok ? 2047.0f / range : 0.f;
#pragma unroll
    for (int j = 0; j < NJ; ++j) { const int s = 64 * j + lane; const bool v = s <= t; int b = (int)((x[j] - mn) * scale); b = b > 2047 ? 2047 : b; b = v ? b : 0; bn[j] = v ? b : -1;
        __hip_atomic_fetch_add(hist + b + (b >> 5), v ? 1u : 0u, __ATOMIC_RELAXED, __HIP_MEMORY_SCOPE_WORKGROUP); }
    unsigned hb[32]; unsigned ls = 0u;
#pragma unroll
    for (int k = 0; k < 32; ++k) { hb[k] = hist[33 * lane + k]; ls += hb[k]; }
    unsigned suf = ls;
#pragma unroll
    for (int o = 1; o < 64; o <<= 1) { const unsigned tt = __shfl_down(suf, o); suf += (lane + o < 64) ? tt : 0u; }
    const unsigned long long lm = __ballot(suf >= 256u);
    const int L = 63 - __builtin_clzll(lm);
    unsigned c = suf - ls; int Bl = 0; unsigned cal = 0u, hB = 0u; bool found = false;
#pragma unroll
    for (int k = 31; k >= 0; --k) { const bool hit = !found && (c + hb[k] >= 256u); Bl = hit ? 32 * lane + k : Bl; cal = hit ? c : cal; hB = hit ? hb[k] : hB; found = found || hit; c += found ? 0u : hb[k]; }
    const int B = __shfl(Bl, L); const unsigned cab = __shfl(cal, L), nB = __shfl(hB, L); const int need = 256 - (int)cab;
#pragma unroll
    for (int j = 0; j < NJ; ++j) { const int b = bn[j] < 0 ? 0 : bn[j]; hist[b + (b >> 5)] = 0u; }
    if (!ok || nB > 64u) { select_row<NJ>(isc, mo, t, lane); return; }
    float Ts = -INFINITY; int Is = 0x7fffffff;
    if ((unsigned)need < nB) {
        int run = 0; const unsigned long long lt = (lane == 0) ? 0ull : (~0ull >> (64 - lane));
#pragma unroll
        for (int j = 0; j < NJ; ++j) { const unsigned long long m = __ballot(bn[j] == B); if (m) { if (bn[j] == B) { const int pos = run + __popcll(m & lt); cand[pos] = x[j]; cand[64 + pos] = __int_as_float(64 * j + lane); } run += __popcll(m); } }
        const float xi = (lane < (int)nB) ? cand[lane] : 0.f; const int si = (lane < (int)nB) ? __float_as_int(cand[64 + lane]) : 0; int rank = 0;
        for (int k = 0; k < (int)nB; ++k) { const float xk = cand[k]; const int sk = __float_as_int(cand[64 + k]); rank += (xk > xi || (xk == xi && sk < si)) ? 1 : 0; }
        const unsigned long long wm = __ballot(lane < (int)nB && rank == need - 1); const int src = __builtin_ctzll(wm);
        Ts = __shfl(xi, src); Is = __shfl(si, src);
    }
#pragma unroll
    for (int j = 0; j < 32; ++j) { unsigned long long m = 0ull;
        if (j < NJ) { const int s = 64 * j + lane; const bool sel = (bn[j] > B) || (bn[j] == B && (x[j] > Ts || (x[j] == Ts && s <= Is))); m = __ballot(sel); }
        if (lane == 0) mo[j] = m; }
}
__device__ __forceinline__ void dsa_select(Frame& F, const EvenPtrs& P) {
    const int lane = F.lane;
    LAS unsigned* hist = (LAS unsigned*)(F.lds + F.wave * 9216); LAS float* cand = (LAS float*)(F.lds + F.wave * 9216 + 8448);
    for (int i = lane; i < 2112; i += 64) hist[i] = 0u;
    for (int idx = F.gw; idx < M; idx += F.NGW) {
        const int k = idx >> 11, gwid = idx & 2047, t = (k & 1) ? 2047 - gwid : gwid; const size_t row = (size_t)k * SEQ + t; const int n = t + 1;
        unsigned long long* mo = (unsigned long long*)(P.MASK + row * 64); const float* isc = P.ISC + row * 2048;
        if (n <= 256) {
#pragma unroll
            for (int j = 0; j < 32; ++j) { const unsigned long long m = __ballot(64 * j + lane <= t); if (lane == 0) mo[j] = m; }
        } else if (n <= 512) select_hist<8>(isc, mo, t, lane, hist, cand);
        else if (n <= 1024) select_hist<16>(isc, mo, t, lane, hist, cand);
        else if (n <= 1536) select_hist<24>(isc, mo, t, lane, hist, cand);
        else select_hist<32>(isc, mo, t, lane, hist, cand);
    }
}
__device__ __forceinline__ void dsa_attn(Frame& F, const EvenPtrs& P) {
    bf16* Kl = (bf16*)F.gl; bf16* Vl = (bf16*)(F.gl + 18432); float* btl = (float*)(F.gl + 36864);
    const int tid = F.tid, lane = F.lane, w = F.wave, fr = lane & 15, fq = lane >> 4, lrow = tid >> 3, lch = tid & 7;
    for (int vu = F.bid; vu < 256; vu += F.G) {
        const int bh = vu >> 2, s4 = vu & 3, b = bh >> 3, hh = bh & 7;
        for (int iu = 0; iu < 4; ++iu) {
            const int qb = (iu == 0) ? s4 : (iu == 1) ? 7 - s4 : (iu == 2) ? 8 + s4 : 15 - s4;
            const int t0 = qb * 128, tw = t0 + 16 * w, t = tw + fr; const size_t rowq = (size_t)b * SEQ + t;
            bf16x8 qf[2];
            { const v4u w0 = *(const v4u*)(P.BQ + rowq * 512 + hh * 64 + 8 * fq), w1 = *(const v4u*)(P.BQ + rowq * 512 + hh * 64 + 32 + 8 * fq);
              float x[16] = {bflo(w0.x), bfhi(w0.x), bflo(w0.y), bfhi(w0.y), bflo(w0.z), bfhi(w0.z), bflo(w0.w), bfhi(w0.w), bflo(w1.x), bfhi(w1.x), bflo(w1.y), bfhi(w1.y), bflo(w1.z), bfhi(w1.z), bflo(w1.w), bfhi(w1.w)};
              float ss = 0.f;
#pragma unroll
              for (int j = 0; j < 16; ++j) ss += x[j] * x[j];
              ss += __shfl_xor(ss, 16); ss += __shfl_xor(ss, 32);
              const float r = rsqrtf(ss * (1.0f / 64.0f) + 1e-6f) * (0.125f * LOG2E);
              const f32x4 g0 = *(const f32x4*)(P.gq + 8 * fq), g1 = *(const f32x4*)(P.gq + 8 * fq + 4), g2 = *(const f32x4*)(P.gq + 32 + 8 * fq), g3 = *(const f32x4*)(P.gq + 32 + 8 * fq + 4);
              v4u q0, q1; q0.x = pk2(x[0] * r * g0.x, x[1] * r * g0.y); q0.y = pk2(x[2] * r * g0.z, x[3] * r * g0.w); q0.z = pk2(x[4] * r * g1.x, x[5] * r * g1.y); q0.w = pk2(x[6] * r * g1.z, x[7] * r * g1.w);
              q1.x = pk2(x[8] * r * g2.x, x[9] * r * g2.y); q1.y = pk2(x[10] * r * g2.z, x[11] * r * g2.w); q1.z = pk2(x[12] * r * g3.x, x[13] * r * g3.y); q1.w = pk2(x[14] * r * g3.z, x[15] * r * g3.w);
              qf[0] = __builtin_bit_cast(bf16x8, q0); qf[1] = __builtin_bit_cast(bf16x8, q1); }
            if (tid < 128) btl[tid] = P.bt[hh * 128 + tid];
            const int nk = 2 * qb + 2;
            const bf16* kg = P.KB + ((size_t)b * SEQ + lrow) * 64 + lch * 8;
            const bf16* vg = P.VT + ((size_t)(b * 8 + hh) * 64 + lrow) * 2048 + lch * 8;
            const v2u* mrow = (const v2u*)(P.MASK + rowq * 64);
            v4u kreg = *(const v4u*)kg, vreg = *(const v4u*)vg; v2u mnext = mrow[0];
            *(v4u*)(Kl + lrow * 72 + lch * 8) = kreg; *(v4u*)(Vl + lrow * 72 + lch * 8) = vreg;
            __syncthreads();
            f32x4 o[4]; o[0] = o[1] = o[2] = o[3] = (f32x4){0.f, 0.f, 0.f, 0.f};
            float mrun = -INFINITY, lrun = 0.f; const float b31 = btl[127];
            for (int kt = 0; kt < nk; ++kt) {
                const int s0 = kt * 64; const bf16* Kb = Kl + (kt & 1) * 4608; const bf16* Vb = Vl + (kt & 1) * 4608; const v2u mw = mnext;
                if (kt + 1 < nk) { kreg = *(const v4u*)(kg + (size_t)(s0 + 64) * 64); vreg = *(const v4u*)(vg + s0 + 64); mnext = mrow[kt + 1]; }
                if (s0 <= tw + 15) {
                    float p[16];
                    const bool near = (tw - (s0 + 63)) < 113;
#pragma unroll
                    for (int st = 0; st < 4; ++st) { const bf16x8 a0 = *(const bf16x8*)(Kb + (16 * st + fr) * 72 + 8 * fq), a1 = *(const bf16x8*)(Kb + (16 * st + fr) * 72 + 32 + 8 * fq);
                        f32x4 acc = MFMA16(a0, qf[0], ((f32x4){0.f, 0.f, 0.f, 0.f})); acc = MFMA16(a1, qf[1], acc);
                        const unsigned mword = (st < 2) ? mw.x : mw.y;
#pragma unroll
                        for (int r = 0; r < 4; ++r) { const int kb = 16 * (st & 1) + 4 * fq + r; float bias = b31;
                            if (near) { int dist = t - (s0 + 16 * st + 4 * fq + r); dist = dist < 0 ? 0 : (dist > 127 ? 127 : dist); bias = btl[dist]; }
                            p[4 * st + r] = ((mword >> kb) & 1u) ? acc[r] + bias : -INFINITY; } }
                    float mx = p[0];
#pragma unroll
                    for (int j = 1; j < 16; ++j) mx = fmaxf(mx, p[j]);
                    mx = fmaxf(mx, __shfl_xor(mx, 16)); mx = fmaxf(mx, __shfl_xor(mx, 32));
                    const float mnew = fmaxf(mrun, mx); float alpha = 1.f, psum = 0.f;
                    if (mnew == -INFINITY) {
#pragma unroll
                        for (int j = 0; j < 16; ++j) p[j] = 0.f;
                    } else { alpha = __builtin_amdgcn_exp2f(mrun - mnew);
#pragma unroll
                        for (int j = 0; j < 16; ++j) { p[j] = __builtin_amdgcn_exp2f(p[j] - mnew); psum += p[j]; } }
                    mrun = mnew; lrun = lrun * alpha + psum;
                    bf16x8 pf[2];
                    { v4u pw; pw.x = pk2(p[0], p[1]); pw.y = pk2(p[2], p[3]); pw.z = pk2(p[4], p[5]); pw.w = pk2(p[6], p[7]); pf[0] = __builtin_bit_cast(bf16x8, pw);
                      pw.x = pk2(p[8], p[9]); pw.y = pk2(p[10], p[11]); pw.z = pk2(p[12], p[13]); pw.w = pk2(p[14], p[15]); pf[1] = __builtin_bit_cast(bf16x8, pw); }
#pragma unroll
                    for (int dt = 0; dt < 4; ++dt) { o[dt] = o[dt] * alpha;
#pragma unroll
                        for (int kk = 0; kk < 2; ++kk) { const bf16* vp = Vb + (16 * dt + fr) * 72 + 32 * kk + 4 * fq; const v2u lo = *(const v2u*)vp, hi = *(const v2u*)(vp + 16);
                            v4u vv; vv.x = lo.x; vv.y = lo.y; vv.z = hi.x; vv.w = hi.y; o[dt] = MFMA16(__builtin_bit_cast(bf16x8, vv), pf[kk], o[dt]); } }
                }
                if (kt + 1 < nk) { *(v4u*)(Kl + ((kt + 1) & 1) * 4608 + lrow * 72 + lch * 8) = kreg; *(v4u*)(Vl + ((kt + 1) & 1) * 4608 + lrow * 72 + lch * 8) = vreg; }
                __syncthreads();
            }
            lrun += __shfl_xor(lrun, 16); lrun += __shfl_xor(lrun, 32); const float linv = 1.0f / lrun;
#pragma unroll
            for (int dt = 0; dt < 4; ++dt) { v2u wv; wv.x = pk2(o[dt].x * linv, o[dt].y * linv); wv.y = pk2(o[dt].z * linv, o[dt].w * linv); *(v2u*)(P.MIX + rowq * 1024 + 512 + hh * 64 + 16 * dt + 4 * fq) = wv; }
        }
    }
}
__device__ __forceinline__ void pool_prep(Frame& F, const float* stats, const float* gmix, bf16* POOLED) {
    float* rl = (float*)F.gl;
    for (int tile = F.bid; tile < M / 64; tile += F.G) {
        const int row0 = tile * 64, tpos0 = row0 & 2047;
        if (F.tid < 79) { const int row = row0 - 15 + F.tid; float r = 0.f;
            if (tpos0 - 15 + F.tid >= 0) { const f32x4* p = (const f32x4*)(stats + (size_t)row * 16); const f32x4 a = p[0], b = p[1], c = p[2], d = p[3];
                const float s = (((a.x + a.y) + (a.z + a.w)) + ((b.x + b.y) + (b.z + b.w))) + (((c.x + c.y) + (c.z + c.w)) + ((d.x + d.y) + (d.z + d.w))); r = rsqrtf(s * (1.0f / 1024.0f) + 1e-6f); }
            rl[F.tid] = r; }
        __syncthreads();
        { const int cgp = F.tid & 127, tsub = F.tid >> 7, c0 = cgp * 8, g = cgp >> 5, win = 2 << g, ts = tsub * 16, tps = tpos0 + ts;
          const float* hbase = F.out + (size_t)(row0 + ts) * DM + c0;
          float S[8] = {0.f, 0.f, 0.f, 0.f, 0.f, 0.f, 0.f, 0.f};
#pragma unroll
          for (int j = 1; j < 16; ++j) if (j < win && tps - j >= 0) { const float* hp = hbase - (size_t)j * DM; const f32x4 a = *(const f32x4*)hp, b = *(const f32x4*)(hp + 4); const float r = rl[15 + ts - j];
              S[0] += a.x * r; S[1] += a.y * r; S[2] += a.z * r; S[3] += a.w * r; S[4] += b.x * r; S[5] += b.y * r; S[6] += b.z * r; S[7] += b.w * r; }
          const f32x4 g0 = *(const f32x4*)(gmix + c0), g1 = *(const f32x4*)(gmix + c0 + 4);
          bf16* op = POOLED + ((size_t)g * M + row0 + ts) * 256 + (c0 & 255);
#pragma unroll
          for (int i = 0; i < 16; ++i) { const float* hp = hbase + (size_t)i * DM; const f32x4 a = *(const f32x4*)hp, b = *(const f32x4*)(hp + 4); const float r = rl[15 + ts + i];
              const float y[8] = {a.x * r, a.y * r, a.z * r, a.w * r, b.x * r, b.y * r, b.z * r, b.w * r};
#pragma unroll
              for (int q = 0; q < 8; ++q) S[q] += y[q];
              const int n = (tps + i + 1 < win) ? tps + i + 1 : win; const float inv = 1.0f / (float)n;
              v4u o; o.x = pk2((S[0] * inv - y[0]) * g0.x, (S[1] * inv - y[1]) * g0.y); o.y = pk2((S[2] * inv - y[2]) * g0.z, (S[3] * inv - y[3]) * g0.w);
              o.z = pk2((S[4] * inv - y[4]) * g1.x, (S[5] * inv - y[5]) * g1.y); o.w = pk2((S[6] * inv - y[6]) * g1.z, (S[7] * inv - y[7]) * g1.w);
              *(v4u*)(op + (size_t)i * 256) = o;
              const int dep = i - (win - 1);
              if (tps + dep >= 0) { const float* dp = hbase + (ptrdiff_t)dep * DM; const f32x4 da = *(const f32x4*)dp, db = *(const f32x4*)(dp + 4); const float dr = rl[15 + ts + dep];
                  S[0] -= da.x * dr; S[1] -= da.y * dr; S[2] -= da.z * dr; S[3] -= da.w * dr; S[4] -= db.x * dr; S[5] -= db.y * dr; S[6] -= db.z * dr; S[7] -= db.w * dr; } } }
        __syncthreads();
    }
}
struct RoutePtrs { int* TOKE; float* TOKG; float* TOKR; int* CNT; int* ROWTS; float* ROWG; float* ROWR; int* TILEE; int* NT; };
__device__ __forceinline__ RoutePtrs route_ptrs(unsigned char* ws) { unsigned char* r = ws + WS_ROUTE; RoutePtrs p;
    p.TOKE = (int*)(r + RT_TOKE); p.TOKG = (float*)(r + RT_TOKG); p.TOKR = (float*)(r + RT_TOKR); p.CNT = (int*)(r + RT_CNT); p.ROWTS = (int*)(r + RT_ROWTS); p.ROWG = (float*)(r + RT_ROWG); p.ROWR = (float*)(r + RT_ROWR);
    p.TILEE = (int*)(r + RT_TILEE); p.NT = (int*)(r + RT_NT); return p; }
__device__ __forceinline__ void moe_route(Frame& F, const RoutePtrs& R, const float* gffn, const float* wr, const float* br) {
    int* cnt = (int*)F.gl; const int lane = F.lane;
    float wreg[16][8];
#pragma unroll
    for (int j = 0; j < 4; ++j) { const int c0 = 4 * lane + 256 * j; const f32x4 g = *(const f32x4*)(gffn + c0); const float gg[4] = {g.x, g.y, g.z, g.w};
#pragma unroll
        for (int q = 0; q < 4; ++q) { const f32x4 w0 = *(const f32x4*)(wr + (size_t)(c0 + q) * 8), w1 = *(const f32x4*)(wr + (size_t)(c0 + q) * 8 + 4);
            wreg[4 * j + q][0] = w0.x * gg[q]; wreg[4 * j + q][1] = w0.y * gg[q]; wreg[4 * j + q][2] = w0.z * gg[q]; wreg[4 * j + q][3] = w0.w * gg[q];
            wreg[4 * j + q][4] = w1.x * gg[q]; wreg[4 * j + q][5] = w1.y * gg[q]; wreg[4 * j + q][6] = w1.z * gg[q]; wreg[4 * j + q][7] = w1.w * gg[q]; } }
    const int myexp = ((lane >> 5) & 1) * 4 + ((lane >> 4) & 1) * 2 + ((lane >> 3) & 1); const float mybias = br[myexp];
    for (int tile = F.bid; tile < M / 64; tile += F.G) {
        if (F.tid < 8) cnt[F.tid] = 0;
        __syncthreads();
        for (int ib = 0; ib < 2; ++ib) {
            f32x4 v[4][4];
#pragma unroll
            for (int i = 0; i < 4; ++i) { const f32x4* hr = (const f32x4*)(F.out + (size_t)(tile * 64 + F.wave * 8 + ib * 4 + i) * DM) + lane;
#pragma unroll
                for (int j = 0; j < 4; ++j) v[i][j] = hr[64 * j]; }
#pragma unroll
            for (int i = 0; i < 4; ++i) { const int row = tile * 64 + F.wave * 8 + ib * 4 + i; float ss = 0.f; float lg[8] = {0.f, 0.f, 0.f, 0.f, 0.f, 0.f, 0.f, 0.f};
#pragma unroll
                for (int j = 0; j < 4; ++j) { const float y[4] = {v[i][j].x, v[i][j].y, v[i][j].z, v[i][j].w};
#pragma unroll
                    for (int q = 0; q < 4; ++q) { ss += y[q] * y[q];
#pragma unroll
                        for (int e = 0; e < 8; ++e) lg[e] += y[q] * wreg[4 * j + q][e]; } }
                ss = wave_sum(ss); const float r = rsqrtf(ss * (1.0f / 1024.0f) + 1e-6f);
                float a4[4];
#pragma unroll
                for (int e = 0; e < 4; ++e) { const bool hi = (lane & 32) != 0; const float keep = hi ? lg[e + 4] : lg[e], send = hi ? lg[e] : lg[e + 4]; a4[e] = keep + __shfl_xor(send, 32); }
                float a2[2];
#pragma unroll
                for (int e = 0; e < 2; ++e) { const bool hi = (lane & 16) != 0; const float keep = hi ? a4[e + 2] : a4[e], send = hi ? a4[e] : a4[e + 2]; a2[e] = keep + __shfl_xor(send, 16); }
                float a1; { const bool hi = (lane & 8) != 0; const float keep = hi ? a2[1] : a2[0], send = hi ? a2[0] : a2[1]; a1 = keep + __shfl_xor(send, 8); }
                a1 += __shfl_xor(a1, 4); a1 += __shfl_xor(a1, 2); a1 += __shfl_xor(a1, 1);
                const float mylogit = a1 * r + mybias;
                float l8[8];
#pragma unroll
                for (int e = 0; e < 8; ++e) l8[e] = __shfl(mylogit, 32 * (e >> 2) + 16 * ((e >> 1) & 1) + 8 * (e & 1));
                int e1 = 0; float v1 = l8[0];
#pragma unroll
                for (int e = 1; e < 8; ++e) if (l8[e] > v1) { v1 = l8[e]; e1 = e; }
                int e2 = -1; float v2 = -INFINITY;
#pragma unroll
                for (int e = 0; e < 8; ++e) if (e != e1 && l8[e] > v2) { v2 = l8[e]; e2 = e; }
                const float ex = __expf(v2 - v1), g1 = 1.0f / (1.0f + ex), g2 = ex * g1;
                if (lane == 0) { R.TOKE[row] = e1 | (e2 << 8); R.TOKG[row * 2] = g1; R.TOKG[row * 2 + 1] = g2; R.TOKR[row] = r; atomicAdd(&cnt[e1], 1); atomicAdd(&cnt[e2], 1); } }
        }
        __syncthreads();
        if (F.tid < 8) R.CNT[tile * 8 + F.tid] = cnt[F.tid];
        __syncthreads();
    }
}
__device__ __forceinline__ void moe_scatter(Frame& F, const RoutePtrs& R, const bf16* HB, bf16* YG) {
    int* sm = (int*)F.gl;
    for (int tile = F.bid; tile < M / 64; tile += F.G) {
        if (F.tid < 16) sm[F.tid] = 0;
        __syncthreads();
        for (int i = F.tid; i < (M / 64) * 8; i += 512) { const int v = R.CNT[i]; atomicAdd(&sm[i & 7], v); if ((i >> 3) < tile) atomicAdd(&sm[8 + (i & 7)], v); }
        __syncthreads();
        if (F.tid == 0) { int base = 0; for (int e = 0; e < 8; ++e) { sm[16 + e] = base; base += (sm[e] + 255) & ~255; } sm[24] = base >> 8; }
        __syncthreads();
        if (F.wave == 0) { const int row = tile * 64 + F.lane, te = R.TOKE[row], e1 = te & 255, e2 = te >> 8; int p1 = 0, p2 = 0; const unsigned long long lt = (F.lane == 0) ? 0ull : (~0ull >> (64 - F.lane));
#pragma unroll
            for (int e = 0; e < 8; ++e) { const unsigned long long m1 = __ballot(e1 == e), m2 = __ballot(e2 == e); const int rk = __popcll(m1 & lt) + __popcll(m2 & lt), bs = sm[16 + e] + sm[8 + e];
                if (e1 == e) p1 = bs + rk; if (e2 == e) p2 = bs + rk; }
            const float r = R.TOKR[row]; R.ROWTS[p1] = row * 2; R.ROWTS[p2] = row * 2 + 1; R.ROWG[p1] = R.TOKG[row * 2]; R.ROWG[p2] = R.TOKG[row * 2 + 1]; R.ROWR[p1] = r; R.ROWR[p2] = r;
            sm[32 + 2 * F.lane] = p1; sm[33 + 2 * F.lane] = p2; }
        __syncthreads();
        for (int i = 0; i < 16; ++i) { const int cp = F.wave * 16 + i, tok = cp >> 1, pos = sm[32 + cp]; const v4u* src = (const v4u*)(HB + (size_t)(tile * 64 + tok) * DM); v4u* dst = (v4u*)(YG + (size_t)pos * DM);
            dst[F.lane] = src[F.lane]; dst[64 + F.lane] = src[64 + F.lane]; }
        if (tile == 0) {
            for (int e = 0; e < 8; ++e) { const int lo = sm[16 + e] + sm[e], hi = sm[16 + e] + ((sm[e] + 255) & ~255);
                for (int p = lo + F.tid; p < hi; p += 512) { R.ROWTS[p] = -1; R.ROWG[p] = 0.f; R.ROWR[p] = 0.f; }
                for (int t2 = (sm[16 + e] >> 8) + F.tid; t2 < (hi >> 8); t2 += 512) R.TILEE[t2] = e; }
            if (F.tid == 0) R.NT[0] = sm[24]; }
        __syncthreads();
    }
}
__device__ __forceinline__ void moe_combine(Frame& F, const bf16* D0, const bf16* D1, bf16* HB, float* stats) {
    for (int m = F.gw; m < M; m += F.NGW) { f32x4* hr = (f32x4*)(F.out + (size_t)m * DM) + F.lane; const v2u* a = (const v2u*)(D0 + (size_t)m * DM) + F.lane; const v2u* b = (const v2u*)(D1 + (size_t)m * DM) + F.lane;
        v2u* o8 = (v2u*)(HB + (size_t)m * DM) + F.lane; float s = 0.f;
#pragma unroll
        for (int j = 0; j < 4; ++j) { f32x4 v = hr[64 * j]; const v2u x = a[64 * j], y = b[64 * j];
            v.x += bflo(x.x) + bflo(y.x); v.y += bfhi(x.x) + bfhi(y.x); v.z += bflo(x.y) + bflo(y.y); v.w += bfhi(x.y) + bfhi(y.y);
            hr[64 * j] = v; s += (v.x * v.x + v.y * v.y) + (v.z * v.z + v.w * v.w); v2u w; w.x = pk2(v.x, v.y); w.y = pk2(v.z, v.w); o8[64 * j] = w; }
        s = wave_sum(s);
        if (F.lane < 16) stats[(size_t)m * 16 + F.lane] = (F.lane == 0) ? s : 0.f; }
}
constexpr int N_PHASES = 35;
static_assert(WS_VB == WS_QK + 32 * MiB && WS_OG == WS_VB + 16 * MiB && WS_BQ == WS_OG + 16 * MiB && WS_BQI == WS_BQ + 16 * MiB, "EpiIn address arithmetic");
#ifndef PHASE_SEL
#define PHASE_SEL -1
#endif
#define PHEN(r) (PHASE_SEL < 0 || PHASE_SEL == (r))
#ifndef REP_MASK
#define REP_MASK 0
#endif
#define REPF(bit, call) do { call; if (REP_MASK & (1u << (bit))) { __syncthreads(); call; } } while (0)
#define IN(k) (lo <= (k) && (k) < hi)
#ifndef PROBE_SLOT
#define PROBE_SLOT -1
#endif
#ifndef PROBE_MULT
#define PROBE_MULT 8
#endif
#define SEAM(k) do { if ((k) + 1 < hi) { XcdBarrier b2_ = bar; asm volatile("" : "+s"(b2_.bar)); xcd_barrier(b2_); } \
    if (PROBE_SLOT >= 0) { const unsigned long long now_ = wall_clock64(); if ((((k) == 0) ? 100 : (((k) - 1) % 17)) == PROBE_SLOT) F.tacc += now_ - F.tprev; F.tprev = now_; } } while (0)
#define HBSEL(i) ((bf16*)(ws + ((i) ? WS_HB1 : WS_HB0)))
#define STSEL(i) ((float*)(ws + WS_STATS + ((i) ? MiB : (size_t)0)))
template <int lp> __device__ __forceinline__ void layer_pair(Frame& F, const Args& args, const XcdBarrier& bar, const int lo, const int hi, LAS unsigned char* ring, const int K256) {
    unsigned char* ws = F.ws; bf16* Eb = (bf16*)(ws + WS_E);
        const int pb = 1 + 17 * lp;
        int hbi = 0, si = 0;

        {
            const int e = lp, li = 2 * lp;
            EvenPtrs P;
            P.QK = (const bf16*)(ws + WS_QK); P.VB = (const bf16*)(ws + WS_VB); P.OG = (const bf16*)(ws + WS_OG); P.BQ = (const bf16*)(ws + WS_BQ); P.BQI = (const bf16*)(ws + WS_BQI); P.MISC = (const float*)(ws + WS_MISC);
            P.MIX = (bf16*)(ws + WS_MIX); P.QKC = (bf16*)(ws + WS_QKC); P.KB = (bf16*)(ws + WS_KB); P.KIB = (bf16*)(ws + WS_KIB); P.VT = (bf16*)(ws + WS_VT); P.MASK = (unsigned*)(ws + WS_MASK); P.CHS = (float*)(ws + WS_CHS); P.MST = (float*)(ws + WS_CHS + 65536);
            P.ISC = (float*)(ws + WS_ISC); P.U = (float*)(ws + WS_U); P.CB = (bf16*)(ws + WS_CB);
            P.bgate = INP(IN_B_GATE) + e * 8; P.conv = INP(IN_CONV) + e * 4 * 1024; P.gh = INP(IN_NORM_H) + e * 512; P.gq = INP(IN_NORM_Q) + e * 64; P.gk = INP(IN_NORM_K) + e * 64; P.gkv = INP(IN_NORM_KV) + e * 128;
            P.WukT = (const bf16*)(ws + WS_SMALL + 8192) + (size_t)e * 64 * 128; P.WuvT = (const bf16*)(ws + WS_SMALL + 65536) + (size_t)e * 512 * 128; P.bt = (const float*)(ws + WS_SMALL);
            if (PHEN(1) && IN(pb + 1)) {
                pg8::Gemm g{HBSEL(hbi), (const bf16*)(ws + WS_W_IN) + (size_t)e * NINP * DM, M, NINP, DM}; pg8::StaticOrder S; S.init(M, NINP, F.G, F.bid);
                pg8::EpiIn E{STSEL(si), (bf16*)(ws + WS_QK), (float*)(ws + WS_MISC), (bf16*)(ws + WS_KIB)};
                pg8::gemm_phase<pg8::EpiIn, pg8::StaticOrder, true, true>(ring, g, S, E);
                {
                  int c0 = (((M / 256) * (NINP / 256)) % F.G + 7) & ~7; if (c0 >= F.G) c0 = 0;
                  if (F.bid >= c0) { pg8::Gemm g2{(const bf16*)(ws + WS_PB) + (size_t)li * M * PLED, (const bf16*)(ws + WS_W_PL) + (size_t)li * DM * PLED, M, DM, K256}; pg8::StaticOrder S2; S2.init(M, DM, F.G - c0, F.bid - c0);
                    pg8::EpiStore E2{Eb, DM};
                    pg8::gemm_phase<pg8::EpiStore, pg8::StaticOrder, true, true>(ring, g2, S2, E2); } }
                  SEAM(pb + 1); }
            if (PHEN(2) && IN(pb + 2)) { REPF(1, mlstm_a(F, P)); REPF(2, dsa_prep(F, P)); REPF(3, dsa_index(F, P)); SEAM(pb + 2); }
            if (PHEN(3) && IN(pb + 3)) { REPF(4, mlstm_b(F, P)); REPF(5, dsa_select(F, P)); SEAM(pb + 3); }
            if (PHEN(4) && IN(pb + 4)) { REPF(6, mlstm_c(F, P)); REPF(7, dsa_attn(F, P)); SEAM(pb + 4); }
            if (PHEN(5) && IN(pb + 5)) {
                { pg8::Gemm g{(const bf16*)(ws + WS_MIX), (const bf16*)(ws + WS_W_OUT) + (size_t)e * DM * DM, M, DM, DM}; pg8::StaticOrder S; S.init(M, DM, F.G, F.bid);
                  pg8::EpiResid<0> E{F.out, HBSEL(hbi), STSEL(si ^ 1), nullptr, nullptr, nullptr};
                  pg8::gemm_phase<pg8::EpiResid<0>, pg8::StaticOrder, true, true>(ring, g, S, E); }
                SEAM(pb + 5); }
            si ^= 1;
            if (PHEN(6) && IN(pb + 6)) {
                pg8::Gemm g{HBSEL(hbi), (const bf16*)(ws + WS_W_GU) + (size_t)e * 7168 * DM, M, 7168, DM}; pg8::StaticOrder S; S.init(M, 7168, F.G, F.bid);
                pg8::EpiGLU<false> E{STSEL(si), nullptr, (bf16*)(ws + WS_ACT)};
                pg8::gemm_phase<pg8::EpiGLU<false>, pg8::StaticOrder, true, true>(ring, g, S, E);
                  SEAM(pb + 6); }
            if (PHEN(7) && IN(pb + 7)) {
                pg8::Gemm g{(const bf16*)(ws + WS_ACT), (const bf16*)(ws + WS_W_DN) + (size_t)e * DM * DFF, M, DM, DFF}; pg8::StaticOrder S; S.init(M, DM, F.G, F.bid);
                pg8::EpiResid<0> E{F.out, HBSEL(hbi), STSEL(si ^ 1), nullptr, nullptr, nullptr};
                pg8::gemm_phase<pg8::EpiResid<0>, pg8::StaticOrder, true, true>(ring, g, S, E);
                SEAM(pb + 7); }
            si ^= 1;
            if (PHEN(8) && IN(pb + 8)) {
                pg8::Gemm g{HBSEL(hbi), (const bf16*)(ws + WS_W_PG) + (size_t)li * DM * DM, M, DM, DM}; pg8::StaticOrder S; S.init(M, DM, F.G, F.bid);
                pg8::EpiResid<2> E{F.out, HBSEL(hbi ^ 1), STSEL(si ^ 1), STSEL(si), Eb, nullptr};
                pg8::gemm_phase<pg8::EpiResid<2>, pg8::StaticOrder, true, true>(ring, g, S, E);
                SEAM(pb + 8); }
            si ^= 1; hbi ^= 1;
        }
        {
            const int o = lp, li = 2 * lp + 1;
            const RoutePtrs R = route_ptrs(ws);
            if (PHEN(9) && IN(pb + 9)) {
                pool_prep(F, STSEL(si), INP(IN_NORM_MIX) + li * DM, (bf16*)(ws + WS_POOLED));
                  SEAM(pb + 9); }
            if (PHEN(10) && IN(pb + 10)) {
                pg8::Gemm g{(const bf16*)(ws + WS_POOLED), (const bf16*)(ws + WS_W_POOL) + (size_t)o * 4 * 256 * 256, 4 * M, 1024, K256}; pg8::PoolOrder S{F.G, F.bid};
                pg8::EpiResid<1> E{F.out, HBSEL(hbi), STSEL(si ^ 1), nullptr, nullptr, INP(IN_SCALE_POOL) + o * DM};
                pg8::gemm_phase<pg8::EpiResid<1>, pg8::PoolOrder, true, true>(ring, g, S, E);
                SEAM(pb + 10); }
            si ^= 1;
            if (PHEN(11) && IN(pb + 11)) {   moe_route(F, R, INP(IN_NORM_FFN) + li * DM, INP(IN_W_ROUTER) + (size_t)o * DM * 8, INP(IN_B_ROUTER) + o * 8);   SEAM(pb + 11); }
            if (PHEN(12) && IN(pb + 12)) {   moe_scatter(F, R, HBSEL(hbi), (bf16*)(ws + WS_YG));   SEAM(pb + 12); }
            if (PHEN(13) && IN(pb + 13)) {
                const int nt = __builtin_amdgcn_readfirstlane(R.NT[0]);
                pg8::Gemm g{(const bf16*)(ws + WS_YG), (const bf16*)(ws + WS_W_MGU), MAXROWS, 8 * 7168, DM}; pg8::MoeOrder S{R.TILEE, nt, 28, F.G, F.bid};
                pg8::EpiGLU<true> E{nullptr, R.ROWR, (bf16*)(ws + WS_ACTM)};
                pg8::gemm_phase<pg8::EpiGLU<true>, pg8::MoeOrder, true, true>(ring, g, S, E);
                  SEAM(pb + 13); }
            if (PHEN(14) && IN(pb + 14)) {
                const int nt = __builtin_amdgcn_readfirstlane(R.NT[0]);
                pg8::Gemm g{(const bf16*)(ws + WS_ACTM), (const bf16*)(ws + WS_W_MDN), MAXROWS, 8 * 1024, DFF}; pg8::MoeOrder S{R.TILEE, nt, 4, F.G, F.bid};
                pg8::EpiScatter E{R.ROWTS, R.ROWG, (bf16*)(ws + WS_D0), (bf16*)(ws + WS_D1)};
                pg8::gemm_phase<pg8::EpiScatter, pg8::MoeOrder, true, true>(ring, g, S, E);
                {
                  int c0 = (((nt * 4) % F.G) + 7) & ~7; if (c0 >= F.G) c0 = 0;
                  if (F.bid >= c0) { pg8::Gemm g2{(const bf16*)(ws + WS_PB) + (size_t)li * M * PLED, (const bf16*)(ws + WS_W_PL) + (size_t)li * DM * PLED, M, DM, K256}; pg8::StaticOrder S2; S2.init(M, DM, F.G - c0, F.bid - c0);
                    pg8::EpiStore E2{Eb, DM};
                    pg8::gemm_phase<pg8::EpiStore, pg8::StaticOrder, true, true>(ring, g2, S2, E2); } }
                  SEAM(pb + 14); }
            if (PHEN(15) && IN(pb + 15)) { moe_combine(F, (const bf16*)(ws + WS_D0), (const bf16*)(ws + WS_D1), HBSEL(hbi), STSEL(si ^ 1)); if (lp == 0) REPF(16, conv_moe(F, args, 1));     SEAM(pb + 15); }
            si ^= 1;
            if (PHEN(16) && IN(pb + 16)) {
                pg8::Gemm g{HBSEL(hbi), (const bf16*)(ws + WS_W_PG) + (size_t)li * DM * DM, M, DM, DM}; pg8::StaticOrder S; S.init(M, DM, F.G, F.bid);
                pg8::EpiResid<2> E{F.out, HBSEL(hbi ^ 1), STSEL(si ^ 1), STSEL(si), Eb, nullptr};
                pg8::gemm_phase<pg8::EpiResid<2>, pg8::StaticOrder, true, true>(ring, g, S, E);
                SEAM(pb + 16); }
            si ^= 1; hbi ^= 1;
        }

}
__global__ void __launch_bounds__(NWAVES * 64, 2) fwd(Args args) {
    extern __shared__ __attribute__((aligned(16))) unsigned char lds[];
    Frame F;
    F.lds = (LAS unsigned char*)lds; F.gl = lds; F.MISCW = (volatile LAS unsigned*)(F.lds + MISC_OFF);
    F.tid = threadIdx.x; F.lane = F.tid & 63; F.wave = __builtin_amdgcn_readfirstlane(F.tid >> 6); F.G = gridDim.x; F.bid = blockIdx.x; F.gw = F.bid * NWAVES + F.wave; F.NGW = F.G * NWAVES;
    F.out = args.out; F.ws = args.ws;
    unsigned char* ws = args.ws;
    for (int u = F.tid; u < (LDS_BYTES - LDSCTL_OFF) / 4; u += NWAVES * 64) ((LAS unsigned*)(F.lds + LDSCTL_OFF))[u] = 0u;
    __syncthreads();
    XcdBarrier bar = xcd_barrier_post((unsigned*)(ws + WS_CTL) + CW_BAR, F.MISCW + 8);
    const int lo = args.ph_lo, hi = args.ph_hi;
    F.tacc = 0ull; F.tprev = (PROBE_SLOT >= 0) ? wall_clock64() : 0ull;
    LAS unsigned char* ring = F.lds;
    int K256 = 256; asm volatile("" : "+s"(K256));

    if (PHEN(100) && IN(0)) { REPF(8, p0_prologue(F, args)); SEAM(0); }

    layer_pair<0>(F, args, bar, lo, hi, ring, K256);
    layer_pair<1>(F, args, bar, lo, hi, ring, K256);
    if (PROBE_SLOT >= 0 && F.bid == 0 && F.tid == 0) { const unsigned long long t0_ = wall_clock64(), dl_ = (unsigned long long)PROBE_MULT * F.tacc; while (wall_clock64() - t0_ < dl_) __builtin_amdgcn_s_sleep(8); }
#undef IN
#undef SEAM
}

extern "C" void kernel_launch(void* const* d_in, const int* in_sizes, int n_in, void* d_out, int out_size, void* d_ws, size_t ws_size, hipStream_t stream) {
    static int grid = 0;
    if (grid == 0) {
        if (n_in != 28 || in_sizes[0] != M * DM || out_size != M * DM || ws_size < WS_END) { fprintf(stderr, "kernel_launch: unexpected shapes (n_in %d, in0 %d, out %d, ws %zu < %zu); nothing launched\n", n_in, n_in > 0 ? in_sizes[0] : -1, out_size, ws_size, (size_t)WS_END); grid = -1; return; }
        int dev = 0, cus = 0, per_cu = 0;
        if (hipGetDevice(&dev) != hipSuccess || hipDeviceGetAttribute(&cus, hipDeviceAttributeMultiprocessorCount, dev) != hipSuccess) { grid = -1; return; }
        if (hipFuncSetAttribute((const void*)fwd, hipFuncAttributeMaxDynamicSharedMemorySize, LDS_BYTES) != hipSuccess) { fprintf(stderr, "kernel_launch: hipFuncSetAttribute failed\n"); grid = -1; return; }
        if (hipOccupancyMaxActiveBlocksPerMultiprocessor(&per_cu, (const void*)fwd, NWAVES * 64, LDS_BYTES) != hipSuccess || per_cu < 1) fprintf(stderr, "kernel_launch: occupancy query reports %d workgroups per CU\n", per_cu);
        (void)hipGetLastError();
        grid = cus;
    }
    if (grid < 0) return;
    if (hipMemsetAsync((char*)d_ws + WS_CTL, 0, CTL_ZERO_BYTES, stream) != hipSuccess) return;
    Args a{};
    for (int i = 0; i < 28; ++i) a.in[i] = (const float*)d_in[i];
    a.out = (float*)d_out; a.ws = (unsigned char*)d_ws;
#if MK_ONE_LAUNCH
    a.ph_lo = 0; a.ph_hi = N_PHASES;
    hipLaunchKernelGGL(fwd, dim3(grid), dim3(NWAVES * 64), LDS_BYTES, stream, a);
#else
    for (int ph = 0; ph < N_PHASES; ++ph) { if (ph == 1) continue; a.ph_lo = ph; a.ph_hi = ph + 1;
        hipLaunchKernelGGL(fwd, dim3(grid), dim3(NWAVES * 64), LDS_BYTES, stream, a); }
#endif
}
```

```cpp
#include <hip/hip_runtime.h>
#include <cstdio>
#include <cstdint>
#ifndef MK_ONE_LAUNCH
#define MK_ONE_LAUNCH 1
#endif
namespace pg8 {
#define PG8_LAS __attribute__((address_space(3)))
typedef unsigned short bf16_t;
typedef short bf16x8 __attribute__((ext_vector_type(8)));
typedef float f32x4 __attribute__((ext_vector_type(4)));
typedef unsigned u32x4 __attribute__((ext_vector_type(4)));
constexpr int BM = 256, BK = 64, HALF = 128, HTB = HALF * BK * 2  , STAGE_BYTES = 8 * HTB, NXCD = 8, WGM = 8;

__host__ __device__ __forceinline__ int lds_byte(int r, int c) { const int st = (r >> 4) * 2 + (c >> 5), rr = r & 15, cc = c & 31, ob = rr * 64 + cc * 2; return st * 1024 + (ob ^ (((ob >> 9) & 1) << 5)); }
__host__ __device__ __forceinline__ void stage_rc(int b, int& R, int& C) { const int st = b / 1024, sb = b % 1024, swz = sb ^ (((sb >> 9) & 1) << 5); R = (st >> 1) * 16 + swz / 64; C = (st & 1) * 32 + (swz % 64) / 2; }
__host__ __device__ __forceinline__ int perm32(int rho) { const int n = rho >> 4, i = rho & 15; return 8 * (i >> 2) + 4 * n + (i & 3); }

struct Unit { int pm, pn; };
struct Gemm { const bf16_t* A; const bf16_t* Bt; int M, N, K; };

struct StaticOrder {
    int nM, nN, nwg, G, c;
    __host__ __device__ void init(int M, int N, int G_, int c_) { nM = M / BM; nN = N / BM; nwg = nM * nN; G = G_; c = c_; }
    __host__ __device__ bool next(int i, Unit& u) const {
        const long L = (long)i * G + c; if (L >= nwg) return false;
        int wgid = (int)L; { const int q = nwg / NXCD, r = nwg % NXCD, xcd = wgid % NXCD, off = wgid / NXCD; wgid = (xcd < r ? xcd * (q + 1) : r * (q + 1) + (xcd - r) * q) + off; }
        const int nig = WGM * nN, gid = wgid / nig, fm = gid * WGM, gsz = (nM - fm) < WGM ? (nM - fm) : WGM;
        u.pm = fm + ((wgid % nig) % gsz); u.pn = (wgid % nig) / gsz; return true;
    }
    __device__ __forceinline__ void a_ready(const Unit&) const {}
    __device__ __forceinline__ void done(const Unit&) const {}
};
__device__ __forceinline__ unsigned cvt_pk_bf16(float lo, float hi) { unsigned r; asm volatile("v_cvt_pk_bf16_f32 %0, %1, %2" : "=v"(r) : "v"(lo), "v"(hi)); return r; }
typedef float f32x2 __attribute__((ext_vector_type(2)));
constexpr float RMS_EPS = 1e-6f;
__device__ __forceinline__ float fsigmoid(float x) { return __builtin_amdgcn_rcpf(1.0f + __builtin_amdgcn_exp2f(-1.44269504f * x)); }
__device__ __forceinline__ f32x4 sig4(f32x4 v) { f32x4 o; o.x = fsigmoid(v.x); o.y = fsigmoid(v.y); o.z = fsigmoid(v.z); o.w = fsigmoid(v.w); return o; }
__device__ __forceinline__ u32x4 pack8(f32x4 v0, f32x4 v1) { u32x4 w; w.x = cvt_pk_bf16(v0[0], v0[1]); w.y = cvt_pk_bf16(v0[2], v0[3]); w.z = cvt_pk_bf16(v1[0], v1[1]); w.w = cvt_pk_bf16(v1[2], v1[3]); return w; }
__device__ __forceinline__ void unpack8(u32x4 w, f32x4& a, f32x4& b) {
    a.x = __uint_as_float(w.x << 16); a.y = __uint_as_float(w.x & 0xffff0000u); a.z = __uint_as_float(w.y << 16); a.w = __uint_as_float(w.y & 0xffff0000u);
    b.x = __uint_as_float(w.z << 16); b.y = __uint_as_float(w.z & 0xffff0000u); b.z = __uint_as_float(w.w << 16); b.w = __uint_as_float(w.w & 0xffff0000u); }
__device__ __forceinline__ void load_rstd(const float* stats, int rowb, int fr, int fq, float (&rs)[2][4]) {
    float mine[2];
#pragma unroll
    for (int ai = 0; ai < 2; ++ai) { const f32x4* p = (const f32x4*)(stats + (size_t)(rowb + ai * HALF + fq * 16) * 16); const f32x4 a = p[0], b = p[1], c = p[2], d = p[3];
        const float s = (((a.x + a.y) + (a.z + a.w)) + ((b.x + b.y) + (b.z + b.w))) + (((c.x + c.y) + (c.z + c.w)) + ((d.x + d.y) + (d.z + d.w)));
        mine[ai] = rsqrtf(s * (1.0f / 1024.0f) + RMS_EPS); }
#pragma unroll
    for (int ai = 0; ai < 2; ++ai)
#pragma unroll
        for (int m = 0; m < 4; ++m) rs[ai][m] = __shfl(mine[ai], fr + 16 * m);
}
struct EpiIn {
    static constexpr bool PERM = true, AFTER_DRAIN = false;
    const float* stats; bf16_t* QK; float* MISC; bf16_t* KIB;
    __device__ __forceinline__ void operator()(const f32x4 (&acc)[2][2][4][2], const Unit& u, int wr, int wc, int fr, int fq) const {
        const int rowb = u.pm * BM + wr * 64 + fr, cl = wc * 32 + 8 * fq, pn = u.pn;
        float rs[2][4]; load_rstd(stats, rowb, fr, fq, rs);
        if (pn < 12) {
            bf16_t* base; int ld, colt; bool sig = false;
            if (pn < 4) { base = QK; ld = 1024; colt = pn * 256; }
            else { const int t = (pn - 4) >> 1; base = QK + (size_t)16777216 + (size_t)t * 8388608; ld = 512; colt = ((pn - 4) & 1) * 256; sig = (t == 1); }
#pragma unroll
            for (int ai = 0; ai < 2; ++ai)
#pragma unroll
                for (int m = 0; m < 4; ++m) { const float r = rs[ai][m]; bf16_t* rp = base + (size_t)(rowb + ai * HALF + m * 16) * ld + colt + cl;
#pragma unroll
                    for (int bj = 0; bj < 2; ++bj) { f32x4 v0 = acc[ai][bj][m][0] * r, v1 = acc[ai][bj][m][1] * r; if (sig) { v0 = sig4(v0); v1 = sig4(v1); }
                        *(u32x4*)(rp + bj * HALF) = pack8(v0, v1); }
                    asm volatile("" ::: "memory"); }
        } else {
#pragma unroll
            for (int ai = 0; ai < 2; ++ai)
#pragma unroll
                for (int m = 0; m < 4; ++m) { const float r = rs[ai][m]; float* rp = MISC + (size_t)(rowb + ai * HALF + m * 16) * 256 + cl;
#pragma unroll
                    for (int bj = 0; bj < 2; ++bj)
#pragma unroll
                        for (int n = 0; n < 2; ++n) *(f32x4*)(rp + bj * HALF + 4 * n) = acc[ai][bj][m][n] * r;
                    if (wc < 2) *(u32x4*)(KIB + (size_t)(rowb + ai * HALF + m * 16) * 64 + cl) = pack8(acc[ai][1][m][0] * r, acc[ai][1][m][1] * r);
                    asm volatile("" ::: "memory"); }
        }
    }
};
template <int MODE> struct EpiResid {
    static constexpr bool PERM = true, AFTER_DRAIN = false;
    float* H; bf16_t* HBo; float* statsW; const float* statsR; const bf16_t* E; const float* scale;
    __device__ __forceinline__ void operator()(const f32x4 (&acc)[2][2][4][2], const Unit& u, int wr, int wc, int fr, int fq) const {
        int pm = u.pm; const int pn = u.pn; if (MODE == 1) pm -= 64 * pn;
        const int rowb = pm * BM + wr * 64 + fr, colb = pn * BM + wc * 32 + 8 * fq;
        float rs[2][4]; if (MODE == 2) load_rstd(statsR, rowb, fr, fq, rs);
        f32x4 sc[2][2];
        if (MODE == 1) {
#pragma unroll
            for (int bj = 0; bj < 2; ++bj)
#pragma unroll
                for (int n = 0; n < 2; ++n) sc[bj][n] = *(const f32x4*)(scale + colb + bj * HALF + 4 * n); }
#pragma unroll
        for (int ai = 0; ai < 2; ++ai)
#pragma unroll
            for (int m = 0; m < 4; ++m) { const size_t off = (size_t)(rowb + ai * HALF + m * 16) * 1024 + colb; float ssq = 0.f;
#pragma unroll
                for (int bj = 0; bj < 2; ++bj) { float* hp = H + off + bj * HALF; f32x4 h0 = ((const f32x4*)hp)[0], h1 = ((const f32x4*)hp)[1];
                    f32x4 v0 = acc[ai][bj][m][0], v1 = acc[ai][bj][m][1];
                    if (MODE == 1) { v0 = v0 * sc[bj][0]; v1 = v1 * sc[bj][1]; }
                    if (MODE == 2) { const u32x4 ew = *(const u32x4*)(E + off + bj * HALF); f32x4 e0, e1; unpack8(ew, e0, e1); const float r = rs[ai][m]; v0 = e0 * sig4(v0 * r); v1 = e1 * sig4(v1 * r); }
                    h0 = h0 + v0; h1 = h1 + v1; ((f32x4*)hp)[0] = h0; ((f32x4*)hp)[1] = h1;
                    ssq += ((h0.x * h0.x + h0.y * h0.y) + (h0.z * h0.z + h0.w * h0.w)) + ((h1.x * h1.x + h1.y * h1.y) + (h1.z * h1.z + h1.w * h1.w));
                    *(u32x4*)(HBo + off + bj * HALF) = pack8(h0, h1); }
                ssq += __shfl_xor(ssq, 16); ssq += __shfl_xor(ssq, 32);
                if (fq == 0) statsW[(size_t)(rowb + ai * HALF + m * 16) * 16 + pn * 4 + wc] = ssq;
                asm volatile("" ::: "memory"); }
    }
};
template <bool MOE> struct EpiGLU {
    static constexpr bool PERM = true, AFTER_DRAIN = false;
    const float* stats; const float* rowr; bf16_t* ACT;
    __device__ __forceinline__ void operator()(const f32x4 (&acc)[2][2][4][2], const Unit& u, int wr, int wc, int fr, int fq) const {
        const int rowb = u.pm * BM + wr * 64 + fr, jt = MOE ? (u.pn % 28) : u.pn;
        float rs[2][4];
        if (MOE) {
#pragma unroll
            for (int ai = 0; ai < 2; ++ai)
#pragma unroll
                for (int m = 0; m < 4; ++m) rs[ai][m] = rowr[rowb + ai * HALF + m * 16];
        } else load_rstd(stats, rowb, fr, fq, rs);
#pragma unroll
        for (int ai = 0; ai < 2; ++ai)
#pragma unroll
            for (int m = 0; m < 4; ++m) { const float r = rs[ai][m]; bf16_t* rp = ACT + (size_t)(rowb + ai * HALF + m * 16) * 3584 + jt * 128 + wc * 32 + 8 * fq;
                const f32x4 g0 = acc[ai][0][m][0] * r, g1 = acc[ai][0][m][1] * r, u0 = acc[ai][1][m][0] * r, u1 = acc[ai][1][m][1] * r;
                *(u32x4*)rp = pack8(g0 * sig4(g0) * u0, g1 * sig4(g1) * u1);
                asm volatile("" ::: "memory"); }
    }
};
struct EpiScatter {
    static constexpr bool PERM = true, AFTER_DRAIN = false;
    const int* rowts; const float* rowg; bf16_t *D0, *D1;
    __device__ __forceinline__ void operator()(const f32x4 (&acc)[2][2][4][2], const Unit& u, int wr, int wc, int fr, int fq) const {
        const int rowb = u.pm * BM + wr * 64 + fr, jt = u.pn & 3;
#pragma unroll
        for (int ai = 0; ai < 2; ++ai)
#pragma unroll
            for (int m = 0; m < 4; ++m) { const int row = rowb + ai * HALF + m * 16; const int ts = rowts[row];
                if (ts >= 0) { const float g = rowg[row]; bf16_t* dp = ((ts & 1) ? D1 : D0) + (size_t)(ts >> 1) * 1024 + jt * 256 + wc * 32 + 8 * fq;
#pragma unroll
                    for (int bj = 0; bj < 2; ++bj) *(u32x4*)(dp + bj * HALF) = pack8(acc[ai][bj][m][0] * g, acc[ai][bj][m][1] * g); }
                asm volatile("" ::: "memory"); }
    }
};
struct EpiStore {
    static constexpr bool PERM = true, AFTER_DRAIN = false;
    bf16_t* O; int ldc;
    __device__ __forceinline__ void operator()(const f32x4 (&acc)[2][2][4][2], const Unit& u, int wr, int wc, int fr, int fq) const {
        const int rowb = u.pm * BM + wr * 64 + fr, colb = u.pn * BM + wc * 32 + 8 * fq;
#pragma unroll
        for (int ai = 0; ai < 2; ++ai)
#pragma unroll
            for (int m = 0; m < 4; ++m) { bf16_t* rp = O + (size_t)(rowb + ai * HALF + m * 16) * ldc + colb;
#pragma unroll
                for (int bj = 0; bj < 2; ++bj) *(u32x4*)(rp + bj * HALF) = pack8(acc[ai][bj][m][0], acc[ai][bj][m][1]); }
    }
};
struct PoolOrder {
    int G, c;
    __device__ __forceinline__ bool next(int i, Unit& u) const { const int L = i * G + c; if (L >= 256) return false; const int g = L & 3; u.pm = g * 64 + (L >> 2); u.pn = g; return true; }
    __device__ __forceinline__ void a_ready(const Unit&) const {}
    __device__ __forceinline__ void done(const Unit&) const {}
};
struct MoeOrder {
    const int* tileE; const int* expb; const int* expn; int ntiles, ncol, G, c;
    __device__ __forceinline__ bool next(int i, Unit& u) const {
        if (G == 256) { const int e = c & 7, lu = i * 32 + (c >> 3), nrt = __builtin_amdgcn_readfirstlane(expn[e]); if (lu >= nrt * ncol) return false;
            const int per = 4 * nrt, cbk = lu / per, rem = lu - cbk * per; u.pm = __builtin_amdgcn_readfirstlane(expb[e]) + (rem >> 2); u.pn = e * ncol + cbk * 4 + (rem & 3); return true; }
        const int L = i * G + c; if (L >= ntiles * ncol) return false; const int rt = L / ncol, j = L - rt * ncol;
        u.pm = rt; u.pn = __builtin_amdgcn_readfirstlane(tileE[rt]) * ncol + j; return true; }
    __device__ __forceinline__ void a_ready(const Unit&) const {}
    __device__ __forceinline__ void done(const Unit&) const {}
};
template <class Epi, class Sched, bool ALIGN_EPI = false, bool SP2 = false>
__device__ __forceinline__ void gemm_phase(PG8_LAS unsigned char* lds, const Gemm g, const Sched& S, const Epi& E) {
    const int tid = threadIdx.x, wid = __builtin_amdgcn_readfirstlane(tid >> 6), lane = tid & 63, wr = wid >> 2, wc = wid & 3, fr = lane & 15, fq = lane >> 4;
    const int K = g.K, nt = K / BK;
    unsigned voffA[2], voffB[2];
#pragma unroll
    for (int i = 0; i < 2; ++i) { int R, C; stage_rc(tid * 16 + i * 8192, R, C); const int Rb = Epi::PERM ? ((R & ~31) + perm32(R & 31)) : R;
        voffA[i] = (unsigned)(R * K + C) * 2u; voffB[i] = (unsigned)(Rb * K + C) * 2u; }
    const size_t kstep = (size_t)(BK * 2);
    const size_t hstep = (size_t)HALF * K * 2;
    const size_t tstep = 2 * hstep;
    const unsigned ldsw = (unsigned)wid * 1024u;
    const int aoff = lds_byte(wr * 64 + fr, fq * 8), boff = lds_byte(wc * 32 + fr, fq * 8);
#define PG8_SA(b, h) (((b) * 2 + (h)) * HTB)
#define PG8_SB(b, h) ((4 + (b) * 2 + (h)) * HTB)
#define PG8_STAGE(bufoff, gbase, voff) do { _Pragma("unroll") for (int _i = 0; _i < 2; ++_i) \
        __builtin_amdgcn_global_load_lds((const unsigned*)((const char*)(gbase) + (voff)[_i]), (PG8_LAS unsigned*)(lds + (bufoff) + ldsw + _i * 8192), 16, 0, 0); } while (0)
#define PG8_LDA(dst, b, h) do { _Pragma("unroll") for (int m = 0; m < 4; ++m) _Pragma("unroll") for (int k = 0; k < 2; ++k) dst[m][k] = *(const PG8_LAS bf16x8*)(lds + PG8_SA(b, h) + aoff + m * 2048 + k * 1024); } while (0)
#define PG8_LDB(dst, b, h) do { _Pragma("unroll") for (int n = 0; n < 2; ++n) _Pragma("unroll") for (int k = 0; k < 2; ++k) dst[n][k] = *(const PG8_LAS bf16x8*)(lds + PG8_SB(b, h) + boff + n * 2048 + k * 1024); } while (0)
#define PG8_MMA(ai, bj, At, Bt) do { __builtin_amdgcn_s_setprio(1); _Pragma("unroll") for (int m = 0; m < 4; ++m) _Pragma("unroll") for (int n = 0; n < 2; ++n) _Pragma("unroll") for (int k = 0; k < 2; ++k) \
        acc[ai][bj][m][n] = __builtin_amdgcn_mfma_f32_16x16x32_bf16(Bt[n][k], At[m][k], acc[ai][bj][m][n], 0, 0, 0); __builtin_amdgcn_s_setprio(0); } while (0)
#define PG8_WAIT_V(n) asm volatile("s_waitcnt vmcnt(" #n ")" ::: "memory")
#define PG8_WAIT_L(n) asm volatile("s_waitcnt lgkmcnt(" #n ")" ::: "memory")
#define PG8_BAR __builtin_amdgcn_s_barrier()
#define PG8_SCHED __builtin_amdgcn_sched_barrier(0)
    Unit cur, nxt; int ui = 0;
    if (!S.next(0, cur)) return;
    f32x4 acc[2][2][4][2];
#pragma unroll
    for (int a = 0; a < 2; ++a)
#pragma unroll
        for (int b = 0; b < 2; ++b)
#pragma unroll
            for (int m = 0; m < 4; ++m)
#pragma unroll
                for (int n = 0; n < 2; ++n) acc[a][b][m][n] = (f32x4){0.f, 0.f, 0.f, 0.f};
    bf16x8 At[4][2], B0[2][2], B1[2][2];
    const char* cA = (const char*)g.A + (size_t)cur.pm * tstep; const char* cB = (const char*)g.Bt + (size_t)cur.pn * tstep;
    S.a_ready(cur);
    if constexpr (SP2) {
        PG8_STAGE(PG8_SB(0, 0), cB, voffB); PG8_STAGE(PG8_SB(0, 1), cB + hstep, voffB); PG8_STAGE(PG8_SA(0, 0), cA, voffA); PG8_STAGE(PG8_SA(0, 1), cA + hstep, voffA);
        if (wr == 1) PG8_BAR;
        PG8_WAIT_V(2); PG8_BAR;
        PG8_STAGE(PG8_SB(1, 0), cB + kstep, voffB); PG8_STAGE(PG8_SA(1, 0), cA + kstep, voffA); PG8_STAGE(PG8_SB(1, 1), cB + hstep + kstep, voffB);
        PG8_WAIT_V(6); PG8_BAR;
    } else {
        PG8_STAGE(PG8_SB(0, 0), cB, voffB); PG8_STAGE(PG8_SA(0, 0), cA, voffA); PG8_STAGE(PG8_SB(0, 1), cB + hstep, voffB); PG8_STAGE(PG8_SA(0, 1), cA + hstep, voffA);
        if (wr == 1) PG8_BAR;
        PG8_WAIT_V(4); PG8_BAR;
        PG8_STAGE(PG8_SB(1, 0), cB + kstep, voffB); PG8_STAGE(PG8_SA(1, 0), cA + kstep, voffA); PG8_STAGE(PG8_SB(1, 1), cB + hstep + kstep, voffB);
        PG8_WAIT_V(6); PG8_BAR;
    }
    for (;;) {
        const bool has_next = S.next(ui + 1, nxt);
        const char* nA = has_next ? (const char*)g.A + (size_t)nxt.pm * tstep : cA; const char* nB = has_next ? (const char*)g.Bt + (size_t)nxt.pn * tstep : cB;
        for (int t = 0; t < nt; t += 2) {
            const bool last = (t == nt - 2);
            const char* a1 = cA + (size_t)(t + 1) * kstep;
            const char* a2 = last ? nA : cA + (size_t)(t + 2) * kstep; const char* b2 = last ? nB : cB + (size_t)(t + 2) * kstep;
            const char* a3 = a2 + kstep; const char* b3 = b2 + kstep;
            if (last && has_next) S.a_ready(nxt);
            if constexpr (SP2) {
            PG8_LDB(B0, 0, 0); PG8_LDB(B1, 0, 1); PG8_SCHED; PG8_LDA(At, 0, 0); PG8_STAGE(PG8_SA(1, 1), a1 + hstep, voffA);
            PG8_WAIT_V(8); PG8_WAIT_L(0); PG8_BAR; PG8_MMA(0, 0, At, B0); PG8_MMA(0, 1, At, B1); PG8_BAR; PG8_SCHED;
            PG8_LDA(At, 0, 1); PG8_STAGE(PG8_SB(0, 0), b2, voffB); PG8_STAGE(PG8_SB(0, 1), b2 + hstep, voffB); PG8_STAGE(PG8_SA(0, 0), a2, voffA);
            PG8_WAIT_V(8); PG8_WAIT_L(0); PG8_BAR; PG8_MMA(1, 0, At, B0); PG8_MMA(1, 1, At, B1); PG8_BAR; PG8_SCHED;
            PG8_LDB(B0, 1, 0); PG8_LDB(B1, 1, 1); PG8_SCHED; PG8_LDA(At, 1, 0); PG8_STAGE(PG8_SA(0, 1), a2 + hstep, voffA);
            PG8_WAIT_V(8); PG8_WAIT_L(0); PG8_BAR; PG8_MMA(0, 0, At, B0); PG8_MMA(0, 1, At, B1); PG8_BAR; PG8_SCHED;
            PG8_LDA(At, 1, 1); PG8_STAGE(PG8_SB(1, 0), b3, voffB); PG8_STAGE(PG8_SB(1, 1), b3 + hstep, voffB); PG8_STAGE(PG8_SA(1, 0), a3, voffA);
            PG8_WAIT_V(8); PG8_WAIT_L(0); PG8_BAR; PG8_MMA(1, 0, At, B0); PG8_MMA(1, 1, At, B1); PG8_BAR; PG8_SCHED;
            } else {
            PG8_LDB(B0, 0, 0); PG8_SCHED; PG8_LDA(At, 0, 0); PG8_STAGE(PG8_SA(1, 1), a1 + hstep, voffA);
            PG8_WAIT_L(8); PG8_BAR; PG8_WAIT_L(0); PG8_MMA(0, 0, At, B0); PG8_BAR; PG8_SCHED;
            PG8_LDB(B1, 0, 1); PG8_STAGE(PG8_SB(0, 0), b2, voffB);
            PG8_BAR; PG8_WAIT_L(0); PG8_MMA(0, 1, At, B1); PG8_BAR;
            PG8_LDA(At, 0, 1); PG8_STAGE(PG8_SA(0, 0), a2, voffA);
            PG8_BAR; PG8_WAIT_L(0); PG8_MMA(1, 0, At, B0); PG8_BAR; PG8_SCHED;
            PG8_STAGE(PG8_SB(0, 1), b2 + hstep, voffB);
            PG8_WAIT_V(6); PG8_BAR; PG8_MMA(1, 1, At, B1); PG8_BAR;
            PG8_LDB(B0, 1, 0); PG8_SCHED; PG8_LDA(At, 1, 0); PG8_STAGE(PG8_SA(0, 1), a2 + hstep, voffA);
            PG8_WAIT_L(8); PG8_BAR; PG8_WAIT_L(0); PG8_MMA(0, 0, At, B0); PG8_BAR; PG8_SCHED;
            PG8_LDB(B1, 1, 1); PG8_STAGE(PG8_SB(1, 0), b3, voffB);
            PG8_BAR; PG8_WAIT_L(0); PG8_MMA(0, 1, At, B1); PG8_BAR;
            PG8_LDA(At, 1, 1); PG8_STAGE(PG8_SA(1, 0), a3, voffA);
            PG8_BAR; PG8_WAIT_L(0); PG8_MMA(1, 0, At, B0); PG8_BAR; PG8_SCHED;
            PG8_STAGE(PG8_SB(1, 1), b3 + hstep, voffB);
            PG8_WAIT_V(6); PG8_BAR; PG8_MMA(1, 1, At, B1); PG8_BAR;
            }
        }
        if constexpr (ALIGN_EPI) { if (wr == 0) PG8_BAR; }
        if constexpr (!Epi::AFTER_DRAIN) { E(acc, cur, wr, wc, fr, fq); S.done(cur); }
        if (!has_next) break;
#pragma unroll
        for (int a = 0; a < 2; ++a)
#pragma unroll
            for (int b = 0; b < 2; ++b)
#pragma unroll
                for (int m = 0; m < 4; ++m)
#pragma unroll
                    for (int n = 0; n < 2; ++n) acc[a][b][m][n] = (f32x4){0.f, 0.f, 0.f, 0.f};
        cur = nxt; cA = nA; cB = nB; ++ui;
        if constexpr (ALIGN_EPI) { if (wr == 1) PG8_BAR; }
    }
    PG8_WAIT_V(0);
    if constexpr (!ALIGN_EPI) { if (wr == 0) PG8_BAR; }
    PG8_BAR;
    if constexpr (Epi::AFTER_DRAIN) { E.fused(acc, cur, wr, wc, fr, fq, lds, wid, lane); S.done(cur); }
#undef PG8_SA
#undef PG8_SB
#undef PG8_STAGE
#undef PG8_LDA
#undef PG8_LDB
#undef PG8_MMA
#undef PG8_WAIT_V
#undef PG8_WAIT_L
#undef PG8_BAR
#undef PG8_SCHED
}
}
constexpr int NWAVES = 8;
constexpr int BATCH = 8, SEQ = 2048, DM = 1024, M = BATCH * SEQ, DFF = 3584, NEXP = 8, PLED = 256, NINP = 3328, NCHUNK = 32;
constexpr float LOG2E = 1.4426950408889634f;
constexpr size_t MiB = 1u << 20;
constexpr size_t WS_CTL = 0, CTL_ZERO_BYTES = 1 * MiB;
constexpr size_t WS_SMALL = 1 * MiB;
constexpr size_t WS_W_IN = 2 * MiB, WS_W_OUT = 15 * MiB, WS_W_GU = 19 * MiB, WS_W_DN = 47 * MiB, WS_W_PG = 61 * MiB, WS_W_PL = 69 * MiB, WS_W_POOL = 71 * MiB;
constexpr size_t WS_W_MGU = 72 * MiB, WS_W_MDN = 184 * MiB;
constexpr size_t WS_HB0 = 240 * MiB, WS_HB1 = 272 * MiB, WS_STATS = 304 * MiB, WS_PB = 306 * MiB, WS_E = 338 * MiB;
constexpr size_t WS_OVL = 370 * MiB;
constexpr size_t WS_QK = WS_OVL, WS_VB = WS_OVL + 32 * MiB, WS_OG = WS_OVL + 48 * MiB, WS_BQ = WS_OVL + 64 * MiB, WS_BQI = WS_OVL + 80 * MiB, WS_MISC = WS_OVL + 96 * MiB, WS_MIX = WS_OVL + 112 * MiB;
constexpr size_t WS_KB = WS_OVL + 144 * MiB, WS_KIB = WS_OVL + 146 * MiB, WS_VT = WS_OVL + 148 * MiB, WS_MASK = WS_OVL + 164 * MiB, WS_CHS = WS_OVL + 168 * MiB;
constexpr size_t WS_ISC = WS_OVL + 169 * MiB, WS_U = WS_OVL + 297 * MiB, WS_CB = WS_OVL + 369 * MiB, WS_QKC = WS_OVL + 406 * MiB, WS_ACT = WS_ISC;
constexpr size_t WS_POOLED = WS_OVL, WS_YG = WS_OVL + 32 * MiB, WS_ACTM = WS_OVL + 100 * MiB, WS_D0 = WS_OVL + 338 * MiB, WS_D1 = WS_OVL + 370 * MiB, WS_ROUTE = WS_OVL + 402 * MiB;
constexpr size_t WS_END = WS_OVL + 438 * MiB;
constexpr int MAXROWS = 34816;
constexpr size_t RT_TOKE = 0, RT_TOKG = 65536, RT_TOKR = 196608, RT_CNT = 262144, RT_ROWTS = 270336, RT_ROWG = 409600, RT_ROWR = 548864, RT_TILEE = 688128, RT_NT = 688128 + 1024;
constexpr int CW_BAR = 4096;
constexpr int RING_BYTES = 131072, LDSCTL_OFF = RING_BYTES, MISC_OFF = LDSCTL_OFF + 320, LDS_BYTES = 147456;

#define GAS __attribute__((address_space(1)))
#define LAS __attribute__((address_space(3)))
typedef unsigned short bf16;
typedef unsigned v4u __attribute__((ext_vector_type(4)));
typedef unsigned v2u __attribute__((ext_vector_type(2)));
typedef float f32x4 __attribute__((ext_vector_type(4)));
typedef float f32x2 __attribute__((ext_vector_type(2)));
typedef short bf16x8 __attribute__((ext_vector_type(8)));
#define LDS_WAIT() asm volatile("s_waitcnt lgkmcnt(0)" ::: "memory")
__device__ __forceinline__ unsigned f2bf(float f) { unsigned u = __builtin_bit_cast(unsigned, f); return (u + 0x7fffu + ((u >> 16) & 1u)) >> 16; }
__device__ __forceinline__ unsigned pk2(float lo, float hi) { return f2bf(lo) | (f2bf(hi) << 16); }
__device__ __forceinline__ float bflo(unsigned w) { return __uint_as_float(w << 16); }
__device__ __forceinline__ float bfhi(unsigned w) { return __uint_as_float(w & 0xffff0000u); }
__device__ __forceinline__ float bf2f(bf16 b) { return __uint_as_float(((unsigned)b) << 16); }
__device__ __forceinline__ float wave_sum(float v) {
#pragma unroll
    for (int o = 1; o < 64; o <<= 1) v += __shfl_xor(v, o);
    return v;
}
__device__ __forceinline__ float wave_max(float v) {
#pragma unroll
    for (int o = 1; o < 64; o <<= 1) v = fmaxf(v, __shfl_xor(v, o));
    return v;
}
__device__ __forceinline__ float fsig(float x) { return 1.0f / (1.0f + __expf(-x)); }
#define MFMA16(a, b, c) __builtin_amdgcn_mfma_f32_16x16x32_bf16((a), (b), (c), 0, 0, 0)
#define XB_TMO      128
#define XB_XCNT(j)  (256  + 64 * (j))
#define XB_XSUB(j)  (1280 + 64 * (j))
#define XB_XGEN(j)  (2304 + 64 * (j))
#define XB_TOP      3328
#define XB_TOPGEN   3392
#define XCD_BAR_WORDS 3456
#define XB_SPIN_CAP (1u << 18)

__device__ __forceinline__ unsigned xb_ld(unsigned* p)              { return __hip_atomic_load(p, __ATOMIC_RELAXED, __HIP_MEMORY_SCOPE_AGENT); }
__device__ __forceinline__ unsigned xb_add(unsigned* p, unsigned v) { return __hip_atomic_fetch_add(p, v, __ATOMIC_RELAXED, __HIP_MEMORY_SCOPE_AGENT); }
__device__ __forceinline__ unsigned xb_xcc_id() { return (unsigned)__builtin_amdgcn_s_getreg((3 << 11) | 20) & 0xFu; }
#define XB_SPIN(cond, bar) do { unsigned _sp = 0; while (cond) { __builtin_amdgcn_s_sleep(1); \
    if ((++_sp & 255u) == 0u) { if (xb_ld(&(bar)[XB_TMO])) break; if (_sp > XB_SPIN_CAP) { atomicAdd(&(bar)[XB_TMO], 1u); break; } } } } while (0)

struct XcdBarrier {
    unsigned* bar; unsigned x;
    volatile LAS unsigned* st;
};

__device__ __forceinline__ XcdBarrier xcd_barrier_post(unsigned* bar, volatile LAS unsigned* st) {
    XcdBarrier b; b.bar = bar; b.x = xb_xcc_id(); b.st = st;
    if (threadIdx.x == 0) (void)xb_add(&bar[XB_XCNT(b.x)], 1u);
    return b;
}
__device__ __forceinline__ void xcd_barrier_complete(unsigned* bar, unsigned x, unsigned& nloc, unsigned& nx) {
    const unsigned G = gridDim.x * gridDim.y * gridDim.z;
    unsigned sum, cnt, mine, sp = 0u;
    for (;;) {
        sum = 0u; cnt = 0u; mine = 0u;
#pragma unroll
        for (unsigned j = 0; j < 16; ++j) { const unsigned c = xb_ld(&bar[XB_XCNT(j)]); sum += c; cnt += (c > 0u) ? 1u : 0u; mine = (j == x) ? c : mine; }
        if (sum == G) break;
        __builtin_amdgcn_s_sleep(1);
        if ((++sp & 255u) == 0u) { if (xb_ld(&bar[XB_TMO])) break; if (sp > XB_SPIN_CAP) { atomicAdd(&bar[XB_TMO], 1u); break; } }
    }
    nloc = mine > 0u ? mine : 1u; nx = cnt > 0u ? cnt : 1u;
}

__device__ __forceinline__ void xcd_barrier(const XcdBarrier& b) {
    asm volatile("s_waitcnt vmcnt(0)" ::: "memory");
    __syncthreads();
    if (threadIdx.x == 0) {
        unsigned* bar = b.bar;
        __builtin_amdgcn_s_waitcnt(0);
        unsigned nloc = b.st[0], nx = b.st[1];
        if (nloc == 0u) { xcd_barrier_complete(bar, b.x, nloc, nx); b.st[0] = nloc; b.st[1] = nx; }
        const unsigned old = xb_add(&bar[XB_XSUB(b.x)], 1u);
        const unsigned gen = old / nloc;
        if (old + 1u == (gen + 1u) * nloc) {
            __builtin_amdgcn_fence(__ATOMIC_RELEASE, "agent");
            asm volatile("s_waitcnt vmcnt(0)" ::: "memory");
            const unsigned og = xb_add(&bar[XB_TOP], 1u);
            const unsigned tg = og / nx;
            if (og + 1u == (tg + 1u) * nx) xb_add(&bar[XB_TOPGEN], 1u);
            else XB_SPIN(xb_ld(&bar[XB_TOPGEN]) == tg, bar);
            __builtin_amdgcn_fence(__ATOMIC_ACQUIRE, "agent");
            xb_add(&bar[XB_XGEN(b.x)], 1u);
            asm volatile("s_waitcnt vmcnt(0)" ::: "memory");
        } else {
            XB_SPIN(xb_ld(&bar[XB_XGEN(b.x)]) == gen, bar);
            __builtin_amdgcn_fence(__ATOMIC_ACQUIRE, "agent");
            asm volatile("s_waitcnt vmcnt(0)" ::: "memory");
        }
    }
    __syncthreads();
}
struct Args { const float* in[28]; float* out; unsigned char* ws; int ph_lo, ph_hi; };
struct Frame {
    LAS unsigned char* lds; unsigned char* gl;
    volatile LAS unsigned* MISCW;
    int tid, lane, wave, G, bid, gw, NGW;
    float* out; unsigned char* ws;
    unsigned long long tacc, tprev;
};
#define INP(k) (args.in[k])
#define IN_X 0
#define IN_P 1
#define IN_NORM_MIX 2
#define IN_NORM_FFN 3
#define IN_W_IN 4
#define IN_B_GATE 5
#define IN_CONV 6
#define IN_NORM_H 7
#define IN_NORM_Q 8
#define IN_NORM_K 9
#define IN_NORM_KV 10
#define IN_W_UK 11
#define IN_W_UV 12
#define IN_W_OUT 13
#define IN_REL_BIAS 14
#define IN_W_POOL 15
#define IN_SCALE_POOL 16
#define IN_W_GATE_D 17
#define IN_W_UP_D 18
#define IN_W_DOWN_D 19
#define IN_W_ROUTER 20
#define IN_B_ROUTER 21
#define IN_W_GATE_M 22
#define IN_W_UP_M 23
#define IN_W_DOWN_M 24
#define IN_W_PLE 25
#define IN_W_PLE_GATE 26
#define IN_NORM_PLE 27

template <int MODE> __device__ __forceinline__ int dst_row(int n) {
    if (MODE == 0) return n;
    if (MODE == 1) return ((n >> 7) << 8) + (n & 127);
    if (MODE == 2) return ((n >> 7) << 8) + 128 + (n & 127);
    if (n < 2048) return n;
    if (n < 2052) return 3264 + (n - 2048);
    if (n < 2056) return 3268 + (n - 2052);
    if (n < 2568) return 2048 + (n - 2056);
    if (n < 2696) return 3072 + (n - 2568);
    if (n < 3208) return 2560 + (n - 2696);
    if (n < 3272) return 3200 + (n - 3208);
    return 3272 + (n - 3272);
}
template <int MODE> __device__ __forceinline__ void conv_mat(Frame& F, const float* W, int K, int N, bf16* WT, const float* gain, int wi, int nw) {
    LAS float* scr = (LAS float*)(F.lds + F.wave * 16384);
    const int nblk = (N + 31) >> 5, nitems = (K >> 6) * nblk, lane = F.lane, r = lane >> 3, c4 = lane & 7;
    for (int it = wi; it < nitems; it += nw) {
        const int kb = it / nblk, nb = it - kb * nblk, k0 = 64 * kb, n0 = 32 * nb, nn = n0 + 4 * c4; const bool okn = nn < N;
        f32x4 v[8];
#pragma unroll
        for (int i = 0; i < 8; ++i) v[i] = okn ? *(const f32x4*)(W + (size_t)(k0 + 8 * i + r) * N + nn) : (f32x4){0.f, 0.f, 0.f, 0.f};
        if (gain) {
#pragma unroll
            for (int i = 0; i < 8; ++i) v[i] = v[i] * gain[k0 + 8 * i + r]; }
#pragma unroll
        for (int i = 0; i < 8; ++i) { LAS float* d = scr + (8 * i + r) * 33 + 4 * c4; d[0] = v[i].x; d[1] = v[i].y; d[2] = v[i].z; d[3] = v[i].w; }
        LDS_WAIT(); asm volatile("" ::: "memory");
        const int c = lane & 7;
#pragma unroll
        for (int j = 0; j < 4; ++j) { const int n = (lane >> 3) + 8 * j; const LAS float* s = scr + (8 * c) * 33 + n;
            v4u o; o.x = pk2(s[0 * 33], s[1 * 33]); o.y = pk2(s[2 * 33], s[3 * 33]); o.z = pk2(s[4 * 33], s[5 * 33]); o.w = pk2(s[6 * 33], s[7 * 33]);
            if (n0 + n < N) *(v4u*)(WT + (size_t)dst_row<MODE>(n0 + n) * K + k0 + 8 * c) = o; }
        LDS_WAIT(); asm volatile("" ::: "memory");
    }
}
__device__ __forceinline__ void conv_moe(Frame& F, const Args& args, int o) {
    bf16* mgu = (bf16*)(F.ws + WS_W_MGU); bf16* mdn = (bf16*)(F.ws + WS_W_MDN);
    const float* gain = INP(IN_NORM_FFN) + (2 * o + 1) * DM;
    for (int e = 0; e < NEXP; ++e) {
        const size_t wo = ((size_t)o * NEXP + e) * DM * DFF;
        conv_mat<1>(F, INP(IN_W_GATE_M) + wo, DM, DFF, mgu + (size_t)e * 7168 * 1024, gain, F.gw, F.NGW);
        conv_mat<2>(F, INP(IN_W_UP_M) + wo, DM, DFF, mgu + (size_t)e * 7168 * 1024, gain, F.gw, F.NGW);
        conv_mat<0>(F, INP(IN_W_DOWN_M) + wo, DFF, DM, mdn + (size_t)e * 1024 * 3584, nullptr, F.gw, F.NGW);
    }
}
__device__ __forceinline__ void p0_prologue(Frame& F, const Args& args) {
    unsigned char* ws = F.ws;
    for (int e = 0; e < 2; ++e) {
        conv_mat<3>(F, INP(IN_W_IN) + (size_t)e * DM * 3280, DM, 3280, (bf16*)(ws + WS_W_IN) + (size_t)e * NINP * DM, INP(IN_NORM_MIX) + (2 * e) * DM, F.gw, F.NGW);
        conv_mat<0>(F, INP(IN_W_OUT) + (size_t)e * DM * DM, DM, DM, (bf16*)(ws + WS_W_OUT) + (size_t)e * DM * DM, nullptr, F.gw, F.NGW);
        conv_mat<1>(F, INP(IN_W_GATE_D) + (size_t)e * DM * DFF, DM, DFF, (bf16*)(ws + WS_W_GU) + (size_t)e * 7168 * DM, INP(IN_NORM_FFN) + (2 * e) * DM, F.gw, F.NGW);
        conv_mat<2>(F, INP(IN_W_UP_D) + (size_t)e * DM * DFF, DM, DFF, (bf16*)(ws + WS_W_GU) + (size_t)e * 7168 * DM, INP(IN_NORM_FFN) + (2 * e) * DM, F.gw, F.NGW);
        conv_mat<0>(F, INP(IN_W_DOWN_D) + (size_t)e * DFF * DM, DFF, DM, (bf16*)(ws + WS_W_DN) + (size_t)e * DM * DFF, nullptr, F.gw, F.NGW);
        conv_mat<0>(F, INP(IN_W_UK) + (size_t)e * 128 * 64, 128, 64, (bf16*)(ws + WS_SMALL + 8192) + (size_t)e * 64 * 128, nullptr, F.gw, F.NGW);
        for (int h = 0; h < 8; ++h)
            conv_mat<0>(F, INP(IN_W_UV) + ((size_t)e * 8 + h) * 128 * 64, 128, 64, (bf16*)(ws + WS_SMALL + 65536) + ((size_t)e * 512 + h * 64) * 128, nullptr, F.gw, F.NGW);
        for (int g = 0; g < 4; ++g)
            conv_mat<0>(F, INP(IN_W_POOL) + ((size_t)e * 4 + g) * 256 * 256, 256, 256, (bf16*)(ws + WS_W_POOL) + ((size_t)e * 4 + g) * 256 * 256, nullptr, F.gw, F.NGW);
    }
    for (int i = 0; i < 4; ++i) {
        conv_mat<0>(F, INP(IN_W_PLE_GATE) + (size_t)i * DM * DM, DM, DM, (bf16*)(ws + WS_W_PG) + (size_t)i * DM * DM, INP(IN_NORM_PLE) + i * DM, F.gw, F.NGW);
        conv_mat<0>(F, INP(IN_W_PLE) + (size_t)i * PLED * DM, PLED, DM, (bf16*)(ws + WS_W_PL) + (size_t)i * DM * PLED, nullptr, F.gw, F.NGW);
    }
    conv_moe(F, args, 0);
    const int gt = F.bid * 512 + F.tid, NT = F.G * 512;
    for (int i = gt; i < 2 * 48 * DM / 8; i += NT) { const int e = i / (48 * DM / 8), r = i - e * (48 * DM / 8); *(v4u*)((bf16*)(ws + WS_W_IN) + ((size_t)e * NINP + 3280) * DM + (size_t)r * 8) = (v4u){0u, 0u, 0u, 0u}; }
    if (F.bid == 0) for (int t = F.tid; t < 1024; t += 512) { const int hh = t >> 7, d = t & 127; int bk = d;
        if (d >= 16) { bk = 16 + (d >= 19) + (d >= 21) + (d >= 24) + (d >= 27) + (d >= 31) + (d >= 35) + (d >= 40) + (d >= 46) + (d >= 52) + (d >= 59) + (d >= 67) + (d >= 77) + (d >= 87) + (d >= 99) + (d >= 113); }
        ((float*)(ws + WS_SMALL))[t] = INP(IN_REL_BIAS)[bk * 8 + hh] * LOG2E; }
    { const f32x4* src = (const f32x4*)INP(IN_P); v4u* dst = (v4u*)(ws + WS_PB);
      for (int i = gt; i < 4 * M * PLED / 8; i += NT) { const f32x4 a = src[2 * i], b = src[2 * i + 1]; v4u o; o.x = pk2(a.x, a.y); o.y = pk2(a.z, a.w); o.z = pk2(b.x, b.y); o.w = pk2(b.z, b.w); dst[i] = o; } }
    { const float* x = INP(IN_X); bf16* hb = (bf16*)(ws + WS_HB0); float* st = (float*)(ws + WS_STATS);
      for (int m = F.gw; m < M; m += F.NGW) { const f32x4* xr = (const f32x4*)(x + (size_t)m * DM) + F.lane; f32x4* orow = (f32x4*)(F.out + (size_t)m * DM) + F.lane; f32x4 v[4]; float s = 0.f;
#pragma unroll
          for (int j = 0; j < 4; ++j) { v[j] = xr[64 * j]; orow[64 * j] = v[j]; s += (v[j].x * v[j].x + v[j].y * v[j].y) + (v[j].z * v[j].z + v[j].w * v[j].w); }
          s = wave_sum(s);
          v2u* o8 = (v2u*)(hb + (size_t)m * DM) + F.lane;
#pragma unroll
          for (int j = 0; j < 4; ++j) { v2u w; w.x = pk2(v[j].x, v[j].y); w.y = pk2(v[j].z, v[j].w); o8[64 * j] = w; }
          if (F.lane < 16) st[(size_t)m * 16 + F.lane] = (F.lane == 0) ? s : 0.f; } }
}

struct EvenPtrs {
    const bf16 *QK, *VB, *OG, *BQ, *BQI; const float* MISC; bf16 *MIX, *KB, *KIB, *VT, *QKC; unsigned* MASK; float* CHS; float* MST; float* ISC; float* U; bf16* CB;
    const float *bgate, *conv, *gh, *gq, *gk, *gkv; const bf16 *WukT, *WuvT; const float* bt;
};
__device__ __forceinline__ void conv8(const bf16* QK, const float* cw, int rowb, int tpos, int ch, float (&o)[8]) {
#pragma unroll
    for (int j = 0; j < 8; ++j) o[j] = 0.f;
#pragma unroll
    for (int tap = 0; tap < 4; ++tap) { const int tp = tpos - 3 + tap;
        if (tp >= 0) { const v4u w = *(const v4u*)(QK + (size_t)(rowb + tp) * 1024 + ch); const f32x4 c0 = *(const f32x4*)(cw + tap * 1024 + ch), c1 = *(const f32x4*)(cw + tap * 1024 + ch + 4);
            o[0] += bflo(w.x) * c0.x; o[1] += bfhi(w.x) * c0.y; o[2] += bflo(w.y) * c0.z; o[3] += bfhi(w.y) * c0.w;
            o[4] += bflo(w.z) * c1.x; o[5] += bfhi(w.z) * c1.y; o[6] += bflo(w.w) * c1.z; o[7] += bfhi(w.w) * c1.w; } }
#pragma unroll
    for (int j = 0; j < 8; ++j) o[j] = o[j] * fsig(o[j]);
}
__device__ __forceinline__ void chunk_gates(const EvenPtrs& P, int row, int hh, int lane, float& li, float& bc) {
    const float ai = P.MISC[(size_t)row * 256 + 192 + hh], af = P.MISC[(size_t)row * 256 + 196 + hh];
    li = ai + P.bgate[hh]; const float x = af + P.bgate[4 + hh]; const float lf = fminf(x, 0.f) - log1pf(__expf(-fabsf(x)));
    bc = lf;
#pragma unroll
    for (int o = 1; o < 64; o <<= 1) { const float t = __shfl_up(bc, o); if (lane >= o) bc += t; }
}
__device__ __forceinline__ void mlstm_a(Frame& F, const EvenPtrs& P) {
    bf16* KT = (bf16*)F.gl; bf16* VwT = (bf16*)(F.gl + 18432); float* wv = (float*)(F.gl + 18432 + 20736);
    const int tid = F.tid, lane = F.lane, w = F.wave, fr = lane & 15, fq = lane >> 4;
    for (int unit = F.bid; unit < BATCH * 4 * NCHUNK; unit += F.G) {
        const int b = unit >> 7, hh = (unit >> 5) & 3, c = unit & 31, rowb = b * SEQ, t0 = c * 64;
        if (w == 0) { float li, bc; chunk_gates(P, rowb + t0 + lane, hh, lane, li, bc); const float blast = __shfl(bc, 63), g = blast - bc + li, gmax = wave_max(g);
            wv[lane] = __expf(g - gmax); if (lane == 0) { P.CHS[unit * 2] = blast; P.CHS[unit * 2 + 1] = gmax; } }
        { const int cg = tid & 31, s0 = (tid >> 5) * 4, ch = (cg < 16 ? 0 : 512 - 128) + hh * 128 + cg * 8;
          float cw[4][8];
#pragma unroll
          for (int tap = 0; tap < 4; ++tap) { const f32x4 c0 = *(const f32x4*)(P.conv + tap * 1024 + ch), c1 = *(const f32x4*)(P.conv + tap * 1024 + ch + 4);
              cw[tap][0] = c0.x; cw[tap][1] = c0.y; cw[tap][2] = c0.z; cw[tap][3] = c0.w; cw[tap][4] = c1.x; cw[tap][5] = c1.y; cw[tap][6] = c1.z; cw[tap][7] = c1.w; }
          v4u xin[7];
#pragma unroll
          for (int i = 0; i < 7; ++i) { const int tp = t0 + s0 - 3 + i; xin[i] = (tp >= 0) ? *(const v4u*)(P.QK + (size_t)(rowb + tp) * 1024 + ch) : (v4u){0u, 0u, 0u, 0u}; }
          float o[4][8];
#pragma unroll
          for (int r = 0; r < 4; ++r) {
#pragma unroll
              for (int j = 0; j < 8; ++j) o[r][j] = 0.f;
#pragma unroll
              for (int tap = 0; tap < 4; ++tap) { const v4u xw = xin[r + tap];
                  o[r][0] += bflo(xw.x) * cw[tap][0]; o[r][1] += bfhi(xw.x) * cw[tap][1]; o[r][2] += bflo(xw.y) * cw[tap][2]; o[r][3] += bfhi(xw.y) * cw[tap][3];
                  o[r][4] += bflo(xw.z) * cw[tap][4]; o[r][5] += bfhi(xw.z) * cw[tap][5]; o[r][6] += bflo(xw.w) * cw[tap][6]; o[r][7] += bfhi(xw.w) * cw[tap][7]; }
              const float sc = (cg < 16) ? 1.0f : 0.08838834764831845f;
#pragma unroll
              for (int j = 0; j < 8; ++j) o[r][j] = o[r][j] * fsig(o[r][j]) * sc;
              v4u q; q.x = pk2(o[r][0], o[r][1]); q.y = pk2(o[r][2], o[r][3]); q.z = pk2(o[r][4], o[r][5]); q.w = pk2(o[r][6], o[r][7]);
              *(v4u*)(P.QKC + (size_t)(rowb + t0 + s0 + r) * 1024 + ch) = q; }
          if (cg >= 16) { const int d0 = (cg - 16) * 8;
#pragma unroll
              for (int j = 0; j < 8; ++j) { v2u pk; pk.x = pk2(o[0][j], o[1][j]); pk.y = pk2(o[2][j], o[3][j]); *(v2u*)(KT + (d0 + j) * 72 + s0) = pk; } } }
        __syncthreads();
        if (tid < 256) { const int vg = tid & 15, s0 = (tid >> 4) * 4; v4u vw[4]; float ws4[4];
#pragma unroll
            for (int r = 0; r < 4; ++r) { vw[r] = *(const v4u*)(P.VB + (size_t)(rowb + t0 + s0 + r) * 512 + hh * 128 + vg * 8); ws4[r] = wv[s0 + r]; }
#pragma unroll
            for (int j = 0; j < 4; ++j) { const unsigned w0 = j == 0 ? vw[0].x : j == 1 ? vw[0].y : j == 2 ? vw[0].z : vw[0].w, w1 = j == 0 ? vw[1].x : j == 1 ? vw[1].y : j == 2 ? vw[1].z : vw[1].w,
                                                    w2 = j == 0 ? vw[2].x : j == 1 ? vw[2].y : j == 2 ? vw[2].z : vw[2].w, w3 = j == 0 ? vw[3].x : j == 1 ? vw[3].y : j == 2 ? vw[3].z : vw[3].w;
                v2u lo, hi; lo.x = pk2(bflo(w0) * ws4[0], bflo(w1) * ws4[1]); lo.y = pk2(bflo(w2) * ws4[2], bflo(w3) * ws4[3]); hi.x = pk2(bfhi(w0) * ws4[0], bfhi(w1) * ws4[1]); hi.y = pk2(bfhi(w2) * ws4[2], bfhi(w3) * ws4[3]);
                *(v2u*)(VwT + (vg * 8 + 2 * j) * 72 + s0) = lo; *(v2u*)(VwT + (vg * 8 + 2 * j + 1) * 72 + s0) = hi; } }
        else if (tid < 320) VwT[128 * 72 + (tid - 256)] = (bf16)f2bf(wv[tid - 256]);
        else for (int i = tid - 320; i < 15 * 64; i += 192) VwT[(129 + (i >> 6)) * 72 + (i & 63)] = 0;
        __syncthreads();
        { bf16x8 bfr[2]; f32x4 acc[9];
#pragma unroll
          for (int ks = 0; ks < 2; ++ks) bfr[ks] = *(const bf16x8*)(KT + (16 * w + fr) * 72 + 8 * fq + 32 * ks);
#pragma unroll
          for (int rt = 0; rt < 9; ++rt) { acc[rt] = (f32x4){0.f, 0.f, 0.f, 0.f};
#pragma unroll
              for (int ks = 0; ks < 2; ++ks) { const bf16x8 a = *(const bf16x8*)(VwT + (16 * rt + fr) * 72 + 8 * fq + 32 * ks); acc[rt] = MFMA16(a, bfr[ks], acc[rt]); } }
          float* Uo = P.U + (size_t)unit * 144 * 128 + 16 * w + fr;
#pragma unroll
          for (int rt = 0; rt < 9; ++rt)
#pragma unroll
              for (int r = 0; r < 4; ++r) Uo[(size_t)(16 * rt + 4 * fq + r) * 128] = acc[rt][r]; }
        __syncthreads();
    }
}
__device__ __forceinline__ void mlstm_b(Frame& F, const EvenPtrs& P) {
    const int gt = F.bid * 512 + F.tid, NT = F.G * 512;
    for (int e = gt; e < BATCH * 4 * 129 * 128; e += NT) {
        const int d = e & 127, v = (e >> 7) % 129, bh = e / (129 * 128);
        float u[NCHUNK];
#pragma unroll
        for (int c = 0; c < NCHUNK; ++c) u[c] = P.U[((size_t)(bh * 32 + c) * 144 + v) * 128 + d];
        float C = 0.f, m = 0.f;
#pragma unroll
        for (int c = 0; c < NCHUNK; ++c) { const int unit = bh * 32 + c; const size_t idx = ((size_t)unit * 144 + v) * 128 + d;
            P.CB[idx] = (bf16)f2bf(C);
            if (v == 0 && d == 0) P.MST[unit] = m;
            const float blast = P.CHS[unit * 2], gmax = P.CHS[unit * 2 + 1], mn = fmaxf(blast + m, gmax);
            C = __expf(blast + m - mn) * C + __expf(gmax - mn) * u[c]; m = mn; }
    }
    for (int e = gt; e < BATCH * 4 * NCHUNK * 15 * 128; e += NT) { const int d = e & 127, r = (e >> 7) % 15, unit = e / (15 * 128); P.CB[((size_t)unit * 144 + 129 + r) * 128 + d] = 0; }
}
__device__ __forceinline__ void mlstm_c(Frame& F, const EvenPtrs& P) {
    bf16* Qs = (bf16*)F.gl; bf16* Ks = (bf16*)(F.gl + 17408); bf16* VTa = (bf16*)(F.gl + 34816); bf16* Ps = (bf16*)(F.gl + 55552);
    float* av = (float*)(F.gl + 64768); float* pmv = av + 64; float* bcv = av + 128; float* ssb = av + 192;
    const int tid = F.tid, lane = F.lane, w = F.wave, fr = lane & 15, fq = lane >> 4;
    for (int unit = F.bid; unit < BATCH * 4 * NCHUNK; unit += F.G) {
        const int b = unit >> 7, hh = (unit >> 5) & 3, c = unit & 31, rowb = b * SEQ, t0 = c * 64;
        const float mc = P.MST[unit];
        if (w == 0) { float li, bc; chunk_gates(P, rowb + t0 + lane, hh, lane, li, bc); const float a = li - bc; float p = a;
#pragma unroll
            for (int o = 1; o < 64; o <<= 1) { const float tt = __shfl_up(p, o); if (lane >= o) p = fmaxf(p, tt); }
            av[lane] = a; pmv[lane] = fmaxf(p, mc); bcv[lane] = bc; }
        {
#pragma unroll
          for (int i = 0; i < 2; ++i) { const int idx = tid + 512 * i, s = idx >> 4, ch = (idx & 15) * 8;
              *(v4u*)(Qs + s * 136 + ch) = *(const v4u*)(P.QKC + (size_t)(rowb + t0 + s) * 1024 + hh * 128 + ch);
              *(v4u*)(Ks + s * 136 + ch) = *(const v4u*)(P.QKC + (size_t)(rowb + t0 + s) * 1024 + 512 + hh * 128 + ch); }
          if (tid < 256) { const int vg = tid & 15, s0 = (tid >> 4) * 4; v4u vw[4];
#pragma unroll
              for (int r = 0; r < 4; ++r) vw[r] = *(const v4u*)(P.VB + (size_t)(rowb + t0 + s0 + r) * 512 + hh * 128 + vg * 8);
#pragma unroll
              for (int j = 0; j < 4; ++j) { const unsigned w0 = j == 0 ? vw[0].x : j == 1 ? vw[0].y : j == 2 ? vw[0].z : vw[0].w, w1 = j == 0 ? vw[1].x : j == 1 ? vw[1].y : j == 2 ? vw[1].z : vw[1].w,
                                                      w2 = j == 0 ? vw[2].x : j == 1 ? vw[2].y : j == 2 ? vw[2].z : vw[2].w, w3 = j == 0 ? vw[3].x : j == 1 ? vw[3].y : j == 2 ? vw[3].z : vw[3].w;
                  v2u lo, hi; lo.x = (w0 & 0xffffu) | (w1 << 16); lo.y = (w2 & 0xffffu) | (w3 << 16); hi.x = (w0 >> 16) | (w1 & 0xffff0000u); hi.y = (w2 >> 16) | (w3 & 0xffff0000u);
                  *(v2u*)(VTa + (vg * 8 + 2 * j) * 72 + s0) = lo; *(v2u*)(VTa + (vg * 8 + 2 * j + 1) * 72 + s0) = hi; } }
          else if (tid < 320) VTa[128 * 72 + (tid - 256)] = (bf16)0x3f80u;
          else for (int i = tid - 320; i < 15 * 64; i += 192) VTa[(129 + (i >> 6)) * 72 + (i & 63)] = 0; }
        __syncthreads();
        { const int rt = w >> 1;
#pragma unroll
          for (int c2 = 0; c2 < 2; ++c2) { const int ct = 2 * (w & 1) + c2; f32x4 acc = (f32x4){0.f, 0.f, 0.f, 0.f};
#pragma unroll
              for (int ks = 0; ks < 4; ++ks) { const bf16x8 a = *(const bf16x8*)(Qs + (16 * rt + fr) * 136 + 8 * fq + 32 * ks), bb = *(const bf16x8*)(Ks + (16 * ct + fr) * 136 + 8 * fq + 32 * ks); acc = MFMA16(a, bb, acc); }
              const int s = 16 * ct + fr; const float as = av[s];
#pragma unroll
              for (int r = 0; r < 4; ++r) { const int t = 16 * rt + 4 * fq + r; const float p = (s <= t) ? acc[r] * __expf(as - pmv[t]) : 0.f; Ps[t * 72 + s] = (bf16)f2bf(p); } } }
        __syncthreads();
        { const int tt = w & 3, hf = w >> 2, t = 16 * tt + fr; f32x4 ni[5], ne[5];
#pragma unroll
          for (int i = 0; i < 5; ++i) { const int vt = (i < 4) ? 4 * hf + i : 8; ni[i] = (f32x4){0.f, 0.f, 0.f, 0.f}; ne[i] = (f32x4){0.f, 0.f, 0.f, 0.f};
#pragma unroll
              for (int ks = 0; ks < 2; ++ks) { const bf16x8 a = *(const bf16x8*)(VTa + (16 * vt + fr) * 72 + 8 * fq + 32 * ks), bb = *(const bf16x8*)(Ps + (16 * tt + fr) * 72 + 8 * fq + 32 * ks); ni[i] = MFMA16(a, bb, ni[i]); }
#pragma unroll
              for (int ks = 0; ks < 4; ++ks) { const bf16x8 a = *(const bf16x8*)(P.CB + ((size_t)unit * 144 + 16 * vt + fr) * 128 + 8 * fq + 32 * ks), bb = *(const bf16x8*)(Qs + (16 * tt + fr) * 136 + 8 * fq + 32 * ks); ne[i] = MFMA16(a, bb, ne[i]); } }
          const float pm = pmv[t], wi = __expf(mc - pm), fl = __expf(-(bcv[t] + pm));
#pragma unroll
          for (int i = 0; i < 5; ++i) ni[i] = ni[i] + ne[i] * wi;
          const float den = __shfl(ni[4].x, fr), rinv = 1.0f / fmaxf(fabsf(den), fl); float q = 0.f;
#pragma unroll
          for (int i = 0; i < 4; ++i) { ni[i] = ni[i] * rinv; q += (ni[i].x * ni[i].x + ni[i].y * ni[i].y) + (ni[i].z * ni[i].z + ni[i].w * ni[i].w); }
          q += __shfl_xor(q, 16); q += __shfl_xor(q, 32);
          if (fq == 0) ssb[w * 16 + fr] = q;
          __syncthreads();
          const float rs = rsqrtf((q + ssb[(w ^ 4) * 16 + fr]) * (1.0f / 128.0f) + 1e-6f);
          const size_t row = (size_t)(rowb + t0 + t);
#pragma unroll
          for (int i = 0; i < 4; ++i) { const int col = hh * 128 + 16 * (4 * hf + i) + 4 * fq; const f32x4 g = *(const f32x4*)(P.gh + col); const v2u og = *(const v2u*)(P.OG + row * 512 + col);
              v2u o; o.x = pk2(ni[i].x * rs * g.x * bflo(og.x), ni[i].y * rs * g.y * bfhi(og.x)); o.y = pk2(ni[i].z * rs * g.z * bflo(og.y), ni[i].w * rs * g.w * bfhi(og.y));
              *(v2u*)(P.MIX + row * 1024 + col) = o; } }
        __syncthreads();
    }
}
__device__ __forceinline__ void dsa_prep(Frame& F, const EvenPtrs& P) {
    bf16* LAT = (bf16*)F.gl;
    const int lane = F.lane, w = F.wave, fr = lane & 15, fq = lane >> 4;
    for (int tile = F.bid; tile < M / 64; tile += F.G) {
        const int row0 = tile * 64, b = row0 >> 11, s0 = row0 & 2047;
        for (int i = 0; i < 8; ++i) { const int tok = w * 8 + i; const size_t row = (size_t)(row0 + tok);
            const f32x2 x = *(const f32x2*)(P.MISC + row * 256 + 2 * lane); const float ss = wave_sum(x.x * x.x + x.y * x.y), r = rsqrtf(ss * (1.0f / 128.0f) + 1e-6f);
            const f32x2 g = *(const f32x2*)(P.gkv + 2 * lane);
            *(unsigned*)(LAT + tok * 136 + 2 * lane) = pk2(x.x * r * g.x, x.y * r * g.y);
            }
        __syncthreads();
        if (w < 4) { const int rt = w; f32x4 acc[4]; float q[4] = {0.f, 0.f, 0.f, 0.f};
#pragma unroll
            for (int ct = 0; ct < 4; ++ct) { acc[ct] = (f32x4){0.f, 0.f, 0.f, 0.f};
#pragma unroll
                for (int ks = 0; ks < 4; ++ks) { const bf16x8 a = *(const bf16x8*)(LAT + (16 * rt + fr) * 136 + 8 * fq + 32 * ks), bb = *(const bf16x8*)(P.WukT + (16 * ct + fr) * 128 + 8 * fq + 32 * ks); acc[ct] = MFMA16(a, bb, acc[ct]); }
#pragma unroll
                for (int r = 0; r < 4; ++r) q[r] += acc[ct][r] * acc[ct][r]; }
#pragma unroll
            for (int r = 0; r < 4; ++r) { float s = q[r]; s += __shfl_xor(s, 1); s += __shfl_xor(s, 2); s += __shfl_xor(s, 4); s += __shfl_xor(s, 8); q[r] = rsqrtf(s * (1.0f / 64.0f) + 1e-6f); }
#pragma unroll
            for (int ct = 0; ct < 4; ++ct) { const float g = P.gk[16 * ct + fr];
#pragma unroll
                for (int r = 0; r < 4; ++r) P.KB[(size_t)(row0 + 16 * rt + 4 * fq + r) * 64 + 16 * ct + fr] = (bf16)f2bf(acc[ct][r] * q[r] * g); } }
        for (int i = 0; i < 4; ++i) { const int rt = w + 8 * i;
#pragma unroll
            for (int ct = 0; ct < 4; ++ct) { f32x4 acc = (f32x4){0.f, 0.f, 0.f, 0.f};
#pragma unroll
                for (int ks = 0; ks < 4; ++ks) { const bf16x8 a = *(const bf16x8*)(P.WuvT + (size_t)(16 * rt + fr) * 128 + 8 * fq + 32 * ks), bb = *(const bf16x8*)(LAT + (16 * ct + fr) * 136 + 8 * fq + 32 * ks); acc = MFMA16(a, bb, acc); }
#pragma unroll
                for (int r = 0; r < 4; ++r) { const int hd = 16 * rt + 4 * fq + r; P.VT[((size_t)(b * 8 + (hd >> 6)) * 64 + (hd & 63)) * 2048 + s0 + 16 * ct + fr] = (bf16)f2bf(acc[r]); } } }
        __syncthreads();
    }
}
__device__ __forceinline__ void dsa_index(Frame& F, const EvenPtrs& P) {
    const int lane = F.lane, fr = lane & 15, fq = lane >> 4;
    for (int uid = F.gw; uid < BATCH * 576; uid += F.NGW) {
        const int b = uid / 576, rr0 = uid - b * 576; int gq = 0;
        while (gq < 7 && 8 * (gq + 1) * (gq + 2) <= rr0) ++gq;
        const int rr = rr0 - 8 * gq * (gq + 1), qt = gq * 16 + rr / (gq + 1), kc = rr % (gq + 1);
        const int t0 = qt * 16; int nkt = ((t0 + 15 - kc * 256) >> 4) + 1; if (nkt > 16) nkt = 16;
        const size_t rowq = (size_t)b * SEQ + t0 + fr;
        bf16x8 qf[8][2]; float wq[8];
#pragma unroll
        for (int hh = 0; hh < 8; ++hh)
#pragma unroll
            for (int ks = 0; ks < 2; ++ks) qf[hh][ks] = *(const bf16x8*)(P.BQI + rowq * 512 + hh * 64 + 32 * ks + 8 * fq);
        { const f32x4 w0 = *(const f32x4*)(P.MISC + rowq * 256 + 200), w1 = *(const f32x4*)(P.MISC + rowq * 256 + 204); wq[0] = w0.x; wq[1] = w0.y; wq[2] = w0.z; wq[3] = w0.w; wq[4] = w1.x; wq[5] = w1.y; wq[6] = w1.z; wq[7] = w1.w; }
        const bf16* kip = P.KIB + ((size_t)b * SEQ + kc * 256 + fr) * 64 + 8 * fq;
        bf16x8 a0 = *(const bf16x8*)kip, a1 = *(const bf16x8*)(kip + 32);
        for (int kt = 0; kt < nkt; ++kt) { const int sk = kc * 256 + kt * 16; const bf16x8 c0 = a0, c1 = a1;
            if (kt + 1 < nkt) { a0 = *(const bf16x8*)(kip + (size_t)(kt + 1) * 16 * 64); a1 = *(const bf16x8*)(kip + (size_t)(kt + 1) * 16 * 64 + 32); }
            f32x4 sc = (f32x4){0.f, 0.f, 0.f, 0.f};
#pragma unroll
            for (int hh = 0; hh < 8; ++hh) { f32x4 acc = MFMA16(c0, qf[hh][0], ((f32x4){0.f, 0.f, 0.f, 0.f})); acc = MFMA16(c1, qf[hh][1], acc);
                sc.x += wq[hh] * fmaxf(acc.x, 0.f); sc.y += wq[hh] * fmaxf(acc.y, 0.f); sc.z += wq[hh] * fmaxf(acc.z, 0.f); sc.w += wq[hh] * fmaxf(acc.w, 0.f); }
            *(f32x4*)(P.ISC + rowq * 2048 + sk + 4 * fq) = sc; }
    }
}
__device__ __forceinline__ unsigned fkey(float f) { const unsigned u = __float_as_uint(f); return (u & 0x80000000u) ? ~u : (u | 0x80000000u); }
template <int NJ> __device__ __forceinline__ void select_row(const float* isc, unsigned long long* mo, int t, int lane) {
    unsigned key[NJ];
#pragma unroll
    for (int j = 0; j < NJ; ++j) { const int s = 64 * j + lane; const float x = (s <= t) ? isc[s] : 0.f; key[j] = (s <= t) ? fkey(x) : 0u; }
    unsigned T = 0u;
    for (int bit = 31; bit >= 0; --bit) { const unsigned cand = T | (1u << bit); int cnt = 0;
#pragma unroll
        for (int j = 0; j < NJ; ++j) cnt += __popcll(__ballot(key[j] >= cand));
        if (cnt >= 256) T = cand; }
    int cgt = 0;
#pragma unroll
    for (int j = 0; j < NJ; ++j) cgt += __popcll(__ballot(key[j] > T));
    const int need = 256 - cgt; int run = 0; const unsigned long long lt = (lane == 0) ? 0ull : (~0ull >> (64 - lane));
#pragma unroll
    for (int j = 0; j < 32; ++j) { unsigned long long m = 0ull;
        if (j < NJ) { const unsigned long long eq = __ballot(key[j] == T); const int before = run + __popcll(eq & lt); const bool sel = (key[j] > T) || (key[j] == T && before < need); m = __ballot(sel); run += __popcll(eq); }
        if (lane == 0) mo[j] = m; }
}
template <int NJ> __device__ __forceinline__ void select_hist(const float* isc, unsigned long long* mo, int t, int lane, LAS unsigned* hist  , LAS float* cand  ) {
    float x[NJ]; int bn[NJ];
    float mn = INFINITY, mxv = -INFINITY;
#pragma unroll
    for (int j = 0; j < NJ; ++j) { const int s = 64 * j + lane; const bool v = s <= t; x[j] = v ? isc[s] : 0.f; mn = fminf(mn, v ? x[j] : INFINITY); mxv = fmaxf(mxv, v ? x[j] : -INFINITY); }
    mn = -wave_max(-mn); mxv = wave_max(mxv);
    const float range = mxv - mn; const bool ok = (range > 0.f) && (range < 3.0e38f);
    const float scale = ok ? 2047.0f / range : 0.f;
#pragma unroll
    for (int j = 0; j < NJ; ++j) { const int s = 64 * j + lane; const bool v = s <= t; int b = (int)((x[j] - mn) * scale); b = b > 2047 ? 2047 : b; b = v ? b : 0; bn[j] = v ? b : -1;
        __hip_atomic_fetch_add(hist + b + (b >> 5), v ? 1u : 0u, __ATOMIC_RELAXED, __HIP_MEMORY_SCOPE_WORKGROUP); }
    unsigned hb[32]; unsigned ls = 0u;
#pragma unroll
    for (int k = 0; k < 32; ++k) { hb[k] = hist[33 * lane + k]; ls += hb[k]; }
    unsigned suf = ls;
#pragma unroll
    for (int o = 1; o < 64; o <<= 1) { const unsigned tt = __shfl_down(suf, o); suf += (lane + o < 64) ? tt : 0u; }
    const unsigned long long lm = __ballot(suf >= 256u);
    const int L = 63 - __builtin_clzll(lm);
    unsigned c = suf - ls; int Bl = 0; unsigned cal = 0u, hB = 0u; bool found = false;
#pragma unroll
    for (int k = 31; k >= 0; --k) { const bool hit = !found && (c + hb[k] >= 256u); Bl = hit ? 32 * lane + k : Bl; cal = hit ? c : cal; hB = hit ? hb[k] : hB; found = found || hit; c += found ? 0u : hb[k]; }
    const int B = __shfl(Bl, L); const unsigned cab = __shfl(cal, L), nB = __shfl(hB, L); const int need = 256 - (int)cab;
#pragma unroll
    for (int j = 0; j < NJ; ++j) { const int b = bn[j] < 0 ? 0 : bn[j]; hist[b + (b >> 5)] = 0u; }
    if (!ok || nB > 64u) { select_row<NJ>(isc, mo, t, lane); return; }
    float Ts = -INFINITY; int Is = 0x7fffffff;
    if ((unsigned)need < nB) {
        int run = 0; const unsigned long long lt = (lane == 0) ? 0ull : (~0ull >> (64 - lane));
#pragma unroll
        for (int j = 0; j < NJ; ++j) { const unsigned long long m = __ballot(bn[j] == B); if (m) { if (bn[j] == B) { const int pos = run + __popcll(m & lt); cand[pos] = x[j]; cand[64 + pos] = __int_as_float(64 * j + lane); } run += __popcll(m); } }
        const float xi = (lane < (int)nB) ? cand[lane] : 0.f; const int si = (lane < (int)nB) ? __float_as_int(cand[64 + lane]) : 0; int rank = 0;
        for (int k = 0; k < (int)nB; ++k) { const float xk = cand[k]; const int sk = __float_as_int(cand[64 + k]); rank += (xk > xi || (xk == xi && sk < si)) ? 1 : 0; }
        const unsigned long long wm = __ballot(lane < (int)nB && rank == need - 1); const int src = __builtin_ctzll(wm);
        Ts = __shfl(xi, src); Is = __shfl(si, src);
    }
#pragma unroll
    for (int j = 0; j < 32; ++j) { unsigned long long m = 0ull;
        if (j < NJ) { const int s = 64 * j + lane; const bool sel = (bn[j] > B) || (bn[j] == B && (x[j] > Ts || (x[j] == Ts && s <= Is))); m = __ballot(sel); }
        if (lane == 0) mo[j] = m; }
}
__device__ __forceinline__ void dsa_select(Frame& F, const EvenPtrs& P) {
    const int lane = F.lane;
    LAS unsigned* hist = (LAS unsigned*)(F.lds + F.wave * 9216); LAS float* cand = (LAS float*)(F.lds + F.wave * 9216 + 8448);
    for (int i = lane; i < 2112; i += 64) hist[i] = 0u;
    for (int idx = F.gw; idx < M; idx += F.NGW) {
        const int k = idx >> 11, gwid = idx & 2047, t = (k & 1) ? 2047 - gwid : gwid; const size_t row = (size_t)k * SEQ + t; const int n = t + 1;
        unsigned long long* mo = (unsigned long long*)(P.MASK + row * 64); const float* isc = P.ISC + row * 2048;
        if (n <= 256) {
#pragma unroll
            for (int j = 0; j < 32; ++j) { const unsigned long long m = __ballot(64 * j + lane <= t); if (lane == 0) mo[j] = m; }
        } else if (n <= 512) select_hist<8>(isc, mo, t, lane, hist, cand);
        else if (n <= 1024) select_hist<16>(isc, mo, t, lane, hist, cand);
        else if (n <= 1536) select_hist<24>(isc, mo, t, lane, hist, cand);
        else select_hist<32>(isc, mo, t, lane, hist, cand);
    }
}
__device__ __forceinline__ void dsa_attn(Frame& F, const EvenPtrs& P) {
    bf16* Kl = (bf16*)F.gl; bf16* Vl = (bf16*)(F.gl + 18432); float* btl = (float*)(F.gl + 41472); float* mtl = (float*)(F.gl + 41984);
    const int tid = F.tid, lane = F.lane, w = F.wave, fr = lane & 15, fq = lane >> 4, lrow = tid >> 3, lch = tid & 7;
    for (int i = tid; i < 2 * 16 * 64; i += 512) { const int bufi = i >> 10, r = (i >> 6) & 15, cc = i & 63; Vl[bufi * 5760 + (64 + r) * 72 + cc] = (r == 0) ? (bf16)0x3f80u : (bf16)0; }
    if (tid < 64) mtl[tid] = ((tid >> 2) >> (tid & 3)) & 1 ? 1.0f : 0.0f;
    for (int vu = F.bid; vu < 256; vu += F.G) {
        const int bh = vu >> 2, s4 = vu & 3, b = bh >> 3, hh = bh & 7;
        for (int iu = 0; iu < 2; ++iu) {
            const int qb = (iu == 0) ? s4 : 7 - s4;
            const int t0 = qb * 256, tw = t0 + 32 * w;
            bf16x8 qf[2][2]; const v2u* mrow[2];
#pragma unroll
            for (int cb = 0; cb < 2; ++cb) { const size_t rowq = (size_t)b * SEQ + tw + 16 * cb + fr; mrow[cb] = (const v2u*)(P.MASK + rowq * 64);
              const v4u w0 = *(const v4u*)(P.BQ + rowq * 512 + hh * 64 + 8 * fq), w1 = *(const v4u*)(P.BQ + rowq * 512 + hh * 64 + 32 + 8 * fq);
              float x[16] = {bflo(w0.x), bfhi(w0.x), bflo(w0.y), bfhi(w0.y), bflo(w0.z), bfhi(w0.z), bflo(w0.w), bfhi(w0.w), bflo(w1.x), bfhi(w1.x), bflo(w1.y), bfhi(w1.y), bflo(w1.z), bfhi(w1.z), bflo(w1.w), bfhi(w1.w)};
              float ss = 0.f;
#pragma unroll
              for (int j = 0; j < 16; ++j) ss += x[j] * x[j];
              ss += __shfl_xor(ss, 16); ss += __shfl_xor(ss, 32);
              const float r = rsqrtf(ss * (1.0f / 64.0f) + 1e-6f) * (0.125f * LOG2E);
              const f32x4 g0 = *(const f32x4*)(P.gq + 8 * fq), g1 = *(const f32x4*)(P.gq + 8 * fq + 4), g2 = *(const f32x4*)(P.gq + 32 + 8 * fq), g3 = *(const f32x4*)(P.gq + 32 + 8 * fq + 4);
              v4u q0, q1; q0.x = pk2(x[0] * r * g0.x, x[1] * r * g0.y); q0.y = pk2(x[2] * r * g0.z, x[3] * r * g0.w); q0.z = pk2(x[4] * r * g1.x, x[5] * r * g1.y); q0.w = pk2(x[6] * r * g1.z, x[7] * r * g1.w);
              q1.x = pk2(x[8] * r * g2.x, x[9] * r * g2.y); q1.y = pk2(x[10] * r * g2.z, x[11] * r * g2.w); q1.z = pk2(x[12] * r * g3.x, x[13] * r * g3.y); q1.w = pk2(x[14] * r * g3.z, x[15] * r * g3.w);
              qf[cb][0] = __builtin_bit_cast(bf16x8, q0); qf[cb][1] = __builtin_bit_cast(bf16x8, q1); }
            if (tid < 128) btl[tid] = P.bt[hh * 128 + tid] - P.bt[hh * 128 + 127];
            const int nk = 4 * qb + 4;
            const bf16* kg = P.KB + ((size_t)b * SEQ + lrow) * 64 + lch * 8;
            const bf16* vg = P.VT + ((size_t)(b * 8 + hh) * 64 + lrow) * 2048 + lch * 8;
            v4u kreg = *(const v4u*)kg, vreg = *(const v4u*)vg; v2u mnext[2] = {mrow[0][0], mrow[1][0]};
            *(v4u*)(Kl + lrow * 72 + lch * 8) = kreg; *(v4u*)(Vl + lrow * 72 + lch * 8) = vreg;
            __syncthreads();
            f32x4 o[2][5];
#pragma unroll
            for (int cb = 0; cb < 2; ++cb)
#pragma unroll
                for (int dt = 0; dt < 5; ++dt) o[cb][dt] = (f32x4){0.f, 0.f, 0.f, 0.f};
            float mrun[2] = {0.f, 0.f}; bool first = true;
            for (int kt = 0; kt < nk; ++kt) {
                const int s0 = kt * 64; const bf16* Kb = Kl + (kt & 1) * 4608; const bf16* Vb = Vl + (kt & 1) * 5760; const v2u mw[2] = {mnext[0], mnext[1]};
                if (kt + 1 < nk) { kreg = *(const v4u*)(kg + (size_t)(s0 + 64) * 64); vreg = *(const v4u*)(vg + s0 + 64); mnext[0] = mrow[0][kt + 1]; mnext[1] = mrow[1][kt + 1]; }
                if (s0 <= tw + 31) {
                    f32x4 acc[2][4];
#pragma unroll
                    for (int cb = 0; cb < 2; ++cb) { const f32x4 cin = (f32x4){-mrun[cb], -mrun[cb], -mrun[cb], -mrun[cb]};
#pragma unroll
                        for (int st = 0; st < 4; ++st) acc[cb][st] = cin; }
#pragma unroll
                    for (int st = 0; st < 4; ++st) { const bf16x8 a0 = *(const bf16x8*)(Kb + (16 * st + fr) * 72 + 8 * fq), a1 = *(const bf16x8*)(Kb + (16 * st + fr) * 72 + 32 + 8 * fq);
#pragma unroll
                        for (int cb = 0; cb < 2; ++cb) { acc[cb][st] = MFMA16(a0, qf[cb][0], acc[cb][st]); acc[cb][st] = MFMA16(a1, qf[cb][1], acc[cb][st]); } }
                    bf16x8 pf[2][2]; bool resc = false; float mxs[2];
#pragma unroll
                    for (int cb = 0; cb < 2; ++cb) { const int tb = tw + 16 * cb, t = tb + fr;
                        if ((tb - (s0 + 63)) < 113) {
#pragma unroll
                            for (int st = 0; st < 4; ++st)
#pragma unroll
                                for (int r = 0; r < 4; ++r) { int dist = t - (s0 + 16 * st + 4 * fq + r); dist = dist < 0 ? 0 : (dist > 127 ? 127 : dist); acc[cb][st][r] += btl[dist]; } }
                        float mx = fmaxf(fmaxf(fmaxf(acc[cb][0].x, acc[cb][0].y), fmaxf(acc[cb][0].z, acc[cb][0].w)), fmaxf(fmaxf(acc[cb][1].x, acc[cb][1].y), fmaxf(acc[cb][1].z, acc[cb][1].w)));
                        mx = fmaxf(mx, fmaxf(fmaxf(fmaxf(acc[cb][2].x, acc[cb][2].y), fmaxf(acc[cb][2].z, acc[cb][2].w)), fmaxf(fmaxf(acc[cb][3].x, acc[cb][3].y), fmaxf(acc[cb][3].z, acc[cb][3].w))));
                        mx = fmaxf(mx, __shfl_xor(mx, 16)); mx = fmaxf(mx, __shfl_xor(mx, 32)); mxs[cb] = mx; resc = resc || (mx > 8.0f); }
                    if (first || __any(resc)) {
#pragma unroll
                        for (int cb = 0; cb < 2; ++cb) { const float dl = first ? mxs[cb] : fmaxf(mxs[cb], 0.f); mrun[cb] += dl; const float alpha = first ? 1.0f : __builtin_amdgcn_exp2f(-dl);
#pragma unroll
                            for (int st = 0; st < 4; ++st) acc[cb][st] = acc[cb][st] - dl;
#pragma unroll
                            for (int dt = 0; dt < 5; ++dt) o[cb][dt] = o[cb][dt] * alpha; }
                        first = false; }
#pragma unroll
                    for (int cb = 0; cb < 2; ++cb)
#pragma unroll
                        for (int kk = 0; kk < 2; ++kk) { const unsigned mword = (kk == 0) ? mw[cb].x : mw[cb].y;
                            const f32x4 m0 = *(const f32x4*)(mtl + 4 * ((mword >> (4 * fq)) & 15u)), m1 = *(const f32x4*)(mtl + 4 * ((mword >> (16 + 4 * fq)) & 15u));
                            const f32x4 a = acc[cb][2 * kk], c = acc[cb][2 * kk + 1];
                            v4u pw; pw.x = pk2(__builtin_amdgcn_exp2f(a.x) * m0.x, __builtin_amdgcn_exp2f(a.y) * m0.y); pw.y = pk2(__builtin_amdgcn_exp2f(a.z) * m0.z, __builtin_amdgcn_exp2f(a.w) * m0.w);
                            pw.z = pk2(__builtin_amdgcn_exp2f(c.x) * m1.x, __builtin_amdgcn_exp2f(c.y) * m1.y); pw.w = pk2(__builtin_amdgcn_exp2f(c.z) * m1.z, __builtin_amdgcn_exp2f(c.w) * m1.w);
                            pf[cb][kk] = __builtin_bit_cast(bf16x8, pw); }
#pragma unroll
                    for (int dt = 0; dt < 5; ++dt)
#pragma unroll
                        for (int kk = 0; kk < 2; ++kk) { const bf16* vp = Vb + (16 * dt + fr) * 72 + 32 * kk + 4 * fq; const v2u lo = *(const v2u*)vp, hi = *(const v2u*)(vp + 16);
                            v4u vv; vv.x = lo.x; vv.y = lo.y; vv.z = hi.x; vv.w = hi.y; const bf16x8 vf = __builtin_bit_cast(bf16x8, vv);
                            o[0][dt] = MFMA16(vf, pf[0][kk], o[0][dt]); o[1][dt] = MFMA16(vf, pf[1][kk], o[1][dt]); }
                }
                if (kt + 1 < nk) { *(v4u*)(Kl + ((kt + 1) & 1) * 4608 + lrow * 72 + lch * 8) = kreg; *(v4u*)(Vl + ((kt + 1) & 1) * 5760 + lrow * 72 + lch * 8) = vreg; }
                __syncthreads();
            }
#pragma unroll
            for (int cb = 0; cb < 2; ++cb) { const size_t rowq = (size_t)b * SEQ + tw + 16 * cb + fr; const float linv = 1.0f / __shfl(o[cb][4].x, fr);
#pragma unroll
                for (int dt = 0; dt < 4; ++dt) { v2u wv; wv.x = pk2(o[cb][dt].x * linv, o[cb][dt].y * linv); wv.y = pk2(o[cb][dt].z * linv, o[cb][dt].w * linv); *(v2u*)(P.MIX + rowq * 1024 + 512 + hh * 64 + 16 * dt + 4 * fq) = wv; } }
        }
    }
}
__device__ __forceinline__ void pool_prep(Frame& F, const float* stats, const float* gmix, bf16* POOLED) {
    float* rl = (float*)F.gl;
    for (int tile = F.bid; tile < M / 64; tile += F.G) {
        const int row0 = tile * 64, tpos0 = row0 & 2047;
        if (F.tid < 79) { const int row = row0 - 15 + F.tid; float r = 0.f;
            if (tpos0 - 15 + F.tid >= 0) { const f32x4* p = (const f32x4*)(stats + (size_t)row * 16); const f32x4 a = p[0], b = p[1], c = p[2], d = p[3];
                const float s = (((a.x + a.y) + (a.z + a.w)) + ((b.x + b.y) + (b.z + b.w))) + (((c.x + c.y) + (c.z + c.w)) + ((d.x + d.y) + (d.z + d.w))); r = rsqrtf(s * (1.0f / 1024.0f) + 1e-6f); }
            rl[F.tid] = r; }
        __syncthreads();
        { const int cgp = F.tid & 127, tsub = F.tid >> 7, c0 = cgp * 8, g = cgp >> 5, win = 2 << g, ts = tsub * 16, tps = tpos0 + ts;
          const float* hbase = F.out + (size_t)(row0 + ts) * DM + c0;
          float S[8] = {0.f, 0.f, 0.f, 0.f, 0.f, 0.f, 0.f, 0.f};
#pragma unroll
          for (int j = 1; j < 16; ++j) if (j < win && tps - j >= 0) { const float* hp = hbase - (size_t)j * DM; const f32x4 a = *(const f32x4*)hp, b = *(const f32x4*)(hp + 4); const float r = rl[15 + ts - j];
              S[0] += a.x * r; S[1] += a.y * r; S[2] += a.z * r; S[3] += a.w * r; S[4] += b.x * r; S[5] += b.y * r; S[6] += b.z * r; S[7] += b.w * r; }
          const f32x4 g0 = *(const f32x4*)(gmix + c0), g1 = *(const f32x4*)(gmix + c0 + 4);
          bf16* op = POOLED + ((size_t)g * M + row0 + ts) * 256 + (c0 & 255);
#pragma unroll
          for (int i = 0; i < 16; ++i) { const float* hp = hbase + (size_t)i * DM; const f32x4 a = *(const f32x4*)hp, b = *(const f32x4*)(hp + 4); const float r = rl[15 + ts + i];
              const float y[8] = {a.x * r, a.y * r, a.z * r, a.w * r, b.x * r, b.y * r, b.z * r, b.w * r};
#pragma unroll
              for (int q = 0; q < 8; ++q) S[q] += y[q];
              const int n = (tps + i + 1 < win) ? tps + i + 1 : win; const float inv = 1.0f / (float)n;
              v4u o; o.x = pk2((S[0] * inv - y[0]) * g0.x, (S[1] * inv - y[1]) * g0.y); o.y = pk2((S[2] * inv - y[2]) * g0.z, (S[3] * inv - y[3]) * g0.w);
              o.z = pk2((S[4] * inv - y[4]) * g1.x, (S[5] * inv - y[5]) * g1.y); o.w = pk2((S[6] * inv - y[6]) * g1.z, (S[7] * inv - y[7]) * g1.w);
              *(v4u*)(op + (size_t)i * 256) = o;
              const int dep = i - (win - 1);
              if (tps + dep >= 0) { const float* dp = hbase + (ptrdiff_t)dep * DM; const f32x4 da = *(const f32x4*)dp, db = *(const f32x4*)(dp + 4); const float dr = rl[15 + ts + dep];
                  S[0] -= da.x * dr; S[1] -= da.y * dr; S[2] -= da.z * dr; S[3] -= da.w * dr; S[4] -= db.x * dr; S[5] -= db.y * dr; S[6] -= db.z * dr; S[7] -= db.w * dr; } } }
        __syncthreads();
    }
}
struct RoutePtrs { int* TOKE; float* TOKG; float* TOKR; int* CNT; int* ROWTS; float* ROWG; float* ROWR; int* TILEE; int* NT; int* EXPB; int* EXPN; };
__device__ __forceinline__ RoutePtrs route_ptrs(unsigned char* ws) { unsigned char* r = ws + WS_ROUTE; RoutePtrs p;
    p.TOKE = (int*)(r + RT_TOKE); p.TOKG = (float*)(r + RT_TOKG); p.TOKR = (float*)(r + RT_TOKR); p.CNT = (int*)(r + RT_CNT); p.ROWTS = (int*)(r + RT_ROWTS); p.ROWG = (float*)(r + RT_ROWG); p.ROWR = (float*)(r + RT_ROWR);
    p.TILEE = (int*)(r + RT_TILEE); p.NT = (int*)(r + RT_NT); p.EXPB = p.NT + 16; p.EXPN = p.NT + 32; return p; }
__device__ __forceinline__ void moe_route(Frame& F, const RoutePtrs& R, const float* gffn, const float* wr, const float* br) {
    int* cnt = (int*)F.gl; const int lane = F.lane;
    float wreg[16][8];
#pragma unroll
    for (int j = 0; j < 4; ++j) { const int c0 = 4 * lane + 256 * j; const f32x4 g = *(const f32x4*)(gffn + c0); const float gg[4] = {g.x, g.y, g.z, g.w};
#pragma unroll
        for (int q = 0; q < 4; ++q) { const f32x4 w0 = *(const f32x4*)(wr + (size_t)(c0 + q) * 8), w1 = *(const f32x4*)(wr + (size_t)(c0 + q) * 8 + 4);
            wreg[4 * j + q][0] = w0.x * gg[q]; wreg[4 * j + q][1] = w0.y * gg[q]; wreg[4 * j + q][2] = w0.z * gg[q]; wreg[4 * j + q][3] = w0.w * gg[q];
            wreg[4 * j + q][4] = w1.x * gg[q]; wreg[4 * j + q][5] = w1.y * gg[q]; wreg[4 * j + q][6] = w1.z * gg[q]; wreg[4 * j + q][7] = w1.w * gg[q]; } }
    const int myexp = ((lane >> 5) & 1) * 4 + ((lane >> 4) & 1) * 2 + ((lane >> 3) & 1); const float mybias = br[myexp];
    for (int tile = F.bid; tile < M / 64; tile += F.G) {
        if (F.tid < 8) cnt[F.tid] = 0;
        __syncthreads();
        for (int ib = 0; ib < 2; ++ib) {
            f32x4 v[4][4];
#pragma unroll
            for (int i = 0; i < 4; ++i) { const f32x4* hr = (const f32x4*)(F.out + (size_t)(tile * 64 + F.wave * 8 + ib * 4 + i) * DM) + lane;
#pragma unroll
                for (int j = 0; j < 4; ++j) v[i][j] = hr[64 * j]; }
#pragma unroll
            for (int i = 0; i < 4; ++i) { const int row = tile * 64 + F.wave * 8 + ib * 4 + i; float ss = 0.f; float lg[8] = {0.f, 0.f, 0.f, 0.f, 0.f, 0.f, 0.f, 0.f};
#pragma unroll
                for (int j = 0; j < 4; ++j) { const float y[4] = {v[i][j].x, v[i][j].y, v[i][j].z, v[i][j].w};
#pragma unroll
                    for (int q = 0; q < 4; ++q) { ss += y[q] * y[q];
#pragma unroll
                        for (int e = 0; e < 8; ++e) lg[e] += y[q] * wreg[4 * j + q][e]; } }
                ss = wave_sum(ss); const float r = rsqrtf(ss * (1.0f / 1024.0f) + 1e-6f);
                float a4[4];
#pragma unroll
                for (int e = 0; e < 4; ++e) { const bool hi = (lane & 32) != 0; const float keep = hi ? lg[e + 4] : lg[e], send = hi ? lg[e] : lg[e + 4]; a4[e] = keep + __shfl_xor(send, 32); }
                float a2[2];
#pragma unroll
                for (int e = 0; e < 2; ++e) { const bool hi = (lane & 16) != 0; const float keep = hi ? a4[e + 2] : a4[e], send = hi ? a4[e] : a4[e + 2]; a2[e] = keep + __shfl_xor(send, 16); }
                float a1; { const bool hi = (lane & 8) != 0; const float keep = hi ? a2[1] : a2[0], send = hi ? a2[0] : a2[1]; a1 = keep + __shfl_xor(send, 8); }
                a1 += __shfl_xor(a1, 4); a1 += __shfl_xor(a1, 2); a1 += __shfl_xor(a1, 1);
                const float mylogit = a1 * r + mybias;
                float l8[8];
#pragma unroll
                for (int e = 0; e < 8; ++e) l8[e] = __shfl(mylogit, 32 * (e >> 2) + 16 * ((e >> 1) & 1) + 8 * (e & 1));
                int e1 = 0; float v1 = l8[0];
#pragma unroll
                for (int e = 1; e < 8; ++e) if (l8[e] > v1) { v1 = l8[e]; e1 = e; }
                int e2 = -1; float v2 = -INFINITY;
#pragma unroll
                for (int e = 0; e < 8; ++e) if (e != e1 && l8[e] > v2) { v2 = l8[e]; e2 = e; }
                const float ex = __expf(v2 - v1), g1 = 1.0f / (1.0f + ex), g2 = ex * g1;
                if (lane == 0) { R.TOKE[row] = e1 | (e2 << 8); R.TOKG[row * 2] = g1; R.TOKG[row * 2 + 1] = g2; R.TOKR[row] = r; atomicAdd(&cnt[e1], 1); atomicAdd(&cnt[e2], 1); } }
        }
        __syncthreads();
        if (F.tid < 8) R.CNT[tile * 8 + F.tid] = cnt[F.tid];
        __syncthreads();
    }
}
__device__ __forceinline__ void moe_scatter(Frame& F, const RoutePtrs& R, const bf16* HB, bf16* YG) {
    int* sm = (int*)F.gl;
    for (int tile = F.bid; tile < M / 64; tile += F.G) {
        if (F.tid < 16) sm[F.tid] = 0;
        __syncthreads();
        for (int i = F.tid; i < (M / 64) * 8; i += 512) { const int v = R.CNT[i]; atomicAdd(&sm[i & 7], v); if ((i >> 3) < tile) atomicAdd(&sm[8 + (i & 7)], v); }
        __syncthreads();
        if (F.tid == 0) { int base = 0; for (int e = 0; e < 8; ++e) { sm[16 + e] = base; base += (sm[e] + 255) & ~255; } sm[24] = base >> 8; }
        __syncthreads();
        if (F.wave == 0) { const int row = tile * 64 + F.lane, te = R.TOKE[row], e1 = te & 255, e2 = te >> 8; int p1 = 0, p2 = 0; const unsigned long long lt = (F.lane == 0) ? 0ull : (~0ull >> (64 - F.lane));
#pragma unroll
            for (int e = 0; e < 8; ++e) { const unsigned long long m1 = __ballot(e1 == e), m2 = __ballot(e2 == e); const int rk = __popcll(m1 & lt) + __popcll(m2 & lt), bs = sm[16 + e] + sm[8 + e];
                if (e1 == e) p1 = bs + rk; if (e2 == e) p2 = bs + rk; }
            const float r = R.TOKR[row]; R.ROWTS[p1] = row * 2; R.ROWTS[p2] = row * 2 + 1; R.ROWG[p1] = R.TOKG[row * 2]; R.ROWG[p2] = R.TOKG[row * 2 + 1]; R.ROWR[p1] = r; R.ROWR[p2] = r;
            sm[32 + 2 * F.lane] = p1; sm[33 + 2 * F.lane] = p2; }
        __syncthreads();
        for (int i = 0; i < 16; ++i) { const int cp = F.wave * 16 + i, tok = cp >> 1, pos = sm[32 + cp]; const v4u* src = (const v4u*)(HB + (size_t)(tile * 64 + tok) * DM); v4u* dst = (v4u*)(YG + (size_t)pos * DM);
            dst[F.lane] = src[F.lane]; dst[64 + F.lane] = src[64 + F.lane]; }
        if (tile == 0) {
            for (int e = 0; e < 8; ++e) { const int lo = sm[16 + e] + sm[e], hi = sm[16 + e] + ((sm[e] + 255) & ~255);
                for (int p = lo + F.tid; p < hi; p += 512) { R.ROWTS[p] = -1; R.ROWG[p] = 0.f; R.ROWR[p] = 0.f; }
                for (int t2 = (sm[16 + e] >> 8) + F.tid; t2 < (hi >> 8); t2 += 512) R.TILEE[t2] = e; }
            if (F.tid == 0) R.NT[0] = sm[24];
            if (F.tid < 8) { R.EXPB[F.tid] = sm[16 + F.tid] >> 8; R.EXPN[F.tid] = (sm[F.tid] + 255) >> 8; } }
        __syncthreads();
    }
}
__device__ __forceinline__ void moe_combine(Frame& F, const bf16* D0, const bf16* D1, bf16* HB, float* stats) {
    for (int m = F.gw; m < M; m += F.NGW) { f32x4* hr = (f32x4*)(F.out + (size_t)m * DM) + F.lane; const v2u* a = (const v2u*)(D0 + (size_t)m * DM) + F.lane; const v2u* b = (const v2u*)(D1 + (size_t)m * DM) + F.lane;
        v2u* o8 = (v2u*)(HB + (size_t)m * DM) + F.lane; float s = 0.f;
#pragma unroll
        for (int j = 0; j < 4; ++j) { f32x4 v = hr[64 * j]; const v2u x = a[64 * j], y = b[64 * j];
            v.x += bflo(x.x) + bflo(y.x); v.y += bfhi(x.x) + bfhi(y.x); v.z += bflo(x.y) + bflo(y.y); v.w += bfhi(x.y) + bfhi(y.y);
            hr[64 * j] = v; s += (v.x * v.x + v.y * v.y) + (v.z * v.z + v.w * v.w); v2u w; w.x = pk2(v.x, v.y); w.y = pk2(v.z, v.w); o8[64 * j] = w; }
        s = wave_sum(s);
        if (F.lane < 16) stats[(size_t)m * 16 + F.lane] = (F.lane == 0) ? s : 0.f; }
}
constexpr int N_PHASES = 35;
static_assert(WS_VB == WS_QK + 32 * MiB && WS_OG == WS_VB + 16 * MiB && WS_BQ == WS_OG + 16 * MiB && WS_BQI == WS_BQ + 16 * MiB, "EpiIn address arithmetic");
#ifndef PHASE_SEL
#define PHASE_SEL -1
#endif
#define PHEN(r) (PHASE_SEL < 0 || PHASE_SEL == (r))
#ifndef REP_MASK
#define REP_MASK 0
#endif
#define REPF(bit, call) do { call; if (REP_MASK & (1u << (bit))) { __syncthreads(); call; } } while (0)
#define IN(k) (lo <= (k) && (k) < hi)
#ifndef PROBE_SLOT
#define PROBE_SLOT -1
#endif
#ifndef PROBE_MULT
#define PROBE_MULT 8
#endif
#define SEAM(k) do { if ((k) + 1 < hi) { XcdBarrier b2_ = bar; asm volatile("" : "+s"(b2_.bar)); xcd_barrier(b2_); } \
    if (PROBE_SLOT >= 0) { const unsigned long long now_ = wall_clock64(); if ((((k) == 0) ? 100 : (((k) - 1) % 17)) == PROBE_SLOT) F.tacc += now_ - F.tprev; F.tprev = now_; } } while (0)
#define HBSEL(i) ((bf16*)(ws + ((i) ? WS_HB1 : WS_HB0)))
#define STSEL(i) ((float*)(ws + WS_STATS + ((i) ? MiB : (size_t)0)))
template <int lp> __device__ __forceinline__ void layer_pair(Frame& F, const Args& args, const XcdBarrier& bar, const int lo, const int hi, LAS unsigned char* ring, const int K256) {
    unsigned char* ws = F.ws; bf16* Eb = (bf16*)(ws + WS_E);
        const int pb = 1 + 17 * lp;
        int hbi = 0, si = 0;

        {
            const int e = lp, li = 2 * lp;
            EvenPtrs P;
            P.QK = (const bf16*)(ws + WS_QK); P.VB = (const bf16*)(ws + WS_VB); P.OG = (const bf16*)(ws + WS_OG); P.BQ = (const bf16*)(ws + WS_BQ); P.BQI = (const bf16*)(ws + WS_BQI); P.MISC = (const float*)(ws + WS_MISC);
            P.MIX = (bf16*)(ws + WS_MIX); P.QKC = (bf16*)(ws + WS_QKC); P.KB = (bf16*)(ws + WS_KB); P.KIB = (bf16*)(ws + WS_KIB); P.VT = (bf16*)(ws + WS_VT); P.MASK = (unsigned*)(ws + WS_MASK); P.CHS = (float*)(ws + WS_CHS); P.MST = (float*)(ws + WS_CHS + 65536);
            P.ISC = (float*)(ws + WS_ISC); P.U = (float*)(ws + WS_U); P.CB = (bf16*)(ws + WS_CB);
            P.bgate = INP(IN_B_GATE) + e * 8; P.conv = INP(IN_CONV) + e * 4 * 1024; P.gh = INP(IN_NORM_H) + e * 512; P.gq = INP(IN_NORM_Q) + e * 64; P.gk = INP(IN_NORM_K) + e * 64; P.gkv = INP(IN_NORM_KV) + e * 128;
            P.WukT = (const bf16*)(ws + WS_SMALL + 8192) + (size_t)e * 64 * 128; P.WuvT = (const bf16*)(ws + WS_SMALL + 65536) + (size_t)e * 512 * 128; P.bt = (const float*)(ws + WS_SMALL);
            if (PHEN(1) && IN(pb + 1)) {
                pg8::Gemm g{HBSEL(hbi), (const bf16*)(ws + WS_W_IN) + (size_t)e * NINP * DM, M, NINP, DM}; pg8::StaticOrder S; S.init(M, NINP, F.G, F.bid);
                pg8::EpiIn E{STSEL(si), (bf16*)(ws + WS_QK), (float*)(ws + WS_MISC), (bf16*)(ws + WS_KIB)};
                pg8::gemm_phase<pg8::EpiIn, pg8::StaticOrder, true, true>(ring, g, S, E);
                {
                  int c0 = (((M / 256) * (NINP / 256)) % F.G + 7) & ~7; if (c0 >= F.G) c0 = 0;
                  if (F.bid >= c0) { pg8::Gemm g2{(const bf16*)(ws + WS_PB) + (size_t)li * M * PLED, (const bf16*)(ws + WS_W_PL) + (size_t)li * DM * PLED, M, DM, K256}; pg8::StaticOrder S2; S2.init(M, DM, F.G - c0, F.bid - c0);
                    pg8::EpiStore E2{Eb, DM};
                    pg8::gemm_phase<pg8::EpiStore, pg8::StaticOrder, true, true>(ring, g2, S2, E2); } }
                  SEAM(pb + 1); }
            if (PHEN(2) && IN(pb + 2)) { REPF(1, mlstm_a(F, P)); REPF(2, dsa_prep(F, P)); REPF(3, dsa_index(F, P)); SEAM(pb + 2); }
            if (PHEN(3) && IN(pb + 3)) { REPF(4, mlstm_b(F, P)); REPF(5, dsa_select(F, P)); SEAM(pb + 3); }
            if (PHEN(4) && IN(pb + 4)) { REPF(6, mlstm_c(F, P)); REPF(7, dsa_attn(F, P)); SEAM(pb + 4); }
            if (PHEN(5) && IN(pb + 5)) {
                { pg8::Gemm g{(const bf16*)(ws + WS_MIX), (const bf16*)(ws + WS_W_OUT) + (size_t)e * DM * DM, M, DM, DM}; pg8::StaticOrder S; S.init(M, DM, F.G, F.bid);
                  pg8::EpiResid<0> E{F.out, HBSEL(hbi), STSEL(si ^ 1), nullptr, nullptr, nullptr};
                  pg8::gemm_phase<pg8::EpiResid<0>, pg8::StaticOrder, true, true>(ring, g, S, E); }
                SEAM(pb + 5); }
            si ^= 1;
            if (PHEN(6) && IN(pb + 6)) {
                pg8::Gemm g{HBSEL(hbi), (const bf16*)(ws + WS_W_GU) + (size_t)e * 7168 * DM, M, 7168, DM}; pg8::StaticOrder S; S.init(M, 7168, F.G, F.bid);
                pg8::EpiGLU<false> E{STSEL(si), nullptr, (bf16*)(ws + WS_ACT)};
                pg8::gemm_phase<pg8::EpiGLU<false>, pg8::StaticOrder, true, true>(ring, g, S, E);
                  SEAM(pb + 6); }
            if (PHEN(7) && IN(pb + 7)) {
                pg8::Gemm g{(const bf16*)(ws + WS_ACT), (const bf16*)(ws + WS_W_DN) + (size_t)e * DM * DFF, M, DM, DFF}; pg8::StaticOrder S; S.init(M, DM, F.G, F.bid);
                pg8::EpiResid<0> E{F.out, HBSEL(hbi), STSEL(si ^ 1), nullptr, nullptr, nullptr};
                pg8::gemm_phase<pg8::EpiResid<0>, pg8::StaticOrder, true, true>(ring, g, S, E);
                SEAM(pb + 7); }
            si ^= 1;
            if (PHEN(8) && IN(pb + 8)) {
                pg8::Gemm g{HBSEL(hbi), (const bf16*)(ws + WS_W_PG) + (size_t)li * DM * DM, M, DM, DM}; pg8::StaticOrder S; S.init(M, DM, F.G, F.bid);
                pg8::EpiResid<2> E{F.out, HBSEL(hbi ^ 1), STSEL(si ^ 1), STSEL(si), Eb, nullptr};
                pg8::gemm_phase<pg8::EpiResid<2>, pg8::StaticOrder, true, true>(ring, g, S, E);
                SEAM(pb + 8); }
            si ^= 1; hbi ^= 1;
        }
        {
            const int o = lp, li = 2 * lp + 1;
            const RoutePtrs R = route_ptrs(ws);
            if (PHEN(9) && IN(pb + 9)) {
                pool_prep(F, STSEL(si), INP(IN_NORM_MIX) + li * DM, (bf16*)(ws + WS_POOLED));
                  SEAM(pb + 9); }
            if (PHEN(10) && IN(pb + 10)) {
                pg8::Gemm g{(const bf16*)(ws + WS_POOLED), (const bf16*)(ws + WS_W_POOL) + (size_t)o * 4 * 256 * 256, 4 * M, 1024, K256}; pg8::PoolOrder S{F.G, F.bid};
                pg8::EpiResid<1> E{F.out, HBSEL(hbi), STSEL(si ^ 1), nullptr, nullptr, INP(IN_SCALE_POOL) + o * DM};
                pg8::gemm_phase<pg8::EpiResid<1>, pg8::PoolOrder, true, true>(ring, g, S, E);
                SEAM(pb + 10); }
            si ^= 1;
            if (PHEN(11) && IN(pb + 11)) {   moe_route(F, R, INP(IN_NORM_FFN) + li * DM, INP(IN_W_ROUTER) + (size_t)o * DM * 8, INP(IN_B_ROUTER) + o * 8);   SEAM(pb + 11); }
            if (PHEN(12) && IN(pb + 12)) {   moe_scatter(F, R, HBSEL(hbi), (bf16*)(ws + WS_YG));   SEAM(pb + 12); }
            if (PHEN(13) && IN(pb + 13)) {
                const int nt = __builtin_amdgcn_readfirstlane(R.NT[0]);
                pg8::Gemm g{(const bf16*)(ws + WS_YG), (const bf16*)(ws + WS_W_MGU), MAXROWS, 8 * 7168, DM}; pg8::MoeOrder S{R.TILEE, R.EXPB, R.EXPN, nt, 28, F.G, F.bid};
                pg8::EpiGLU<true> E{nullptr, R.ROWR, (bf16*)(ws + WS_ACTM)};
                pg8::gemm_phase<pg8::EpiGLU<true>, pg8::MoeOrder, true, true>(ring, g, S, E);
                  SEAM(pb + 13); }
            if (PHEN(14) && IN(pb + 14)) {
                const int nt = __builtin_amdgcn_readfirstlane(R.NT[0]);
                pg8::Gemm g{(const bf16*)(ws + WS_ACTM), (const bf16*)(ws + WS_W_MDN), MAXROWS, 8 * 1024, DFF}; pg8::MoeOrder S{R.TILEE, R.EXPB, R.EXPN, nt, 4, F.G, F.bid};
                pg8::EpiScatter E{R.ROWTS, R.ROWG, (bf16*)(ws + WS_D0), (bf16*)(ws + WS_D1)};
                pg8::gemm_phase<pg8::EpiScatter, pg8::MoeOrder, true, true>(ring, g, S, E);
                {
                  const int c0 = 0;
                  if (F.bid >= c0) { pg8::Gemm g2{(const bf16*)(ws + WS_PB) + (size_t)li * M * PLED, (const bf16*)(ws + WS_W_PL) + (size_t)li * DM * PLED, M, DM, K256}; pg8::StaticOrder S2; S2.init(M, DM, F.G - c0, F.bid - c0);
                    pg8::EpiStore E2{Eb, DM};
                    pg8::gemm_phase<pg8::EpiStore, pg8::StaticOrder, true, true>(ring, g2, S2, E2); } }
                  SEAM(pb + 14); }
            if (PHEN(15) && IN(pb + 15)) { moe_combine(F, (const bf16*)(ws + WS_D0), (const bf16*)(ws + WS_D1), HBSEL(hbi), STSEL(si ^ 1)); if (lp == 0) REPF(16, conv_moe(F, args, 1));     SEAM(pb + 15); }
            si ^= 1;
            if (PHEN(16) && IN(pb + 16)) {
                pg8::Gemm g{HBSEL(hbi), (const bf16*)(ws + WS_W_PG) + (size_t)li * DM * DM, M, DM, DM}; pg8::StaticOrder S; S.init(M, DM, F.G, F.bid);
                pg8::EpiResid<2> E{F.out, HBSEL(hbi ^ 1), STSEL(si ^ 1), STSEL(si), Eb, nullptr};
                pg8::gemm_phase<pg8::EpiResid<2>, pg8::StaticOrder, true, true>(ring, g, S, E);
                SEAM(pb + 16); }
            si ^= 1; hbi ^= 1;
        }

}
__global__ void __launch_bounds__(NWAVES * 64, 2) fwd(Args args) {
    extern __shared__ __attribute__((aligned(16))) unsigned char lds[];
    Frame F;
    F.lds = (LAS unsigned char*)lds; F.gl = lds; F.MISCW = (volatile LAS unsigned*)(F.lds + MISC_OFF);
    F.tid = threadIdx.x; F.lane = F.tid & 63; F.wave = __builtin_amdgcn_readfirstlane(F.tid >> 6); F.G = gridDim.x; F.bid = blockIdx.x; F.gw = F.bid * NWAVES + F.wave; F.NGW = F.G * NWAVES;
    F.out = args.out; F.ws = args.ws;
    unsigned char* ws = args.ws;
    for (int u = F.tid; u < (LDS_BYTES - LDSCTL_OFF) / 4; u += NWAVES * 64) ((LAS unsigned*)(F.lds + LDSCTL_OFF))[u] = 0u;
    __syncthreads();
    XcdBarrier bar = xcd_barrier_post((unsigned*)(ws + WS_CTL) + CW_BAR, F.MISCW + 8);
    const int lo = args.ph_lo, hi = args.ph_hi;
    F.tacc = 0ull; F.tprev = (PROBE_SLOT >= 0) ? wall_clock64() : 0ull;
    LAS unsigned char* ring = F.lds;
    int K256 = 256; asm volatile("" : "+s"(K256));

    if (PHEN(100) && IN(0)) { REPF(8, p0_prologue(F, args)); SEAM(0); }

    layer_pair<0>(F, args, bar, lo, hi, ring, K256);
    layer_pair<1>(F, args, bar, lo, hi, ring, K256);
    if (PROBE_SLOT >= 0 && F.bid == 0 && F.tid == 0) { const unsigned long long t0_ = wall_clock64(), dl_ = (unsigned long long)PROBE_MULT * F.tacc; while (wall_clock64() - t0_ < dl_) __builtin_amdgcn_s_sleep(8); }
#undef IN
#undef SEAM
}

extern "C" void kernel_launch(void* const* d_in, const int* in_sizes, int n_in, void* d_out, int out_size, void* d_ws, size_t ws_size, hipStream_t stream) {
    static int grid = 0;
    if (grid == 0) {
        if (n_in != 28 || in_sizes[0] != M * DM || out_size != M * DM || ws_size < WS_END) { fprintf(stderr, "kernel_launch: unexpected shapes (n_in %d, in0 %d, out %d, ws %zu < %zu); nothing launched\n", n_in, n_in > 0 ? in_sizes[0] : -1, out_size, ws_size, (size_t)WS_END); grid = -1; return; }
        int dev = 0, cus = 0, per_cu = 0;
        if (hipGetDevice(&dev) != hipSuccess || hipDeviceGetAttribute(&cus, hipDeviceAttributeMultiprocessorCount, dev) != hipSuccess) { grid = -1; return; }
        if (hipFuncSetAttribute((const void*)fwd, hipFuncAttributeMaxDynamicSharedMemorySize, LDS_BYTES) != hipSuccess) { fprintf(stderr, "kernel_launch: hipFuncSetAttribute failed\n"); grid = -1; return; }
        if (hipOccupancyMaxActiveBlocksPerMultiprocessor(&per_cu, (const void*)fwd, NWAVES * 64, LDS_BYTES) != hipSuccess || per_cu < 1) fprintf(stderr, "kernel_launch: occupancy query reports %d workgroups per CU\n", per_cu);
        (void)hipGetLastError();
        grid = cus;
    }
    if (grid < 0) return;
    if (hipMemsetAsync((char*)d_ws + WS_CTL, 0, CTL_ZERO_BYTES, stream) != hipSuccess) return;
    Args a{};
    for (int i = 0; i < 28; ++i) a.in[i] = (const float*)d_in[i];
    a.out = (float*)d_out; a.ws = (unsigned char*)d_ws;
#if MK_ONE_LAUNCH
    a.ph_lo = 0; a.ph_hi = N_PHASES;
    hipLaunchKernelGGL(fwd, dim3(grid), dim3(NWAVES * 64), LDS_BYTES, stream, a);
#else
    for (int ph = 0; ph < N_PHASES; ++ph) { if (ph == 1) continue; a.ph_lo = ph; a.ph_hi = ph + 1;
        hipLaunchKernelGGL(fwd, dim3(grid), dim3(NWAVES * 64), LDS_BYTES, stream, a); }
#endif
}
```

```cpp
#include <hip/hip_runtime.h>
#include <cstdio>
#include <cstdint>
#ifndef MK_ONE_LAUNCH
#define MK_ONE_LAUNCH 1
#endif
namespace pg8 {
#define PG8_LAS __attribute__((address_space(3)))
typedef unsigned short bf16_t;
typedef short bf16x8 __attribute__((ext_vector_type(8)));
typedef float f32x4 __attribute__((ext_vector_type(4)));
typedef unsigned u32x4 __attribute__((ext_vector_type(4)));
constexpr int BM = 256, BK = 64, HALF = 128, HTB = HALF * BK * 2  , STAGE_BYTES = 8 * HTB, NXCD = 8, WGM = 8;

__host__ __device__ __forceinline__ int lds_byte(int r, int c) { const int st = (r >> 4) * 2 + (c >> 5), rr = r & 15, cc = c & 31, ob = rr * 64 + cc * 2; return st * 1024 + (ob ^ (((ob >> 9) & 1) << 5)); }
__host__ __device__ __forceinline__ void stage_rc(int b, int& R, int& C) { const int st = b / 1024, sb = b % 1024, swz = sb ^ (((sb >> 9) & 1) << 5); R = (st >> 1) * 16 + swz / 64; C = (st & 1) * 32 + (swz % 64) / 2; }
__host__ __device__ __forceinline__ int perm32(int rho) { const int n = rho >> 4, i = rho & 15; return 8 * (i >> 2) + 4 * n + (i & 3); }

struct Unit { int pm, pn; };
struct Gemm { const bf16_t* A; const bf16_t* Bt; int M, N, K; };

struct StaticOrder {
    int nM, nN, nwg, G, c;
    __host__ __device__ void init(int M, int N, int G_, int c_) { nM = M / BM; nN = N / BM; nwg = nM * nN; G = G_; c = c_; }
    __host__ __device__ bool next(int i, Unit& u) const {
        const long L = (long)i * G + c; if (L >= nwg) return false;
        int wgid = (int)L; { const int q = nwg / NXCD, r = nwg % NXCD, xcd = wgid % NXCD, off = wgid / NXCD; wgid = (xcd < r ? xcd * (q + 1) : r * (q + 1) + (xcd - r) * q) + off; }
        const int nig = WGM * nN, gid = wgid / nig, fm = gid * WGM, gsz = (nM - fm) < WGM ? (nM - fm) : WGM;
        u.pm = fm + ((wgid % nig) % gsz); u.pn = (wgid % nig) / gsz; return true;
    }
    __device__ __forceinline__ void a_ready(const Unit&) const {}
    __device__ __forceinline__ void done(const Unit&) const {}
};
__device__ __forceinline__ unsigned cvt_pk_bf16(float lo, float hi) { unsigned r; asm volatile("v_cvt_pk_bf16_f32 %0, %1, %2" : "=v"(r) : "v"(lo), "v"(hi)); return r; }
typedef float f32x2 __attribute__((ext_vector_type(2)));
constexpr float RMS_EPS = 1e-6f;
__device__ __forceinline__ float fsigmoid(float x) { return __builtin_amdgcn_rcpf(1.0f + __builtin_amdgcn_exp2f(-1.44269504f * x)); }
__device__ __forceinline__ f32x4 sig4(f32x4 v) { f32x4 o; o.x = fsigmoid(v.x); o.y = fsigmoid(v.y); o.z = fsigmoid(v.z); o.w = fsigmoid(v.w); return o; }
__device__ __forceinline__ u32x4 pack8(f32x4 v0, f32x4 v1) { u32x4 w; w.x = cvt_pk_bf16(v0[0], v0[1]); w.y = cvt_pk_bf16(v0[2], v0[3]); w.z = cvt_pk_bf16(v1[0], v1[1]); w.w = cvt_pk_bf16(v1[2], v1[3]); return w; }
__device__ __forceinline__ void unpack8(u32x4 w, f32x4& a, f32x4& b) {
    a.x = __uint_as_float(w.x << 16); a.y = __uint_as_float(w.x & 0xffff0000u); a.z = __uint_as_float(w.y << 16); a.w = __uint_as_float(w.y & 0xffff0000u);
    b.x = __uint_as_float(w.z << 16); b.y = __uint_as_float(w.z & 0xffff0000u); b.z = __uint_as_float(w.w << 16); b.w = __uint_as_float(w.w & 0xffff0000u); }
__device__ __forceinline__ void load_rstd(const float* stats, int rowb, int fr, int fq, float (&rs)[2][4]) {
    float mine[2];
#pragma unroll
    for (int ai = 0; ai < 2; ++ai) { const f32x4* p = (const f32x4*)(stats + (size_t)(rowb + ai * HALF + fq * 16) * 16); const f32x4 a = p[0], b = p[1], c = p[2], d = p[3];
        const float s = (((a.x + a.y) + (a.z + a.w)) + ((b.x + b.y) + (b.z + b.w))) + (((c.x + c.y) + (c.z + c.w)) + ((d.x + d.y) + (d.z + d.w)));
        mine[ai] = rsqrtf(s * (1.0f / 1024.0f) + RMS_EPS); }
#pragma unroll
    for (int ai = 0; ai < 2; ++ai)
#pragma unroll
        for (int m = 0; m < 4; ++m) rs[ai][m] = __shfl(mine[ai], fr + 16 * m);
}
struct EpiIn {
    static constexpr bool PERM = true, AFTER_DRAIN = false;
    const float* stats; bf16_t* QK; float* MISC; bf16_t* KIB;
    __device__ __forceinline__ void operator()(const f32x4 (&acc)[2][2][4][2], const Unit& u, int wr, int wc, int fr, int fq) const {
        const int rowb = u.pm * BM + wr * 64 + fr, cl = wc * 32 + 8 * fq, pn = u.pn;
        float rs[2][4]; load_rstd(stats, rowb, fr, fq, rs);
        if (pn < 12) {
            bf16_t* base; int ld, colt; bool sig = false;
            if (pn < 4) { base = QK; ld = 1024; colt = pn * 256; }
            else { const int t = (pn - 4) >> 1; base = QK + (size_t)16777216 + (size_t)t * 8388608; ld = 512; colt = ((pn - 4) & 1) * 256; sig = (t == 1); }
#pragma unroll
            for (int ai = 0; ai < 2; ++ai)
#pragma unroll
                for (int m = 0; m < 4; ++m) { const float r = rs[ai][m]; bf16_t* rp = base + (size_t)(rowb + ai * HALF + m * 16) * ld + colt + cl;
#pragma unroll
                    for (int bj = 0; bj < 2; ++bj) { f32x4 v0 = acc[ai][bj][m][0] * r, v1 = acc[ai][bj][m][1] * r; if (sig) { v0 = sig4(v0); v1 = sig4(v1); }
                        *(u32x4*)(rp + bj * HALF) = pack8(v0, v1); }
                    asm volatile("" ::: "memory"); }
        } else {
#pragma unroll
            for (int ai = 0; ai < 2; ++ai)
#pragma unroll
                for (int m = 0; m < 4; ++m) { const float r = rs[ai][m]; float* rp = MISC + (size_t)(rowb + ai * HALF + m * 16) * 256 + cl;
#pragma unroll
                    for (int bj = 0; bj < 2; ++bj)
#pragma unroll
                        for (int n = 0; n < 2; ++n) *(f32x4*)(rp + bj * HALF + 4 * n) = acc[ai][bj][m][n] * r;
                    if (wc < 2) *(u32x4*)(KIB + (size_t)(rowb + ai * HALF + m * 16) * 64 + cl) = pack8(acc[ai][1][m][0] * r, acc[ai][1][m][1] * r);
                    asm volatile("" ::: "memory"); }
        }
    }
};
template <int MODE, bool FINAL = false> struct EpiResid {
    static constexpr bool PERM = true, AFTER_DRAIN = false;
    const bf16_t* HBi; bf16_t* HBo; float* OUT; float* statsW; const float* statsR; const bf16_t* E; const float* scale;
    __device__ __forceinline__ void operator()(const f32x4 (&acc)[2][2][4][2], const Unit& u, int wr, int wc, int fr, int fq) const {
        int pm = u.pm; const int pn = u.pn; if (MODE == 1) pm -= 64 * pn;
        const int rowb = pm * BM + wr * 64 + fr, colb = pn * BM + wc * 32 + 8 * fq;
        float rs[2][4]; if (MODE == 2) load_rstd(statsR, rowb, fr, fq, rs);
        f32x4 sc[2][2];
        if (MODE == 1) {
#pragma unroll
            for (int bj = 0; bj < 2; ++bj)
#pragma unroll
                for (int n = 0; n < 2; ++n) sc[bj][n] = *(const f32x4*)(scale + colb + bj * HALF + 4 * n); }
#pragma unroll
        for (int ai = 0; ai < 2; ++ai)
#pragma unroll
            for (int m = 0; m < 4; ++m) { const size_t off = (size_t)(rowb + ai * HALF + m * 16) * 1024 + colb; float ssq = 0.f;
#pragma unroll
                for (int bj = 0; bj < 2; ++bj) { f32x4 h0, h1; unpack8(*(const u32x4*)(HBi + off + bj * HALF), h0, h1);
                    f32x4 v0 = acc[ai][bj][m][0], v1 = acc[ai][bj][m][1];
                    if (MODE == 1) { v0 = v0 * sc[bj][0]; v1 = v1 * sc[bj][1]; }
                    if (MODE == 2) { const u32x4 ew = *(const u32x4*)(E + off + bj * HALF); f32x4 e0, e1; unpack8(ew, e0, e1); const float r = rs[ai][m]; v0 = e0 * sig4(v0 * r); v1 = e1 * sig4(v1 * r); }
                    h0 = h0 + v0; h1 = h1 + v1;
                    if (FINAL) { float* hp = OUT + off + bj * HALF; ((f32x4*)hp)[0] = h0; ((f32x4*)hp)[1] = h1; }
                    else { ssq += ((h0.x * h0.x + h0.y * h0.y) + (h0.z * h0.z + h0.w * h0.w)) + ((h1.x * h1.x + h1.y * h1.y) + (h1.z * h1.z + h1.w * h1.w));
                           *(u32x4*)(HBo + off + bj * HALF) = pack8(h0, h1); } }
                if (!FINAL) { ssq += __shfl_xor(ssq, 16); ssq += __shfl_xor(ssq, 32);
                    if (fq == 0) statsW[(size_t)(rowb + ai * HALF + m * 16) * 16 + pn * 4 + wc] = ssq; }
                asm volatile("" ::: "memory"); }
    }
};
template <bool MOE> struct EpiGLU {
    static constexpr bool PERM = true, AFTER_DRAIN = false;
    const float* stats; const float* rowr; bf16_t* ACT;
    __device__ __forceinline__ void operator()(const f32x4 (&acc)[2][2][4][2], const Unit& u, int wr, int wc, int fr, int fq) const {
        const int rowb = u.pm * BM + wr * 64 + fr, jt = MOE ? (u.pn % 28) : u.pn;
        float rs[2][4];
        if (MOE) {
#pragma unroll
            for (int ai = 0; ai < 2; ++ai)
#pragma unroll
                for (int m = 0; m < 4; ++m) rs[ai][m] = rowr[rowb + ai * HALF + m * 16];
        } else load_rstd(stats, rowb, fr, fq, rs);
#pragma unroll
        for (int ai = 0; ai < 2; ++ai)
#pragma unroll
            for (int m = 0; m < 4; ++m) { const float r = rs[ai][m]; bf16_t* rp = ACT + (size_t)(rowb + ai * HALF + m * 16) * 3584 + jt * 128 + wc * 32 + 8 * fq;
                const f32x4 g0 = acc[ai][0][m][0] * r, g1 = acc[ai][0][m][1] * r, u0 = acc[ai][1][m][0] * r, u1 = acc[ai][1][m][1] * r;
                *(u32x4*)rp = pack8(g0 * sig4(g0) * u0, g1 * sig4(g1) * u1);
                asm volatile("" ::: "memory"); }
    }
};
struct EpiScatter {
    static constexpr bool PERM = true, AFTER_DRAIN = false;
    const int* rowts; const float* rowg; bf16_t *D0, *D1;
    __device__ __forceinline__ void operator()(const f32x4 (&acc)[2][2][4][2], const Unit& u, int wr, int wc, int fr, int fq) const {
        const int rowb = u.pm * BM + wr * 64 + fr, jt = u.pn & 3;
#pragma unroll
        for (int ai = 0; ai < 2; ++ai)
#pragma unroll
            for (int m = 0; m < 4; ++m) { const int row = rowb + ai * HALF + m * 16; const int ts = rowts[row];
                if (ts >= 0) { const float g = rowg[row]; bf16_t* dp = ((ts & 1) ? D1 : D0) + (size_t)(ts >> 1) * 1024 + jt * 256 + wc * 32 + 8 * fq;
#pragma unroll
                    for (int bj = 0; bj < 2; ++bj) *(u32x4*)(dp + bj * HALF) = pack8(acc[ai][bj][m][0] * g, acc[ai][bj][m][1] * g); }
                asm volatile("" ::: "memory"); }
    }
};
struct EpiStore {
    static constexpr bool PERM = true, AFTER_DRAIN = false;
    bf16_t* O; int ldc;
    __device__ __forceinline__ void operator()(const f32x4 (&acc)[2][2][4][2], const Unit& u, int wr, int wc, int fr, int fq) const {
        const int rowb = u.pm * BM + wr * 64 + fr, colb = u.pn * BM + wc * 32 + 8 * fq;
#pragma unroll
        for (int ai = 0; ai < 2; ++ai)
#pragma unroll
            for (int m = 0; m < 4; ++m) { bf16_t* rp = O + (size_t)(rowb + ai * HALF + m * 16) * ldc + colb;
#pragma unroll
                for (int bj = 0; bj < 2; ++bj) *(u32x4*)(rp + bj * HALF) = pack8(acc[ai][bj][m][0], acc[ai][bj][m][1]); }
    }
};
struct PoolOrder {
    int G, c;
    __device__ __forceinline__ bool next(int i, Unit& u) const { const int L = i * G + c; if (L >= 256) return false; const int g = L & 3; u.pm = g * 64 + (L >> 2); u.pn = g; return true; }
    __device__ __forceinline__ void a_ready(const Unit&) const {}
    __device__ __forceinline__ void done(const Unit&) const {}
};
struct MoeOrder {
    const int* tileE; const int* expb; const int* expn; int ntiles, ncol, G, c;
    __device__ __forceinline__ bool next(int i, Unit& u) const {
        if (G == 256) { const int e = c & 7, lu = i * 32 + (c >> 3), nrt = __builtin_amdgcn_readfirstlane(expn[e]); if (lu >= nrt * ncol) return false;
            const int per = 4 * nrt, cbk = lu / per, rem = lu - cbk * per; u.pm = __builtin_amdgcn_readfirstlane(expb[e]) + (rem >> 2); u.pn = e * ncol + cbk * 4 + (rem & 3); return true; }
        const int L = i * G + c; if (L >= ntiles * ncol) return false; const int rt = L / ncol, j = L - rt * ncol;
        u.pm = rt; u.pn = __builtin_amdgcn_readfirstlane(tileE[rt]) * ncol + j; return true; }
    __device__ __forceinline__ void a_ready(const Unit&) const {}
    __device__ __forceinline__ void done(const Unit&) const {}
};
template <class Epi, class Sched, bool ALIGN_EPI = false, bool SP2 = false>
__device__ __forceinline__ void gemm_phase(PG8_LAS unsigned char* lds, const Gemm g, const Sched& S, const Epi& E) {
    const int tid = threadIdx.x, wid = __builtin_amdgcn_readfirstlane(tid >> 6), lane = tid & 63, wr = wid >> 2, wc = wid & 3, fr = lane & 15, fq = lane >> 4;
    const int K = g.K, nt = K / BK;
    unsigned voffA[2], voffB[2];
#pragma unroll
    for (int i = 0; i < 2; ++i) { int R, C; stage_rc(tid * 16 + i * 8192, R, C); const int Rb = Epi::PERM ? ((R & ~31) + perm32(R & 31)) : R;
        voffA[i] = (unsigned)(R * K + C) * 2u; voffB[i] = (unsigned)(Rb * K + C) * 2u; }
    const size_t kstep = (size_t)(BK * 2);
    const size_t hstep = (size_t)HALF * K * 2;
    const size_t tstep = 2 * hstep;
    const unsigned ldsw = (unsigned)wid * 1024u;
    const int aoff = lds_byte(wr * 64 + fr, fq * 8), boff = lds_byte(wc * 32 + fr, fq * 8);
#define PG8_SA(b, h) (((b) * 2 + (h)) * HTB)
#define PG8_SB(b, h) ((4 + (b) * 2 + (h)) * HTB)
#define PG8_STAGE(bufoff, gbase, voff) do { _Pragma("unroll") for (int _i = 0; _i < 2; ++_i) \
        __builtin_amdgcn_global_load_lds((const unsigned*)((const char*)(gbase) + (voff)[_i]), (PG8_LAS unsigned*)(lds + (bufoff) + ldsw + _i * 8192), 16, 0, 0); } while (0)
#define PG8_LDA(dst, b, h) do { _Pragma("unroll") for (int m = 0; m < 4; ++m) _Pragma("unroll") for (int k = 0; k < 2; ++k) dst[m][k] = *(const PG8_LAS bf16x8*)(lds + PG8_SA(b, h) + aoff + m * 2048 + k * 1024); } while (0)
#define PG8_LDB(dst, b, h) do { _Pragma("unroll") for (int n = 0; n < 2; ++n) _Pragma("unroll") for (int k = 0; k < 2; ++k) dst[n][k] = *(const PG8_LAS bf16x8*)(lds + PG8_SB(b, h) + boff + n * 2048 + k * 1024); } while (0)
#define PG8_MMA(ai, bj, At, Bt) do { __builtin_amdgcn_s_setprio(1); _Pragma("unroll") for (int m = 0; m < 4; ++m) _Pragma("unroll") for (int n = 0; n < 2; ++n) _Pragma("unroll") for (int k = 0; k < 2; ++k) \
        acc[ai][bj][m][n] = __builtin_amdgcn_mfma_f32_16x16x32_bf16(Bt[n][k], At[m][k], acc[ai][bj][m][n], 0, 0, 0); __builtin_amdgcn_s_setprio(0); } while (0)
#define PG8_WAIT_V(n) asm volatile("s_waitcnt vmcnt(" #n ")" ::: "memory")
#define PG8_WAIT_L(n) asm volatile("s_waitcnt lgkmcnt(" #n ")" ::: "memory")
#define PG8_BAR __builtin_amdgcn_s_barrier()
#define PG8_SCHED __builtin_amdgcn_sched_barrier(0)
    Unit cur, nxt; int ui = 0;
    if (!S.next(0, cur)) return;
    f32x4 acc[2][2][4][2];
#pragma unroll
    for (int a = 0; a < 2; ++a)
#pragma unroll
        for (int b = 0; b < 2; ++b)
#pragma unroll
            for (int m = 0; m < 4; ++m)
#pragma unroll
                for (int n = 0; n < 2; ++n) acc[a][b][m][n] = (f32x4){0.f, 0.f, 0.f, 0.f};
    bf16x8 At[4][2], B0[2][2], B1[2][2];
    const char* cA = (const char*)g.A + (size_t)cur.pm * tstep; const char* cB = (const char*)g.Bt + (size_t)cur.pn * tstep;
    S.a_ready(cur);
    if constexpr (SP2) {
        PG8_STAGE(PG8_SB(0, 0), cB, voffB); PG8_STAGE(PG8_SB(0, 1), cB + hstep, voffB); PG8_STAGE(PG8_SA(0, 0), cA, voffA); PG8_STAGE(PG8_SA(0, 1), cA + hstep, voffA);
        if (wr == 1) PG8_BAR;
        PG8_WAIT_V(2); PG8_BAR;
        PG8_STAGE(PG8_SB(1, 0), cB + kstep, voffB); PG8_STAGE(PG8_SA(1, 0), cA + kstep, voffA); PG8_STAGE(PG8_SB(1, 1), cB + hstep + kstep, voffB);
        PG8_WAIT_V(6); PG8_BAR;
    } else {
        PG8_STAGE(PG8_SB(0, 0), cB, voffB); PG8_STAGE(PG8_SA(0, 0), cA, voffA); PG8_STAGE(PG8_SB(0, 1), cB + hstep, voffB); PG8_STAGE(PG8_SA(0, 1), cA + hstep, voffA);
        if (wr == 1) PG8_BAR;
        PG8_WAIT_V(4); PG8_BAR;
        PG8_STAGE(PG8_SB(1, 0), cB + kstep, voffB); PG8_STAGE(PG8_SA(1, 0), cA + kstep, voffA); PG8_STAGE(PG8_SB(1, 1), cB + hstep + kstep, voffB);
        PG8_WAIT_V(6); PG8_BAR;
    }
    for (;;) {
        const bool has_next = S.next(ui + 1, nxt);
        const char* nA = has_next ? (const char*)g.A + (size_t)nxt.pm * tstep : cA; const char* nB = has_next ? (const char*)g.Bt + (size_t)nxt.pn * tstep : cB;
        for (int t = 0; t < nt; t += 2) {
            const bool last = (t == nt - 2);
            const char* a1 = cA + (size_t)(t + 1) * kstep;
            const char* a2 = last ? nA : cA + (size_t)(t + 2) * kstep; const char* b2 = last ? nB : cB + (size_t)(t + 2) * kstep;
            const char* a3 = a2 + kstep; const char* b3 = b2 + kstep;
            if (last && has_next) S.a_ready(nxt);
            if constexpr (SP2) {
            PG8_LDB(B0, 0, 0); PG8_LDB(B1, 0, 1); PG8_SCHED; PG8_LDA(At, 0, 0); PG8_STAGE(PG8_SA(1, 1), a1 + hstep, voffA);
            PG8_WAIT_V(8); PG8_WAIT_L(0); PG8_BAR; PG8_MMA(0, 0, At, B0); PG8_MMA(0, 1, At, B1); PG8_BAR; PG8_SCHED;
            PG8_LDA(At, 0, 1); PG8_STAGE(PG8_SB(0, 0), b2, voffB); PG8_STAGE(PG8_SB(0, 1), b2 + hstep, voffB); PG8_STAGE(PG8_SA(0, 0), a2, voffA);
            PG8_WAIT_V(8); PG8_WAIT_L(0); PG8_BAR; PG8_MMA(1, 0, At, B0); PG8_MMA(1, 1, At, B1); PG8_BAR; PG8_SCHED;
            PG8_LDB(B0, 1, 0); PG8_LDB(B1, 1, 1); PG8_SCHED; PG8_LDA(At, 1, 0); PG8_STAGE(PG8_SA(0, 1), a2 + hstep, voffA);
            PG8_WAIT_V(8); PG8_WAIT_L(0); PG8_BAR; PG8_MMA(0, 0, At, B0); PG8_MMA(0, 1, At, B1); PG8_BAR; PG8_SCHED;
            PG8_LDA(At, 1, 1); PG8_STAGE(PG8_SB(1, 0), b3, voffB); PG8_STAGE(PG8_SB(1, 1), b3 + hstep, voffB); PG8_STAGE(PG8_SA(1, 0), a3, voffA);
            PG8_WAIT_V(8); PG8_WAIT_L(0); PG8_BAR; PG8_MMA(1, 0, At, B0); PG8_MMA(1, 1, At, B1); PG8_BAR; PG8_SCHED;
            } else {
            PG8_LDB(B0, 0, 0); PG8_SCHED; PG8_LDA(At, 0, 0); PG8_STAGE(PG8_SA(1, 1), a1 + hstep, voffA);
            PG8_WAIT_L(8); PG8_BAR; PG8_WAIT_L(0); PG8_MMA(0, 0, At, B0); PG8_BAR; PG8_SCHED;
            PG8_LDB(B1, 0, 1); PG8_STAGE(PG8_SB(0, 0), b2, voffB);
            PG8_BAR; PG8_WAIT_L(0); PG8_MMA(0, 1, At, B1); PG8_BAR;
            PG8_LDA(At, 0, 1); PG8_STAGE(PG8_SA(0, 0), a2, voffA);
            PG8_BAR; PG8_WAIT_L(0); PG8_MMA(1, 0, At, B0); PG8_BAR; PG8_SCHED;
            PG8_STAGE(PG8_SB(0, 1), b2 + hstep, voffB);
            PG8_WAIT_V(6); PG8_BAR; PG8_MMA(1, 1, At, B1); PG8_BAR;
            PG8_LDB(B0, 1, 0); PG8_SCHED; PG8_LDA(At, 1, 0); PG8_STAGE(PG8_SA(0, 1), a2 + hstep, voffA);
            PG8_WAIT_L(8); PG8_BAR; PG8_WAIT_L(0); PG8_MMA(0, 0, At, B0); PG8_BAR; PG8_SCHED;
            PG8_LDB(B1, 1, 1); PG8_STAGE(PG8_SB(1, 0), b3, voffB);
            PG8_BAR; PG8_WAIT_L(0); PG8_MMA(0, 1, At, B1); PG8_BAR;
            PG8_LDA(At, 1, 1); PG8_STAGE(PG8_SA(1, 0), a3, voffA);
            PG8_BAR; PG8_WAIT_L(0); PG8_MMA(1, 0, At, B0); PG8_BAR; PG8_SCHED;
            PG8_STAGE(PG8_SB(1, 1), b3 + hstep, voffB);
            PG8_WAIT_V(6); PG8_BAR; PG8_MMA(1, 1, At, B1); PG8_BAR;
            }
        }
        if constexpr (ALIGN_EPI) { if (wr == 0) PG8_BAR; }
        if constexpr (!Epi::AFTER_DRAIN) { E(acc, cur, wr, wc, fr, fq); S.done(cur); }
        if (!has_next) break;
#pragma unroll
        for (int a = 0; a < 2; ++a)
#pragma unroll
            for (int b = 0; b < 2; ++b)
#pragma unroll
                for (int m = 0; m < 4; ++m)
#pragma unroll
                    for (int n = 0; n < 2; ++n) acc[a][b][m][n] = (f32x4){0.f, 0.f, 0.f, 0.f};
        cur = nxt; cA = nA; cB = nB; ++ui;
        if constexpr (ALIGN_EPI) { if (wr == 1) PG8_BAR; }
    }
    PG8_WAIT_V(0);
    if constexpr (!ALIGN_EPI) { if (wr == 0) PG8_BAR; }
    PG8_BAR;
    if constexpr (Epi::AFTER_DRAIN) { E.fused(acc, cur, wr, wc, fr, fq, lds, wid, lane); S.done(cur); }
#undef PG8_SA
#undef PG8_SB
#undef PG8_STAGE
#undef PG8_LDA
#undef PG8_LDB
#undef PG8_MMA
#undef PG8_WAIT_V
#undef PG8_WAIT_L
#undef PG8_BAR
#undef PG8_SCHED
}
}
constexpr int NWAVES = 8;
constexpr int BATCH = 8, SEQ = 2048, DM = 1024, M = BATCH * SEQ, DFF = 3584, NEXP = 8, PLED = 256, NINP = 3328, NCHUNK = 32;
constexpr float LOG2E = 1.4426950408889634f;
constexpr size_t MiB = 1u << 20;
constexpr size_t WS_CTL = 0, CTL_ZERO_BYTES = 1 * MiB;
constexpr size_t WS_SMALL = 1 * MiB;
constexpr size_t WS_W_IN = 2 * MiB, WS_W_OUT = 15 * MiB, WS_W_GU = 19 * MiB, WS_W_DN = 47 * MiB, WS_W_PG = 61 * MiB, WS_W_PL = 69 * MiB, WS_W_POOL = 71 * MiB;
constexpr size_t WS_W_MGU = 72 * MiB, WS_W_MDN = 184 * MiB;
constexpr size_t WS_HB0 = 240 * MiB, WS_HB1 = 272 * MiB, WS_STATS = 304 * MiB, WS_PB = 306 * MiB, WS_E = 338 * MiB;
constexpr size_t WS_OVL = 370 * MiB;
constexpr size_t WS_QK = WS_OVL, WS_VB = WS_OVL + 32 * MiB, WS_OG = WS_OVL + 48 * MiB, WS_BQ = WS_OVL + 64 * MiB, WS_BQI = WS_OVL + 80 * MiB, WS_MISC = WS_OVL + 96 * MiB, WS_MIX = WS_OVL + 112 * MiB;
constexpr size_t WS_KB = WS_OVL + 144 * MiB, WS_KIB = WS_OVL + 146 * MiB, WS_VT = WS_OVL + 148 * MiB, WS_MASK = WS_OVL + 164 * MiB, WS_CHS = WS_OVL + 168 * MiB;
constexpr size_t WS_ISC = WS_OVL + 169 * MiB, WS_U = WS_OVL + 297 * MiB, WS_CB = WS_OVL + 369 * MiB, WS_QKC = WS_OVL + 406 * MiB, WS_ACT = WS_ISC;
constexpr size_t WS_POOLED = WS_OVL, WS_YG = WS_OVL + 32 * MiB, WS_ACTM = WS_OVL + 100 * MiB, WS_D0 = WS_OVL + 338 * MiB, WS_D1 = WS_OVL + 370 * MiB, WS_ROUTE = WS_OVL + 402 * MiB;
constexpr size_t WS_END = WS_OVL + 438 * MiB;
constexpr int MAXROWS = 34816;
constexpr size_t RT_TOKE = 0, RT_TOKG = 65536, RT_TOKR = 196608, RT_CNT = 262144, RT_ROWTS = 270336, RT_ROWG = 409600, RT_ROWR = 548864, RT_TILEE = 688128, RT_NT = 688128 + 1024;
constexpr int CW_BAR = 4096;
constexpr int RING_BYTES = 131072, LDSCTL_OFF = RING_BYTES, MISC_OFF = LDSCTL_OFF + 320, LDS_BYTES = 147456;

#define GAS __attribute__((address_space(1)))
#define LAS __attribute__((address_space(3)))
typedef unsigned short bf16;
typedef unsigned v4u __attribute__((ext_vector_type(4)));
typedef unsigned v2u __attribute__((ext_vector_type(2)));
typedef float f32x4 __attribute__((ext_vector_type(4)));
typedef float f32x2 __attribute__((ext_vector_type(2)));
typedef short bf16x8 __attribute__((ext_vector_type(8)));
#define LDS_WAIT() asm volatile("s_waitcnt lgkmcnt(0)" ::: "memory")
__device__ __forceinline__ unsigned f2bf(float f) { unsigned u = __builtin_bit_cast(unsigned, f); return (u + 0x7fffu + ((u >> 16) & 1u)) >> 16; }
__device__ __forceinline__ unsigned pk2(float lo, float hi) { return f2bf(lo) | (f2bf(hi) << 16); }
__device__ __forceinline__ float bflo(unsigned w) { return __uint_as_float(w << 16); }
__device__ __forceinline__ float bfhi(unsigned w) { return __uint_as_float(w & 0xffff0000u); }
__device__ __forceinline__ float bf2f(bf16 b) { return __uint_as_float(((unsigned)b) << 16); }
__device__ __forceinline__ float wave_sum(float v) {
#pragma unroll
    for (int o = 1; o < 64; o <<= 1) v += __shfl_xor(v, o);
    return v;
}
__device__ __forceinline__ float wave_max(float v) {
#pragma unroll
    for (int o = 1; o < 64; o <<= 1) v = fmaxf(v, __shfl_xor(v, o));
    return v;
}
__device__ __forceinline__ float fsig(float x) { return 1.0f / (1.0f + __expf(-x)); }
#define MFMA16(a, b, c) __builtin_amdgcn_mfma_f32_16x16x32_bf16((a), (b), (c), 0, 0, 0)
#define XB_TMO      128
#define XB_XCNT(j)  (256  + 64 * (j))
#define XB_XSUB(j)  (1280 + 64 * (j))
#define XB_XGEN(j)  (2304 + 64 * (j))
#define XB_TOP      3328
#define XB_TOPGEN   3392
#define XCD_BAR_WORDS 3456
#define XB_SPIN_CAP (1u << 18)

__device__ __forceinline__ unsigned xb_ld(unsigned* p)              { return __hip_atomic_load(p, __ATOMIC_RELAXED, __HIP_MEMORY_SCOPE_AGENT); }
__device__ __forceinline__ unsigned xb_add(unsigned* p, unsigned v) { return __hip_atomic_fetch_add(p, v, __ATOMIC_RELAXED, __HIP_MEMORY_SCOPE_AGENT); }
__device__ __forceinline__ unsigned xb_xcc_id() { return (unsigned)__builtin_amdgcn_s_getreg((3 << 11) | 20) & 0xFu; }
#define XB_SPIN(cond, bar) do { unsigned _sp = 0; while (cond) { __builtin_amdgcn_s_sleep(1); \
    if ((++_sp & 255u) == 0u) { if (xb_ld(&(bar)[XB_TMO])) break; if (_sp > XB_SPIN_CAP) { atomicAdd(&(bar)[XB_TMO], 1u); break; } } } } while (0)

struct XcdBarrier {
    unsigned* bar; unsigned x;
    volatile LAS unsigned* st;
};

__device__ __forceinline__ XcdBarrier xcd_barrier_post(unsigned* bar, volatile LAS unsigned* st) {
    XcdBarrier b; b.bar = bar; b.x = xb_xcc_id(); b.st = st;
    if (threadIdx.x == 0) (void)xb_add(&bar[XB_XCNT(b.x)], 1u);
    return b;
}
__device__ __forceinline__ void xcd_barrier_complete(unsigned* bar, unsigned x, unsigned& nloc, unsigned& nx) {
    const unsigned G = gridDim.x * gridDim.y * gridDim.z;
    unsigned sum, cnt, mine, sp = 0u;
    for (;;) {
        sum = 0u; cnt = 0u; mine = 0u;
#pragma unroll
        for (unsigned j = 0; j < 16; ++j) { const unsigned c = xb_ld(&bar[XB_XCNT(j)]); sum += c; cnt += (c > 0u) ? 1u : 0u; mine = (j == x) ? c : mine; }
        if (sum == G) break;
        __builtin_amdgcn_s_sleep(1);
        if ((++sp & 255u) == 0u) { if (xb_ld(&bar[XB_TMO])) break; if (sp > XB_SPIN_CAP) { atomicAdd(&bar[XB_TMO], 1u); break; } }
    }
    nloc = mine > 0u ? mine : 1u; nx = cnt > 0u ? cnt : 1u;
}

__device__ __forceinline__ void xcd_barrier(const XcdBarrier& b) {
    asm volatile("s_waitcnt vmcnt(0)" ::: "memory");
    __syncthreads();
    if (threadIdx.x == 0) {
        unsigned* bar = b.bar;
        __builtin_amdgcn_s_waitcnt(0);
        unsigned nloc = b.st[0], nx = b.st[1];
        if (nloc == 0u) { xcd_barrier_complete(bar, b.x, nloc, nx); b.st[0] = nloc; b.st[1] = nx; }
        const unsigned old = xb_add(&bar[XB_XSUB(b.x)], 1u);
        const unsigned gen = old / nloc;
        if (old + 1u == (gen + 1u) * nloc) {
            __builtin_amdgcn_fence(__ATOMIC_RELEASE, "agent");
            asm volatile("s_waitcnt vmcnt(0)" ::: "memory");
            const unsigned og = xb_add(&bar[XB_TOP], 1u);
            const unsigned tg = og / nx;
            if (og + 1u == (tg + 1u) * nx) xb_add(&bar[XB_TOPGEN], 1u);
            else XB_SPIN(xb_ld(&bar[XB_TOPGEN]) == tg, bar);
            __builtin_amdgcn_fence(__ATOMIC_ACQUIRE, "agent");
            xb_add(&bar[XB_XGEN(b.x)], 1u);
            asm volatile("s_waitcnt vmcnt(0)" ::: "memory");
        } else {
            XB_SPIN(xb_ld(&bar[XB_XGEN(b.x)]) == gen, bar);
            __builtin_amdgcn_fence(__ATOMIC_ACQUIRE, "agent");
            asm volatile("s_waitcnt vmcnt(0)" ::: "memory");
        }
    }
    __syncthreads();
}
struct Args { const float* in[28]; float* out; unsigned char* ws; int ph_lo, ph_hi; };
struct Frame {
    LAS unsigned char* lds; unsigned char* gl;
    volatile LAS unsigned* MISCW;
    int tid, lane, wave, G, bid, gw, NGW;
    float* out; unsigned char* ws;
    unsigned long long tacc, tprev;
};
#define INP(k) (args.in[k])
#define IN_X 0
#define IN_P 1
#define IN_NORM_MIX 2
#define IN_NORM_FFN 3
#define IN_W_IN 4
#define IN_B_GATE 5
#define IN_CONV 6
#define IN_NORM_H 7
#define IN_NORM_Q 8
#define IN_NORM_K 9
#define IN_NORM_KV 10
#define IN_W_UK 11
#define IN_W_UV 12
#define IN_W_OUT 13
#define IN_REL_BIAS 14
#define IN_W_POOL 15
#define IN_SCALE_POOL 16
#define IN_W_GATE_D 17
#define IN_W_UP_D 18
#define IN_W_DOWN_D 19
#define IN_W_ROUTER 20
#define IN_B_ROUTER 21
#define IN_W_GATE_M 22
#define IN_W_UP_M 23
#define IN_W_DOWN_M 24
#define IN_W_PLE 25
#define IN_W_PLE_GATE 26
#define IN_NORM_PLE 27

template <int MODE> __device__ __forceinline__ int dst_row(int n) {
    if (MODE == 0) return n;
    if (MODE == 1) return ((n >> 7) << 8) + (n & 127);
    if (MODE == 2) return ((n >> 7) << 8) + 128 + (n & 127);
    if (n < 2048) return n;
    if (n < 2052) return 3264 + (n - 2048);
    if (n < 2056) return 3268 + (n - 2052);
    if (n < 2568) return 2048 + (n - 2056);
    if (n < 2696) return 3072 + (n - 2568);
    if (n < 3208) return 2560 + (n - 2696);
    if (n < 3272) return 3200 + (n - 3208);
    return 3272 + (n - 3272);
}
template <int MODE> __device__ __forceinline__ void conv_mat(Frame& F, const float* W, int K, int N, bf16* WT, const float* gain, int wi, int nw) {
    LAS float* scr = (LAS float*)(F.lds + F.wave * 16384);
    const int nblk = (N + 31) >> 5, nitems = (K >> 6) * nblk, lane = F.lane, r = lane >> 3, c4 = lane & 7;
    for (int it = wi; it < nitems; it += nw) {
        const int kb = it / nblk, nb = it - kb * nblk, k0 = 64 * kb, n0 = 32 * nb, nn = n0 + 4 * c4; const bool okn = nn < N;
        f32x4 v[8];
#pragma unroll
        for (int i = 0; i < 8; ++i) v[i] = okn ? *(const f32x4*)(W + (size_t)(k0 + 8 * i + r) * N + nn) : (f32x4){0.f, 0.f, 0.f, 0.f};
        if (gain) {
#pragma unroll
            for (int i = 0; i < 8; ++i) v[i] = v[i] * gain[k0 + 8 * i + r]; }
#pragma unroll
        for (int i = 0; i < 8; ++i) { LAS float* d = scr + (8 * i + r) * 33 + 4 * c4; d[0] = v[i].x; d[1] = v[i].y; d[2] = v[i].z; d[3] = v[i].w; }
        LDS_WAIT(); asm volatile("" ::: "memory");
        const int c = lane & 7;
#pragma unroll
        for (int j = 0; j < 4; ++j) { const int n = (lane >> 3) + 8 * j; const LAS float* s = scr + (8 * c) * 33 + n;
            v4u o; o.x = pk2(s[0 * 33], s[1 * 33]); o.y = pk2(s[2 * 33], s[3 * 33]); o.z = pk2(s[4 * 33], s[5 * 33]); o.w = pk2(s[6 * 33], s[7 * 33]);
            if (n0 + n < N) *(v4u*)(WT + (size_t)dst_row<MODE>(n0 + n) * K + k0 + 8 * c) = o; }
        LDS_WAIT(); asm volatile("" ::: "memory");
    }
}
__device__ __forceinline__ void conv_moe(Frame& F, const Args& args, int o) {
    bf16* mgu = (bf16*)(F.ws + WS_W_MGU); bf16* mdn = (bf16*)(F.ws + WS_W_MDN);
    const float* gain = INP(IN_NORM_FFN) + (2 * o + 1) * DM;
    for (int e = 0; e < NEXP; ++e) {
        const size_t wo = ((size_t)o * NEXP + e) * DM * DFF;
        conv_mat<1>(F, INP(IN_W_GATE_M) + wo, DM, DFF, mgu + (size_t)e * 7168 * 1024, gain, F.gw, F.NGW);
        conv_mat<2>(F, INP(IN_W_UP_M) + wo, DM, DFF, mgu + (size_t)e * 7168 * 1024, gain, F.gw, F.NGW);
        conv_mat<0>(F, INP(IN_W_DOWN_M) + wo, DFF, DM, mdn + (size_t)e * 1024 * 3584, nullptr, F.gw, F.NGW);
    }
}
__device__ __forceinline__ void p0_prologue(Frame& F, const Args& args) {
    unsigned char* ws = F.ws;
    for (int e = 0; e < 2; ++e) {
        conv_mat<3>(F, INP(IN_W_IN) + (size_t)e * DM * 3280, DM, 3280, (bf16*)(ws + WS_W_IN) + (size_t)e * NINP * DM, INP(IN_NORM_MIX) + (2 * e) * DM, F.gw, F.NGW);
        conv_mat<0>(F, INP(IN_W_OUT) + (size_t)e * DM * DM, DM, DM, (bf16*)(ws + WS_W_OUT) + (size_t)e * DM * DM, nullptr, F.gw, F.NGW);
        conv_mat<1>(F, INP(IN_W_GATE_D) + (size_t)e * DM * DFF, DM, DFF, (bf16*)(ws + WS_W_GU) + (size_t)e * 7168 * DM, INP(IN_NORM_FFN) + (2 * e) * DM, F.gw, F.NGW);
        conv_mat<2>(F, INP(IN_W_UP_D) + (size_t)e * DM * DFF, DM, DFF, (bf16*)(ws + WS_W_GU) + (size_t)e * 7168 * DM, INP(IN_NORM_FFN) + (2 * e) * DM, F.gw, F.NGW);
        conv_mat<0>(F, INP(IN_W_DOWN_D) + (size_t)e * DFF * DM, DFF, DM, (bf16*)(ws + WS_W_DN) + (size_t)e * DM * DFF, nullptr, F.gw, F.NGW);
        conv_mat<0>(F, INP(IN_W_UK) + (size_t)e * 128 * 64, 128, 64, (bf16*)(ws + WS_SMALL + 8192) + (size_t)e * 64 * 128, nullptr, F.gw, F.NGW);
        for (int h = 0; h < 8; ++h)
            conv_mat<0>(F, INP(IN_W_UV) + ((size_t)e * 8 + h) * 128 * 64, 128, 64, (bf16*)(ws + WS_SMALL + 65536) + ((size_t)e * 512 + h * 64) * 128, nullptr, F.gw, F.NGW);
        for (int g = 0; g < 4; ++g)
            conv_mat<0>(F, INP(IN_W_POOL) + ((size_t)e * 4 + g) * 256 * 256, 256, 256, (bf16*)(ws + WS_W_POOL) + ((size_t)e * 4 + g) * 256 * 256, nullptr, F.gw, F.NGW);
    }
    for (int i = 0; i < 4; ++i) {
        conv_mat<0>(F, INP(IN_W_PLE_GATE) + (size_t)i * DM * DM, DM, DM, (bf16*)(ws + WS_W_PG) + (size_t)i * DM * DM, INP(IN_NORM_PLE) + i * DM, F.gw, F.NGW);
        conv_mat<0>(F, INP(IN_W_PLE) + (size_t)i * PLED * DM, PLED, DM, (bf16*)(ws + WS_W_PL) + (size_t)i * DM * PLED, nullptr, F.gw, F.NGW);
    }
    conv_moe(F, args, 0);
    const int gt = F.bid * 512 + F.tid, NT = F.G * 512;
    for (int i = gt; i < 2 * 48 * DM / 8; i += NT) { const int e = i / (48 * DM / 8), r = i - e * (48 * DM / 8); *(v4u*)((bf16*)(ws + WS_W_IN) + ((size_t)e * NINP + 3280) * DM + (size_t)r * 8) = (v4u){0u, 0u, 0u, 0u}; }
    if (F.bid == 0) for (int t = F.tid; t < 1024; t += 512) { const int hh = t >> 7, d = t & 127; int bk = d;
        if (d >= 16) { bk = 16 + (d >= 19) + (d >= 21) + (d >= 24) + (d >= 27) + (d >= 31) + (d >= 35) + (d >= 40) + (d >= 46) + (d >= 52) + (d >= 59) + (d >= 67) + (d >= 77) + (d >= 87) + (d >= 99) + (d >= 113); }
        ((float*)(ws + WS_SMALL))[t] = INP(IN_REL_BIAS)[bk * 8 + hh] * LOG2E; }
    { const f32x4* src = (const f32x4*)INP(IN_P); v4u* dst = (v4u*)(ws + WS_PB);
      for (int i = gt; i < 4 * M * PLED / 8; i += NT) { const f32x4 a = src[2 * i], b = src[2 * i + 1]; v4u o; o.x = pk2(a.x, a.y); o.y = pk2(a.z, a.w); o.z = pk2(b.x, b.y); o.w = pk2(b.z, b.w); dst[i] = o; } }
    { const float* x = INP(IN_X); bf16* hb = (bf16*)(ws + WS_HB0); float* st = (float*)(ws + WS_STATS);
      for (int m = F.gw; m < M; m += F.NGW) { const f32x4* xr = (const f32x4*)(x + (size_t)m * DM) + F.lane; f32x4 v[4]; float s = 0.f;
#pragma unroll
          for (int j = 0; j < 4; ++j) { v[j] = xr[64 * j]; s += (v[j].x * v[j].x + v[j].y * v[j].y) + (v[j].z * v[j].z + v[j].w * v[j].w); }
          s = wave_sum(s);
          v2u* o8 = (v2u*)(hb + (size_t)m * DM) + F.lane;
#pragma unroll
          for (int j = 0; j < 4; ++j) { v2u w; w.x = pk2(v[j].x, v[j].y); w.y = pk2(v[j].z, v[j].w); o8[64 * j] = w; }
          if (F.lane < 16) st[(size_t)m * 16 + F.lane] = (F.lane == 0) ? s : 0.f; } }
}

struct EvenPtrs {
    const bf16 *QK, *VB, *OG, *BQ, *BQI; const float* MISC; bf16 *MIX, *KB, *KIB, *VT, *QKC; unsigned* MASK; float* CHS; float* MST; float* ISC; float* U; bf16* CB;
    const float *bgate, *conv, *gh, *gq, *gk, *gkv; const bf16 *WukT, *WuvT; const float* bt;
};
__device__ __forceinline__ void conv8(const bf16* QK, const float* cw, int rowb, int tpos, int ch, float (&o)[8]) {
#pragma unroll
    for (int j = 0; j < 8; ++j) o[j] = 0.f;
#pragma unroll
    for (int tap = 0; tap < 4; ++tap) { const int tp = tpos - 3 + tap;
        if (tp >= 0) { const v4u w = *(const v4u*)(QK + (size_t)(rowb + tp) * 1024 + ch); const f32x4 c0 = *(const f32x4*)(cw + tap * 1024 + ch), c1 = *(const f32x4*)(cw + tap * 1024 + ch + 4);
            o[0] += bflo(w.x) * c0.x; o[1] += bfhi(w.x) * c0.y; o[2] += bflo(w.y) * c0.z; o[3] += bfhi(w.y) * c0.w;
            o[4] += bflo(w.z) * c1.x; o[5] += bfhi(w.z) * c1.y; o[6] += bflo(w.w) * c1.z; o[7] += bfhi(w.w) * c1.w; } }
#pragma unroll
    for (int j = 0; j < 8; ++j) o[j] = o[j] * fsig(o[j]);
}
__device__ __forceinline__ void chunk_gates(const EvenPtrs& P, int row, int hh, int lane, float& li, float& bc) {
    const float ai = P.MISC[(size_t)row * 256 + 192 + hh], af = P.MISC[(size_t)row * 256 + 196 + hh];
    li = ai + P.bgate[hh]; const float x = af + P.bgate[4 + hh]; const float lf = fminf(x, 0.f) - log1pf(__expf(-fabsf(x)));
    bc = lf;
#pragma unroll
    for (int o = 1; o < 64; o <<= 1) { const float t = __shfl_up(bc, o); if (lane >= o) bc += t; }
}
__device__ __forceinline__ void mlstm_a(Frame& F, const EvenPtrs& P) {
    bf16* KT = (bf16*)F.gl; bf16* VwT = (bf16*)(F.gl + 18432); float* wv = (float*)(F.gl + 18432 + 20736);
    const int tid = F.tid, lane = F.lane, w = F.wave, fr = lane & 15, fq = lane >> 4;
    for (int unit = F.bid; unit < BATCH * 4 * NCHUNK; unit += F.G) {
        const int b = unit >> 7, hh = (unit >> 5) & 3, c = unit & 31, rowb = b * SEQ, t0 = c * 64;
        if (w == 0) { float li, bc; chunk_gates(P, rowb + t0 + lane, hh, lane, li, bc); const float blast = __shfl(bc, 63), g = blast - bc + li, gmax = wave_max(g);
            wv[lane] = __expf(g - gmax); if (lane == 0) { P.CHS[unit * 2] = blast; P.CHS[unit * 2 + 1] = gmax; } }
        { const int cg = tid & 31, s0 = (tid >> 5) * 4, ch = (cg < 16 ? 0 : 512 - 128) + hh * 128 + cg * 8;
          float cw[4][8];
#pragma unroll
          for (int tap = 0; tap < 4; ++tap) { const f32x4 c0 = *(const f32x4*)(P.conv + tap * 1024 + ch), c1 = *(const f32x4*)(P.conv + tap * 1024 + ch + 4);
              cw[tap][0] = c0.x; cw[tap][1] = c0.y; cw[tap][2] = c0.z; cw[tap][3] = c0.w; cw[tap][4] = c1.x; cw[tap][5] = c1.y; cw[tap][6] = c1.z; cw[tap][7] = c1.w; }
          v4u xin[7];
#pragma unroll
          for (int i = 0; i < 7; ++i) { const int tp = t0 + s0 - 3 + i; xin[i] = (tp >= 0) ? *(const v4u*)(P.QK + (size_t)(rowb + tp) * 1024 + ch) : (v4u){0u, 0u, 0u, 0u}; }
          float o[4][8];
#pragma unroll
          for (int r = 0; r < 4; ++r) {
#pragma unroll
              for (int j = 0; j < 8; ++j) o[r][j] = 0.f;
#pragma unroll
              for (int tap = 0; tap < 4; ++tap) { const v4u xw = xin[r + tap];
                  o[r][0] += bflo(xw.x) * cw[tap][0]; o[r][1] += bfhi(xw.x) * cw[tap][1]; o[r][2] += bflo(xw.y) * cw[tap][2]; o[r][3] += bfhi(xw.y) * cw[tap][3];
                  o[r][4] += bflo(xw.z) * cw[tap][4]; o[r][5] += bfhi(xw.z) * cw[tap][5]; o[r][6] += bflo(xw.w) * cw[tap][6]; o[r][7] += bfhi(xw.w) * cw[tap][7]; }
              const float sc = (cg < 16) ? 1.0f : 0.08838834764831845f;
#pragma unroll
              for (int j = 0; j < 8; ++j) o[r][j] = o[r][j] * fsig(o[r][j]) * sc;
              v4u q; q.x = pk2(o[r][0], o[r][1]); q.y = pk2(o[r][2], o[r][3]); q.z = pk2(o[r][4], o[r][5]); q.w = pk2(o[r][6], o[r][7]);
              *(v4u*)(P.QKC + (size_t)(rowb + t0 + s0 + r) * 1024 + ch) = q; }
          if (cg >= 16) { const int d0 = (cg - 16) * 8;
#pragma unroll
              for (int j = 0; j < 8; ++j) { v2u pk; pk.x = pk2(o[0][j], o[1][j]); pk.y = pk2(o[2][j], o[3][j]); *(v2u*)(KT + (d0 + j) * 72 + s0) = pk; } } }
        __syncthreads();
        if (tid < 256) { const int vg = tid & 15, s0 = (tid >> 4) * 4; v4u vw[4]; float ws4[4];
#pragma unroll
            for (int r = 0; r < 4; ++r) { vw[r] = *(const v4u*)(P.VB + (size_t)(rowb + t0 + s0 + r) * 512 + hh * 128 + vg * 8); ws4[r] = wv[s0 + r]; }
#pragma unroll
            for (int j = 0; j < 4; ++j) { const unsigned w0 = j == 0 ? vw[0].x : j == 1 ? vw[0].y : j == 2 ? vw[0].z : vw[0].w, w1 = j == 0 ? vw[1].x : j == 1 ? vw[1].y : j == 2 ? vw[1].z : vw[1].w,
                                                    w2 = j == 0 ? vw[2].x : j == 1 ? vw[2].y : j == 2 ? vw[2].z : vw[2].w, w3 = j == 0 ? vw[3].x : j == 1 ? vw[3].y : j == 2 ? vw[3].z : vw[3].w;
                v2u lo, hi; lo.x = pk2(bflo(w0) * ws4[0], bflo(w1) * ws4[1]); lo.y = pk2(bflo(w2) * ws4[2], bflo(w3) * ws4[3]); hi.x = pk2(bfhi(w0) * ws4[0], bfhi(w1) * ws4[1]); hi.y = pk2(bfhi(w2) * ws4[2], bfhi(w3) * ws4[3]);
                *(v2u*)(VwT + (vg * 8 + 2 * j) * 72 + s0) = lo; *(v2u*)(VwT + (vg * 8 + 2 * j + 1) * 72 + s0) = hi; } }
        else if (tid < 320) VwT[128 * 72 + (tid - 256)] = (bf16)f2bf(wv[tid - 256]);
        else for (int i = tid - 320; i < 15 * 64; i += 192) VwT[(129 + (i >> 6)) * 72 + (i & 63)] = 0;
        __syncthreads();
        { bf16x8 bfr[2]; f32x4 acc[9];
#pragma unroll
          for (int ks = 0; ks < 2; ++ks) bfr[ks] = *(const bf16x8*)(KT + (16 * w + fr) * 72 + 8 * fq + 32 * ks);
#pragma unroll
          for (int rt = 0; rt < 9; ++rt) { acc[rt] = (f32x4){0.f, 0.f, 0.f, 0.f};
#pragma unroll
              for (int ks = 0; ks < 2; ++ks) { const bf16x8 a = *(const bf16x8*)(VwT + (16 * rt + fr) * 72 + 8 * fq + 32 * ks); acc[rt] = MFMA16(a, bfr[ks], acc[rt]); } }
          float* Uo = P.U + (size_t)unit * 144 * 128 + 16 * w + fr;
#pragma unroll
          for (int rt = 0; rt < 9; ++rt)
#pragma unroll
              for (int r = 0; r < 4; ++r) Uo[(size_t)(16 * rt + 4 * fq + r) * 128] = acc[rt][r]; }
        __syncthreads();
    }
}
__device__ __forceinline__ void mlstm_b(Frame& F, const EvenPtrs& P) {
    const int gt = F.bid * 512 + F.tid, NT = F.G * 512;
    for (int e = gt; e < BATCH * 4 * 129 * 128; e += NT) {
        const int d = e & 127, v = (e >> 7) % 129, bh = e / (129 * 128);
        float u[NCHUNK];
#pragma unroll
        for (int c = 0; c < NCHUNK; ++c) u[c] = P.U[((size_t)(bh * 32 + c) * 144 + v) * 128 + d];
        float C = 0.f, m = 0.f;
#pragma unroll
        for (int c = 0; c < NCHUNK; ++c) { const int unit = bh * 32 + c; const size_t idx = ((size_t)unit * 144 + v) * 128 + d;
            P.CB[idx] = (bf16)f2bf(C);
            if (v == 0 && d == 0) P.MST[unit] = m;
            const float blast = P.CHS[unit * 2], gmax = P.CHS[unit * 2 + 1], mn = fmaxf(blast + m, gmax);
            C = __expf(blast + m - mn) * C + __expf(gmax - mn) * u[c]; m = mn; }
    }
    for (int e = gt; e < BATCH * 4 * NCHUNK * 15 * 128; e += NT) { const int d = e & 127, r = (e >> 7) % 15, unit = e / (15 * 128); P.CB[((size_t)unit * 144 + 129 + r) * 128 + d] = 0; }
}
__device__ __forceinline__ void mlstm_c(Frame& F, const EvenPtrs& P) {
    bf16* Qs = (bf16*)F.gl; bf16* Ks = (bf16*)(F.gl + 17408); bf16* VTa = (bf16*)(F.gl + 34816); bf16* Ps = (bf16*)(F.gl + 55552);
    float* av = (float*)(F.gl + 64768); float* pmv = av + 64; float* bcv = av + 128; float* ssb = av + 192;
    const int tid = F.tid, lane = F.lane, w = F.wave, fr = lane & 15, fq = lane >> 4;
    for (int unit = F.bid; unit < BATCH * 4 * NCHUNK; unit += F.G) {
        const int b = unit >> 7, hh = (unit >> 5) & 3, c = unit & 31, rowb = b * SEQ, t0 = c * 64;
        const float mc = P.MST[unit];
        if (w == 0) { float li, bc; chunk_gates(P, rowb + t0 + lane, hh, lane, li, bc); const float a = li - bc; float p = a;
#pragma unroll
            for (int o = 1; o < 64; o <<= 1) { const float tt = __shfl_up(p, o); if (lane >= o) p = fmaxf(p, tt); }
            av[lane] = a; pmv[lane] = fmaxf(p, mc); bcv[lane] = bc; }
        {
#pragma unroll
          for (int i = 0; i < 2; ++i) { const int idx = tid + 512 * i, s = idx >> 4, ch = (idx & 15) * 8;
              *(v4u*)(Qs + s * 136 + ch) = *(const v4u*)(P.QKC + (size_t)(rowb + t0 + s) * 1024 + hh * 128 + ch);
              *(v4u*)(Ks + s * 136 + ch) = *(const v4u*)(P.QKC + (size_t)(rowb + t0 + s) * 1024 + 512 + hh * 128 + ch); }
          if (tid < 256) { const int vg = tid & 15, s0 = (tid >> 4) * 4; v4u vw[4];
#pragma unroll
              for (int r = 0; r < 4; ++r) vw[r] = *(const v4u*)(P.VB + (size_t)(rowb + t0 + s0 + r) * 512 + hh * 128 + vg * 8);
#pragma unroll
              for (int j = 0; j < 4; ++j) { const unsigned w0 = j == 0 ? vw[0].x : j == 1 ? vw[0].y : j == 2 ? vw[0].z : vw[0].w, w1 = j == 0 ? vw[1].x : j == 1 ? vw[1].y : j == 2 ? vw[1].z : vw[1].w,
                                                      w2 = j == 0 ? vw[2].x : j == 1 ? vw[2].y : j == 2 ? vw[2].z : vw[2].w, w3 = j == 0 ? vw[3].x : j == 1 ? vw[3].y : j == 2 ? vw[3].z : vw[3].w;
                  v2u lo, hi; lo.x = (w0 & 0xffffu) | (w1 << 16); lo.y = (w2 & 0xffffu) | (w3 << 16); hi.x = (w0 >> 16) | (w1 & 0xffff0000u); hi.y = (w2 >> 16) | (w3 & 0xffff0000u);
                  *(v2u*)(VTa + (vg * 8 + 2 * j) * 72 + s0) = lo; *(v2u*)(VTa + (vg * 8 + 2 * j + 1) * 72 + s0) = hi; } }
          else if (tid < 320) VTa[128 * 72 + (tid - 256)] = (bf16)0x3f80u;
          else for (int i = tid - 320; i < 15 * 64; i += 192) VTa[(129 + (i >> 6)) * 72 + (i & 63)] = 0; }
        __syncthreads();
        { const int rt = w >> 1;
#pragma unroll
          for (int c2 = 0; c2 < 2; ++c2) { const int ct = 2 * (w & 1) + c2; f32x4 acc = (f32x4){0.f, 0.f, 0.f, 0.f};
#pragma unroll
              for (int ks = 0; ks < 4; ++ks) { const bf16x8 a = *(const bf16x8*)(Qs + (16 * rt + fr) * 136 + 8 * fq + 32 * ks), bb = *(const bf16x8*)(Ks + (16 * ct + fr) * 136 + 8 * fq + 32 * ks); acc = MFMA16(a, bb, acc); }
              const int s = 16 * ct + fr; const float as = av[s];
#pragma unroll
              for (int r = 0; r < 4; ++r) { const int t = 16 * rt + 4 * fq + r; const float p = (s <= t) ? acc[r] * __expf(as - pmv[t]) : 0.f; Ps[t * 72 + s] = (bf16)f2bf(p); } } }
        __syncthreads();
        { const int tt = w & 3, hf = w >> 2, t = 16 * tt + fr; f32x4 ni[5], ne[5];
#pragma unroll
          for (int i = 0; i < 5; ++i) { const int vt = (i < 4) ? 4 * hf + i : 8; ni[i] = (f32x4){0.f, 0.f, 0.f, 0.f}; ne[i] = (f32x4){0.f, 0.f, 0.f, 0.f};
#pragma unroll
              for (int ks = 0; ks < 2; ++ks) { const bf16x8 a = *(const bf16x8*)(VTa + (16 * vt + fr) * 72 + 8 * fq + 32 * ks), bb = *(const bf16x8*)(Ps + (16 * tt + fr) * 72 + 8 * fq + 32 * ks); ni[i] = MFMA16(a, bb, ni[i]); }
#pragma unroll
              for (int ks = 0; ks < 4; ++ks) { const bf16x8 a = *(const bf16x8*)(P.CB + ((size_t)unit * 144 + 16 * vt + fr) * 128 + 8 * fq + 32 * ks), bb = *(const bf16x8*)(Qs + (16 * tt + fr) * 136 + 8 * fq + 32 * ks); ne[i] = MFMA16(a, bb, ne[i]); } }
          const float pm = pmv[t], wi = __expf(mc - pm), fl = __expf(-(bcv[t] + pm));
#pragma unroll
          for (int i = 0; i < 5; ++i) ni[i] = ni[i] + ne[i] * wi;
          const float den = __shfl(ni[4].x, fr), rinv = 1.0f / fmaxf(fabsf(den), fl); float q = 0.f;
#pragma unroll
          for (int i = 0; i < 4; ++i) { ni[i] = ni[i] * rinv; q += (ni[i].x * ni[i].x + ni[i].y * ni[i].y) + (ni[i].z * ni[i].z + ni[i].w * ni[i].w); }
          q += __shfl_xor(q, 16); q += __shfl_xor(q, 32);
          if (fq == 0) ssb[w * 16 + fr] = q;
          __syncthreads();
          const float rs = rsqrtf((q + ssb[(w ^ 4) * 16 + fr]) * (1.0f / 128.0f) + 1e-6f);
          const size_t row = (size_t)(rowb + t0 + t);
#pragma unroll
          for (int i = 0; i < 4; ++i) { const int col = hh * 128 + 16 * (4 * hf + i) + 4 * fq; const f32x4 g = *(const f32x4*)(P.gh + col); const v2u og = *(const v2u*)(P.OG + row * 512 + col);
              v2u o; o.x = pk2(ni[i].x * rs * g.x * bflo(og.x), ni[i].y * rs * g.y * bfhi(og.x)); o.y = pk2(ni[i].z * rs * g.z * bflo(og.y), ni[i].w * rs * g.w * bfhi(og.y));
              *(v2u*)(P.MIX + row * 1024 + col) = o; } }
        __syncthreads();
    }
}
__device__ __forceinline__ void dsa_prep(Frame& F, const EvenPtrs& P) {
    bf16* LAT = (bf16*)F.gl;
    const int lane = F.lane, w = F.wave, fr = lane & 15, fq = lane >> 4;
    for (int tile = F.bid; tile < M / 64; tile += F.G) {
        const int row0 = tile * 64, b = row0 >> 11, s0 = row0 & 2047;
        for (int i = 0; i < 8; ++i) { const int tok = w * 8 + i; const size_t row = (size_t)(row0 + tok);
            const f32x2 x = *(const f32x2*)(P.MISC + row * 256 + 2 * lane); const float ss = wave_sum(x.x * x.x + x.y * x.y), r = rsqrtf(ss * (1.0f / 128.0f) + 1e-6f);
            const f32x2 g = *(const f32x2*)(P.gkv + 2 * lane);
            *(unsigned*)(LAT + tok * 136 + 2 * lane) = pk2(x.x * r * g.x, x.y * r * g.y);
            }
        __syncthreads();
        if (w < 4) { const int rt = w; f32x4 acc[4]; float q[4] = {0.f, 0.f, 0.f, 0.f};
#pragma unroll
            for (int ct = 0; ct < 4; ++ct) { acc[ct] = (f32x4){0.f, 0.f, 0.f, 0.f};
#pragma unroll
                for (int ks = 0; ks < 4; ++ks) { const bf16x8 a = *(const bf16x8*)(LAT + (16 * rt + fr) * 136 + 8 * fq + 32 * ks), bb = *(const bf16x8*)(P.WukT + (16 * ct + fr) * 128 + 8 * fq + 32 * ks); acc[ct] = MFMA16(a, bb, acc[ct]); }
#pragma unroll
                for (int r = 0; r < 4; ++r) q[r] += acc[ct][r] * acc[ct][r]; }
#pragma unroll
            for (int r = 0; r < 4; ++r) { float s = q[r]; s += __shfl_xor(s, 1); s += __shfl_xor(s, 2); s += __shfl_xor(s, 4); s += __shfl_xor(s, 8); q[r] = rsqrtf(s * (1.0f / 64.0f) + 1e-6f); }
#pragma unroll
            for (int ct = 0; ct < 4; ++ct) { const float g = P.gk[16 * ct + fr];
#pragma unroll
                for (int r = 0; r < 4; ++r) P.KB[(size_t)(row0 + 16 * rt + 4 * fq + r) * 64 + 16 * ct + fr] = (bf16)f2bf(acc[ct][r] * q[r] * g); } }
        for (int i = 0; i < 4; ++i) { const int rt = w + 8 * i;
#pragma unroll
            for (int ct = 0; ct < 4; ++ct) { f32x4 acc = (f32x4){0.f, 0.f, 0.f, 0.f};
#pragma unroll
                for (int ks = 0; ks < 4; ++ks) { const bf16x8 a = *(const bf16x8*)(P.WuvT + (size_t)(16 * rt + fr) * 128 + 8 * fq + 32 * ks), bb = *(const bf16x8*)(LAT + (16 * ct + fr) * 136 + 8 * fq + 32 * ks); acc = MFMA16(a, bb, acc); }
#pragma unroll
                for (int r = 0; r < 4; ++r) { const int hd = 16 * rt + 4 * fq + r; P.VT[((size_t)(b * 8 + (hd >> 6)) * 64 + (hd & 63)) * 2048 + s0 + 16 * ct + fr] = (bf16)f2bf(acc[r]); } } }
        __syncthreads();
    }
}
__device__ __forceinline__ void dsa_index(Frame& F, const EvenPtrs& P) {
    const int lane = F.lane, fr = lane & 15, fq = lane >> 4;
    for (int uid = F.gw; uid < BATCH * 576; uid += F.NGW) {
        const int b = uid / 576, rr0 = uid - b * 576; int gq = 0;
        while (gq < 7 && 8 * (gq + 1) * (gq + 2) <= rr0) ++gq;
        const int rr = rr0 - 8 * gq * (gq + 1), qt = gq * 16 + rr / (gq + 1), kc = rr % (gq + 1);
        const int t0 = qt * 16; int nkt = ((t0 + 15 - kc * 256) >> 4) + 1; if (nkt > 16) nkt = 16;
        const size_t rowq = (size_t)b * SEQ + t0 + fr;
        bf16x8 qf[8][2]; float wq[8];
#pragma unroll
        for (int hh = 0; hh < 8; ++hh)
#pragma unroll
            for (int ks = 0; ks < 2; ++ks) qf[hh][ks] = *(const bf16x8*)(P.BQI + rowq * 512 + hh * 64 + 32 * ks + 8 * fq);
        { const f32x4 w0 = *(const f32x4*)(P.MISC + rowq * 256 + 200), w1 = *(const f32x4*)(P.MISC + rowq * 256 + 204); wq[0] = w0.x; wq[1] = w0.y; wq[2] = w0.z; wq[3] = w0.w; wq[4] = w1.x; wq[5] = w1.y; wq[6] = w1.z; wq[7] = w1.w; }
        const bf16* kip = P.KIB + ((size_t)b * SEQ + kc * 256 + fr) * 64 + 8 * fq;
        bf16x8 a0 = *(const bf16x8*)kip, a1 = *(const bf16x8*)(kip + 32);
        for (int kt = 0; kt < nkt; ++kt) { const int sk = kc * 256 + kt * 16; const bf16x8 c0 = a0, c1 = a1;
            if (kt + 1 < nkt) { a0 = *(const bf16x8*)(kip + (size_t)(kt + 1) * 16 * 64); a1 = *(const bf16x8*)(kip + (size_t)(kt + 1) * 16 * 64 + 32); }
            f32x4 sc = (f32x4){0.f, 0.f, 0.f, 0.f};
#pragma unroll
            for (int hh = 0; hh < 8; ++hh) { f32x4 acc = MFMA16(c0, qf[hh][0], ((f32x4){0.f, 0.f, 0.f, 0.f})); acc = MFMA16(c1, qf[hh][1], acc);
                sc.x += wq[hh] * fmaxf(acc.x, 0.f); sc.y += wq[hh] * fmaxf(acc.y, 0.f); sc.z += wq[hh] * fmaxf(acc.z, 0.f); sc.w += wq[hh] * fmaxf(acc.w, 0.f); }
            *(f32x4*)(P.ISC + rowq * 2048 + sk + 4 * fq) = sc; }
    }
}
__device__ __forceinline__ unsigned fkey(float f) { const unsigned u = __float_as_uint(f); return (u & 0x80000000u) ? ~u : (u | 0x80000000u); }
template <int NJ> __device__ __forceinline__ void select_row(const float* isc, unsigned long long* mo, int t, int lane) {
    unsigned key[NJ];
#pragma unroll
    for (int j = 0; j < NJ; ++j) { const int s = 64 * j + lane; const float x = (s <= t) ? isc[s] : 0.f; key[j] = (s <= t) ? fkey(x) : 0u; }
    unsigned T = 0u;
    for (int bit = 31; bit >= 0; --bit) { const unsigned cand = T | (1u << bit); int cnt = 0;
#pragma unroll
        for (int j = 0; j < NJ; ++j) cnt += __popcll(__ballot(key[j] >= cand));
        if (cnt >= 256) T = cand; }
    int cgt = 0;
#pragma unroll
    for (int j = 0; j < NJ; ++j) cgt += __popcll(__ballot(key[j] > T));
    const int need = 256 - cgt; int run = 0; const unsigned long long lt = (lane == 0) ? 0ull : (~0ull >> (64 - lane));
#pragma unroll
    for (int j = 0; j < 32; ++j) { unsigned long long m = 0ull;
        if (j < NJ) { const unsigned long long eq = __ballot(key[j] == T); const int before = run + __popcll(eq & lt); const bool sel = (key[j] > T) || (key[j] == T && before < need); m = __ballot(sel); run += __popcll(eq); }
        if (lane == 0) mo[j] = m; }
}
template <int NJ> __device__ __forceinline__ void select_hist(const float* isc, unsigned long long* mo, int t, int lane, LAS unsigned* hist  , LAS float* cand  ) {
    float x[NJ]; int bn[NJ];
    float mn = INFINITY, mxv = -INFINITY;
#pragma unroll
    for (int j = 0; j < NJ; ++j) { const int s = 64 * j + lane; const bool v = s <= t; x[j] = v ? isc[s] : 0.f; mn = fminf(mn, v ? x[j] : INFINITY); mxv = fmaxf(mxv, v ? x[j] : -INFINITY); }
    mn = -wave_max(-mn); mxv = wave_max(mxv);
    const float range = mxv - mn; const bool ok = (range > 0.f) && (range < 3.0e38f);
    const float scale = ok ? 2047.0f / range : 0.f;
#pragma unroll
    for (int j = 0; j < NJ; ++j) { const int s = 64 * j + lane; const bool v = s <= t; int b = (int)((x[j] - mn) * scale); b = b > 2047 ? 2047 : b; b = v ? b : 0; bn[j] = v ? b : -1;
        __hip_atomic_fetch_add(hist + b + (b >> 5), v ? 1u : 0u, __ATOMIC_RELAXED, __HIP_MEMORY_SCOPE_WORKGROUP); }
    unsigned hb[32]; unsigned ls = 0u;
#pragma unroll
    for (int k = 0; k < 32; ++k) { hb[k] = hist[33 * lane + k]; ls += hb[k]; }
    unsigned suf = ls;
#pragma unroll
    for (int o = 1; o < 64; o <<= 1) { const unsigned tt = __shfl_down(suf, o); suf += (lane + o < 64) ? tt : 0u; }
    const unsigned long long lm = __ballot(suf >= 256u);
    const int L = 63 - __builtin_clzll(lm);
    unsigned c = suf - ls; int Bl = 0; unsigned cal = 0u, hB = 0u; bool found = false;
#pragma unroll
    for (int k = 31; k >= 0; --k) { const bool hit = !found && (c + hb[k] >= 256u); Bl = hit ? 32 * lane + k : Bl; cal = hit ? c : cal; hB = hit ? hb[k] : hB; found = found || hit; c += found ? 0u : hb[k]; }
    const int B = __shfl(Bl, L); const unsigned cab = __shfl(cal, L), nB = __shfl(hB, L); const int need = 256 - (int)cab;
#pragma unroll
    for (int j = 0; j < NJ; ++j) { const int b = bn[j] < 0 ? 0 : bn[j]; hist[b + (b >> 5)] = 0u; }
    if (!ok || nB > 64u) { select_row<NJ>(isc, mo, t, lane); return; }
    float Ts = -INFINITY; int Is = 0x7fffffff;
    if ((unsigned)need < nB) {
        int run = 0; const unsigned long long lt = (lane == 0) ? 0ull : (~0ull >> (64 - lane));
#pragma unroll
        for (int j = 0; j < NJ; ++j) { const unsigned long long m = __ballot(bn[j] == B); if (m) { if (bn[j] == B) { const int pos = run + __popcll(m & lt); cand[pos] = x[j]; cand[64 + pos] = __int_as_float(64 * j + lane); } run += __popcll(m); } }
        const float xi = (lane < (int)nB) ? cand[lane] : 0.f; const int si = (lane < (int)nB) ? __float_as_int(cand[64 + lane]) : 0; int rank = 0;
        for (int k = 0; k < (int)nB; ++k) { const float xk = cand[k]; const int sk = __float_as_int(cand[64 + k]); rank += (xk > xi || (xk == xi && sk < si)) ? 1 : 0; }
        const unsigned long long wm = __ballot(lane < (int)nB && rank == need - 1); const int src = __builtin_ctzll(wm);
        Ts = __shfl(xi, src); Is = __shfl(si, src);
    }
#pragma unroll
    for (int j = 0; j < 32; ++j) { unsigned long long m = 0ull;
        if (j < NJ) { const int s = 64 * j + lane; const bool sel = (bn[j] > B) || (bn[j] == B && (x[j] > Ts || (x[j] == Ts && s <= Is))); m = __ballot(sel); }
        if (lane == 0) mo[j] = m; }
}
__device__ __forceinline__ void dsa_select(Frame& F, const EvenPtrs& P) {
    const int lane = F.lane;
    LAS unsigned* hist = (LAS unsigned*)(F.lds + F.wave * 9216); LAS float* cand = (LAS float*)(F.lds + F.wave * 9216 + 8448);
    for (int i = lane; i < 2112; i += 64) hist[i] = 0u;
    for (int idx = F.gw; idx < M; idx += F.NGW) {
        const int k = idx >> 11, gwid = idx & 2047, t = (k & 1) ? 2047 - gwid : gwid; const size_t row = (size_t)k * SEQ + t; const int n = t + 1;
        unsigned long long* mo = (unsigned long long*)(P.MASK + row * 64); const float* isc = P.ISC + row * 2048;
        if (n <= 256) {
#pragma unroll
            for (int j = 0; j < 32; ++j) { const unsigned long long m = __ballot(64 * j + lane <= t); if (lane == 0) mo[j] = m; }
        } else if (n <= 512) select_hist<8>(isc, mo, t, lane, hist, cand);
        else if (n <= 1024) select_hist<16>(isc, mo, t, lane, hist, cand);
        else if (n <= 1536) select_hist<24>(isc, mo, t, lane, hist, cand);
        else select_hist<32>(isc, mo, t, lane, hist, cand);
    }
}
__device__ __forceinline__ void dsa_attn(Frame& F, const EvenPtrs& P) {
    bf16* Kl = (bf16*)F.gl; bf16* Vl = (bf16*)(F.gl + 18432); float* btl = (float*)(F.gl + 41472); float* mtl = (float*)(F.gl + 41984);
    const int tid = F.tid, lane = F.lane, w = F.wave, fr = lane & 15, fq = lane >> 4, lrow = tid >> 3, lch = tid & 7;
    for (int i = tid; i < 2 * 16 * 64; i += 512) { const int bufi = i >> 10, r = (i >> 6) & 15, cc = i & 63; Vl[bufi * 5760 + (64 + r) * 72 + cc] = (r == 0) ? (bf16)0x3f80u : (bf16)0; }
    if (tid < 64) mtl[tid] = ((tid >> 2) >> (tid & 3)) & 1 ? 1.0f : 0.0f;
    for (int vu = F.bid; vu < 256; vu += F.G) {
        const int bh = vu >> 2, s4 = vu & 3, b = bh >> 3, hh = bh & 7;
        for (int iu = 0; iu < 2; ++iu) {
            const int qb = (iu == 0) ? s4 : 7 - s4;
            const int t0 = qb * 256, tw = t0 + 32 * w;
            bf16x8 qf[2][2]; const v2u* mrow[2];
#pragma unroll
            for (int cb = 0; cb < 2; ++cb) { const size_t rowq = (size_t)b * SEQ + tw + 16 * cb + fr; mrow[cb] = (const v2u*)(P.MASK + rowq * 64);
              const v4u w0 = *(const v4u*)(P.BQ + rowq * 512 + hh * 64 + 8 * fq), w1 = *(const v4u*)(P.BQ + rowq * 512 + hh * 64 + 32 + 8 * fq);
              float x[16] = {bflo(w0.x), bfhi(w0.x), bflo(w0.y), bfhi(w0.y), bflo(w0.z), bfhi(w0.z), bflo(w0.w), bfhi(w0.w), bflo(w1.x), bfhi(w1.x), bflo(w1.y), bfhi(w1.y), bflo(w1.z), bfhi(w1.z), bflo(w1.w), bfhi(w1.w)};
              float ss = 0.f;
#pragma unroll
              for (int j = 0; j < 16; ++j) ss += x[j] * x[j];
              ss += __shfl_xor(ss, 16); ss += __shfl_xor(ss, 32);
              const float r = rsqrtf(ss * (1.0f / 64.0f) + 1e-6f) * (0.125f * LOG2E);
              const f32x4 g0 = *(const f32x4*)(P.gq + 8 * fq), g1 = *(const f32x4*)(P.gq + 8 * fq + 4), g2 = *(const f32x4*)(P.gq + 32 + 8 * fq), g3 = *(const f32x4*)(P.gq + 32 + 8 * fq + 4);
              v4u q0, q1; q0.x = pk2(x[0] * r * g0.x, x[1] * r * g0.y); q0.y = pk2(x[2] * r * g0.z, x[3] * r * g0.w); q0.z = pk2(x[4] * r * g1.x, x[5] * r * g1.y); q0.w = pk2(x[6] * r * g1.z, x[7] * r * g1.w);
              q1.x = pk2(x[8] * r * g2.x, x[9] * r * g2.y); q1.y = pk2(x[10] * r * g2.z, x[11] * r * g2.w); q1.z = pk2(x[12] * r * g3.x, x[13] * r * g3.y); q1.w = pk2(x[14] * r * g3.z, x[15] * r * g3.w);
              qf[cb][0] = __builtin_bit_cast(bf16x8, q0); qf[cb][1] = __builtin_bit_cast(bf16x8, q1); }
            if (tid < 128) btl[tid] = P.bt[hh * 128 + tid] - P.bt[hh * 128 + 127];
            const int nk = 4 * qb + 4;
            const bf16* kg = P.KB + ((size_t)b * SEQ + lrow) * 64 + lch * 8;
            const bf16* vg = P.VT + ((size_t)(b * 8 + hh) * 64 + lrow) * 2048 + lch * 8;
            v4u kreg = *(const v4u*)kg, vreg = *(const v4u*)vg; v2u mnext[2] = {mrow[0][0], mrow[1][0]};
            *(v4u*)(Kl + lrow * 72 + lch * 8) = kreg; *(v4u*)(Vl + lrow * 72 + lch * 8) = vreg;
            __syncthreads();
            f32x4 o[2][5];
#pragma unroll
            for (int cb = 0; cb < 2; ++cb)
#pragma unroll
                for (int dt = 0; dt < 5; ++dt) o[cb][dt] = (f32x4){0.f, 0.f, 0.f, 0.f};
            float mrun[2] = {0.f, 0.f}; bool first = true;
            for (int kt = 0; kt < nk; ++kt) {
                const int s0 = kt * 64; const bf16* Kb = Kl + (kt & 1) * 4608; const bf16* Vb = Vl + (kt & 1) * 5760; const v2u mw[2] = {mnext[0], mnext[1]};
                if (kt + 1 < nk) { kreg = *(const v4u*)(kg + (size_t)(s0 + 64) * 64); vreg = *(const v4u*)(vg + s0 + 64); mnext[0] = mrow[0][kt + 1]; mnext[1] = mrow[1][kt + 1]; }
                if (s0 <= tw + 31) {
                    f32x4 acc[2][4];
#pragma unroll
                    for (int cb = 0; cb < 2; ++cb) { const f32x4 cin = (f32x4){-mrun[cb], -mrun[cb], -mrun[cb], -mrun[cb]};
#pragma unroll
                        for (int st = 0; st < 4; ++st) acc[cb][st] = cin; }
#pragma unroll
                    for (int st = 0; st < 4; ++st) { const bf16x8 a0 = *(const bf16x8*)(Kb + (16 * st + fr) * 72 + 8 * fq), a1 = *(const bf16x8*)(Kb + (16 * st + fr) * 72 + 32 + 8 * fq);
#pragma unroll
                        for (int cb = 0; cb < 2; ++cb) { acc[cb][st] = MFMA16(a0, qf[cb][0], acc[cb][st]); acc[cb][st] = MFMA16(a1, qf[cb][1], acc[cb][st]); } }
                    bf16x8 pf[2][2]; bool resc = false; float mxs[2];
#pragma unroll
                    for (int cb = 0; cb < 2; ++cb) { const int tb = tw + 16 * cb, t = tb + fr;
                        if ((tb - (s0 + 63)) < 113) {
#pragma unroll
                            for (int st = 0; st < 4; ++st)
#pragma unroll
                                for (int r = 0; r < 4; ++r) { int dist = t - (s0 + 16 * st + 4 * fq + r); dist = dist < 0 ? 0 : (dist > 127 ? 127 : dist); acc[cb][st][r] += btl[dist]; } }
                        float mx = fmaxf(fmaxf(fmaxf(acc[cb][0].x, acc[cb][0].y), fmaxf(acc[cb][0].z, acc[cb][0].w)), fmaxf(fmaxf(acc[cb][1].x, acc[cb][1].y), fmaxf(acc[cb][1].z, acc[cb][1].w)));
                        mx = fmaxf(mx, fmaxf(fmaxf(fmaxf(acc[cb][2].x, acc[cb][2].y), fmaxf(acc[cb][2].z, acc[cb][2].w)), fmaxf(fmaxf(acc[cb][3].x, acc[cb][3].y), fmaxf(acc[cb][3].z, acc[cb][3].w))));
                        mx = fmaxf(mx, __shfl_xor(mx, 16)); mx = fmaxf(mx, __shfl_xor(mx, 32)); mxs[cb] = mx; resc = resc || (mx > 8.0f); }
                    if (first || __any(resc)) {
#pragma unroll
                        for (int cb = 0; cb < 2; ++cb) { const float dl = first ? mxs[cb] : fmaxf(mxs[cb], 0.f); mrun[cb] += dl; const float alpha = first ? 1.0f : __builtin_amdgcn_exp2f(-dl);
#pragma unroll
                            for (int st = 0; st < 4; ++st) acc[cb][st] = acc[cb][st] - dl;
#pragma unroll
                            for (int dt = 0; dt < 5; ++dt) o[cb][dt] = o[cb][dt] * alpha; }
                        first = false; }
#pragma unroll
                    for (int cb = 0; cb < 2; ++cb)
#pragma unroll
                        for (int kk = 0; kk < 2; ++kk) { const unsigned mword = (kk == 0) ? mw[cb].x : mw[cb].y;
                            const f32x4 m0 = *(const f32x4*)(mtl + 4 * ((mword >> (4 * fq)) & 15u)), m1 = *(const f32x4*)(mtl + 4 * ((mword >> (16 + 4 * fq)) & 15u));
                            const f32x4 a = acc[cb][2 * kk], c = acc[cb][2 * kk + 1];
                            v4u pw; pw.x = pk2(__builtin_amdgcn_exp2f(a.x) * m0.x, __builtin_amdgcn_exp2f(a.y) * m0.y); pw.y = pk2(__builtin_amdgcn_exp2f(a.z) * m0.z, __builtin_amdgcn_exp2f(a.w) * m0.w);
                            pw.z = pk2(__builtin_amdgcn_exp2f(c.x) * m1.x, __builtin_amdgcn_exp2f(c.y) * m1.y); pw.w = pk2(__builtin_amdgcn_exp2f(c.z) * m1.z, __builtin_amdgcn_exp2f(c.w) * m1.w);
                            pf[cb][kk] = __builtin_bit_cast(bf16x8, pw); }
#pragma unroll
                    for (int dt = 0; dt < 5; ++dt)
#pragma unroll
                        for (int kk = 0; kk < 2; ++kk) { const bf16* vp = Vb + (16 * dt + fr) * 72 + 32 * kk + 4 * fq; const v2u lo = *(const v2u*)vp, hi = *(const v2u*)(vp + 16);
                            v4u vv; vv.x = lo.x; vv.y = lo.y; vv.z = hi.x; vv.w = hi.y; const bf16x8 vf = __builtin_bit_cast(bf16x8, vv);
                            o[0][dt] = MFMA16(vf, pf[0][kk], o[0][dt]); o[1][dt] = MFMA16(vf, pf[1][kk], o[1][dt]); }
                }
                if (kt + 1 < nk) { *(v4u*)(Kl + ((kt + 1) & 1) * 4608 + lrow * 72 + lch * 8) = kreg; *(v4u*)(Vl + ((kt + 1) & 1) * 5760 + lrow * 72 + lch * 8) = vreg; }
                __syncthreads();
            }
#pragma unroll
            for (int cb = 0; cb < 2; ++cb) { const size_t rowq = (size_t)b * SEQ + tw + 16 * cb + fr; const float linv = 1.0f / __shfl(o[cb][4].x, fr);
#pragma unroll
                for (int dt = 0; dt < 4; ++dt) { v2u wv; wv.x = pk2(o[cb][dt].x * linv, o[cb][dt].y * linv); wv.y = pk2(o[cb][dt].z * linv, o[cb][dt].w * linv); *(v2u*)(P.MIX + rowq * 1024 + 512 + hh * 64 + 16 * dt + 4 * fq) = wv; } }
        }
    }
}
__device__ __forceinline__ void pool_prep(Frame& F, const bf16* HB, const float* stats, const float* gmix, bf16* POOLED) {
    float* rl = (float*)F.gl;
    for (int tile = F.bid; tile < M / 64; tile += F.G) {
        const int row0 = tile * 64, tpos0 = row0 & 2047;
        if (F.tid < 79) { const int row = row0 - 15 + F.tid; float r = 0.f;
            if (tpos0 - 15 + F.tid >= 0) { const f32x4* p = (const f32x4*)(stats + (size_t)row * 16); const f32x4 a = p[0], b = p[1], c = p[2], d = p[3];
                const float s = (((a.x + a.y) + (a.z + a.w)) + ((b.x + b.y) + (b.z + b.w))) + (((c.x + c.y) + (c.z + c.w)) + ((d.x + d.y) + (d.z + d.w))); r = rsqrtf(s * (1.0f / 1024.0f) + 1e-6f); }
            rl[F.tid] = r; }
        __syncthreads();
        { const int cgp = F.tid & 127, tsub = F.tid >> 7, c0 = cgp * 8, g = cgp >> 5, win = 2 << g, ts = tsub * 16, tps = tpos0 + ts;
          const bf16* hbase = HB + (size_t)(row0 + ts) * DM + c0;
          float S[8] = {0.f, 0.f, 0.f, 0.f, 0.f, 0.f, 0.f, 0.f};
#pragma unroll
          for (int j = 1; j < 16; ++j) if (j < win && tps - j >= 0) { f32x4 a, b; pg8::unpack8(*(const v4u*)(hbase - (size_t)j * DM), a, b); const float r = rl[15 + ts - j];
              S[0] += a.x * r; S[1] += a.y * r; S[2] += a.z * r; S[3] += a.w * r; S[4] += b.x * r; S[5] += b.y * r; S[6] += b.z * r; S[7] += b.w * r; }
          const f32x4 g0 = *(const f32x4*)(gmix + c0), g1 = *(const f32x4*)(gmix + c0 + 4);
          bf16* op = POOLED + ((size_t)g * M + row0 + ts) * 256 + (c0 & 255);
#pragma unroll
          for (int i = 0; i < 16; ++i) { f32x4 a, b; pg8::unpack8(*(const v4u*)(hbase + (size_t)i * DM), a, b); const float r = rl[15 + ts + i];
              const float y[8] = {a.x * r, a.y * r, a.z * r, a.w * r, b.x * r, b.y * r, b.z * r, b.w * r};
#pragma unroll
              for (int q = 0; q < 8; ++q) S[q] += y[q];
              const int n = (tps + i + 1 < win) ? tps + i + 1 : win; const float inv = 1.0f / (float)n;
              v4u o; o.x = pk2((S[0] * inv - y[0]) * g0.x, (S[1] * inv - y[1]) * g0.y); o.y = pk2((S[2] * inv - y[2]) * g0.z, (S[3] * inv - y[3]) * g0.w);
              o.z = pk2((S[4] * inv - y[4]) * g1.x, (S[5] * inv - y[5]) * g1.y); o.w = pk2((S[6] * inv - y[6]) * g1.z, (S[7] * inv - y[7]) * g1.w);
              *(v4u*)(op + (size_t)i * 256) = o;
              const int dep = i - (win - 1);
              if (tps + dep >= 0) { f32x4 da, db; pg8::unpack8(*(const v4u*)(hbase + (ptrdiff_t)dep * DM), da, db); const float dr = rl[15 + ts + dep];
                  S[0] -= da.x * dr; S[1] -= da.y * dr; S[2] -= da.z * dr; S[3] -= da.w * dr; S[4] -= db.x * dr; S[5] -= db.y * dr; S[6] -= db.z * dr; S[7] -= db.w * dr; } } }
        __syncthreads();
    }
}
struct RoutePtrs { int* TOKE; float* TOKG; float* TOKR; int* CNT; int* ROWTS; float* ROWG; float* ROWR; int* TILEE; int* NT; int* EXPB; int* EXPN; };
__device__ __forceinline__ RoutePtrs route_ptrs(unsigned char* ws) { unsigned char* r = ws + WS_ROUTE; RoutePtrs p;
    p.TOKE = (int*)(r + RT_TOKE); p.TOKG = (float*)(r + RT_TOKG); p.TOKR = (float*)(r + RT_TOKR); p.CNT = (int*)(r + RT_CNT); p.ROWTS = (int*)(r + RT_ROWTS); p.ROWG = (float*)(r + RT_ROWG); p.ROWR = (float*)(r + RT_ROWR);
    p.TILEE = (int*)(r + RT_TILEE); p.NT = (int*)(r + RT_NT); p.EXPB = p.NT + 16; p.EXPN = p.NT + 32; return p; }
__device__ __forceinline__ void moe_route(Frame& F, const RoutePtrs& R, const bf16* HB, const float* gffn, const float* wr, const float* br) {
    int* cnt = (int*)F.gl; const int lane = F.lane;
    float wreg[16][8];
#pragma unroll
    for (int j = 0; j < 4; ++j) { const int c0 = 4 * lane + 256 * j; const f32x4 g = *(const f32x4*)(gffn + c0); const float gg[4] = {g.x, g.y, g.z, g.w};
#pragma unroll
        for (int q = 0; q < 4; ++q) { const f32x4 w0 = *(const f32x4*)(wr + (size_t)(c0 + q) * 8), w1 = *(const f32x4*)(wr + (size_t)(c0 + q) * 8 + 4);
            wreg[4 * j + q][0] = w0.x * gg[q]; wreg[4 * j + q][1] = w0.y * gg[q]; wreg[4 * j + q][2] = w0.z * gg[q]; wreg[4 * j + q][3] = w0.w * gg[q];
            wreg[4 * j + q][4] = w1.x * gg[q]; wreg[4 * j + q][5] = w1.y * gg[q]; wreg[4 * j + q][6] = w1.z * gg[q]; wreg[4 * j + q][7] = w1.w * gg[q]; } }
    const int myexp = ((lane >> 5) & 1) * 4 + ((lane >> 4) & 1) * 2 + ((lane >> 3) & 1); const float mybias = br[myexp];
    for (int tile = F.bid; tile < M / 64; tile += F.G) {
        if (F.tid < 8) cnt[F.tid] = 0;
        __syncthreads();
        for (int ib = 0; ib < 2; ++ib) {
            f32x4 v[4][4];
#pragma unroll
            for (int i = 0; i < 4; ++i) { const v2u* hr = (const v2u*)(HB + (size_t)(tile * 64 + F.wave * 8 + ib * 4 + i) * DM) + lane;
#pragma unroll
                for (int j = 0; j < 4; ++j) { const v2u hw = hr[64 * j]; v[i][j] = (f32x4){bflo(hw.x), bfhi(hw.x), bflo(hw.y), bfhi(hw.y)}; } }
#pragma unroll
            for (int i = 0; i < 4; ++i) { const int row = tile * 64 + F.wave * 8 + ib * 4 + i; float ss = 0.f; float lg[8] = {0.f, 0.f, 0.f, 0.f, 0.f, 0.f, 0.f, 0.f};
#pragma unroll
                for (int j = 0; j < 4; ++j) { const float y[4] = {v[i][j].x, v[i][j].y, v[i][j].z, v[i][j].w};
#pragma unroll
                    for (int q = 0; q < 4; ++q) { ss += y[q] * y[q];
#pragma unroll
                        for (int e = 0; e < 8; ++e) lg[e] += y[q] * wreg[4 * j + q][e]; } }
                ss = wave_sum(ss); const float r = rsqrtf(ss * (1.0f / 1024.0f) + 1e-6f);
                float a4[4];
#pragma unroll
                for (int e = 0; e < 4; ++e) { const bool hi = (lane & 32) != 0; const float keep = hi ? lg[e + 4] : lg[e], send = hi ? lg[e] : lg[e + 4]; a4[e] = keep + __shfl_xor(send, 32); }
                float a2[2];
#pragma unroll
                for (int e = 0; e < 2; ++e) { const bool hi = (lane & 16) != 0; const float keep = hi ? a4[e + 2] : a4[e], send = hi ? a4[e] : a4[e + 2]; a2[e] = keep + __shfl_xor(send, 16); }
                float a1; { const bool hi = (lane & 8) != 0; const float keep = hi ? a2[1] : a2[0], send = hi ? a2[0] : a2[1]; a1 = keep + __shfl_xor(send, 8); }
                a1 += __shfl_xor(a1, 4); a1 += __shfl_xor(a1, 2); a1 += __shfl_xor(a1, 1);
                const float mylogit = a1 * r + mybias;
                float l8[8];
#pragma unroll
                for (int e = 0; e < 8; ++e) l8[e] = __shfl(mylogit, 32 * (e >> 2) + 16 * ((e >> 1) & 1) + 8 * (e & 1));
                int e1 = 0; float v1 = l8[0];
#pragma unroll
                for (int e = 1; e < 8; ++e) if (l8[e] > v1) { v1 = l8[e]; e1 = e; }
                int e2 = -1; float v2 = -INFINITY;
#pragma unroll
                for (int e = 0; e < 8; ++e) if (e != e1 && l8[e] > v2) { v2 = l8[e]; e2 = e; }
                const float ex = __expf(v2 - v1), g1 = 1.0f / (1.0f + ex), g2 = ex * g1;
                if (lane == 0) { R.TOKE[row] = e1 | (e2 << 8); R.TOKG[row * 2] = g1; R.TOKG[row * 2 + 1] = g2; R.TOKR[row] = r; atomicAdd(&cnt[e1], 1); atomicAdd(&cnt[e2], 1); } }
        }
        __syncthreads();
        if (F.tid < 8) R.CNT[tile * 8 + F.tid] = cnt[F.tid];
        __syncthreads();
    }
}
__device__ __forceinline__ void moe_scatter(Frame& F, const RoutePtrs& R, const bf16* HB, bf16* YG) {
    int* sm = (int*)F.gl;
    for (int tile = F.bid; tile < M / 64; tile += F.G) {
        if (F.tid < 16) sm[F.tid] = 0;
        __syncthreads();
        for (int i = F.tid; i < (M / 64) * 8; i += 512) { const int v = R.CNT[i]; atomicAdd(&sm[i & 7], v); if ((i >> 3) < tile) atomicAdd(&sm[8 + (i & 7)], v); }
        __syncthreads();
        if (F.tid == 0) { int base = 0; for (int e = 0; e < 8; ++e) { sm[16 + e] = base; base += (sm[e] + 255) & ~255; } sm[24] = base >> 8; }
        __syncthreads();
        if (F.wave == 0) { const int row = tile * 64 + F.lane, te = R.TOKE[row], e1 = te & 255, e2 = te >> 8; int p1 = 0, p2 = 0; const unsigned long long lt = (F.lane == 0) ? 0ull : (~0ull >> (64 - F.lane));
#pragma unroll
            for (int e = 0; e < 8; ++e) { const unsigned long long m1 = __ballot(e1 == e), m2 = __ballot(e2 == e); const int rk = __popcll(m1 & lt) + __popcll(m2 & lt), bs = sm[16 + e] + sm[8 + e];
                if (e1 == e) p1 = bs + rk; if (e2 == e) p2 = bs + rk; }
            const float r = R.TOKR[row]; R.ROWTS[p1] = row * 2; R.ROWTS[p2] = row * 2 + 1; R.ROWG[p1] = R.TOKG[row * 2]; R.ROWG[p2] = R.TOKG[row * 2 + 1]; R.ROWR[p1] = r; R.ROWR[p2] = r;
            sm[32 + 2 * F.lane] = p1; sm[33 + 2 * F.lane] = p2; }
        __syncthreads();
        for (int i = 0; i < 16; ++i) { const int cp = F.wave * 16 + i, tok = cp >> 1, pos = sm[32 + cp]; const v4u* src = (const v4u*)(HB + (size_t)(tile * 64 + tok) * DM); v4u* dst = (v4u*)(YG + (size_t)pos * DM);
            dst[F.lane] = src[F.lane]; dst[64 + F.lane] = src[64 + F.lane]; }
        if (tile == 0) {
            for (int e = 0; e < 8; ++e) { const int lo = sm[16 + e] + sm[e], hi = sm[16 + e] + ((sm[e] + 255) & ~255);
                for (int p = lo + F.tid; p < hi; p += 512) { R.ROWTS[p] = -1; R.ROWG[p] = 0.f; R.ROWR[p] = 0.f; }
                for (int t2 = (sm[16 + e] >> 8) + F.tid; t2 < (hi >> 8); t2 += 512) R.TILEE[t2] = e; }
            if (F.tid == 0) R.NT[0] = sm[24];
            if (F.tid < 8) { R.EXPB[F.tid] = sm[16 + F.tid] >> 8; R.EXPN[F.tid] = (sm[F.tid] + 255) >> 8; } }
        __syncthreads();
    }
}
__device__ __forceinline__ void moe_combine(Frame& F, const bf16* D0, const bf16* D1, bf16* HB, float* stats) {
    for (int m = F.gw; m < M; m += F.NGW) { const v2u* a = (const v2u*)(D0 + (size_t)m * DM) + F.lane; const v2u* b = (const v2u*)(D1 + (size_t)m * DM) + F.lane;
        v2u* o8 = (v2u*)(HB + (size_t)m * DM) + F.lane; float s = 0.f; v2u hv[4], x[4], y[4];
#pragma unroll
        for (int j = 0; j < 4; ++j) { hv[j] = o8[64 * j]; x[j] = a[64 * j]; y[j] = b[64 * j]; }
#pragma unroll
        for (int j = 0; j < 4; ++j) { f32x4 v; v.x = bflo(hv[j].x) + bflo(x[j].x) + bflo(y[j].x); v.y = bfhi(hv[j].x) + bfhi(x[j].x) + bfhi(y[j].x); v.z = bflo(hv[j].y) + bflo(x[j].y) + bflo(y[j].y); v.w = bfhi(hv[j].y) + bfhi(x[j].y) + bfhi(y[j].y);
            s += (v.x * v.x + v.y * v.y) + (v.z * v.z + v.w * v.w); v2u w; w.x = pk2(v.x, v.y); w.y = pk2(v.z, v.w); o8[64 * j] = w; }
        s = wave_sum(s);
        if (F.lane < 16) stats[(size_t)m * 16 + F.lane] = (F.lane == 0) ? s : 0.f; }
}
constexpr int N_PHASES = 35;
static_assert(WS_VB == WS_QK + 32 * MiB && WS_OG == WS_VB + 16 * MiB && WS_BQ == WS_OG + 16 * MiB && WS_BQI == WS_BQ + 16 * MiB, "EpiIn address arithmetic");
#ifndef PHASE_SEL
#define PHASE_SEL -1
#endif
#define PHEN(r) (PHASE_SEL < 0 || PHASE_SEL == (r))
#ifndef REP_MASK
#define REP_MASK 0
#endif
#define REPF(bit, call) do { call; if (REP_MASK & (1u << (bit))) { __syncthreads(); call; } } while (0)
#define IN(k) (lo <= (k) && (k) < hi)
#ifndef PROBE_SLOT
#define PROBE_SLOT -1
#endif
#ifndef PROBE_MULT
#define PROBE_MULT 8
#endif
#define SEAM(k) do { if ((k) + 1 < hi) { XcdBarrier b2_ = bar; asm volatile("" : "+s"(b2_.bar)); xcd_barrier(b2_); } \
    if (PROBE_SLOT >= 0) { const unsigned long long now_ = wall_clock64(); if ((((k) == 0) ? 100 : (((k) - 1) % 17)) == PROBE_SLOT) F.tacc += now_ - F.tprev; F.tprev = now_; } } while (0)
#define HBSEL(i) ((bf16*)(ws + ((i) ? WS_HB1 : WS_HB0)))
#define STSEL(i) ((float*)(ws + WS_STATS + ((i) ? MiB : (size_t)0)))
template <int lp> __device__ __forceinline__ void layer_pair(Frame& F, const Args& args, const XcdBarrier& bar, const int lo, const int hi, LAS unsigned char* ring, const int K256) {
    unsigned char* ws = F.ws; bf16* Eb = (bf16*)(ws + WS_E);
        const int pb = 1 + 17 * lp;
        int hbi = 0, si = 0;

        {
            const int e = lp, li = 2 * lp;
            EvenPtrs P;
            P.QK = (const bf16*)(ws + WS_QK); P.VB = (const bf16*)(ws + WS_VB); P.OG = (const bf16*)(ws + WS_OG); P.BQ = (const bf16*)(ws + WS_BQ); P.BQI = (const bf16*)(ws + WS_BQI); P.MISC = (const float*)(ws + WS_MISC);
            P.MIX = (bf16*)(ws + WS_MIX); P.QKC = (bf16*)(ws + WS_QKC); P.KB = (bf16*)(ws + WS_KB); P.KIB = (bf16*)(ws + WS_KIB); P.VT = (bf16*)(ws + WS_VT); P.MASK = (unsigned*)(ws + WS_MASK); P.CHS = (float*)(ws + WS_CHS); P.MST = (float*)(ws + WS_CHS + 65536);
            P.ISC = (float*)(ws + WS_ISC); P.U = (float*)(ws + WS_U); P.CB = (bf16*)(ws + WS_CB);
            P.bgate = INP(IN_B_GATE) + e * 8; P.conv = INP(IN_CONV) + e * 4 * 1024; P.gh = INP(IN_NORM_H) + e * 512; P.gq = INP(IN_NORM_Q) + e * 64; P.gk = INP(IN_NORM_K) + e * 64; P.gkv = INP(IN_NORM_KV) + e * 128;
            P.WukT = (const bf16*)(ws + WS_SMALL + 8192) + (size_t)e * 64 * 128; P.WuvT = (const bf16*)(ws + WS_SMALL + 65536) + (size_t)e * 512 * 128; P.bt = (const float*)(ws + WS_SMALL);
            if (PHEN(1) && IN(pb + 1)) {
                pg8::Gemm g{HBSEL(hbi), (const bf16*)(ws + WS_W_IN) + (size_t)e * NINP * DM, M, NINP, DM}; pg8::StaticOrder S; S.init(M, NINP, F.G, F.bid);
                pg8::EpiIn E{STSEL(si), (bf16*)(ws + WS_QK), (float*)(ws + WS_MISC), (bf16*)(ws + WS_KIB)};
                pg8::gemm_phase<pg8::EpiIn, pg8::StaticOrder, true, true>(ring, g, S, E);
                {
                  int c0 = (((M / 256) * (NINP / 256)) % F.G + 7) & ~7; if (c0 >= F.G) c0 = 0;
                  if (F.bid >= c0) { pg8::Gemm g2{(const bf16*)(ws + WS_PB) + (size_t)li * M * PLED, (const bf16*)(ws + WS_W_PL) + (size_t)li * DM * PLED, M, DM, K256}; pg8::StaticOrder S2; S2.init(M, DM, F.G - c0, F.bid - c0);
                    pg8::EpiStore E2{Eb, DM};
                    pg8::gemm_phase<pg8::EpiStore, pg8::StaticOrder, true, true>(ring, g2, S2, E2); } }
                  SEAM(pb + 1); }
            if (PHEN(2) && IN(pb + 2)) { REPF(1, mlstm_a(F, P)); REPF(2, dsa_prep(F, P)); REPF(3, dsa_index(F, P)); SEAM(pb + 2); }
            if (PHEN(3) && IN(pb + 3)) { REPF(4, mlstm_b(F, P)); REPF(5, dsa_select(F, P)); SEAM(pb + 3); }
            if (PHEN(4) && IN(pb + 4)) { REPF(6, mlstm_c(F, P)); REPF(7, dsa_attn(F, P)); SEAM(pb + 4); }
            if (PHEN(5) && IN(pb + 5)) {
                { pg8::Gemm g{(const bf16*)(ws + WS_MIX), (const bf16*)(ws + WS_W_OUT) + (size_t)e * DM * DM, M, DM, DM}; pg8::StaticOrder S; S.init(M, DM, F.G, F.bid);
                  pg8::EpiResid<0> E{HBSEL(hbi), HBSEL(hbi), nullptr, STSEL(si ^ 1), nullptr, nullptr, nullptr};
                  pg8::gemm_phase<pg8::EpiResid<0>, pg8::StaticOrder, true, true>(ring, g, S, E); }
                SEAM(pb + 5); }
            si ^= 1;
            if (PHEN(6) && IN(pb + 6)) {
                pg8::Gemm g{HBSEL(hbi), (const bf16*)(ws + WS_W_GU) + (size_t)e * 7168 * DM, M, 7168, DM}; pg8::StaticOrder S; S.init(M, 7168, F.G, F.bid);
                pg8::EpiGLU<false> E{STSEL(si), nullptr, (bf16*)(ws + WS_ACT)};
                pg8::gemm_phase<pg8::EpiGLU<false>, pg8::StaticOrder, true, true>(ring, g, S, E);
                  SEAM(pb + 6); }
            if (PHEN(7) && IN(pb + 7)) {
                pg8::Gemm g{(const bf16*)(ws + WS_ACT), (const bf16*)(ws + WS_W_DN) + (size_t)e * DM * DFF, M, DM, DFF}; pg8::StaticOrder S; S.init(M, DM, F.G, F.bid);
                pg8::EpiResid<0> E{HBSEL(hbi), HBSEL(hbi), nullptr, STSEL(si ^ 1), nullptr, nullptr, nullptr};
                pg8::gemm_phase<pg8::EpiResid<0>, pg8::StaticOrder, true, true>(ring, g, S, E);
                SEAM(pb + 7); }
            si ^= 1;
            if (PHEN(8) && IN(pb + 8)) {
                pg8::Gemm g{HBSEL(hbi), (const bf16*)(ws + WS_W_PG) + (size_t)li * DM * DM, M, DM, DM}; pg8::StaticOrder S; S.init(M, DM, F.G, F.bid);
                pg8::EpiResid<2> E{HBSEL(hbi), HBSEL(hbi ^ 1), nullptr, STSEL(si ^ 1), STSEL(si), Eb, nullptr};
                pg8::gemm_phase<pg8::EpiResid<2>, pg8::StaticOrder, true, true>(ring, g, S, E);
                SEAM(pb + 8); }
            si ^= 1; hbi ^= 1;
        }
        {
            const int o = lp, li = 2 * lp + 1;
            const RoutePtrs R = route_ptrs(ws);
            if (PHEN(9) && IN(pb + 9)) {
                pool_prep(F, HBSEL(hbi), STSEL(si), INP(IN_NORM_MIX) + li * DM, (bf16*)(ws + WS_POOLED));
                  SEAM(pb + 9); }
            if (PHEN(10) && IN(pb + 10)) {
                pg8::Gemm g{(const bf16*)(ws + WS_POOLED), (const bf16*)(ws + WS_W_POOL) + (size_t)o * 4 * 256 * 256, 4 * M, 1024, K256}; pg8::PoolOrder S{F.G, F.bid};
                pg8::EpiResid<1> E{HBSEL(hbi), HBSEL(hbi), nullptr, STSEL(si ^ 1), nullptr, nullptr, INP(IN_SCALE_POOL) + o * DM};
                pg8::gemm_phase<pg8::EpiResid<1>, pg8::PoolOrder, true, true>(ring, g, S, E);
                SEAM(pb + 10); }
            si ^= 1;
            if (PHEN(11) && IN(pb + 11)) {   moe_route(F, R, HBSEL(hbi), INP(IN_NORM_FFN) + li * DM, INP(IN_W_ROUTER) + (size_t)o * DM * 8, INP(IN_B_ROUTER) + o * 8);   SEAM(pb + 11); }
            if (PHEN(12) && IN(pb + 12)) {   moe_scatter(F, R, HBSEL(hbi), (bf16*)(ws + WS_YG));   SEAM(pb + 12); }
            if (PHEN(13) && IN(pb + 13)) {
                const int nt = __builtin_amdgcn_readfirstlane(R.NT[0]);
                pg8::Gemm g{(const bf16*)(ws + WS_YG), (const bf16*)(ws + WS_W_MGU), MAXROWS, 8 * 7168, DM}; pg8::MoeOrder S{R.TILEE, R.EXPB, R.EXPN, nt, 28, F.G, F.bid};
                pg8::EpiGLU<true> E{nullptr, R.ROWR, (bf16*)(ws + WS_ACTM)};
                pg8::gemm_phase<pg8::EpiGLU<true>, pg8::MoeOrder, true, true>(ring, g, S, E);
                  SEAM(pb + 13); }
            if (PHEN(14) && IN(pb + 14)) {
                const int nt = __builtin_amdgcn_readfirstlane(R.NT[0]);
                pg8::Gemm g{(const bf16*)(ws + WS_ACTM), (const bf16*)(ws + WS_W_MDN), MAXROWS, 8 * 1024, DFF}; pg8::MoeOrder S{R.TILEE, R.EXPB, R.EXPN, nt, 4, F.G, F.bid};
                pg8::EpiScatter E{R.ROWTS, R.ROWG, (bf16*)(ws + WS_D0), (bf16*)(ws + WS_D1)};
                pg8::gemm_phase<pg8::EpiScatter, pg8::MoeOrder, true, true>(ring, g, S, E);
                {
                  const int c0 = 0;
                  if (F.bid >= c0) { pg8::Gemm g2{(const bf16*)(ws + WS_PB) + (size_t)li * M * PLED, (const bf16*)(ws + WS_W_PL) + (size_t)li * DM * PLED, M, DM, K256}; pg8::StaticOrder S2; S2.init(M, DM, F.G - c0, F.bid - c0);
                    pg8::EpiStore E2{Eb, DM};
                    pg8::gemm_phase<pg8::EpiStore, pg8::StaticOrder, true, true>(ring, g2, S2, E2); } }
                  SEAM(pb + 14); }
            if (PHEN(15) && IN(pb + 15)) { moe_combine(F, (const bf16*)(ws + WS_D0), (const bf16*)(ws + WS_D1), HBSEL(hbi), STSEL(si ^ 1)); if (lp == 0) REPF(16, conv_moe(F, args, 1));     SEAM(pb + 15); }
            si ^= 1;
            if (PHEN(16) && IN(pb + 16)) {
                pg8::Gemm g{HBSEL(hbi), (const bf16*)(ws + WS_W_PG) + (size_t)li * DM * DM, M, DM, DM}; pg8::StaticOrder S; S.init(M, DM, F.G, F.bid);
                if (lp == 1) { pg8::EpiResid<2, true> E{HBSEL(hbi), nullptr, F.out, nullptr, STSEL(si), Eb, nullptr};
                    pg8::gemm_phase<pg8::EpiResid<2, true>, pg8::StaticOrder, true, true>(ring, g, S, E); }
                else { pg8::EpiResid<2> E{HBSEL(hbi), HBSEL(hbi ^ 1), nullptr, STSEL(si ^ 1), STSEL(si), Eb, nullptr};
                    pg8::gemm_phase<pg8::EpiResid<2>, pg8::StaticOrder, true, true>(ring, g, S, E); }
                SEAM(pb + 16); }
            si ^= 1; hbi ^= 1;
        }

}
__global__ void __launch_bounds__(NWAVES * 64, 2) fwd(Args args) {
    extern __shared__ __attribute__((aligned(16))) unsigned char lds[];
    Frame F;
    F.lds = (LAS unsigned char*)lds; F.gl = lds; F.MISCW = (volatile LAS unsigned*)(F.lds + MISC_OFF);
    F.tid = threadIdx.x; F.lane = F.tid & 63; F.wave = __builtin_amdgcn_readfirstlane(F.tid >> 6); F.G = gridDim.x; F.bid = blockIdx.x; F.gw = F.bid * NWAVES + F.wave; F.NGW = F.G * NWAVES;
    F.out = args.out; F.ws = args.ws;
    unsigned char* ws = args.ws;
    for (int u = F.tid; u < (LDS_BYTES - LDSCTL_OFF) / 4; u += NWAVES * 64) ((LAS unsigned*)(F.lds + LDSCTL_OFF))[u] = 0u;
    __syncthreads();
    XcdBarrier bar = xcd_barrier_post((unsigned*)(ws + WS_CTL) + CW_BAR, F.MISCW + 8);
    const int lo = args.ph_lo, hi = args.ph_hi;
    F.tacc = 0ull; F.tprev = (PROBE_SLOT >= 0) ? wall_clock64() : 0ull;
    LAS unsigned char* ring = F.lds;
    int K256 = 256; asm volatile("" : "+s"(K256));

    if (PHEN(100) && IN(0)) { REPF(8, p0_prologue(F, args)); SEAM(0); }

    layer_pair<0>(F, args, bar, lo, hi, ring, K256);
    layer_pair<1>(F, args, bar, lo, hi, ring, K256);
    if (PROBE_SLOT >= 0 && F.bid == 0 && F.tid == 0) { const unsigned long long t0_ = wall_clock64(), dl_ = (unsigned long long)PROBE_MULT * F.tacc; while (wall_clock64() - t0_ < dl_) __builtin_amdgcn_s_sleep(8); }
#undef IN
#undef SEAM
}

extern "C" void kernel_launch(void* const* d_in, const int* in_sizes, int n_in, void* d_out, int out_size, void* d_ws, size_t ws_size, hipStream_t stream) {
    static int grid = 0;
    if (grid == 0) {
        if (n_in != 28 || in_sizes[0] != M * DM || out_size != M * DM || ws_size < WS_END) { fprintf(stderr, "kernel_launch: unexpected shapes (n_in %d, in0 %d, out %d, ws %zu < %zu); nothing launched\n", n_in, n_in > 0 ? in_sizes[0] : -1, out_size, ws_size, (size_t)WS_END); grid = -1; return; }
        int dev = 0, cus = 0, per_cu = 0;
        if (hipGetDevice(&dev) != hipSuccess || hipDeviceGetAttribute(&cus, hipDeviceAttributeMultiprocessorCount, dev) != hipSuccess) { grid = -1; return; }
        if (hipFuncSetAttribute((const void*)fwd, hipFuncAttributeMaxDynamicSharedMemorySize, LDS_BYTES) != hipSuccess) { fprintf(stderr, "kernel_launch: hipFuncSetAttribute failed\n"); grid = -1; return; }
        if (hipOccupancyMaxActiveBlocksPerMultiprocessor(&per_cu, (const void*)fwd, NWAVES * 64, LDS_BYTES) != hipSuccess || per_cu < 1) fprintf(stderr, "kernel_launch: occupancy query reports %d workgroups per CU\n", per_cu);
        (void)hipGetLastError();
        grid = cus;
    }
    if (grid < 0) return;
    if (hipMemsetAsync((char*)d_ws + WS_CTL, 0, CTL_ZERO_BYTES, stream) != hipSuccess) return;
    Args a{};
    for (int i = 0; i < 28; ++i) a.in[i] = (const float*)d_in[i];
    a.out = (float*)d_out; a.ws = (unsigned char*)d_ws;
#if MK_ONE_LAUNCH
    a.ph_lo = 0; a.ph_hi = N_PHASES;
    hipLaunchKernelGGL(fwd, dim3(grid), dim3(NWAVES * 64), LDS_BYTES, stream, a);
#else
    for (int ph = 0; ph < N_PHASES; ++ph) { if (ph == 1) continue; a.ph_lo = ph; a.ph_hi = ph + 1;
        hipLaunchKernelGGL(fwd, dim3(grid), dim3(NWAVES * 64), LDS_BYTES, stream, a); }
#endif
}
```

```cpp
#include <hip/hip_runtime.h>
#include <cstdio>
#include <cstdint>
#ifndef MK_ONE_LAUNCH
#define MK_ONE_LAUNCH 1
#endif
namespace pg8 {
#define PG8_LAS __attribute__((address_space(3)))
typedef unsigned short bf16_t;
typedef short bf16x8 __attribute__((ext_vector_type(8)));
typedef float f32x4 __attribute__((ext_vector_type(4)));
typedef unsigned u32x4 __attribute__((ext_vector_type(4)));
constexpr int BM = 256, BK = 64, HALF = 128, HTB = HALF * BK * 2  , STAGE_BYTES = 8 * HTB, NXCD = 8, WGM = 8;

__host__ __device__ __forceinline__ int lds_byte(int r, int c) { const int st = (r >> 4) * 2 + (c >> 5), rr = r & 15, cc = c & 31, ob = rr * 64 + cc * 2; return st * 1024 + (ob ^ (((ob >> 9) & 1) << 5)); }
__host__ __device__ __forceinline__ void stage_rc(int b, int& R, int& C) { const int st = b / 1024, sb = b % 1024, swz = sb ^ (((sb >> 9) & 1) << 5); R = (st >> 1) * 16 + swz / 64; C = (st & 1) * 32 + (swz % 64) / 2; }
__host__ __device__ __forceinline__ int perm32(int rho) { const int n = rho >> 4, i = rho & 15; return 8 * (i >> 2) + 4 * n + (i & 3); }

struct Unit { int pm, pn, ko, aux; };
struct Gemm { const bf16_t* A; const bf16_t* Bt; int M, N, K, ld; };

struct StaticOrder {
    int nM, nN, nwg, G, c;
    __host__ __device__ void init(int M, int N, int G_, int c_) { nM = M / BM; nN = N / BM; nwg = nM * nN; G = G_; c = c_; }
    __host__ __device__ bool next(int i, Unit& u) const {
        const long L = (long)i * G + c; if (L >= nwg) return false;
        int wgid = (int)L; { const int q = nwg / NXCD, r = nwg % NXCD, xcd = wgid % NXCD, off = wgid / NXCD; wgid = (xcd < r ? xcd * (q + 1) : r * (q + 1) + (xcd - r) * q) + off; }
        const int nig = WGM * nN, gid = wgid / nig, fm = gid * WGM, gsz = (nM - fm) < WGM ? (nM - fm) : WGM;
        u.pm = fm + ((wgid % nig) % gsz); u.pn = (wgid % nig) / gsz; return true;
    }
    __device__ __forceinline__ void a_ready(const Unit&) const {}
    __device__ __forceinline__ void done(const Unit&) const {}
};
__device__ __forceinline__ unsigned cvt_pk_bf16(float lo, float hi) { unsigned r; asm volatile("v_cvt_pk_bf16_f32 %0, %1, %2" : "=v"(r) : "v"(lo), "v"(hi)); return r; }
typedef float f32x2 __attribute__((ext_vector_type(2)));
constexpr float RMS_EPS = 1e-6f;
__device__ __forceinline__ float fsigmoid(float x) { return __builtin_amdgcn_rcpf(1.0f + __builtin_amdgcn_exp2f(-1.44269504f * x)); }
__device__ __forceinline__ f32x4 sig4(f32x4 v) { f32x4 o; o.x = fsigmoid(v.x); o.y = fsigmoid(v.y); o.z = fsigmoid(v.z); o.w = fsigmoid(v.w); return o; }
__device__ __forceinline__ u32x4 pack8(f32x4 v0, f32x4 v1) { u32x4 w; w.x = cvt_pk_bf16(v0[0], v0[1]); w.y = cvt_pk_bf16(v0[2], v0[3]); w.z = cvt_pk_bf16(v1[0], v1[1]); w.w = cvt_pk_bf16(v1[2], v1[3]); return w; }
__device__ __forceinline__ void unpack8(u32x4 w, f32x4& a, f32x4& b) {
    a.x = __uint_as_float(w.x << 16); a.y = __uint_as_float(w.x & 0xffff0000u); a.z = __uint_as_float(w.y << 16); a.w = __uint_as_float(w.y & 0xffff0000u);
    b.x = __uint_as_float(w.z << 16); b.y = __uint_as_float(w.z & 0xffff0000u); b.z = __uint_as_float(w.w << 16); b.w = __uint_as_float(w.w & 0xffff0000u); }
__device__ __forceinline__ void load_rstd(const float* stats, int rowb, int fr, int fq, float (&rs)[2][4]) {
    float mine[2];
#pragma unroll
    for (int ai = 0; ai < 2; ++ai) { const f32x4* p = (const f32x4*)(stats + (size_t)(rowb + ai * HALF + fq * 16) * 16); const f32x4 a = p[0], b = p[1], c = p[2], d = p[3];
        const float s = (((a.x + a.y) + (a.z + a.w)) + ((b.x + b.y) + (b.z + b.w))) + (((c.x + c.y) + (c.z + c.w)) + ((d.x + d.y) + (d.z + d.w)));
        mine[ai] = rsqrtf(s * (1.0f / 1024.0f) + RMS_EPS); }
#pragma unroll
    for (int ai = 0; ai < 2; ++ai)
#pragma unroll
        for (int m = 0; m < 4; ++m) rs[ai][m] = __shfl(mine[ai], fr + 16 * m);
}
struct EpiIn {
    static constexpr bool PERM = true, AFTER_DRAIN = false;
    const float* stats; bf16_t* QK; float* MISC; bf16_t* KIB;
    __device__ __forceinline__ void operator()(const f32x4 (&acc)[2][2][4][2], const Unit& u, int wr, int wc, int fr, int fq) const {
        const int rowb = u.pm * BM + wr * 64 + fr, cl = wc * 32 + 8 * fq, pn = u.pn;
        float rs[2][4]; load_rstd(stats, rowb, fr, fq, rs);
        if (pn < 12) {
            bf16_t* base; int ld, colt; bool sig = false;
            if (pn < 4) { base = QK; ld = 1024; colt = pn * 256; }
            else { const int t = (pn - 4) >> 1; base = QK + (size_t)16777216 + (size_t)t * 8388608; ld = 512; colt = ((pn - 4) & 1) * 256; sig = (t == 1); }
#pragma unroll
            for (int ai = 0; ai < 2; ++ai)
#pragma unroll
                for (int m = 0; m < 4; ++m) { const float r = rs[ai][m]; bf16_t* rp = base + (size_t)(rowb + ai * HALF + m * 16) * ld + colt + cl;
#pragma unroll
                    for (int bj = 0; bj < 2; ++bj) { f32x4 v0 = acc[ai][bj][m][0] * r, v1 = acc[ai][bj][m][1] * r; if (sig) { v0 = sig4(v0); v1 = sig4(v1); }
                        *(u32x4*)(rp + bj * HALF) = pack8(v0, v1); }
                    asm volatile("" ::: "memory"); }
        } else {
#pragma unroll
            for (int ai = 0; ai < 2; ++ai)
#pragma unroll
                for (int m = 0; m < 4; ++m) { const float r = rs[ai][m]; float* rp = MISC + (size_t)(rowb + ai * HALF + m * 16) * 256 + cl;
#pragma unroll
                    for (int bj = 0; bj < 2; ++bj)
#pragma unroll
                        for (int n = 0; n < 2; ++n) *(f32x4*)(rp + bj * HALF + 4 * n) = acc[ai][bj][m][n] * r;
                    if (wc < 2) *(u32x4*)(KIB + (size_t)(rowb + ai * HALF + m * 16) * 64 + cl) = pack8(acc[ai][1][m][0] * r, acc[ai][1][m][1] * r);
                    asm volatile("" ::: "memory"); }
        }
    }
};
template <int MODE, bool FINAL = false> struct EpiResid {
    static constexpr bool PERM = true, AFTER_DRAIN = false;
    const bf16_t* HBi; bf16_t* HBo; float* OUT; float* statsW; const float* statsR; const bf16_t* E; const float* scale;
    __device__ __forceinline__ void operator()(const f32x4 (&acc)[2][2][4][2], const Unit& u, int wr, int wc, int fr, int fq) const {
        int pm = u.pm; const int pn = u.pn; if (MODE == 1) pm -= 64 * pn;
        const int rowb = pm * BM + wr * 64 + fr, colb = pn * BM + wc * 32 + 8 * fq;
        float rs[2][4]; if (MODE == 2) load_rstd(statsR, rowb, fr, fq, rs);
        f32x4 sc[2][2];
        if (MODE == 1) {
#pragma unroll
            for (int bj = 0; bj < 2; ++bj)
#pragma unroll
                for (int n = 0; n < 2; ++n) sc[bj][n] = *(const f32x4*)(scale + colb + bj * HALF + 4 * n); }
#pragma unroll
        for (int ai = 0; ai < 2; ++ai)
#pragma unroll
            for (int m = 0; m < 4; ++m) { const size_t off = (size_t)(rowb + ai * HALF + m * 16) * 1024 + colb; float ssq = 0.f;
#pragma unroll
                for (int bj = 0; bj < 2; ++bj) { f32x4 h0, h1; unpack8(*(const u32x4*)(HBi + off + bj * HALF), h0, h1);
                    f32x4 v0 = acc[ai][bj][m][0], v1 = acc[ai][bj][m][1];
                    if (MODE == 1) { v0 = v0 * sc[bj][0]; v1 = v1 * sc[bj][1]; }
                    if (MODE == 2) { const u32x4 ew = *(const u32x4*)(E + off + bj * HALF); f32x4 e0, e1; unpack8(ew, e0, e1); const float r = rs[ai][m]; v0 = e0 * sig4(v0 * r); v1 = e1 * sig4(v1 * r); }
                    h0 = h0 + v0; h1 = h1 + v1;
                    if (FINAL) { float* hp = OUT + off + bj * HALF; ((f32x4*)hp)[0] = h0; ((f32x4*)hp)[1] = h1; }
                    else { ssq += ((h0.x * h0.x + h0.y * h0.y) + (h0.z * h0.z + h0.w * h0.w)) + ((h1.x * h1.x + h1.y * h1.y) + (h1.z * h1.z + h1.w * h1.w));
                           *(u32x4*)(HBo + off + bj * HALF) = pack8(h0, h1); } }
                if (!FINAL) { ssq += __shfl_xor(ssq, 16); ssq += __shfl_xor(ssq, 32);
                    if (fq == 0) statsW[(size_t)(rowb + ai * HALF + m * 16) * 16 + pn * 4 + wc] = ssq; }
                asm volatile("" ::: "memory"); }
    }
};
template <bool MOE> struct EpiGLU {
    static constexpr bool PERM = true, AFTER_DRAIN = false;
    const float* stats; const float* rowr; bf16_t* ACT;
    __device__ __forceinline__ void operator()(const f32x4 (&acc)[2][2][4][2], const Unit& u, int wr, int wc, int fr, int fq) const {
        const int rowb = u.pm * BM + wr * 64 + fr, jt = MOE ? (u.pn % 28) : u.pn;
        float rs[2][4];
        if (MOE) {
#pragma unroll
            for (int ai = 0; ai < 2; ++ai)
#pragma unroll
                for (int m = 0; m < 4; ++m) rs[ai][m] = rowr[rowb + ai * HALF + m * 16];
        } else load_rstd(stats, rowb, fr, fq, rs);
#pragma unroll
        for (int ai = 0; ai < 2; ++ai)
#pragma unroll
            for (int m = 0; m < 4; ++m) { const float r = rs[ai][m]; bf16_t* rp = ACT + (size_t)(rowb + ai * HALF + m * 16) * 3584 + jt * 128 + wc * 32 + 8 * fq;
                const f32x4 g0 = acc[ai][0][m][0] * r, g1 = acc[ai][0][m][1] * r, u0 = acc[ai][1][m][0] * r, u1 = acc[ai][1][m][1] * r;
                *(u32x4*)rp = pack8(g0 * sig4(g0) * u0, g1 * sig4(g1) * u1);
                asm volatile("" ::: "memory"); }
    }
};
struct EpiScatter {
    static constexpr bool PERM = true, AFTER_DRAIN = false;
    const int* rowts; const float* rowg; bf16_t *D0, *D1;
    __device__ __forceinline__ void operator()(const f32x4 (&acc)[2][2][4][2], const Unit& u, int wr, int wc, int fr, int fq) const {
        const int rowb = u.pm * BM + wr * 64 + fr, jt = u.pn & 3;
#pragma unroll
        for (int ai = 0; ai < 2; ++ai)
#pragma unroll
            for (int m = 0; m < 4; ++m) { const int row = rowb + ai * HALF + m * 16; const int ts = rowts[row];
                if (ts >= 0) { const float g = rowg[row]; bf16_t* dp = ((ts & 1) ? D1 : D0) + (size_t)(ts >> 1) * 1024 + jt * 256 + wc * 32 + 8 * fq;
#pragma unroll
                    for (int bj = 0; bj < 2; ++bj) *(u32x4*)(dp + bj * HALF) = pack8(acc[ai][bj][m][0] * g, acc[ai][bj][m][1] * g); }
                asm volatile("" ::: "memory"); }
    }
};
struct EpiPart {
    static constexpr bool PERM = true, AFTER_DRAIN = false;
    float* PART;
    __device__ __forceinline__ void operator()(const f32x4 (&acc)[2][2][4][2], const Unit& u, int wr, int wc, int fr, int fq) const {
        float* base = PART + ((size_t)u.aux * 256 + wr * 64 + fr) * 1024 + (u.pn & 3) * 256 + wc * 32 + 8 * fq;
#pragma unroll
        for (int ai = 0; ai < 2; ++ai)
#pragma unroll
            for (int m = 0; m < 4; ++m) { float* rp = base + (size_t)(ai * HALF + m * 16) * 1024;
#pragma unroll
                for (int bj = 0; bj < 2; ++bj) { *(f32x4*)(rp + bj * HALF) = acc[ai][bj][m][0]; *(f32x4*)(rp + bj * HALF + 4) = acc[ai][bj][m][1]; }
                asm volatile("" ::: "memory"); }
    }
};
template <bool SPLIT> struct LeftOrder {
    const int* lt; int nl, G, c;
    __device__ __forceinline__ bool next(int i, Unit& u) const { const int L = i * G + c; if (L >= nl) return false; const int tl = L / 28, rem = L - 28 * tl;
        u.pm = __builtin_amdgcn_readfirstlane(lt[tl]); const int e = __builtin_amdgcn_readfirstlane(lt[16 + tl]);
        if (SPLIT) { const int j = rem / 7, kc = rem - 7 * j; u.pn = e * 4 + j; u.ko = kc * 512; u.aux = tl * 7 + kc; } else { u.pn = e * 28 + rem; u.ko = 0; u.aux = 0; }
        return true; }
    __device__ __forceinline__ void a_ready(const Unit&) const {}
    __device__ __forceinline__ void done(const Unit&) const {}
};
struct EpiStore {
    static constexpr bool PERM = true, AFTER_DRAIN = false;
    bf16_t* O; int ldc;
    __device__ __forceinline__ void operator()(const f32x4 (&acc)[2][2][4][2], const Unit& u, int wr, int wc, int fr, int fq) const {
        const int rowb = u.pm * BM + wr * 64 + fr, colb = u.pn * BM + wc * 32 + 8 * fq;
#pragma unroll
        for (int ai = 0; ai < 2; ++ai)
#pragma unroll
            for (int m = 0; m < 4; ++m) { bf16_t* rp = O + (size_t)(rowb + ai * HALF + m * 16) * ldc + colb;
#pragma unroll
                for (int bj = 0; bj < 2; ++bj) *(u32x4*)(rp + bj * HALF) = pack8(acc[ai][bj][m][0], acc[ai][bj][m][1]); }
    }
};
struct PoolOrder {
    int G, c;
    __device__ __forceinline__ bool next(int i, Unit& u) const { const int L = i * G + c; if (L >= 256) return false; const int g = L & 3; u.pm = g * 64 + (L >> 2); u.pn = g; return true; }
    __device__ __forceinline__ void a_ready(const Unit&) const {}
    __device__ __forceinline__ void done(const Unit&) const {}
};
struct MoeOrder {
    const int* tileE; const int* expb; const int* expn; int ntiles, ncol, G, c;
    __device__ __forceinline__ bool next(int i, Unit& u) const {
        if (G == 256) { const int e = c & 7, lu = i * 32 + (c >> 3), nrt = __builtin_amdgcn_readfirstlane(expn[e]); if (lu >= nrt * ncol) return false;
            const int per = 4 * nrt, cbk = lu / per, rem = lu - cbk * per; u.pm = __builtin_amdgcn_readfirstlane(expb[e]) + (rem >> 2); u.pn = e * ncol + cbk * 4 + (rem & 3); return true; }
        const int L = i * G + c; if (L >= ntiles * ncol) return false; const int rt = L / ncol, j = L - rt * ncol;
        u.pm = rt; u.pn = __builtin_amdgcn_readfirstlane(tileE[rt]) * ncol + j; return true; }
    __device__ __forceinline__ void a_ready(const Unit&) const {}
    __device__ __forceinline__ void done(const Unit&) const {}
};
template <class Epi, class Sched, bool ALIGN_EPI = false, bool SP2 = false>
__device__ __forceinline__ void gemm_phase(PG8_LAS unsigned char* lds, const Gemm g, const Sched& S, const Epi& E) {
    const int tid = threadIdx.x, wid = __builtin_amdgcn_readfirstlane(tid >> 6), lane = tid & 63, wr = wid >> 2, wc = wid & 3, fr = lane & 15, fq = lane >> 4;
    const int K = g.K, nt = K / BK, LD = g.ld ? g.ld : K;
    unsigned voffA[2], voffB[2];
#pragma unroll
    for (int i = 0; i < 2; ++i) { int R, C; stage_rc(tid * 16 + i * 8192, R, C); const int Rb = Epi::PERM ? ((R & ~31) + perm32(R & 31)) : R;
        voffA[i] = (unsigned)(R * LD + C) * 2u; voffB[i] = (unsigned)(Rb * LD + C) * 2u; }
    const size_t kstep = (size_t)(BK * 2);
    const size_t hstep = (size_t)HALF * LD * 2;
    const size_t tstep = 2 * hstep;
    const unsigned ldsw = (unsigned)wid * 1024u;
    const int aoff = lds_byte(wr * 64 + fr, fq * 8), boff = lds_byte(wc * 32 + fr, fq * 8);
#define PG8_SA(b, h) (((b) * 2 + (h)) * HTB)
#define PG8_SB(b, h) ((4 + (b) * 2 + (h)) * HTB)
#define PG8_STAGE(bufoff, gbase, voff) do { _Pragma("unroll") for (int _i = 0; _i < 2; ++_i) \
        __builtin_amdgcn_global_load_lds((const unsigned*)((const char*)(gbase) + (voff)[_i]), (PG8_LAS unsigned*)(lds + (bufoff) + ldsw + _i * 8192), 16, 0, 0); } while (0)
#define PG8_LDA(dst, b, h) do { _Pragma("unroll") for (int m = 0; m < 4; ++m) _Pragma("unroll") for (int k = 0; k < 2; ++k) dst[m][k] = *(const PG8_LAS bf16x8*)(lds + PG8_SA(b, h) + aoff + m * 2048 + k * 1024); } while (0)
#define PG8_LDB(dst, b, h) do { _Pragma("unroll") for (int n = 0; n < 2; ++n) _Pragma("unroll") for (int k = 0; k < 2; ++k) dst[n][k] = *(const PG8_LAS bf16x8*)(lds + PG8_SB(b, h) + boff + n * 2048 + k * 1024); } while (0)
#define PG8_MMA(ai, bj, At, Bt) do { __builtin_amdgcn_s_setprio(1); _Pragma("unroll") for (int m = 0; m < 4; ++m) _Pragma("unroll") for (int n = 0; n < 2; ++n) _Pragma("unroll") for (int k = 0; k < 2; ++k) \
        acc[ai][bj][m][n] = __builtin_amdgcn_mfma_f32_16x16x32_bf16(Bt[n][k], At[m][k], acc[ai][bj][m][n], 0, 0, 0); __builtin_amdgcn_s_setprio(0); } while (0)
#define PG8_WAIT_V(n) asm volatile("s_waitcnt vmcnt(" #n ")" ::: "memory")
#define PG8_WAIT_L(n) asm volatile("s_waitcnt lgkmcnt(" #n ")" ::: "memory")
#define PG8_BAR __builtin_amdgcn_s_barrier()
#define PG8_SCHED __builtin_amdgcn_sched_barrier(0)
    Unit cur{0, 0, 0, 0}, nxt{0, 0, 0, 0}; int ui = 0;
    if (!S.next(0, cur)) return;
    f32x4 acc[2][2][4][2];
#pragma unroll
    for (int a = 0; a < 2; ++a)
#pragma unroll
        for (int b = 0; b < 2; ++b)
#pragma unroll
            for (int m = 0; m < 4; ++m)
#pragma unroll
                for (int n = 0; n < 2; ++n) acc[a][b][m][n] = (f32x4){0.f, 0.f, 0.f, 0.f};
    bf16x8 At[4][2], B0[2][2], B1[2][2];
    const char* cA = (const char*)g.A + (size_t)cur.pm * tstep + (size_t)cur.ko * 2; const char* cB = (const char*)g.Bt + (size_t)cur.pn * tstep + (size_t)cur.ko * 2;
    S.a_ready(cur);
    if constexpr (SP2) {
        PG8_STAGE(PG8_SB(0, 0), cB, voffB); PG8_STAGE(PG8_SB(0, 1), cB + hstep, voffB); PG8_STAGE(PG8_SA(0, 0), cA, voffA); PG8_STAGE(PG8_SA(0, 1), cA + hstep, voffA);
        if (wr == 1) PG8_BAR;
        PG8_WAIT_V(2); PG8_BAR;
        PG8_STAGE(PG8_SB(1, 0), cB + kstep, voffB); PG8_STAGE(PG8_SA(1, 0), cA + kstep, voffA); PG8_STAGE(PG8_SB(1, 1), cB + hstep + kstep, voffB);
        PG8_WAIT_V(6); PG8_BAR;
    } else {
        PG8_STAGE(PG8_SB(0, 0), cB, voffB); PG8_STAGE(PG8_SA(0, 0), cA, voffA); PG8_STAGE(PG8_SB(0, 1), cB + hstep, voffB); PG8_STAGE(PG8_SA(0, 1), cA + hstep, voffA);
        if (wr == 1) PG8_BAR;
        PG8_WAIT_V(4); PG8_BAR;
        PG8_STAGE(PG8_SB(1, 0), cB + kstep, voffB); PG8_STAGE(PG8_SA(1, 0), cA + kstep, voffA); PG8_STAGE(PG8_SB(1, 1), cB + hstep + kstep, voffB);
        PG8_WAIT_V(6); PG8_BAR;
    }
    for (;;) {
        const bool has_next = S.next(ui + 1, nxt);
        const char* nA = has_next ? (const char*)g.A + (size_t)nxt.pm * tstep + (size_t)nxt.ko * 2 : cA; const char* nB = has_next ? (const char*)g.Bt + (size_t)nxt.pn * tstep + (size_t)nxt.ko * 2 : cB;
        for (int t = 0; t < nt; t += 2) {
            const bool last = (t == nt - 2);
            const char* a1 = cA + (size_t)(t + 1) * kstep;
            const char* a2 = last ? nA : cA + (size_t)(t + 2) * kstep; const char* b2 = last ? nB : cB + (size_t)(t + 2) * kstep;
            const char* a3 = a2 + kstep; const char* b3 = b2 + kstep;
            if (last && has_next) S.a_ready(nxt);
            if constexpr (SP2) {
            PG8_LDB(B0, 0, 0); PG8_LDB(B1, 0, 1); PG8_SCHED; PG8_LDA(At, 0, 0); PG8_STAGE(PG8_SA(1, 1), a1 + hstep, voffA);
            PG8_WAIT_V(8); PG8_WAIT_L(0); PG8_BAR; PG8_MMA(0, 0, At, B0); PG8_MMA(0, 1, At, B1); PG8_BAR; PG8_SCHED;
            PG8_LDA(At, 0, 1); PG8_STAGE(PG8_SB(0, 0), b2, voffB); PG8_STAGE(PG8_SB(0, 1), b2 + hstep, voffB); PG8_STAGE(PG8_SA(0, 0), a2, voffA);
            PG8_WAIT_V(8); PG8_WAIT_L(0); PG8_BAR; PG8_MMA(1, 0, At, B0); PG8_MMA(1, 1, At, B1); PG8_BAR; PG8_SCHED;
            PG8_LDB(B0, 1, 0); PG8_LDB(B1, 1, 1); PG8_SCHED; PG8_LDA(At, 1, 0); PG8_STAGE(PG8_SA(0, 1), a2 + hstep, voffA);
            PG8_WAIT_V(8); PG8_WAIT_L(0); PG8_BAR; PG8_MMA(0, 0, At, B0); PG8_MMA(0, 1, At, B1); PG8_BAR; PG8_SCHED;
            PG8_LDA(At, 1, 1); PG8_STAGE(PG8_SB(1, 0), b3, voffB); PG8_STAGE(PG8_SB(1, 1), b3 + hstep, voffB); PG8_STAGE(PG8_SA(1, 0), a3, voffA);
            PG8_WAIT_V(8); PG8_WAIT_L(0); PG8_BAR; PG8_MMA(1, 0, At, B0); PG8_MMA(1, 1, At, B1); PG8_BAR; PG8_SCHED;
            } else {
            PG8_LDB(B0, 0, 0); PG8_SCHED; PG8_LDA(At, 0, 0); PG8_STAGE(PG8_SA(1, 1), a1 + hstep, voffA);
            PG8_WAIT_L(8); PG8_BAR; PG8_WAIT_L(0); PG8_MMA(0, 0, At, B0); PG8_BAR; PG8_SCHED;
            PG8_LDB(B1, 0, 1); PG8_STAGE(PG8_SB(0, 0), b2, voffB);
            PG8_BAR; PG8_WAIT_L(0); PG8_MMA(0, 1, At, B1); PG8_BAR;
            PG8_LDA(At, 0, 1); PG8_STAGE(PG8_SA(0, 0), a2, voffA);
            PG8_BAR; PG8_WAIT_L(0); PG8_MMA(1, 0, At, B0); PG8_BAR; PG8_SCHED;
            PG8_STAGE(PG8_SB(0, 1), b2 + hstep, voffB);
            PG8_WAIT_V(6); PG8_BAR; PG8_MMA(1, 1, At, B1); PG8_BAR;
            PG8_LDB(B0, 1, 0); PG8_SCHED; PG8_LDA(At, 1, 0); PG8_STAGE(PG8_SA(0, 1), a2 + hstep, voffA);
            PG8_WAIT_L(8); PG8_BAR; PG8_WAIT_L(0); PG8_MMA(0, 0, At, B0); PG8_BAR; PG8_SCHED;
            PG8_LDB(B1, 1, 1); PG8_STAGE(PG8_SB(1, 0), b3, voffB);
            PG8_BAR; PG8_WAIT_L(0); PG8_MMA(0, 1, At, B1); PG8_BAR;
            PG8_LDA(At, 1, 1); PG8_STAGE(PG8_SA(1, 0), a3, voffA);
            PG8_BAR; PG8_WAIT_L(0); PG8_MMA(1, 0, At, B0); PG8_BAR; PG8_SCHED;
            PG8_STAGE(PG8_SB(1, 1), b3 + hstep, voffB);
            PG8_WAIT_V(6); PG8_BAR; PG8_MMA(1, 1, At, B1); PG8_BAR;
            }
        }
        if constexpr (ALIGN_EPI) { if (wr == 0) PG8_BAR; }
        if constexpr (!Epi::AFTER_DRAIN) { E(acc, cur, wr, wc, fr, fq); S.done(cur); }
        if (!has_next) break;
#pragma unroll
        for (int a = 0; a < 2; ++a)
#pragma unroll
            for (int b = 0; b < 2; ++b)
#pragma unroll
                for (int m = 0; m < 4; ++m)
#pragma unroll
                    for (int n = 0; n < 2; ++n) acc[a][b][m][n] = (f32x4){0.f, 0.f, 0.f, 0.f};
        cur = nxt; cA = nA; cB = nB; ++ui;
        if constexpr (ALIGN_EPI) { if (wr == 1) PG8_BAR; }
    }
    PG8_WAIT_V(0);
    if constexpr (!ALIGN_EPI) { if (wr == 0) PG8_BAR; }
    PG8_BAR;
    if constexpr (Epi::AFTER_DRAIN) { E.fused(acc, cur, wr, wc, fr, fq, lds, wid, lane); S.done(cur); }
#undef PG8_SA
#undef PG8_SB
#undef PG8_STAGE
#undef PG8_LDA
#undef PG8_LDB
#undef PG8_MMA
#undef PG8_WAIT_V
#undef PG8_WAIT_L
#undef PG8_BAR
#undef PG8_SCHED
}
}
constexpr int NWAVES = 8;
constexpr int BATCH = 8, SEQ = 2048, DM = 1024, M = BATCH * SEQ, DFF = 3584, NEXP = 8, PLED = 256, NINP = 3328, NCHUNK = 32;
constexpr float LOG2E = 1.4426950408889634f;
constexpr size_t MiB = 1u << 20;
constexpr size_t WS_CTL = 0, CTL_ZERO_BYTES = 1 * MiB;
constexpr size_t WS_SMALL = 1 * MiB;
constexpr size_t WS_W_IN = 2 * MiB, WS_W_OUT = 15 * MiB, WS_W_GU = 19 * MiB, WS_W_DN = 47 * MiB, WS_W_PG = 61 * MiB, WS_W_PL = 69 * MiB, WS_W_POOL = 71 * MiB;
constexpr size_t WS_W_MGU = 72 * MiB, WS_W_MDN = 184 * MiB;
constexpr size_t WS_HB0 = 240 * MiB, WS_HB1 = 272 * MiB, WS_STATS = 304 * MiB, WS_PB = 306 * MiB, WS_E = 338 * MiB;
constexpr size_t WS_OVL = 370 * MiB;
constexpr size_t WS_QK = WS_OVL, WS_VB = WS_OVL + 32 * MiB, WS_OG = WS_OVL + 48 * MiB, WS_BQ = WS_OVL + 64 * MiB, WS_BQI = WS_OVL + 80 * MiB, WS_MISC = WS_OVL + 96 * MiB, WS_MIX = WS_OVL + 112 * MiB;
constexpr size_t WS_KB = WS_OVL + 144 * MiB, WS_KIB = WS_OVL + 146 * MiB, WS_VT = WS_OVL + 148 * MiB, WS_MASK = WS_OVL + 164 * MiB, WS_CHS = WS_OVL + 168 * MiB;
constexpr size_t WS_ISC = WS_OVL + 169 * MiB, WS_U = WS_OVL + 297 * MiB, WS_CB = WS_OVL + 369 * MiB, WS_QKC = WS_OVL + 406 * MiB, WS_ACT = WS_ISC;
constexpr size_t WS_POOLED = WS_OVL, WS_YG = WS_OVL + 32 * MiB, WS_ACTM = WS_OVL + 100 * MiB, WS_D0 = WS_OVL + 338 * MiB, WS_D1 = WS_OVL + 370 * MiB, WS_ROUTE = WS_OVL + 402 * MiB, WS_PART = WS_OVL + 406 * MiB;
constexpr size_t WS_END = WS_OVL + 518 * MiB;
constexpr int MAXROWS = 34816;
constexpr size_t RT_TOKE = 0, RT_TOKG = 65536, RT_TOKR = 196608, RT_CNT = 262144, RT_ROWTS = 270336, RT_ROWG = 409600, RT_ROWR = 548864, RT_TILEE = 688128, RT_NT = 688128 + 1024, RT_TOKPOS = 1048576, RT_LT = 1048576 + 131072;
constexpr int CW_BAR = 4096;
constexpr int RING_BYTES = 131072, LDSCTL_OFF = RING_BYTES, MISC_OFF = LDSCTL_OFF + 320, LDS_BYTES = 147456;

#define GAS __attribute__((address_space(1)))
#define LAS __attribute__((address_space(3)))
typedef unsigned short bf16;
typedef unsigned v4u __attribute__((ext_vector_type(4)));
typedef unsigned v2u __attribute__((ext_vector_type(2)));
typedef float f32x4 __attribute__((ext_vector_type(4)));
typedef float f32x2 __attribute__((ext_vector_type(2)));
typedef short bf16x8 __attribute__((ext_vector_type(8)));
#define LDS_WAIT() asm volatile("s_waitcnt lgkmcnt(0)" ::: "memory")
__device__ __forceinline__ unsigned f2bf(float f) { unsigned u = __builtin_bit_cast(unsigned, f); return (u + 0x7fffu + ((u >> 16) & 1u)) >> 16; }
__device__ __forceinline__ unsigned pk2(float lo, float hi) { return f2bf(lo) | (f2bf(hi) << 16); }
__device__ __forceinline__ float bflo(unsigned w) { return __uint_as_float(w << 16); }
__device__ __forceinline__ float bfhi(unsigned w) { return __uint_as_float(w & 0xffff0000u); }
__device__ __forceinline__ float bf2f(bf16 b) { return __uint_as_float(((unsigned)b) << 16); }
__device__ __forceinline__ float wave_sum(float v) {
#pragma unroll
    for (int o = 1; o < 64; o <<= 1) v += __shfl_xor(v, o);
    return v;
}
__device__ __forceinline__ float wave_max(float v) {
#pragma unroll
    for (int o = 1; o < 64; o <<= 1) v = fmaxf(v, __shfl_xor(v, o));
    return v;
}
__device__ __forceinline__ float fsig(float x) { return 1.0f / (1.0f + __expf(-x)); }
#define MFMA16(a, b, c) __builtin_amdgcn_mfma_f32_16x16x32_bf16((a), (b), (c), 0, 0, 0)
#define XB_TMO      128
#define XB_XCNT(j)  (256  + 64 * (j))
#define XB_XSUB(j)  (1280 + 64 * (j))
#define XB_XGEN(j)  (2304 + 64 * (j))
#define XB_TOP      3328
#define XB_TOPGEN   3392
#define XCD_BAR_WORDS 3456
#define XB_SPIN_CAP (1u << 18)

__device__ __forceinline__ unsigned xb_ld(unsigned* p)              { return __hip_atomic_load(p, __ATOMIC_RELAXED, __HIP_MEMORY_SCOPE_AGENT); }
__device__ __forceinline__ unsigned xb_add(unsigned* p, unsigned v) { return __hip_atomic_fetch_add(p, v, __ATOMIC_RELAXED, __HIP_MEMORY_SCOPE_AGENT); }
__device__ __forceinline__ unsigned xb_xcc_id() { return (unsigned)__builtin_amdgcn_s_getreg((3 << 11) | 20) & 0xFu; }
#define XB_SPIN(cond, bar) do { unsigned _sp = 0; while (cond) { __builtin_amdgcn_s_sleep(1); \
    if ((++_sp & 255u) == 0u) { if (xb_ld(&(bar)[XB_TMO])) break; if (_sp > XB_SPIN_CAP) { atomicAdd(&(bar)[XB_TMO], 1u); break; } } } } while (0)

struct XcdBarrier {
    unsigned* bar; unsigned x;
    volatile LAS unsigned* st;
};

__device__ __forceinline__ XcdBarrier xcd_barrier_post(unsigned* bar, volatile LAS unsigned* st) {
    XcdBarrier b; b.bar = bar; b.x = xb_xcc_id(); b.st = st;
    if (threadIdx.x == 0) (void)xb_add(&bar[XB_XCNT(b.x)], 1u);
    return b;
}
__device__ __forceinline__ void xcd_barrier_complete(unsigned* bar, unsigned x, unsigned& nloc, unsigned& nx) {
    const unsigned G = gridDim.x * gridDim.y * gridDim.z;
    unsigned sum, cnt, mine, sp = 0u;
    for (;;) {
        sum = 0u; cnt = 0u; mine = 0u;
#pragma unroll
        for (unsigned j = 0; j < 16; ++j) { const unsigned c = xb_ld(&bar[XB_XCNT(j)]); sum += c; cnt += (c > 0u) ? 1u : 0u; mine = (j == x) ? c : mine; }
        if (sum == G) break;
        __builtin_amdgcn_s_sleep(1);
        if ((++sp & 255u) == 0u) { if (xb_ld(&bar[XB_TMO])) break; if (sp > XB_SPIN_CAP) { atomicAdd(&bar[XB_TMO], 1u); break; } }
    }
    nloc = mine > 0u ? mine : 1u; nx = cnt > 0u ? cnt : 1u;
}

__device__ __forceinline__ void xcd_barrier(const XcdBarrier& b) {
    asm volatile("s_waitcnt vmcnt(0)" ::: "memory");
    __syncthreads();
    if (threadIdx.x == 0) {
        unsigned* bar = b.bar;
        __builtin_amdgcn_s_waitcnt(0);
        unsigned nloc = b.st[0], nx = b.st[1];
        if (nloc == 0u) { xcd_barrier_complete(bar, b.x, nloc, nx); b.st[0] = nloc; b.st[1] = nx; }
        const unsigned old = xb_add(&bar[XB_XSUB(b.x)], 1u);
        const unsigned gen = old / nloc;
        if (old + 1u == (gen + 1u) * nloc) {
            __builtin_amdgcn_fence(__ATOMIC_RELEASE, "agent");
            asm volatile("s_waitcnt vmcnt(0)" ::: "memory");
            const unsigned og = xb_add(&bar[XB_TOP], 1u);
            const unsigned tg = og / nx;
            if (og + 1u == (tg + 1u) * nx) xb_add(&bar[XB_TOPGEN], 1u);
            else XB_SPIN(xb_ld(&bar[XB_TOPGEN]) == tg, bar);
            __builtin_amdgcn_fence(__ATOMIC_ACQUIRE, "agent");
            xb_add(&bar[XB_XGEN(b.x)], 1u);
            asm volatile("s_waitcnt vmcnt(0)" ::: "memory");
        } else {
            XB_SPIN(xb_ld(&bar[XB_XGEN(b.x)]) == gen, bar);
            __builtin_amdgcn_fence(__ATOMIC_ACQUIRE, "agent");
            asm volatile("s_waitcnt vmcnt(0)" ::: "memory");
        }
    }
    __syncthreads();
}
struct Args { const float* in[28]; float* out; unsigned char* ws; int ph_lo, ph_hi; };
struct Frame {
    LAS unsigned char* lds; unsigned char* gl;
    volatile LAS unsigned* MISCW;
    int tid, lane, wave, G, bid, gw, NGW;
    float* out; unsigned char* ws;
    unsigned long long tacc, tprev;
};
#define INP(k) (args.in[k])
#define IN_X 0
#define IN_P 1
#define IN_NORM_MIX 2
#define IN_NORM_FFN 3
#define IN_W_IN 4
#define IN_B_GATE 5
#define IN_CONV 6
#define IN_NORM_H 7
#define IN_NORM_Q 8
#define IN_NORM_K 9
#define IN_NORM_KV 10
#define IN_W_UK 11
#define IN_W_UV 12
#define IN_W_OUT 13
#define IN_REL_BIAS 14
#define IN_W_POOL 15
#define IN_SCALE_POOL 16
#define IN_W_GATE_D 17
#define IN_W_UP_D 18
#define IN_W_DOWN_D 19
#define IN_W_ROUTER 20
#define IN_B_ROUTER 21
#define IN_W_GATE_M 22
#define IN_W_UP_M 23
#define IN_W_DOWN_M 24
#define IN_W_PLE 25
#define IN_W_PLE_GATE 26
#define IN_NORM_PLE 27

template <int MODE> __device__ __forceinline__ int dst_row(int n) {
    if (MODE == 0) return n;
    if (MODE == 1) return ((n >> 7) << 8) + (n & 127);
    if (MODE == 2) return ((n >> 7) << 8) + 128 + (n & 127);
    if (n < 2048) return n;
    if (n < 2052) return 3264 + (n - 2048);
    if (n < 2056) return 3268 + (n - 2052);
    if (n < 2568) return 2048 + (n - 2056);
    if (n < 2696) return 3072 + (n - 2568);
    if (n < 3208) return 2560 + (n - 2696);
    if (n < 3272) return 3200 + (n - 3208);
    return 3272 + (n - 3272);
}
template <int MODE> __device__ __forceinline__ void conv_mat(Frame& F, const float* W, int K, int N, bf16* WT, const float* gain, int wi, int nw) {
    LAS float* scr = (LAS float*)(F.lds + F.wave * 16384);
    const int nblk = (N + 31) >> 5, nitems = (K >> 6) * nblk, lane = F.lane, r = lane >> 3, c4 = lane & 7;
    for (int it = wi; it < nitems; it += nw) {
        const int kb = it / nblk, nb = it - kb * nblk, k0 = 64 * kb, n0 = 32 * nb, nn = n0 + 4 * c4; const bool okn = nn < N;
        f32x4 v[8];
#pragma unroll
        for (int i = 0; i < 8; ++i) v[i] = okn ? *(const f32x4*)(W + (size_t)(k0 + 8 * i + r) * N + nn) : (f32x4){0.f, 0.f, 0.f, 0.f};
        if (gain) {
#pragma unroll
            for (int i = 0; i < 8; ++i) v[i] = v[i] * gain[k0 + 8 * i + r]; }
#pragma unroll
        for (int i = 0; i < 8; ++i) { LAS float* d = scr + (8 * i + r) * 33 + 4 * c4; d[0] = v[i].x; d[1] = v[i].y; d[2] = v[i].z; d[3] = v[i].w; }
        LDS_WAIT(); asm volatile("" ::: "memory");
        const int c = lane & 7;
#pragma unroll
        for (int j = 0; j < 4; ++j) { const int n = (lane >> 3) + 8 * j; const LAS float* s = scr + (8 * c) * 33 + n;
            v4u o; o.x = pk2(s[0 * 33], s[1 * 33]); o.y = pk2(s[2 * 33], s[3 * 33]); o.z = pk2(s[4 * 33], s[5 * 33]); o.w = pk2(s[6 * 33], s[7 * 33]);
            if (n0 + n < N) *(v4u*)(WT + (size_t)dst_row<MODE>(n0 + n) * K + k0 + 8 * c) = o; }
        LDS_WAIT(); asm volatile("" ::: "memory");
    }
}
__device__ __forceinline__ void conv_moe(Frame& F, const Args& args, int o) {
    bf16* mgu = (bf16*)(F.ws + WS_W_MGU); bf16* mdn = (bf16*)(F.ws + WS_W_MDN);
    const float* gain = INP(IN_NORM_FFN) + (2 * o + 1) * DM;
    for (int e = 0; e < NEXP; ++e) {
        const size_t wo = ((size_t)o * NEXP + e) * DM * DFF;
        conv_mat<1>(F, INP(IN_W_GATE_M) + wo, DM, DFF, mgu + (size_t)e * 7168 * 1024, gain, F.gw, F.NGW);
        conv_mat<2>(F, INP(IN_W_UP_M) + wo, DM, DFF, mgu + (size_t)e * 7168 * 1024, gain, F.gw, F.NGW);
        conv_mat<0>(F, INP(IN_W_DOWN_M) + wo, DFF, DM, mdn + (size_t)e * 1024 * 3584, nullptr, F.gw, F.NGW);
    }
}
__device__ __forceinline__ void p0_prologue(Frame& F, const Args& args) {
    unsigned char* ws = F.ws;
    for (int e = 0; e < 2; ++e) {
        conv_mat<3>(F, INP(IN_W_IN) + (size_t)e * DM * 3280, DM, 3280, (bf16*)(ws + WS_W_IN) + (size_t)e * NINP * DM, INP(IN_NORM_MIX) + (2 * e) * DM, F.gw, F.NGW);
        conv_mat<0>(F, INP(IN_W_OUT) + (size_t)e * DM * DM, DM, DM, (bf16*)(ws + WS_W_OUT) + (size_t)e * DM * DM, nullptr, F.gw, F.NGW);
        conv_mat<1>(F, INP(IN_W_GATE_D) + (size_t)e * DM * DFF, DM, DFF, (bf16*)(ws + WS_W_GU) + (size_t)e * 7168 * DM, INP(IN_NORM_FFN) + (2 * e) * DM, F.gw, F.NGW);
        conv_mat<2>(F, INP(IN_W_UP_D) + (size_t)e * DM * DFF, DM, DFF, (bf16*)(ws + WS_W_GU) + (size_t)e * 7168 * DM, INP(IN_NORM_FFN) + (2 * e) * DM, F.gw, F.NGW);
        conv_mat<0>(F, INP(IN_W_DOWN_D) + (size_t)e * DFF * DM, DFF, DM, (bf16*)(ws + WS_W_DN) + (size_t)e * DM * DFF, nullptr, F.gw, F.NGW);
        conv_mat<0>(F, INP(IN_W_UK) + (size_t)e * 128 * 64, 128, 64, (bf16*)(ws + WS_SMALL + 8192) + (size_t)e * 64 * 128, nullptr, F.gw, F.NGW);
        for (int h = 0; h < 8; ++h)
            conv_mat<0>(F, INP(IN_W_UV) + ((size_t)e * 8 + h) * 128 * 64, 128, 64, (bf16*)(ws + WS_SMALL + 65536) + ((size_t)e * 512 + h * 64) * 128, nullptr, F.gw, F.NGW);
        for (int g = 0; g < 4; ++g)
            conv_mat<0>(F, INP(IN_W_POOL) + ((size_t)e * 4 + g) * 256 * 256, 256, 256, (bf16*)(ws + WS_W_POOL) + ((size_t)e * 4 + g) * 256 * 256, nullptr, F.gw, F.NGW);
    }
    for (int i = 0; i < 4; ++i) {
        conv_mat<0>(F, INP(IN_W_PLE_GATE) + (size_t)i * DM * DM, DM, DM, (bf16*)(ws + WS_W_PG) + (size_t)i * DM * DM, INP(IN_NORM_PLE) + i * DM, F.gw, F.NGW);
        conv_mat<0>(F, INP(IN_W_PLE) + (size_t)i * PLED * DM, PLED, DM, (bf16*)(ws + WS_W_PL) + (size_t)i * DM * PLED, nullptr, F.gw, F.NGW);
    }
    conv_moe(F, args, 0);
    const int gt = F.bid * 512 + F.tid, NT = F.G * 512;
    for (int i = gt; i < 2 * 48 * DM / 8; i += NT) { const int e = i / (48 * DM / 8), r = i - e * (48 * DM / 8); *(v4u*)((bf16*)(ws + WS_W_IN) + ((size_t)e * NINP + 3280) * DM + (size_t)r * 8) = (v4u){0u, 0u, 0u, 0u}; }
    if (F.bid == 0) for (int t = F.tid; t < 1024; t += 512) { const int hh = t >> 7, d = t & 127; int bk = d;
        if (d >= 16) { bk = 16 + (d >= 19) + (d >= 21) + (d >= 24) + (d >= 27) + (d >= 31) + (d >= 35) + (d >= 40) + (d >= 46) + (d >= 52) + (d >= 59) + (d >= 67) + (d >= 77) + (d >= 87) + (d >= 99) + (d >= 113); }
        ((float*)(ws + WS_SMALL))[t] = INP(IN_REL_BIAS)[bk * 8 + hh] * LOG2E; }
    { const f32x4* src = (const f32x4*)INP(IN_P); v4u* dst = (v4u*)(ws + WS_PB);
      for (int i = gt; i < 4 * M * PLED / 8; i += NT) { const f32x4 a = src[2 * i], b = src[2 * i + 1]; v4u o; o.x = pk2(a.x, a.y); o.y = pk2(a.z, a.w); o.z = pk2(b.x, b.y); o.w = pk2(b.z, b.w); dst[i] = o; } }
    { const float* x = INP(IN_X); bf16* hb = (bf16*)(ws + WS_HB0); float* st = (float*)(ws + WS_STATS);
      for (int m = F.gw; m < M; m += F.NGW) { const f32x4* xr = (const f32x4*)(x + (size_t)m * DM) + F.lane; f32x4 v[4]; float s = 0.f;
#pragma unroll
          for (int j = 0; j < 4; ++j) { v[j] = xr[64 * j]; s += (v[j].x * v[j].x + v[j].y * v[j].y) + (v[j].z * v[j].z + v[j].w * v[j].w); }
          s = wave_sum(s);
          v2u* o8 = (v2u*)(hb + (size_t)m * DM) + F.lane;
#pragma unroll
          for (int j = 0; j < 4; ++j) { v2u w; w.x = pk2(v[j].x, v[j].y); w.y = pk2(v[j].z, v[j].w); o8[64 * j] = w; }
          if (F.lane < 16) st[(size_t)m * 16 + F.lane] = (F.lane == 0) ? s : 0.f; } }
}

struct EvenPtrs {
    const bf16 *QK, *VB, *OG, *BQ, *BQI; const float* MISC; bf16 *MIX, *KB, *KIB, *VT, *QKC; unsigned* MASK; float* CHS; float* MST; float* ISC; float* U; bf16* CB;
    const float *bgate, *conv, *gh, *gq, *gk, *gkv; const bf16 *WukT, *WuvT; const float* bt;
};
__device__ __forceinline__ void conv8(const bf16* QK, const float* cw, int rowb, int tpos, int ch, float (&o)[8]) {
#pragma unroll
    for (int j = 0; j < 8; ++j) o[j] = 0.f;
#pragma unroll
    for (int tap = 0; tap < 4; ++tap) { const int tp = tpos - 3 + tap;
        if (tp >= 0) { const v4u w = *(const v4u*)(QK + (size_t)(rowb + tp) * 1024 + ch); const f32x4 c0 = *(const f32x4*)(cw + tap * 1024 + ch), c1 = *(const f32x4*)(cw + tap * 1024 + ch + 4);
            o[0] += bflo(w.x) * c0.x; o[1] += bfhi(w.x) * c0.y; o[2] += bflo(w.y) * c0.z; o[3] += bfhi(w.y) * c0.w;
            o[4] += bflo(w.z) * c1.x; o[5] += bfhi(w.z) * c1.y; o[6] += bflo(w.w) * c1.z; o[7] += bfhi(w.w) * c1.w; } }
#pragma unroll
    for (int j = 0; j < 8; ++j) o[j] = o[j] * fsig(o[j]);
}
__device__ __forceinline__ void chunk_gates(const EvenPtrs& P, int row, int hh, int lane, float& li, float& bc) {
    const float ai = P.MISC[(size_t)row * 256 + 192 + hh], af = P.MISC[(size_t)row * 256 + 196 + hh];
    li = ai + P.bgate[hh]; const float x = af + P.bgate[4 + hh]; const float lf = fminf(x, 0.f) - log1pf(__expf(-fabsf(x)));
    bc = lf;
#pragma unroll
    for (int o = 1; o < 64; o <<= 1) { const float t = __shfl_up(bc, o); if (lane >= o) bc += t; }
}
__device__ __forceinline__ void mlstm_a(Frame& F, const EvenPtrs& P) {
    bf16* KT = (bf16*)F.gl; bf16* VwT = (bf16*)(F.gl + 18432); float* wv = (float*)(F.gl + 18432 + 20736);
    const int tid = F.tid, lane = F.lane, w = F.wave, fr = lane & 15, fq = lane >> 4;
    for (int unit = F.bid; unit < BATCH * 4 * NCHUNK; unit += F.G) {
        const int b = unit >> 7, hh = (unit >> 5) & 3, c = unit & 31, rowb = b * SEQ, t0 = c * 64;
        if (w == 0) { float li, bc; chunk_gates(P, rowb + t0 + lane, hh, lane, li, bc); const float blast = __shfl(bc, 63), g = blast - bc + li, gmax = wave_max(g);
            wv[lane] = __expf(g - gmax); if (lane == 0) { P.CHS[unit * 2] = blast; P.CHS[unit * 2 + 1] = gmax; } }
        { const int cg = tid & 31, s0 = (tid >> 5) * 4, ch = (cg < 16 ? 0 : 512 - 128) + hh * 128 + cg * 8;
          float cw[4][8];
#pragma unroll
          for (int tap = 0; tap < 4; ++tap) { const f32x4 c0 = *(const f32x4*)(P.conv + tap * 1024 + ch), c1 = *(const f32x4*)(P.conv + tap * 1024 + ch + 4);
              cw[tap][0] = c0.x; cw[tap][1] = c0.y; cw[tap][2] = c0.z; cw[tap][3] = c0.w; cw[tap][4] = c1.x; cw[tap][5] = c1.y; cw[tap][6] = c1.z; cw[tap][7] = c1.w; }
          v4u xin[7];
#pragma unroll
          for (int i = 0; i < 7; ++i) { const int tp = t0 + s0 - 3 + i; xin[i] = (tp >= 0) ? *(const v4u*)(P.QK + (size_t)(rowb + tp) * 1024 + ch) : (v4u){0u, 0u, 0u, 0u}; }
          float o[4][8];
#pragma unroll
          for (int r = 0; r < 4; ++r) {
#pragma unroll
              for (int j = 0; j < 8; ++j) o[r][j] = 0.f;
#pragma unroll
              for (int tap = 0; tap < 4; ++tap) { const v4u xw = xin[r + tap];
                  o[r][0] += bflo(xw.x) * cw[tap][0]; o[r][1] += bfhi(xw.x) * cw[tap][1]; o[r][2] += bflo(xw.y) * cw[tap][2]; o[r][3] += bfhi(xw.y) * cw[tap][3];
                  o[r][4] += bflo(xw.z) * cw[tap][4]; o[r][5] += bfhi(xw.z) * cw[tap][5]; o[r][6] += bflo(xw.w) * cw[tap][6]; o[r][7] += bfhi(xw.w) * cw[tap][7]; }
              const float sc = (cg < 16) ? 1.0f : 0.08838834764831845f;
#pragma unroll
              for (int j = 0; j < 8; ++j) o[r][j] = o[r][j] * fsig(o[r][j]) * sc;
              v4u q; q.x = pk2(o[r][0], o[r][1]); q.y = pk2(o[r][2], o[r][3]); q.z = pk2(o[r][4], o[r][5]); q.w = pk2(o[r][6], o[r][7]);
              *(v4u*)(P.QKC + (size_t)(rowb + t0 + s0 + r) * 1024 + ch) = q; }
          if (cg >= 16) { const int d0 = (cg - 16) * 8;
#pragma unroll
              for (int j = 0; j < 8; ++j) { v2u pk; pk.x = pk2(o[0][j], o[1][j]); pk.y = pk2(o[2][j], o[3][j]); *(v2u*)(KT + (d0 + j) * 72 + s0) = pk; } } }
        __syncthreads();
        if (tid < 256) { const int vg = tid & 15, s0 = (tid >> 4) * 4; v4u vw[4]; float ws4[4];
#pragma unroll
            for (int r = 0; r < 4; ++r) { vw[r] = *(const v4u*)(P.VB + (size_t)(rowb + t0 + s0 + r) * 512 + hh * 128 + vg * 8); ws4[r] = wv[s0 + r]; }
#pragma unroll
            for (int j = 0; j < 4; ++j) { const unsigned w0 = j == 0 ? vw[0].x : j == 1 ? vw[0].y : j == 2 ? vw[0].z : vw[0].w, w1 = j == 0 ? vw[1].x : j == 1 ? vw[1].y : j == 2 ? vw[1].z : vw[1].w,
                                                    w2 = j == 0 ? vw[2].x : j == 1 ? vw[2].y : j == 2 ? vw[2].z : vw[2].w, w3 = j == 0 ? vw[3].x : j == 1 ? vw[3].y : j == 2 ? vw[3].z : vw[3].w;
                v2u lo, hi; lo.x = pk2(bflo(w0) * ws4[0], bflo(w1) * ws4[1]); lo.y = pk2(bflo(w2) * ws4[2], bflo(w3) * ws4[3]); hi.x = pk2(bfhi(w0) * ws4[0], bfhi(w1) * ws4[1]); hi.y = pk2(bfhi(w2) * ws4[2], bfhi(w3) * ws4[3]);
                *(v2u*)(VwT + (vg * 8 + 2 * j) * 72 + s0) = lo; *(v2u*)(VwT + (vg * 8 + 2 * j + 1) * 72 + s0) = hi; } }
        else if (tid < 320) VwT[128 * 72 + (tid - 256)] = (bf16)f2bf(wv[tid - 256]);
        else for (int i = tid - 320; i < 15 * 64; i += 192) VwT[(129 + (i >> 6)) * 72 + (i & 63)] = 0;
        __syncthreads();
        { bf16x8 bfr[2]; f32x4 acc[9];
#pragma unroll
          for (int ks = 0; ks < 2; ++ks) bfr[ks] = *(const bf16x8*)(KT + (16 * w + fr) * 72 + 8 * fq + 32 * ks);
#pragma unroll
          for (int rt = 0; rt < 9; ++rt) { acc[rt] = (f32x4){0.f, 0.f, 0.f, 0.f};
#pragma unroll
              for (int ks = 0; ks < 2; ++ks) { const bf16x8 a = *(const bf16x8*)(VwT + (16 * rt + fr) * 72 + 8 * fq + 32 * ks); acc[rt] = MFMA16(a, bfr[ks], acc[rt]); } }
          float* Uo = P.U + (size_t)unit * 144 * 128 + 16 * w + fr;
#pragma unroll
          for (int rt = 0; rt < 9; ++rt)
#pragma unroll
              for (int r = 0; r < 4; ++r) Uo[(size_t)(16 * rt + 4 * fq + r) * 128] = acc[rt][r]; }
        __syncthreads();
    }
}
__device__ __forceinline__ void mlstm_b(Frame& F, const EvenPtrs& P) {
    const int gt = F.bid * 512 + F.tid, NT = F.G * 512;
    for (int e = gt; e < BATCH * 4 * 129 * 128; e += NT) {
        const int d = e & 127, v = (e >> 7) % 129, bh = e / (129 * 128);
        float u[NCHUNK];
#pragma unroll
        for (int c = 0; c < NCHUNK; ++c) u[c] = P.U[((size_t)(bh * 32 + c) * 144 + v) * 128 + d];
        float C = 0.f, m = 0.f;
#pragma unroll
        for (int c = 0; c < NCHUNK; ++c) { const int unit = bh * 32 + c; const size_t idx = ((size_t)unit * 144 + v) * 128 + d;
            P.CB[idx] = (bf16)f2bf(C);
            if (v == 0 && d == 0) P.MST[unit] = m;
            const float blast = P.CHS[unit * 2], gmax = P.CHS[unit * 2 + 1], mn = fmaxf(blast + m, gmax);
            C = __expf(blast + m - mn) * C + __expf(gmax - mn) * u[c]; m = mn; }
    }
    for (int e = gt; e < BATCH * 4 * NCHUNK * 15 * 128; e += NT) { const int d = e & 127, r = (e >> 7) % 15, unit = e / (15 * 128); P.CB[((size_t)unit * 144 + 129 + r) * 128 + d] = 0; }
}
__device__ __forceinline__ void mlstm_c(Frame& F, const EvenPtrs& P) {
    bf16* Qs = (bf16*)F.gl; bf16* Ks = (bf16*)(F.gl + 17408); bf16* VTa = (bf16*)(F.gl + 34816); bf16* Ps = (bf16*)(F.gl + 55552);
    float* av = (float*)(F.gl + 64768); float* pmv = av + 64; float* bcv = av + 128; float* ssb = av + 192;
    const int tid = F.tid, lane = F.lane, w = F.wave, fr = lane & 15, fq = lane >> 4;
    for (int unit = F.bid; unit < BATCH * 4 * NCHUNK; unit += F.G) {
        const int b = unit >> 7, hh = (unit >> 5) & 3, c = unit & 31, rowb = b * SEQ, t0 = c * 64;
        const float mc = P.MST[unit];
        if (w == 0) { float li, bc; chunk_gates(P, rowb + t0 + lane, hh, lane, li, bc); const float a = li - bc; float p = a;
#pragma unroll
            for (int o = 1; o < 64; o <<= 1) { const float tt = __shfl_up(p, o); if (lane >= o) p = fmaxf(p, tt); }
            av[lane] = a; pmv[lane] = fmaxf(p, mc); bcv[lane] = bc; }
        {
#pragma unroll
          for (int i = 0; i < 2; ++i) { const int idx = tid + 512 * i, s = idx >> 4, ch = (idx & 15) * 8;
              *(v4u*)(Qs + s * 136 + ch) = *(const v4u*)(P.QKC + (size_t)(rowb + t0 + s) * 1024 + hh * 128 + ch);
              *(v4u*)(Ks + s * 136 + ch) = *(const v4u*)(P.QKC + (size_t)(rowb + t0 + s) * 1024 + 512 + hh * 128 + ch); }
          if (tid < 256) { const int vg = tid & 15, s0 = (tid >> 4) * 4; v4u vw[4];
#pragma unroll
              for (int r = 0; r < 4; ++r) vw[r] = *(const v4u*)(P.VB + (size_t)(rowb + t0 + s0 + r) * 512 + hh * 128 + vg * 8);
#pragma unroll
              for (int j = 0; j < 4; ++j) { const unsigned w0 = j == 0 ? vw[0].x : j == 1 ? vw[0].y : j == 2 ? vw[0].z : vw[0].w, w1 = j == 0 ? vw[1].x : j == 1 ? vw[1].y : j == 2 ? vw[1].z : vw[1].w,
                                                      w2 = j == 0 ? vw[2].x : j == 1 ? vw[2].y : j == 2 ? vw[2].z : vw[2].w, w3 = j == 0 ? vw[3].x : j == 1 ? vw[3].y : j == 2 ? vw[3].z : vw[3].w;
                  v2u lo, hi; lo.x = (w0 & 0xffffu) | (w1 << 16); lo.y = (w2 & 0xffffu) | (w3 << 16); hi.x = (w0 >> 16) | (w1 & 0xffff0000u); hi.y = (w2 >> 16) | (w3 & 0xffff0000u);
                  *(v2u*)(VTa + (vg * 8 + 2 * j) * 72 + s0) = lo; *(v2u*)(VTa + (vg * 8 + 2 * j + 1) * 72 + s0) = hi; } }
          else if (tid < 320) VTa[128 * 72 + (tid - 256)] = (bf16)0x3f80u;
          else for (int i = tid - 320; i < 15 * 64; i += 192) VTa[(129 + (i >> 6)) * 72 + (i & 63)] = 0; }
        __syncthreads();
        { const int rt = w >> 1;
#pragma unroll
          for (int c2 = 0; c2 < 2; ++c2) { const int ct = 2 * (w & 1) + c2; f32x4 acc = (f32x4){0.f, 0.f, 0.f, 0.f};
#pragma unroll
              for (int ks = 0; ks < 4; ++ks) { const bf16x8 a = *(const bf16x8*)(Qs + (16 * rt + fr) * 136 + 8 * fq + 32 * ks), bb = *(const bf16x8*)(Ks + (16 * ct + fr) * 136 + 8 * fq + 32 * ks); acc = MFMA16(a, bb, acc); }
              const int s = 16 * ct + fr; const float as = av[s];
#pragma unroll
              for (int r = 0; r < 4; ++r) { const int t = 16 * rt + 4 * fq + r; const float p = (s <= t) ? acc[r] * __expf(as - pmv[t]) : 0.f; Ps[t * 72 + s] = (bf16)f2bf(p); } } }
        __syncthreads();
        { const int tt = w & 3, hf = w >> 2, t = 16 * tt + fr; f32x4 ni[5], ne[5];
#pragma unroll
          for (int i = 0; i < 5; ++i) { const int vt = (i < 4) ? 4 * hf + i : 8; ni[i] = (f32x4){0.f, 0.f, 0.f, 0.f}; ne[i] = (f32x4){0.f, 0.f, 0.f, 0.f};
#pragma unroll
              for (int ks = 0; ks < 2; ++ks) { const bf16x8 a = *(const bf16x8*)(VTa + (16 * vt + fr) * 72 + 8 * fq + 32 * ks), bb = *(const bf16x8*)(Ps + (16 * tt + fr) * 72 + 8 * fq + 32 * ks); ni[i] = MFMA16(a, bb, ni[i]); }
#pragma unroll
              for (int ks = 0; ks < 4; ++ks) { const bf16x8 a = *(const bf16x8*)(P.CB + ((size_t)unit * 144 + 16 * vt + fr) * 128 + 8 * fq + 32 * ks), bb = *(const bf16x8*)(Qs + (16 * tt + fr) * 136 + 8 * fq + 32 * ks); ne[i] = MFMA16(a, bb, ne[i]); } }
          const float pm = pmv[t], wi = __expf(mc - pm), fl = __expf(-(bcv[t] + pm));
#pragma unroll
          for (int i = 0; i < 5; ++i) ni[i] = ni[i] + ne[i] * wi;
          const float den = __shfl(ni[4].x, fr), rinv = 1.0f / fmaxf(fabsf(den), fl); float q = 0.f;
#pragma unroll
          for (int i = 0; i < 4; ++i) { ni[i] = ni[i] * rinv; q += (ni[i].x * ni[i].x + ni[i].y * ni[i].y) + (ni[i].z * ni[i].z + ni[i].w * ni[i].w); }
          q += __shfl_xor(q, 16); q += __shfl_xor(q, 32);
          if (fq == 0) ssb[w * 16 + fr] = q;
          __syncthreads();
          const float rs = rsqrtf((q + ssb[(w ^ 4) * 16 + fr]) * (1.0f / 128.0f) + 1e-6f);
          const size_t row = (size_t)(rowb + t0 + t);
#pragma unroll
          for (int i = 0; i < 4; ++i) { const int col = hh * 128 + 16 * (4 * hf + i) + 4 * fq; const f32x4 g = *(const f32x4*)(P.gh + col); const v2u og = *(const v2u*)(P.OG + row * 512 + col);
              v2u o; o.x = pk2(ni[i].x * rs * g.x * bflo(og.x), ni[i].y * rs * g.y * bfhi(og.x)); o.y = pk2(ni[i].z * rs * g.z * bflo(og.y), ni[i].w * rs * g.w * bfhi(og.y));
              *(v2u*)(P.MIX + row * 1024 + col) = o; } }
        __syncthreads();
    }
}
__device__ __forceinline__ void dsa_prep(Frame& F, const EvenPtrs& P) {
    bf16* LAT = (bf16*)F.gl;
    const int lane = F.lane, w = F.wave, fr = lane & 15, fq = lane >> 4;
    for (int tile = F.bid; tile < M / 64; tile += F.G) {
        const int row0 = tile * 64, b = row0 >> 11, s0 = row0 & 2047;
        for (int i = 0; i < 8; ++i) { const int tok = w * 8 + i; const size_t row = (size_t)(row0 + tok);
            const f32x2 x = *(const f32x2*)(P.MISC + row * 256 + 2 * lane); const float ss = wave_sum(x.x * x.x + x.y * x.y), r = rsqrtf(ss * (1.0f / 128.0f) + 1e-6f);
            const f32x2 g = *(const f32x2*)(P.gkv + 2 * lane);
            *(unsigned*)(LAT + tok * 136 + 2 * lane) = pk2(x.x * r * g.x, x.y * r * g.y);
            }
        __syncthreads();
        if (w < 4) { const int rt = w; f32x4 acc[4]; float q[4] = {0.f, 0.f, 0.f, 0.f};
#pragma unroll
            for (int ct = 0; ct < 4; ++ct) { acc[ct] = (f32x4){0.f, 0.f, 0.f, 0.f};
#pragma unroll
                for (int ks = 0; ks < 4; ++ks) { const bf16x8 a = *(const bf16x8*)(LAT + (16 * rt + fr) * 136 + 8 * fq + 32 * ks), bb = *(const bf16x8*)(P.WukT + (16 * ct + fr) * 128 + 8 * fq + 32 * ks); acc[ct] = MFMA16(a, bb, acc[ct]); }
#pragma unroll
                for (int r = 0; r < 4; ++r) q[r] += acc[ct][r] * acc[ct][r]; }
#pragma unroll
            for (int r = 0; r < 4; ++r) { float s = q[r]; s += __shfl_xor(s, 1); s += __shfl_xor(s, 2); s += __shfl_xor(s, 4); s += __shfl_xor(s, 8); q[r] = rsqrtf(s * (1.0f / 64.0f) + 1e-6f); }
#pragma unroll
            for (int ct = 0; ct < 4; ++ct) { const float g = P.gk[16 * ct + fr];
#pragma unroll
                for (int r = 0; r < 4; ++r) P.KB[(size_t)(row0 + 16 * rt + 4 * fq + r) * 64 + 16 * ct + fr] = (bf16)f2bf(acc[ct][r] * q[r] * g); } }
        for (int i = 0; i < 4; ++i) { const int rt = w + 8 * i;
#pragma unroll
            for (int ct = 0; ct < 4; ++ct) { f32x4 acc = (f32x4){0.f, 0.f, 0.f, 0.f};
#pragma unroll
                for (int ks = 0; ks < 4; ++ks) { const bf16x8 a = *(const bf16x8*)(P.WuvT + (size_t)(16 * rt + fr) * 128 + 8 * fq + 32 * ks), bb = *(const bf16x8*)(LAT + (16 * ct + fr) * 136 + 8 * fq + 32 * ks); acc = MFMA16(a, bb, acc); }
#pragma unroll
                for (int r = 0; r < 4; ++r) { const int hd = 16 * rt + 4 * fq + r; P.VT[((size_t)(b * 8 + (hd >> 6)) * 64 + (hd & 63)) * 2048 + s0 + 16 * ct + fr] = (bf16)f2bf(acc[r]); } } }
        __syncthreads();
    }
}
__device__ __forceinline__ void dsa_index(Frame& F, const EvenPtrs& P) {
    const int lane = F.lane, fr = lane & 15, fq = lane >> 4;
    for (int uid = F.gw; uid < BATCH * 576; uid += F.NGW) {
        const int b = uid / 576, rr0 = uid - b * 576; int gq = 0;
        while (gq < 7 && 8 * (gq + 1) * (gq + 2) <= rr0) ++gq;
        const int rr = rr0 - 8 * gq * (gq + 1), qt = gq * 16 + rr / (gq + 1), kc = rr % (gq + 1);
        const int t0 = qt * 16; int nkt = ((t0 + 15 - kc * 256) >> 4) + 1; if (nkt > 16) nkt = 16;
        const size_t rowq = (size_t)b * SEQ + t0 + fr;
        bf16x8 qf[8][2]; float wq[8];
#pragma unroll
        for (int hh = 0; hh < 8; ++hh)
#pragma unroll
            for (int ks = 0; ks < 2; ++ks) qf[hh][ks] = *(const bf16x8*)(P.BQI + rowq * 512 + hh * 64 + 32 * ks + 8 * fq);
        { const f32x4 w0 = *(const f32x4*)(P.MISC + rowq * 256 + 200), w1 = *(const f32x4*)(P.MISC + rowq * 256 + 204); wq[0] = w0.x; wq[1] = w0.y; wq[2] = w0.z; wq[3] = w0.w; wq[4] = w1.x; wq[5] = w1.y; wq[6] = w1.z; wq[7] = w1.w; }
        const bf16* kip = P.KIB + ((size_t)b * SEQ + kc * 256 + fr) * 64 + 8 * fq;
        bf16x8 a0 = *(const bf16x8*)kip, a1 = *(const bf16x8*)(kip + 32);
        for (int kt = 0; kt < nkt; ++kt) { const int sk = kc * 256 + kt * 16; const bf16x8 c0 = a0, c1 = a1;
            if (kt + 1 < nkt) { a0 = *(const bf16x8*)(kip + (size_t)(kt + 1) * 16 * 64); a1 = *(const bf16x8*)(kip + (size_t)(kt + 1) * 16 * 64 + 32); }
            f32x4 sc = (f32x4){0.f, 0.f, 0.f, 0.f};
#pragma unroll
            for (int hh = 0; hh < 8; ++hh) { f32x4 acc = MFMA16(c0, qf[hh][0], ((f32x4){0.f, 0.f, 0.f, 0.f})); acc = MFMA16(c1, qf[hh][1], acc);
                sc.x += wq[hh] * fmaxf(acc.x, 0.f); sc.y += wq[hh] * fmaxf(acc.y, 0.f); sc.z += wq[hh] * fmaxf(acc.z, 0.f); sc.w += wq[hh] * fmaxf(acc.w, 0.f); }
            *(f32x4*)(P.ISC + rowq * 2048 + sk + 4 * fq) = sc; }
    }
}
__device__ __forceinline__ unsigned fkey(float f) { const unsigned u = __float_as_uint(f); return (u & 0x80000000u) ? ~u : (u | 0x80000000u); }
template <int NJ> __device__ __forceinline__ void select_row(const float* isc, unsigned long long* mo, int t, int lane) {
    unsigned key[NJ];
#pragma unroll
    for (int j = 0; j < NJ; ++j) { const int s = 64 * j + lane; const float x = (s <= t) ? isc[s] : 0.f; key[j] = (s <= t) ? fkey(x) : 0u; }
    unsigned T = 0u;
    for (int bit = 31; bit >= 0; --bit) { const unsigned cand = T | (1u << bit); int cnt = 0;
#pragma unroll
        for (int j = 0; j < NJ; ++j) cnt += __popcll(__ballot(key[j] >= cand));
        if (cnt >= 256) T = cand; }
    int cgt = 0;
#pragma unroll
    for (int j = 0; j < NJ; ++j) cgt += __popcll(__ballot(key[j] > T));
    const int need = 256 - cgt; int run = 0; const unsigned long long lt = (lane == 0) ? 0ull : (~0ull >> (64 - lane));
#pragma unroll
    for (int j = 0; j < 32; ++j) { unsigned long long m = 0ull;
        if (j < NJ) { const unsigned long long eq = __ballot(key[j] == T); const int before = run + __popcll(eq & lt); const bool sel = (key[j] > T) || (key[j] == T && before < need); m = __ballot(sel); run += __popcll(eq); }
        if (lane == 0) mo[j] = m; }
}
template <int NJ> __device__ __forceinline__ void select_hist(const float* isc, unsigned long long* mo, int t, int lane, LAS unsigned* hist  , LAS float* cand  ) {
    float x[NJ]; int bn[NJ];
    float mn = INFINITY, mxv = -INFINITY;
#pragma unroll
    for (int j = 0; j < NJ; ++j) { const int s = 64 * j + lane; const bool v = s <= t; x[j] = v ? isc[s] : 0.f; mn = fminf(mn, v ? x[j] : INFINITY); mxv = fmaxf(mxv, v ? x[j] : -INFINITY); }
    mn = -wave_max(-mn); mxv = wave_max(mxv);
    const float range = mxv - mn; const bool ok = (range > 0.f) && (range < 3.0e38f);
    const float scale = ok ? 2047.0f / range : 0.f;
#pragma unroll
    for (int j = 0; j < NJ; ++j) { const int s = 64 * j + lane; const bool v = s <= t; int b = (int)((x[j] - mn) * scale); b = b > 2047 ? 2047 : b; b = v ? b : 0; bn[j] = v ? b : -1;
        __hip_atomic_fetch_add(hist + b + (b >> 5), v ? 1u : 0u, __ATOMIC_RELAXED, __HIP_MEMORY_SCOPE_WORKGROUP); }
    unsigned hb[32]; unsigned ls = 0u;
#pragma unroll
    for (int k = 0; k < 32; ++k) { hb[k] = hist[33 * lane + k]; ls += hb[k]; }
    unsigned suf = ls;
#pragma unroll
    for (int o = 1; o < 64; o <<= 1) { const unsigned tt = __shfl_down(suf, o); suf += (lane + o < 64) ? tt : 0u; }
    const unsigned long long lm = __ballot(suf >= 256u);
    const int L = 63 - __builtin_clzll(lm);
    unsigned c = suf - ls; int Bl = 0; unsigned cal = 0u, hB = 0u; bool found = false;
#pragma unroll
    for (int k = 31; k >= 0; --k) { const bool hit = !found && (c + hb[k] >= 256u); Bl = hit ? 32 * lane + k : Bl; cal = hit ? c : cal; hB = hit ? hb[k] : hB; found = found || hit; c += found ? 0u : hb[k]; }
    const int B = __shfl(Bl, L); const unsigned cab = __shfl(cal, L), nB = __shfl(hB, L); const int need = 256 - (int)cab;
#pragma unroll
    for (int j = 0; j < NJ; ++j) { const int b = bn[j] < 0 ? 0 : bn[j]; hist[b + (b >> 5)] = 0u; }
    if (!ok || nB > 64u) { select_row<NJ>(isc, mo, t, lane); return; }
    float Ts = -INFINITY; int Is = 0x7fffffff;
    if ((unsigned)need < nB) {
        int run = 0; const unsigned long long lt = (lane == 0) ? 0ull : (~0ull >> (64 - lane));
#pragma unroll
        for (int j = 0; j < NJ; ++j) { const unsigned long long m = __ballot(bn[j] == B); if (m) { if (bn[j] == B) { const int pos = run + __popcll(m & lt); cand[pos] = x[j]; cand[64 + pos] = __int_as_float(64 * j + lane); } run += __popcll(m); } }
        const float xi = (lane < (int)nB) ? cand[lane] : 0.f; const int si = (lane < (int)nB) ? __float_as_int(cand[64 + lane]) : 0; int rank = 0;
        for (int k = 0; k < (int)nB; ++k) { const float xk = cand[k]; const int sk = __float_as_int(cand[64 + k]); rank += (xk > xi || (xk == xi && sk < si)) ? 1 : 0; }
        const unsigned long long wm = __ballot(lane < (int)nB && rank == need - 1); const int src = __builtin_ctzll(wm);
        Ts = __shfl(xi, src); Is = __shfl(si, src);
    }
#pragma unroll
    for (int j = 0; j < 32; ++j) { unsigned long long m = 0ull;
        if (j < NJ) { const int s = 64 * j + lane; const bool sel = (bn[j] > B) || (bn[j] == B && (x[j] > Ts || (x[j] == Ts && s <= Is))); m = __ballot(sel); }
        if (lane == 0) mo[j] = m; }
}
__device__ __forceinline__ void dsa_select(Frame& F, const EvenPtrs& P) {
    const int lane = F.lane;
    LAS unsigned* hist = (LAS unsigned*)(F.lds + F.wave * 9216); LAS float* cand = (LAS float*)(F.lds + F.wave * 9216 + 8448);
    for (int i = lane; i < 2112; i += 64) hist[i] = 0u;
    for (int idx = F.gw; idx < M; idx += F.NGW) {
        const int k = idx >> 11, gwid = idx & 2047, t = (k & 1) ? 2047 - gwid : gwid; const size_t row = (size_t)k * SEQ + t; const int n = t + 1;
        unsigned long long* mo = (unsigned long long*)(P.MASK + row * 64); const float* isc = P.ISC + row * 2048;
        if (n <= 256) {
#pragma unroll
            for (int j = 0; j < 32; ++j) { const unsigned long long m = __ballot(64 * j + lane <= t); if (lane == 0) mo[j] = m; }
        } else if (n <= 512) select_hist<8>(isc, mo, t, lane, hist, cand);
        else if (n <= 1024) select_hist<16>(isc, mo, t, lane, hist, cand);
        else if (n <= 1536) select_hist<24>(isc, mo, t, lane, hist, cand);
        else select_hist<32>(isc, mo, t, lane, hist, cand);
    }
}
__device__ __forceinline__ void dsa_attn(Frame& F, const EvenPtrs& P) {
    bf16* Kl = (bf16*)F.gl; bf16* Vl = (bf16*)(F.gl + 18432); float* btl = (float*)(F.gl + 41472); float* mtl = (float*)(F.gl + 41984);
    const int tid = F.tid, lane = F.lane, w = F.wave, fr = lane & 15, fq = lane >> 4, lrow = tid >> 3, lch = tid & 7;
    for (int i = tid; i < 2 * 16 * 64; i += 512) { const int bufi = i >> 10, r = (i >> 6) & 15, cc = i & 63; Vl[bufi * 5760 + (64 + r) * 72 + cc] = (r == 0) ? (bf16)0x3f80u : (bf16)0; }
    if (tid < 64) mtl[tid] = ((tid >> 2) >> (tid & 3)) & 1 ? 1.0f : 0.0f;
    for (int vu = F.bid; vu < 256; vu += F.G) {
        const int bh = vu >> 2, s4 = vu & 3, b = bh >> 3, hh = bh & 7;
        for (int iu = 0; iu < 2; ++iu) {
            const int qb = (iu == 0) ? s4 : 7 - s4;
            const int t0 = qb * 256, tw = t0 + 32 * w;
            bf16x8 qf[2][2]; const v2u* mrow[2];
#pragma unroll
            for (int cb = 0; cb < 2; ++cb) { const size_t rowq = (size_t)b * SEQ + tw + 16 * cb + fr; mrow[cb] = (const v2u*)(P.MASK + rowq * 64);
              const v4u w0 = *(const v4u*)(P.BQ + rowq * 512 + hh * 64 + 8 * fq), w1 = *(const v4u*)(P.BQ + rowq * 512 + hh * 64 + 32 + 8 * fq);
              float x[16] = {bflo(w0.x), bfhi(w0.x), bflo(w0.y), bfhi(w0.y), bflo(w0.z), bfhi(w0.z), bflo(w0.w), bfhi(w0.w), bflo(w1.x), bfhi(w1.x), bflo(w1.y), bfhi(w1.y), bflo(w1.z), bfhi(w1.z), bflo(w1.w), bfhi(w1.w)};
              float ss = 0.f;
#pragma unroll
              for (int j = 0; j < 16; ++j) ss += x[j] * x[j];
              ss += __shfl_xor(ss, 16); ss += __shfl_xor(ss, 32);
              const float r = rsqrtf(ss * (1.0f / 64.0f) + 1e-6f) * (0.125f * LOG2E);
              const f32x4 g0 = *(const f32x4*)(P.gq + 8 * fq), g1 = *(const f32x4*)(P.gq + 8 * fq + 4), g2 = *(const f32x4*)(P.gq + 32 + 8 * fq), g3 = *(const f32x4*)(P.gq + 32 + 8 * fq + 4);
              v4u q0, q1; q0.x = pk2(x[0] * r * g0.x, x[1] * r * g0.y); q0.y = pk2(x[2] * r * g0.z, x[3] * r * g0.w); q0.z = pk2(x[4] * r * g1.x, x[5] * r * g1.y); q0.w = pk2(x[6] * r * g1.z, x[7] * r * g1.w);
              q1.x = pk2(x[8] * r * g2.x, x[9] * r * g2.y); q1.y = pk2(x[10] * r * g2.z, x[11] * r * g2.w); q1.z = pk2(x[12] * r * g3.x, x[13] * r * g3.y); q1.w = pk2(x[14] * r * g3.z, x[15] * r * g3.w);
              qf[cb][0] = __builtin_bit_cast(bf16x8, q0); qf[cb][1] = __builtin_bit_cast(bf16x8, q1); }
            if (tid < 128) btl[tid] = P.bt[hh * 128 + tid] - P.bt[hh * 128 + 127];
            const int nk = 4 * qb + 4;
            const bf16* kg = P.KB + ((size_t)b * SEQ + lrow) * 64 + lch * 8;
            const bf16* vg = P.VT + ((size_t)(b * 8 + hh) * 64 + lrow) * 2048 + lch * 8;
            v4u kreg = *(const v4u*)kg, vreg = *(const v4u*)vg; v2u mnext[2] = {mrow[0][0], mrow[1][0]};
            *(v4u*)(Kl + lrow * 72 + lch * 8) = kreg; *(v4u*)(Vl + lrow * 72 + lch * 8) = vreg;
            __syncthreads();
            f32x4 o[2][5];
#pragma unroll
            for (int cb = 0; cb < 2; ++cb)
#pragma unroll
                for (int dt = 0; dt < 5; ++dt) o[cb][dt] = (f32x4){0.f, 0.f, 0.f, 0.f};
            float mrun[2] = {0.f, 0.f}; bool first = true;
            for (int kt = 0; kt < nk; ++kt) {
                const int s0 = kt * 64; const bf16* Kb = Kl + (kt & 1) * 4608; const bf16* Vb = Vl + (kt & 1) * 5760; const v2u mw[2] = {mnext[0], mnext[1]};
                if (kt + 1 < nk) { kreg = *(const v4u*)(kg + (size_t)(s0 + 64) * 64); vreg = *(const v4u*)(vg + s0 + 64); mnext[0] = mrow[0][kt + 1]; mnext[1] = mrow[1][kt + 1]; }
                if (s0 <= tw + 31) {
                    f32x4 acc[2][4];
#pragma unroll
                    for (int cb = 0; cb < 2; ++cb) { const f32x4 cin = (f32x4){-mrun[cb], -mrun[cb], -mrun[cb], -mrun[cb]};
#pragma unroll
                        for (int st = 0; st < 4; ++st) acc[cb][st] = cin; }
#pragma unroll
                    for (int st = 0; st < 4; ++st) { const bf16x8 a0 = *(const bf16x8*)(Kb + (16 * st + fr) * 72 + 8 * fq), a1 = *(const bf16x8*)(Kb + (16 * st + fr) * 72 + 32 + 8 * fq);
#pragma unroll
                        for (int cb = 0; cb < 2; ++cb) { acc[cb][st] = MFMA16(a0, qf[cb][0], acc[cb][st]); acc[cb][st] = MFMA16(a1, qf[cb][1], acc[cb][st]); } }
                    bf16x8 pf[2][2]; bool resc = false; float mxs[2];
#pragma unroll
                    for (int cb = 0; cb < 2; ++cb) { const int tb = tw + 16 * cb, t = tb + fr;
                        if ((tb - (s0 + 63)) < 113) {
#pragma unroll
                            for (int st = 0; st < 4; ++st)
#pragma unroll
                                for (int r = 0; r < 4; ++r) { int dist = t - (s0 + 16 * st + 4 * fq + r); dist = dist < 0 ? 0 : (dist > 127 ? 127 : dist); acc[cb][st][r] += btl[dist]; } }
                        float mx = fmaxf(fmaxf(fmaxf(acc[cb][0].x, acc[cb][0].y), fmaxf(acc[cb][0].z, acc[cb][0].w)), fmaxf(fmaxf(acc[cb][1].x, acc[cb][1].y), fmaxf(acc[cb][1].z, acc[cb][1].w)));
                        mx = fmaxf(mx, fmaxf(fmaxf(fmaxf(acc[cb][2].x, acc[cb][2].y), fmaxf(acc[cb][2].z, acc[cb][2].w)), fmaxf(fmaxf(acc[cb][3].x, acc[cb][3].y), fmaxf(acc[cb][3].z, acc[cb][3].w))));
                        mx = fmaxf(mx, __shfl_xor(mx, 16)); mx = fmaxf(mx, __shfl_xor(mx, 32)); mxs[cb] = mx; resc = resc || (mx > 8.0f); }
                    if (first || __any(resc)) {
#pragma unroll
                        for (int cb = 0; cb < 2; ++cb) { const float dl = first ? mxs[cb] : fmaxf(mxs[cb], 0.f); mrun[cb] += dl; const float alpha = first ? 1.0f : __builtin_amdgcn_exp2f(-dl);
#pragma unroll
                            for (int st = 0; st < 4; ++st) acc[cb][st] = acc[cb][st] - dl;
#pragma unroll
                            for (int dt = 0; dt < 5; ++dt) o[cb][dt] = o[cb][dt] * alpha; }
                        first = false; }
#pragma unroll
                    for (int cb = 0; cb < 2; ++cb)
#pragma unroll
                        for (int kk = 0; kk < 2; ++kk) { const unsigned mword = (kk == 0) ? mw[cb].x : mw[cb].y;
                            const f32x4 m0 = *(const f32x4*)(mtl + 4 * ((mword >> (4 * fq)) & 15u)), m1 = *(const f32x4*)(mtl + 4 * ((mword >> (16 + 4 * fq)) & 15u));
                            const f32x4 a = acc[cb][2 * kk], c = acc[cb][2 * kk + 1];
                            v4u pw; pw.x = pk2(__builtin_amdgcn_exp2f(a.x) * m0.x, __builtin_amdgcn_exp2f(a.y) * m0.y); pw.y = pk2(__builtin_amdgcn_exp2f(a.z) * m0.z, __builtin_amdgcn_exp2f(a.w) * m0.w);
                            pw.z = pk2(__builtin_amdgcn_exp2f(c.x) * m1.x, __builtin_amdgcn_exp2f(c.y) * m1.y); pw.w = pk2(__builtin_amdgcn_exp2f(c.z) * m1.z, __builtin_amdgcn_exp2f(c.w) * m1.w);
                            pf[cb][kk] = __builtin_bit_cast(bf16x8, pw); }
#pragma unroll
                    for (int dt = 0; dt < 5; ++dt)
#pragma unroll
                        for (int kk = 0; kk < 2; ++kk) { const bf16* vp = Vb + (16 * dt + fr) * 72 + 32 * kk + 4 * fq; const v2u lo = *(const v2u*)vp, hi = *(const v2u*)(vp + 16);
                            v4u vv; vv.x = lo.x; vv.y = lo.y; vv.z = hi.x; vv.w = hi.y; const bf16x8 vf = __builtin_bit_cast(bf16x8, vv);
                            o[0][dt] = MFMA16(vf, pf[0][kk], o[0][dt]); o[1][dt] = MFMA16(vf, pf[1][kk], o[1][dt]); }
                }
                if (kt + 1 < nk) { *(v4u*)(Kl + ((kt + 1) & 1) * 4608 + lrow * 72 + lch * 8) = kreg; *(v4u*)(Vl + ((kt + 1) & 1) * 5760 + lrow * 72 + lch * 8) = vreg; }
                __syncthreads();
            }
#pragma unroll
            for (int cb = 0; cb < 2; ++cb) { const size_t rowq = (size_t)b * SEQ + tw + 16 * cb + fr; const float linv = 1.0f / __shfl(o[cb][4].x, fr);
#pragma unroll
                for (int dt = 0; dt < 4; ++dt) { v2u wv; wv.x = pk2(o[cb][dt].x * linv, o[cb][dt].y * linv); wv.y = pk2(o[cb][dt].z * linv, o[cb][dt].w * linv); *(v2u*)(P.MIX + rowq * 1024 + 512 + hh * 64 + 16 * dt + 4 * fq) = wv; } }
        }
    }
}
__device__ __forceinline__ void pool_fused(Frame& F, const bf16* HBi, bf16* HBo, const float* statsR, float* statsW, const float* gmix, const bf16* Wp  , const float* scale) {
    bf16* HT = (bf16*)F.gl; bf16* PT = (bf16*)(F.gl + 41712); float* rl = (float*)(F.gl + 75504); float* sq = (float*)(F.gl + 75824);
    const int tid = F.tid, lane = F.lane, w = F.wave, fr = lane & 15, fq = lane >> 4;
    for (int u = F.bid; u < (M / 64) * 4; u += F.G) {
        const int tile = u >> 2, g = ((u & 3) + (u >> 8)) & 3, row0 = tile * 64, tpos0 = row0 & 2047, win = 2 << g;
        for (int i = tid; i < 79 * 32; i += 512) { const int rr = i >> 5, ch = (i & 31) * 8; v4u v = (v4u){0u, 0u, 0u, 0u};
            if (tpos0 - 15 + rr >= 0) v = *(const v4u*)(HBi + (size_t)(row0 - 15 + rr) * DM + g * 256 + ch);
            *(v4u*)(HT + rr * 264 + ch) = v; }
        bf16x8 af[8][2];
#pragma unroll
        for (int ks = 0; ks < 8; ++ks)
#pragma unroll
            for (int oi = 0; oi < 2; ++oi) af[ks][oi] = *(const bf16x8*)(Wp + ((size_t)g * 256 + 16 * (2 * w + oi) + fr) * 256 + 8 * fq + 32 * ks);
        if (tid < 79) { float r = 0.f;
            if (tpos0 - 15 + tid >= 0) { const f32x4* p = (const f32x4*)(statsR + (size_t)(row0 - 15 + tid) * 16); const f32x4 a = p[0], b = p[1], c = p[2], d2 = p[3];
                const float s = (((a.x + a.y) + (a.z + a.w)) + ((b.x + b.y) + (b.z + b.w))) + (((c.x + c.y) + (c.z + c.w)) + ((d2.x + d2.y) + (d2.z + d2.w))); r = rsqrtf(s * (1.0f / 1024.0f) + 1e-6f); }
            rl[tid] = r; }
        __syncthreads();
        { const int cg = tid & 31, t4 = (tid >> 5) * 4, c0 = cg * 8; const f32x4 g0 = *(const f32x4*)(gmix + g * 256 + c0), g1 = *(const f32x4*)(gmix + g * 256 + c0 + 4);
          float S[8] = {0.f, 0.f, 0.f, 0.f, 0.f, 0.f, 0.f, 0.f};
          for (int j = 1; j < win; ++j) if (tpos0 + t4 - j >= 0) { f32x4 a, b; pg8::unpack8(*(const v4u*)(HT + (15 + t4 - j) * 264 + c0), a, b); const float r = rl[15 + t4 - j];
              S[0] += a.x * r; S[1] += a.y * r; S[2] += a.z * r; S[3] += a.w * r; S[4] += b.x * r; S[5] += b.y * r; S[6] += b.z * r; S[7] += b.w * r; }
#pragma unroll
          for (int i = 0; i < 4; ++i) { const int tok = t4 + i, tpos = tpos0 + tok, n = (tpos + 1 < win) ? tpos + 1 : win;
              f32x4 a, b; pg8::unpack8(*(const v4u*)(HT + (15 + tok) * 264 + c0), a, b); const float r = rl[15 + tok];
              const float y[8] = {a.x * r, a.y * r, a.z * r, a.w * r, b.x * r, b.y * r, b.z * r, b.w * r};
#pragma unroll
              for (int q = 0; q < 8; ++q) S[q] += y[q];
              const float inv = 1.0f / (float)n;
              v4u o; o.x = pk2((S[0] * inv - y[0]) * g0.x, (S[1] * inv - y[1]) * g0.y); o.y = pk2((S[2] * inv - y[2]) * g0.z, (S[3] * inv - y[3]) * g0.w);
              o.z = pk2((S[4] * inv - y[4]) * g1.x, (S[5] * inv - y[5]) * g1.y); o.w = pk2((S[6] * inv - y[6]) * g1.z, (S[7] * inv - y[7]) * g1.w);
              *(v4u*)(PT + tok * 264 + c0) = o;
              const int dep = tok - (win - 1);
              if (tpos0 + dep >= 0) { f32x4 da, db; pg8::unpack8(*(const v4u*)(HT + (15 + dep) * 264 + c0), da, db); const float dr = rl[15 + dep];
                  S[0] -= da.x * dr; S[1] -= da.y * dr; S[2] -= da.z * dr; S[3] -= da.w * dr; S[4] -= db.x * dr; S[5] -= db.y * dr; S[6] -= db.z * dr; S[7] -= db.w * dr; } } }
        __syncthreads();
        { f32x4 acc[2][4]; float ssq[4] = {0.f, 0.f, 0.f, 0.f};
#pragma unroll
          for (int oi = 0; oi < 2; ++oi)
#pragma unroll
              for (int tt = 0; tt < 4; ++tt) acc[oi][tt] = (f32x4){0.f, 0.f, 0.f, 0.f};
#pragma unroll
          for (int ks = 0; ks < 8; ++ks) { bf16x8 bfv[4];
#pragma unroll
              for (int tt = 0; tt < 4; ++tt) bfv[tt] = *(const bf16x8*)(PT + (16 * tt + fr) * 264 + 8 * fq + 32 * ks);
#pragma unroll
              for (int oi = 0; oi < 2; ++oi)
#pragma unroll
                  for (int tt = 0; tt < 4; ++tt) acc[oi][tt] = MFMA16(af[ks][oi], bfv[tt], acc[oi][tt]); }
#pragma unroll
          for (int oi = 0; oi < 2; ++oi) { const int cl = 16 * (2 * w + oi) + 4 * fq; const f32x4 sc = *(const f32x4*)(scale + g * 256 + cl);
#pragma unroll
              for (int tt = 0; tt < 4; ++tt) { const int tok = 16 * tt + fr; const v2u hw = *(const v2u*)(HT + (15 + tok) * 264 + cl);
                  const float h0 = bflo(hw.x) + sc.x * acc[oi][tt].x, h1 = bfhi(hw.x) + sc.y * acc[oi][tt].y, h2 = bflo(hw.y) + sc.z * acc[oi][tt].z, h3 = bfhi(hw.y) + sc.w * acc[oi][tt].w;
                  ssq[tt] += (h0 * h0 + h1 * h1) + (h2 * h2 + h3 * h3);
                  v2u o; o.x = pk2(h0, h1); o.y = pk2(h2, h3); *(v2u*)(HBo + (size_t)(row0 + tok) * DM + g * 256 + cl) = o; } }
#pragma unroll
          for (int tt = 0; tt < 4; ++tt) { float s = ssq[tt]; s += __shfl_xor(s, 16); s += __shfl_xor(s, 32); if (fq == 0) sq[(16 * tt + fr) * 8 + w] = s; } }
        __syncthreads();
        if (tid < 64) { const f32x4 a = *(const f32x4*)(sq + tid * 8), b = *(const f32x4*)(sq + tid * 8 + 4); const float s = ((a.x + a.y) + (a.z + a.w)) + ((b.x + b.y) + (b.z + b.w));
            *(f32x4*)(statsW + (size_t)(row0 + tid) * 16 + 4 * g) = (f32x4){s, 0.f, 0.f, 0.f}; }
        __syncthreads();
    }
}
struct RoutePtrs { int* TOKE; float* TOKG; float* TOKR; int* CNT; int* ROWTS; float* ROWG; float* ROWR; int* TILEE; int* NT; int* EXPB; int* EXPN; int* TOKPOS; int* LT; int* TOKLT; };
__device__ __forceinline__ RoutePtrs route_ptrs(unsigned char* ws) { unsigned char* r = ws + WS_ROUTE; RoutePtrs p;
    p.TOKE = (int*)(r + RT_TOKE); p.TOKG = (float*)(r + RT_TOKG); p.TOKR = (float*)(r + RT_TOKR); p.CNT = (int*)(r + RT_CNT); p.ROWTS = (int*)(r + RT_ROWTS); p.ROWG = (float*)(r + RT_ROWG); p.ROWR = (float*)(r + RT_ROWR);
    p.TILEE = (int*)(r + RT_TILEE); p.NT = (int*)(r + RT_NT); p.EXPB = p.NT + 16; p.EXPN = p.NT + 32; p.TOKPOS = (int*)(r + RT_TOKPOS); p.LT = (int*)(r + RT_LT); p.TOKLT = (int*)(r + RT_LT + 4096); return p; }
__device__ __forceinline__ void moe_route(Frame& F, const RoutePtrs& R, const bf16* HB, const float* gffn, const float* wr, const float* br) {
    int* cnt = (int*)F.gl; const int lane = F.lane;
    float wreg[16][8];
#pragma unroll
    for (int j = 0; j < 4; ++j) { const int c0 = 4 * lane + 256 * j; const f32x4 g = *(const f32x4*)(gffn + c0); const float gg[4] = {g.x, g.y, g.z, g.w};
#pragma unroll
        for (int q = 0; q < 4; ++q) { const f32x4 w0 = *(const f32x4*)(wr + (size_t)(c0 + q) * 8), w1 = *(const f32x4*)(wr + (size_t)(c0 + q) * 8 + 4);
            wreg[4 * j + q][0] = w0.x * gg[q]; wreg[4 * j + q][1] = w0.y * gg[q]; wreg[4 * j + q][2] = w0.z * gg[q]; wreg[4 * j + q][3] = w0.w * gg[q];
            wreg[4 * j + q][4] = w1.x * gg[q]; wreg[4 * j + q][5] = w1.y * gg[q]; wreg[4 * j + q][6] = w1.z * gg[q]; wreg[4 * j + q][7] = w1.w * gg[q]; } }
    const int myexp = ((lane >> 5) & 1) * 4 + ((lane >> 4) & 1) * 2 + ((lane >> 3) & 1); const float mybias = br[myexp];
    for (int tile = F.bid; tile < M / 64; tile += F.G) {
        if (F.tid < 8) cnt[F.tid] = 0;
        __syncthreads();
        for (int ib = 0; ib < 2; ++ib) {
            f32x4 v[4][4];
#pragma unroll
            for (int i = 0; i < 4; ++i) { const v2u* hr = (const v2u*)(HB + (size_t)(tile * 64 + F.wave * 8 + ib * 4 + i) * DM) + lane;
#pragma unroll
                for (int j = 0; j < 4; ++j) { const v2u hw = hr[64 * j]; v[i][j] = (f32x4){bflo(hw.x), bfhi(hw.x), bflo(hw.y), bfhi(hw.y)}; } }
#pragma unroll
            for (int i = 0; i < 4; ++i) { const int row = tile * 64 + F.wave * 8 + ib * 4 + i; float ss = 0.f; float lg[8] = {0.f, 0.f, 0.f, 0.f, 0.f, 0.f, 0.f, 0.f};
#pragma unroll
                for (int j = 0; j < 4; ++j) { const float y[4] = {v[i][j].x, v[i][j].y, v[i][j].z, v[i][j].w};
#pragma unroll
                    for (int q = 0; q < 4; ++q) { ss += y[q] * y[q];
#pragma unroll
                        for (int e = 0; e < 8; ++e) lg[e] += y[q] * wreg[4 * j + q][e]; } }
                ss = wave_sum(ss); const float r = rsqrtf(ss * (1.0f / 1024.0f) + 1e-6f);
                float a4[4];
#pragma unroll
                for (int e = 0; e < 4; ++e) { const bool hi = (lane & 32) != 0; const float keep = hi ? lg[e + 4] : lg[e], send = hi ? lg[e] : lg[e + 4]; a4[e] = keep + __shfl_xor(send, 32); }
                float a2[2];
#pragma unroll
                for (int e = 0; e < 2; ++e) { const bool hi = (lane & 16) != 0; const float keep = hi ? a4[e + 2] : a4[e], send = hi ? a4[e] : a4[e + 2]; a2[e] = keep + __shfl_xor(send, 16); }
                float a1; { const bool hi = (lane & 8) != 0; const float keep = hi ? a2[1] : a2[0], send = hi ? a2[0] : a2[1]; a1 = keep + __shfl_xor(send, 8); }
                a1 += __shfl_xor(a1, 4); a1 += __shfl_xor(a1, 2); a1 += __shfl_xor(a1, 1);
                const float mylogit = a1 * r + mybias;
                float l8[8];
#pragma unroll
                for (int e = 0; e < 8; ++e) l8[e] = __shfl(mylogit, 32 * (e >> 2) + 16 * ((e >> 1) & 1) + 8 * (e & 1));
                int e1 = 0; float v1 = l8[0];
#pragma unroll
                for (int e = 1; e < 8; ++e) if (l8[e] > v1) { v1 = l8[e]; e1 = e; }
                int e2 = -1; float v2 = -INFINITY;
#pragma unroll
                for (int e = 0; e < 8; ++e) if (e != e1 && l8[e] > v2) { v2 = l8[e]; e2 = e; }
                const float ex = __expf(v2 - v1), g1 = 1.0f / (1.0f + ex), g2 = ex * g1;
                if (lane == 0) { R.TOKE[row] = e1 | (e2 << 8); R.TOKG[row * 2] = g1; R.TOKG[row * 2 + 1] = g2; R.TOKR[row] = r; atomicAdd(&cnt[e1], 1); atomicAdd(&cnt[e2], 1); } }
        }
        __syncthreads();
        if (F.tid < 8) R.CNT[tile * 8 + F.tid] = cnt[F.tid];
        __syncthreads();
    }
}
__device__ __forceinline__ void moe_scatter(Frame& F, const RoutePtrs& R, const bf16* HB, bf16* YG) {
    int* sm = (int*)F.gl;
    for (int tile = F.bid; tile < M / 64; tile += F.G) {
        if (F.tid < 16) sm[F.tid] = 0;
        __syncthreads();
        for (int i = F.tid; i < (M / 64) * 8; i += 512) { const int v = R.CNT[i]; atomicAdd(&sm[i & 7], v); if ((i >> 3) < tile) atomicAdd(&sm[8 + (i & 7)], v); }
        __syncthreads();
        if (F.tid == 0) { int base = 0; for (int e = 0; e < 8; ++e) { sm[16 + e] = base; base += (sm[e] + 255) & ~255; } sm[24] = base >> 8; }
        __syncthreads();
        if (F.wave == 0) { const int row = tile * 64 + F.lane, te = R.TOKE[row], e1 = te & 255, e2 = te >> 8; int p1 = 0, p2 = 0; const unsigned long long lt = (F.lane == 0) ? 0ull : (~0ull >> (64 - F.lane));
#pragma unroll
            for (int e = 0; e < 8; ++e) { const unsigned long long m1 = __ballot(e1 == e), m2 = __ballot(e2 == e); const int rk = __popcll(m1 & lt) + __popcll(m2 & lt), bs = sm[16 + e] + sm[8 + e];
                if (e1 == e) p1 = bs + rk; if (e2 == e) p2 = bs + rk; }
            const float r = R.TOKR[row]; R.ROWTS[p1] = row * 2; R.ROWTS[p2] = row * 2 + 1; R.ROWG[p1] = R.TOKG[row * 2]; R.ROWG[p2] = R.TOKG[row * 2 + 1]; R.ROWR[p1] = r; R.ROWR[p2] = r;
            sm[32 + 2 * F.lane] = p1; sm[33 + 2 * F.lane] = p2; R.TOKPOS[row * 2] = p1; R.TOKPOS[row * 2 + 1] = p2; }
        __syncthreads();
        for (int i = 0; i < 16; ++i) { const int cp = F.wave * 16 + i, tok = cp >> 1, pos = sm[32 + cp]; const v4u* src = (const v4u*)(HB + (size_t)(tile * 64 + tok) * DM); v4u* dst = (v4u*)(YG + (size_t)pos * DM);
            dst[F.lane] = src[F.lane]; dst[64 + F.lane] = src[64 + F.lane]; }
        if (tile == 0) {
            for (int e = 0; e < 8; ++e) { const int lo = sm[16 + e] + sm[e], hi = sm[16 + e] + ((sm[e] + 255) & ~255);
                for (int p = lo + F.tid; p < hi; p += 512) { R.ROWTS[p] = -1; R.ROWG[p] = 0.f; R.ROWR[p] = 0.f; }
                for (int t2 = (sm[16 + e] >> 8) + F.tid; t2 < (hi >> 8); t2 += 512) R.TILEE[t2] = e; }
            if (F.tid == 0) R.NT[0] = sm[24];
            if (F.tid < 8) { R.EXPB[F.tid] = sm[16 + F.tid] >> 8; R.EXPN[F.tid] = (sm[F.tid] + 255) >> 8; }
            for (int t2 = F.tid; t2 < 136; t2 += 512) R.LT[48 + t2] = -1;
            __syncthreads();
            if (F.tid == 0) { int nl = 0; for (int e = 0; e < 8; ++e) { const int nrt = (sm[e] + 255) >> 8; nl += nrt > 16 ? nrt - 16 : 0; } const bool use = (F.G == 256) && nl <= 16; int tl = 0;
                for (int e = 0; e < 8; ++e) { const int nrt = (sm[e] + 255) >> 8, nmain = (use && nrt > 16) ? 16 : nrt; R.LT[40 + e] = nmain;
                    for (int q = nmain; q < nrt; ++q) { const int rt = (sm[16 + e] >> 8) + q; R.LT[tl] = rt; R.LT[16 + tl] = e; R.LT[48 + rt] = tl; ++tl; } }
                R.LT[32] = tl; } }
        __syncthreads();
    }
}
__device__ __forceinline__ void moe_combine(Frame& F, const RoutePtrs& R, const bf16* D0, const bf16* D1, const float* PART, bf16* HB, float* stats) {
    for (int m = F.gw; m < M; m += F.NGW) { v2u* o8 = (v2u*)(HB + (size_t)m * DM) + F.lane; const v2u* a = (const v2u*)(D0 + (size_t)m * DM) + F.lane; const v2u* b = (const v2u*)(D1 + (size_t)m * DM) + F.lane;
        float s = 0.f; v2u hv[4], x[2][4]; f32x4 add[2][4];
        const int pos0 = R.TOKPOS[m * 2], pos1 = R.TOKPOS[m * 2 + 1];
#pragma unroll
        for (int j = 0; j < 4; ++j) { hv[j] = o8[64 * j]; x[0][j] = a[64 * j]; x[1][j] = b[64 * j]; }
        const int tl0 = __builtin_amdgcn_readfirstlane(R.LT[48 + (pos0 >> 8)]), tl1 = __builtin_amdgcn_readfirstlane(R.LT[48 + (pos1 >> 8)]);
#pragma unroll
        for (int sl = 0; sl < 2; ++sl) { const int tl = sl ? tl1 : tl0, pos = __builtin_amdgcn_readfirstlane(sl ? pos1 : pos0);
#pragma unroll
            for (int j = 0; j < 4; ++j) add[sl][j] = (f32x4){bflo(x[sl][j].x), bfhi(x[sl][j].x), bflo(x[sl][j].y), bfhi(x[sl][j].y)};
            if (tl >= 0) { const float g = R.TOKG[m * 2 + sl]; const f32x4* pp = (const f32x4*)(PART + ((size_t)(tl * 7) * 256 + (pos & 255)) * 1024) + F.lane;
#pragma unroll
                for (int j = 0; j < 4; ++j) { f32x4 acc = pp[64 * j];
#pragma unroll
                    for (int kc = 1; kc < 7; ++kc) acc = acc + pp[(size_t)kc * 256 * 256 + 64 * j];
                    add[sl][j] = acc * g; } } }
#pragma unroll
        for (int j = 0; j < 4; ++j) { f32x4 v; v.x = bflo(hv[j].x) + add[0][j].x + add[1][j].x; v.y = bfhi(hv[j].x) + add[0][j].y + add[1][j].y; v.z = bflo(hv[j].y) + add[0][j].z + add[1][j].z; v.w = bfhi(hv[j].y) + add[0][j].w + add[1][j].w;
            s += (v.x * v.x + v.y * v.y) + (v.z * v.z + v.w * v.w); v2u w; w.x = pk2(v.x, v.y); w.y = pk2(v.z, v.w); o8[64 * j] = w; }
        s = wave_sum(s);
        if (F.lane < 16) stats[(size_t)m * 16 + F.lane] = (F.lane == 0) ? s : 0.f; }
}
constexpr int N_PHASES = 35;
static_assert(WS_VB == WS_QK + 32 * MiB && WS_OG == WS_VB + 16 * MiB && WS_BQ == WS_OG + 16 * MiB && WS_BQI == WS_BQ + 16 * MiB, "EpiIn address arithmetic");
#ifndef PHASE_SEL
#define PHASE_SEL -1
#endif
#define PHEN(r) (PHASE_SEL < 0 || PHASE_SEL == (r))
#ifndef REP_MASK
#define REP_MASK 0
#endif
#define REPF(bit, call) do { call; if (REP_MASK & (1u << (bit))) { __syncthreads(); call; } } while (0)
#define IN(k) (lo <= (k) && (k) < hi)
#ifndef PROBE_SLOT
#define PROBE_SLOT -1
#endif
#ifndef PROBE_MULT
#define PROBE_MULT 8
#endif
#define SEAM(k) do { if ((k) + 1 < hi) { XcdBarrier b2_ = bar; asm volatile("" : "+s"(b2_.bar)); xcd_barrier(b2_); } \
    if (PROBE_SLOT >= 0) { const unsigned long long now_ = wall_clock64(); if ((((k) == 0) ? 100 : (((k) - 1) % 17)) == PROBE_SLOT) F.tacc += now_ - F.tprev; F.tprev = now_; } } while (0)
#define HBSEL(i) ((bf16*)(ws + ((i) ? WS_HB1 : WS_HB0)))
#define STSEL(i) ((float*)(ws + WS_STATS + ((i) ? MiB : (size_t)0)))
template <int lp> __device__ __forceinline__ void layer_pair(Frame& F, const Args& args, const XcdBarrier& bar, const int lo, const int hi, LAS unsigned char* ring, const int K256, const int K512) {
    unsigned char* ws = F.ws; bf16* Eb = (bf16*)(ws + WS_E);
        const int pb = 1 + 17 * lp;
        int hbi = lp & 1, si = 0;

        {
            const int e = lp, li = 2 * lp;
            EvenPtrs P;
            P.QK = (const bf16*)(ws + WS_QK); P.VB = (const bf16*)(ws + WS_VB); P.OG = (const bf16*)(ws + WS_OG); P.BQ = (const bf16*)(ws + WS_BQ); P.BQI = (const bf16*)(ws + WS_BQI); P.MISC = (const float*)(ws + WS_MISC);
            P.MIX = (bf16*)(ws + WS_MIX); P.QKC = (bf16*)(ws + WS_QKC); P.KB = (bf16*)(ws + WS_KB); P.KIB = (bf16*)(ws + WS_KIB); P.VT = (bf16*)(ws + WS_VT); P.MASK = (unsigned*)(ws + WS_MASK); P.CHS = (float*)(ws + WS_CHS); P.MST = (float*)(ws + WS_CHS + 65536);
            P.ISC = (float*)(ws + WS_ISC); P.U = (float*)(ws + WS_U); P.CB = (bf16*)(ws + WS_CB);
            P.bgate = INP(IN_B_GATE) + e * 8; P.conv = INP(IN_CONV) + e * 4 * 1024; P.gh = INP(IN_NORM_H) + e * 512; P.gq = INP(IN_NORM_Q) + e * 64; P.gk = INP(IN_NORM_K) + e * 64; P.gkv = INP(IN_NORM_KV) + e * 128;
            P.WukT = (const bf16*)(ws + WS_SMALL + 8192) + (size_t)e * 64 * 128; P.WuvT = (const bf16*)(ws + WS_SMALL + 65536) + (size_t)e * 512 * 128; P.bt = (const float*)(ws + WS_SMALL);
            if (PHEN(1) && IN(pb + 1)) {
                pg8::Gemm g{HBSEL(hbi), (const bf16*)(ws + WS_W_IN) + (size_t)e * NINP * DM, M, NINP, DM}; pg8::StaticOrder S; S.init(M, NINP, F.G, F.bid);
                pg8::EpiIn E{STSEL(si), (bf16*)(ws + WS_QK), (float*)(ws + WS_MISC), (bf16*)(ws + WS_KIB)};
                pg8::gemm_phase<pg8::EpiIn, pg8::StaticOrder, true, true>(ring, g, S, E);
                {
                  int c0 = (((M / 256) * (NINP / 256)) % F.G + 7) & ~7; if (c0 >= F.G) c0 = 0;
                  if (F.bid >= c0) { pg8::Gemm g2{(const bf16*)(ws + WS_PB) + (size_t)li * M * PLED, (const bf16*)(ws + WS_W_PL) + (size_t)li * DM * PLED, M, DM, K256}; pg8::StaticOrder S2; S2.init(M, DM, F.G - c0, F.bid - c0);
                    pg8::EpiStore E2{Eb, DM};
                    pg8::gemm_phase<pg8::EpiStore, pg8::StaticOrder, true, true>(ring, g2, S2, E2); } }
                  SEAM(pb + 1); }
            if (PHEN(2) && IN(pb + 2)) { REPF(1, mlstm_a(F, P)); REPF(2, dsa_prep(F, P)); REPF(3, dsa_index(F, P)); SEAM(pb + 2); }
            if (PHEN(3) && IN(pb + 3)) { REPF(4, mlstm_b(F, P)); REPF(5, dsa_select(F, P)); SEAM(pb + 3); }
            if (PHEN(4) && IN(pb + 4)) { REPF(6, mlstm_c(F, P)); REPF(7, dsa_attn(F, P)); SEAM(pb + 4); }
            if (PHEN(5) && IN(pb + 5)) {
                { pg8::Gemm g{(const bf16*)(ws + WS_MIX), (const bf16*)(ws + WS_W_OUT) + (size_t)e * DM * DM, M, DM, DM}; pg8::StaticOrder S; S.init(M, DM, F.G, F.bid);
                  pg8::EpiResid<0> E{HBSEL(hbi), HBSEL(hbi), nullptr, STSEL(si ^ 1), nullptr, nullptr, nullptr};
                  pg8::gemm_phase<pg8::EpiResid<0>, pg8::StaticOrder, true, true>(ring, g, S, E); }
                SEAM(pb + 5); }
            si ^= 1;
            if (PHEN(6) && IN(pb + 6)) {
                pg8::Gemm g{HBSEL(hbi), (const bf16*)(ws + WS_W_GU) + (size_t)e * 7168 * DM, M, 7168, DM}; pg8::StaticOrder S; S.init(M, 7168, F.G, F.bid);
                pg8::EpiGLU<false> E{STSEL(si), nullptr, (bf16*)(ws + WS_ACT)};
                pg8::gemm_phase<pg8::EpiGLU<false>, pg8::StaticOrder, true, true>(ring, g, S, E);
                  SEAM(pb + 6); }
            if (PHEN(7) && IN(pb + 7)) {
                pg8::Gemm g{(const bf16*)(ws + WS_ACT), (const bf16*)(ws + WS_W_DN) + (size_t)e * DM * DFF, M, DM, DFF}; pg8::StaticOrder S; S.init(M, DM, F.G, F.bid);
                pg8::EpiResid<0> E{HBSEL(hbi), HBSEL(hbi), nullptr, STSEL(si ^ 1), nullptr, nullptr, nullptr};
                pg8::gemm_phase<pg8::EpiResid<0>, pg8::StaticOrder, true, true>(ring, g, S, E);
                SEAM(pb + 7); }
            si ^= 1;
            if (PHEN(8) && IN(pb + 8)) {
                pg8::Gemm g{HBSEL(hbi), (const bf16*)(ws + WS_W_PG) + (size_t)li * DM * DM, M, DM, DM}; pg8::StaticOrder S; S.init(M, DM, F.G, F.bid);
                pg8::EpiResid<2> E{HBSEL(hbi), HBSEL(hbi ^ 1), nullptr, STSEL(si ^ 1), STSEL(si), Eb, nullptr};
                pg8::gemm_phase<pg8::EpiResid<2>, pg8::StaticOrder, true, true>(ring, g, S, E);
                SEAM(pb + 8); }
            si ^= 1; hbi ^= 1;
        }
        {
            const int o = lp, li = 2 * lp + 1;
            const RoutePtrs R = route_ptrs(ws);
            if (PHEN(9) && IN(pb + 9)) {
                REPF(13, pool_fused(F, HBSEL(hbi), HBSEL(hbi ^ 1), STSEL(si), STSEL(si ^ 1), INP(IN_NORM_MIX) + li * DM, (const bf16*)(ws + WS_W_POOL) + (size_t)o * 4 * 256 * 256, INP(IN_SCALE_POOL) + o * DM));
                SEAM(pb + 9); }
            si ^= 1; hbi ^= 1;
            if (PHEN(11) && IN(pb + 11)) {   moe_route(F, R, HBSEL(hbi), INP(IN_NORM_FFN) + li * DM, INP(IN_W_ROUTER) + (size_t)o * DM * 8, INP(IN_B_ROUTER) + o * 8);   SEAM(pb + 11); }
            if (PHEN(12) && IN(pb + 12)) {   moe_scatter(F, R, HBSEL(hbi), (bf16*)(ws + WS_YG));   SEAM(pb + 12); }
            if (PHEN(13) && IN(pb + 13)) {
                const int nt = __builtin_amdgcn_readfirstlane(R.NT[0]);
                pg8::Gemm g{(const bf16*)(ws + WS_YG), (const bf16*)(ws + WS_W_MGU), MAXROWS, 8 * 7168, DM}; pg8::MoeOrder S{R.TILEE, R.EXPB, R.LT + 40, nt, 28, F.G, F.bid};
                pg8::EpiGLU<true> E{nullptr, R.ROWR, (bf16*)(ws + WS_ACTM)};
                pg8::gemm_phase<pg8::EpiGLU<true>, pg8::MoeOrder, true, true>(ring, g, S, E);
                { const int nlt = __builtin_amdgcn_readfirstlane(R.LT[32]); pg8::LeftOrder<false> S2{R.LT, nlt * 28, F.G, F.bid};
                  pg8::gemm_phase<pg8::EpiGLU<true>, pg8::LeftOrder<false>, true, true>(ring, g, S2, E); }
                  SEAM(pb + 13); }
            if (PHEN(14) && IN(pb + 14)) {
                const int nt = __builtin_amdgcn_readfirstlane(R.NT[0]);
                pg8::Gemm g{(const bf16*)(ws + WS_ACTM), (const bf16*)(ws + WS_W_MDN), MAXROWS, 8 * 1024, DFF}; pg8::MoeOrder S{R.TILEE, R.EXPB, R.LT + 40, nt, 4, F.G, F.bid};
                pg8::EpiScatter E{R.ROWTS, R.ROWG, (bf16*)(ws + WS_D0), (bf16*)(ws + WS_D1)};
                pg8::gemm_phase<pg8::EpiScatter, pg8::MoeOrder, true, true>(ring, g, S, E);
                {
                  const int nlt = __builtin_amdgcn_readfirstlane(R.LT[32]);
                  pg8::Gemm g3{(const bf16*)(ws + WS_ACTM), (const bf16*)(ws + WS_W_MDN), MAXROWS, 8 * 1024, K512, DFF}; pg8::LeftOrder<true> S3{R.LT, nlt * 28, F.G, F.bid};
                  pg8::EpiPart E3{(float*)(ws + WS_PART)};
                  pg8::gemm_phase<pg8::EpiPart, pg8::LeftOrder<true>, true, true>(ring, g3, S3, E3); }
                {
                  const int c0 = 0;
                  if (F.bid >= c0) { pg8::Gemm g2{(const bf16*)(ws + WS_PB) + (size_t)li * M * PLED, (const bf16*)(ws + WS_W_PL) + (size_t)li * DM * PLED, M, DM, K256}; pg8::StaticOrder S2; S2.init(M, DM, F.G - c0, F.bid - c0);
                    pg8::EpiStore E2{Eb, DM};
                    pg8::gemm_phase<pg8::EpiStore, pg8::StaticOrder, true, true>(ring, g2, S2, E2); } }
                  SEAM(pb + 14); }
            if (PHEN(15) && IN(pb + 15)) { moe_combine(F, R, (const bf16*)(ws + WS_D0), (const bf16*)(ws + WS_D1), (const float*)(ws + WS_PART), HBSEL(hbi), STSEL(si ^ 1)); if (lp == 0) REPF(16, conv_moe(F, args, 1));     SEAM(pb + 15); }
            si ^= 1;
            if (PHEN(16) && IN(pb + 16)) {
                pg8::Gemm g{HBSEL(hbi), (const bf16*)(ws + WS_W_PG) + (size_t)li * DM * DM, M, DM, DM}; pg8::StaticOrder S; S.init(M, DM, F.G, F.bid);
                if (lp == 1) { pg8::EpiResid<2, true> E{HBSEL(hbi), nullptr, F.out, nullptr, STSEL(si), Eb, nullptr};
                    pg8::gemm_phase<pg8::EpiResid<2, true>, pg8::StaticOrder, true, true>(ring, g, S, E); }
                else { pg8::EpiResid<2> E{HBSEL(hbi), HBSEL(hbi ^ 1), nullptr, STSEL(si ^ 1), STSEL(si), Eb, nullptr};
                    pg8::gemm_phase<pg8::EpiResid<2>, pg8::StaticOrder, true, true>(ring, g, S, E); }
                SEAM(pb + 16); }
            si ^= 1; hbi ^= 1;
        }

}
__global__ void __launch_bounds__(NWAVES * 64, 2) fwd(Args args) {
    extern __shared__ __attribute__((aligned(16))) unsigned char lds[];
    Frame F;
    F.lds = (LAS unsigned char*)lds; F.gl = lds; F.MISCW = (volatile LAS unsigned*)(F.lds + MISC_OFF);
    F.tid = threadIdx.x; F.lane = F.tid & 63; F.wave = __builtin_amdgcn_readfirstlane(F.tid >> 6); F.G = gridDim.x; F.bid = blockIdx.x; F.gw = F.bid * NWAVES + F.wave; F.NGW = F.G * NWAVES;
    F.out = args.out; F.ws = args.ws;
    unsigned char* ws = args.ws;
    for (int u = F.tid; u < (LDS_BYTES - LDSCTL_OFF) / 4; u += NWAVES * 64) ((LAS unsigned*)(F.lds + LDSCTL_OFF))[u] = 0u;
    __syncthreads();
    XcdBarrier bar = xcd_barrier_post((unsigned*)(ws + WS_CTL) + CW_BAR, F.MISCW + 8);
    const int lo = args.ph_lo, hi = args.ph_hi;
    F.tacc = 0ull; F.tprev = (PROBE_SLOT >= 0) ? wall_clock64() : 0ull;
    LAS unsigned char* ring = F.lds;
    int K512 = 512; asm volatile("" : "+s"(K512));
    int K256 = 256; asm volatile("" : "+s"(K256));

    if (PHEN(100) && IN(0)) { REPF(8, p0_prologue(F, args)); SEAM(0); }

    layer_pair<0>(F, args, bar, lo, hi, ring, K256, K512);
    layer_pair<1>(F, args, bar, lo, hi, ring, K256, K512);
    if (PROBE_SLOT >= 0 && F.bid == 0 && F.tid == 0) { const unsigned long long t0_ = wall_clock64(), dl_ = (unsigned long long)PROBE_MULT * F.tacc; while (wall_clock64() - t0_ < dl_) __builtin_amdgcn_s_sleep(8); }
#undef IN
#undef SEAM
}

extern "C" void kernel_launch(void* const* d_in, const int* in_sizes, int n_in, void* d_out, int out_size, void* d_ws, size_t ws_size, hipStream_t stream) {
    static int grid = 0;
    if (grid == 0) {
        if (n_in != 28 || in_sizes[0] != M * DM || out_size != M * DM || ws_size < WS_END) { fprintf(stderr, "kernel_launch: unexpected shapes (n_in %d, in0 %d, out %d, ws %zu < %zu); nothing launched\n", n_in, n_in > 0 ? in_sizes[0] : -1, out_size, ws_size, (size_t)WS_END); grid = -1; return; }
        int dev = 0, cus = 0, per_cu = 0;
        if (hipGetDevice(&dev) != hipSuccess || hipDeviceGetAttribute(&cus, hipDeviceAttributeMultiprocessorCount, dev) != hipSuccess) { grid = -1; return; }
        if (hipFuncSetAttribute((const void*)fwd, hipFuncAttributeMaxDynamicSharedMemorySize, LDS_BYTES) != hipSuccess) { fprintf(stderr, "kernel_launch: hipFuncSetAttribute failed\n"); grid = -1; return; }
        if (hipOccupancyMaxActiveBlocksPerMultiprocessor(&per_cu, (const void*)fwd, NWAVES * 64, LDS_BYTES) != hipSuccess || per_cu < 1) fprintf(stderr, "kernel_launch: occupancy query reports %d workgroups per CU\n", per_cu);
        (void)hipGetLastError();
        grid = cus;
    }
    if (grid < 0) return;
    if (hipMemsetAsync((char*)d_ws + WS_CTL, 0, CTL_ZERO_BYTES, stream) != hipSuccess) return;
    Args a{};
    for (int i = 0; i < 28; ++i) a.in[i] = (const float*)d_in[i];
    a.out = (float*)d_out; a.ws = (unsigned char*)d_ws;
#if MK_ONE_LAUNCH
    a.ph_lo = 0; a.ph_hi = N_PHASES;
    hipLaunchKernelGGL(fwd, dim3(grid), dim3(NWAVES * 64), LDS_BYTES, stream, a);
#else
    for (int ph = 0; ph < N_PHASES; ++ph) { if (ph == 1) continue; a.ph_lo = ph; a.ph_hi = ph + 1;
        hipLaunchKernelGGL(fwd, dim3(grid), dim3(NWAVES * 64), LDS_BYTES, stream, a); }
#endif
}
```

```cpp
#include <hip/hip_runtime.h>
#include <cstdio>
#include <cstdint>
#ifndef MK_ONE_LAUNCH
#define MK_ONE_LAUNCH 1
#endif
namespace pg8 {
#define PG8_LAS __attribute__((address_space(3)))
typedef unsigned short bf16_t;
typedef short bf16x8 __attribute__((ext_vector_type(8)));
typedef float f32x4 __attribute__((ext_vector_type(4)));
typedef unsigned u32x4 __attribute__((ext_vector_type(4)));
constexpr int BM = 256, BK = 64, HALF = 128, HTB = HALF * BK * 2  , STAGE_BYTES = 8 * HTB, NXCD = 8, WGM = 8;

__host__ __device__ __forceinline__ int lds_byte(int r, int c) { const int st = (r >> 4) * 2 + (c >> 5), rr = r & 15, cc = c & 31, ob = rr * 64 + cc * 2; return st * 1024 + (ob ^ (((ob >> 9) & 1) << 5)); }
__host__ __device__ __forceinline__ void stage_rc(int b, int& R, int& C) { const int st = b / 1024, sb = b % 1024, swz = sb ^ (((sb >> 9) & 1) << 5); R = (st >> 1) * 16 + swz / 64; C = (st & 1) * 32 + (swz % 64) / 2; }
__host__ __device__ __forceinline__ int perm32(int rho) { const int n = rho >> 4, i = rho & 15; return 8 * (i >> 2) + 4 * n + (i & 3); }

struct Unit { int pm, pn, ko, aux; };
struct Gemm { const bf16_t* A; const bf16_t* Bt; int M, N, K, ld; };

struct StaticOrder {
    int nM, nN, nwg, G, c;
    __host__ __device__ void init(int M, int N, int G_, int c_) { nM = M / BM; nN = N / BM; nwg = nM * nN; G = G_; c = c_; }
    __host__ __device__ bool next(int i, Unit& u) const {
        const long L = (long)i * G + c; if (L >= nwg) return false;
        int wgid = (int)L; { const int q = nwg / NXCD, r = nwg % NXCD, xcd = wgid % NXCD, off = wgid / NXCD; wgid = (xcd < r ? xcd * (q + 1) : r * (q + 1) + (xcd - r) * q) + off; }
        const int nig = WGM * nN, gid = wgid / nig, fm = gid * WGM, gsz = (nM - fm) < WGM ? (nM - fm) : WGM;
        u.pm = fm + ((wgid % nig) % gsz); u.pn = (wgid % nig) / gsz; return true;
    }
    __device__ __forceinline__ void a_ready(const Unit&) const {}
    __device__ __forceinline__ void done(const Unit&) const {}
};
__device__ __forceinline__ unsigned cvt_pk_bf16(float lo, float hi) { unsigned r; asm volatile("v_cvt_pk_bf16_f32 %0, %1, %2" : "=v"(r) : "v"(lo), "v"(hi)); return r; }
typedef float f32x2 __attribute__((ext_vector_type(2)));
constexpr float RMS_EPS = 1e-6f;
__device__ __forceinline__ float fsigmoid(float x) { return __builtin_amdgcn_rcpf(1.0f + __builtin_amdgcn_exp2f(-1.44269504f * x)); }
__device__ __forceinline__ f32x4 sig4(f32x4 v) { f32x4 o; o.x = fsigmoid(v.x); o.y = fsigmoid(v.y); o.z = fsigmoid(v.z); o.w = fsigmoid(v.w); return o; }
__device__ __forceinline__ u32x4 pack8(f32x4 v0, f32x4 v1) { u32x4 w; w.x = cvt_pk_bf16(v0[0], v0[1]); w.y = cvt_pk_bf16(v0[2], v0[3]); w.z = cvt_pk_bf16(v1[0], v1[1]); w.w = cvt_pk_bf16(v1[2], v1[3]); return w; }
__device__ __forceinline__ void unpack8(u32x4 w, f32x4& a, f32x4& b) {
    a.x = __uint_as_float(w.x << 16); a.y = __uint_as_float(w.x & 0xffff0000u); a.z = __uint_as_float(w.y << 16); a.w = __uint_as_float(w.y & 0xffff0000u);
    b.x = __uint_as_float(w.z << 16); b.y = __uint_as_float(w.z & 0xffff0000u); b.z = __uint_as_float(w.w << 16); b.w = __uint_as_float(w.w & 0xffff0000u); }
__device__ __forceinline__ void load_rstd(const float* stats, int rowb, int fr, int fq, float (&rs)[2][4]) {
    float mine[2];
#pragma unroll
    for (int ai = 0; ai < 2; ++ai) { const f32x4* p = (const f32x4*)(stats + (size_t)(rowb + ai * HALF + fq * 16) * 16); const f32x4 a = p[0], b = p[1], c = p[2], d = p[3];
        const float s = (((a.x + a.y) + (a.z + a.w)) + ((b.x + b.y) + (b.z + b.w))) + (((c.x + c.y) + (c.z + c.w)) + ((d.x + d.y) + (d.z + d.w)));
        mine[ai] = rsqrtf(s * (1.0f / 1024.0f) + RMS_EPS); }
#pragma unroll
    for (int ai = 0; ai < 2; ++ai)
#pragma unroll
        for (int m = 0; m < 4; ++m) rs[ai][m] = __shfl(mine[ai], fr + 16 * m);
}
struct EpiIn {
    static constexpr bool PERM = true, AFTER_DRAIN = false;
    const float* stats; bf16_t* QK; float* MISC; bf16_t* KIB;
    __device__ __forceinline__ void operator()(const f32x4 (&acc)[2][2][4][2], const Unit& u, int wr, int wc, int fr, int fq) const {
        const int rowb = u.pm * BM + wr * 64 + fr, cl = wc * 32 + 8 * fq, pn = u.pn;
        float rs[2][4]; load_rstd(stats, rowb, fr, fq, rs);
        if (pn < 12) {
            bf16_t* base; int ld, colt; bool sig = false;
            if (pn < 4) { base = QK; ld = 1024; colt = pn * 256; }
            else { const int t = (pn - 4) >> 1; base = QK + (size_t)16777216 + (size_t)t * 8388608; ld = 512; colt = ((pn - 4) & 1) * 256; sig = (t == 1); }
#pragma unroll
            for (int ai = 0; ai < 2; ++ai)
#pragma unroll
                for (int m = 0; m < 4; ++m) { const float r = rs[ai][m]; bf16_t* rp = base + (size_t)(rowb + ai * HALF + m * 16) * ld + colt + cl;
#pragma unroll
                    for (int bj = 0; bj < 2; ++bj) { f32x4 v0 = acc[ai][bj][m][0] * r, v1 = acc[ai][bj][m][1] * r; if (sig) { v0 = sig4(v0); v1 = sig4(v1); }
                        *(u32x4*)(rp + bj * HALF) = pack8(v0, v1); }
                    asm volatile("" ::: "memory"); }
        } else {
#pragma unroll
            for (int ai = 0; ai < 2; ++ai)
#pragma unroll
                for (int m = 0; m < 4; ++m) { const float r = rs[ai][m]; float* rp = MISC + (size_t)(rowb + ai * HALF + m * 16) * 256 + cl;
#pragma unroll
                    for (int bj = 0; bj < 2; ++bj)
#pragma unroll
                        for (int n = 0; n < 2; ++n) *(f32x4*)(rp + bj * HALF + 4 * n) = acc[ai][bj][m][n] * r;
                    if (wc < 2) *(u32x4*)(KIB + (size_t)(rowb + ai * HALF + m * 16) * 64 + cl) = pack8(acc[ai][1][m][0] * r, acc[ai][1][m][1] * r);
                    asm volatile("" ::: "memory"); }
        }
    }
};
template <int MODE, bool FINAL = false> struct EpiResid {
    static constexpr bool PERM = true, AFTER_DRAIN = false;
    const bf16_t* HBi; bf16_t* HBo; float* OUT; float* statsW; const float* statsR; const bf16_t* E; const float* scale;
    __device__ __forceinline__ void operator()(const f32x4 (&acc)[2][2][4][2], const Unit& u, int wr, int wc, int fr, int fq) const {
        int pm = u.pm; const int pn = u.pn; if (MODE == 1) pm -= 64 * pn;
        const int rowb = pm * BM + wr * 64 + fr, colb = pn * BM + wc * 32 + 8 * fq;
        float rs[2][4]; if (MODE == 2) load_rstd(statsR, rowb, fr, fq, rs);
        f32x4 sc[2][2];
        if (MODE == 1) {
#pragma unroll
            for (int bj = 0; bj < 2; ++bj)
#pragma unroll
                for (int n = 0; n < 2; ++n) sc[bj][n] = *(const f32x4*)(scale + colb + bj * HALF + 4 * n); }
#pragma unroll
        for (int ai = 0; ai < 2; ++ai)
#pragma unroll
            for (int m = 0; m < 4; ++m) { const size_t off = (size_t)(rowb + ai * HALF + m * 16) * 1024 + colb; float ssq = 0.f;
#pragma unroll
                for (int bj = 0; bj < 2; ++bj) { f32x4 h0, h1; unpack8(*(const u32x4*)(HBi + off + bj * HALF), h0, h1);
                    f32x4 v0 = acc[ai][bj][m][0], v1 = acc[ai][bj][m][1];
                    if (MODE == 1) { v0 = v0 * sc[bj][0]; v1 = v1 * sc[bj][1]; }
                    if (MODE == 2) { const u32x4 ew = *(const u32x4*)(E + off + bj * HALF); f32x4 e0, e1; unpack8(ew, e0, e1); const float r = rs[ai][m]; v0 = e0 * sig4(v0 * r); v1 = e1 * sig4(v1 * r); }
                    h0 = h0 + v0; h1 = h1 + v1;
                    if (FINAL) { float* hp = OUT + off + bj * HALF; ((f32x4*)hp)[0] = h0; ((f32x4*)hp)[1] = h1; }
                    else { ssq += ((h0.x * h0.x + h0.y * h0.y) + (h0.z * h0.z + h0.w * h0.w)) + ((h1.x * h1.x + h1.y * h1.y) + (h1.z * h1.z + h1.w * h1.w));
                           *(u32x4*)(HBo + off + bj * HALF) = pack8(h0, h1); } }
                if (!FINAL) { ssq += __shfl_xor(ssq, 16); ssq += __shfl_xor(ssq, 32);
                    if (fq == 0) statsW[(size_t)(rowb + ai * HALF + m * 16) * 16 + pn * 4 + wc] = ssq; }
                asm volatile("" ::: "memory"); }
    }
};
template <bool MOE> struct EpiGLU {
    static constexpr bool PERM = true, AFTER_DRAIN = false;
    const float* stats; const float* rowr; bf16_t* ACT;
    __device__ __forceinline__ void operator()(const f32x4 (&acc)[2][2][4][2], const Unit& u, int wr, int wc, int fr, int fq) const {
        const int rowb = u.pm * BM + wr * 64 + fr, jt = MOE ? (u.pn % 28) : u.pn;
        float rs[2][4];
        if (MOE) {
#pragma unroll
            for (int ai = 0; ai < 2; ++ai)
#pragma unroll
                for (int m = 0; m < 4; ++m) rs[ai][m] = rowr[rowb + ai * HALF + m * 16];
        } else load_rstd(stats, rowb, fr, fq, rs);
#pragma unroll
        for (int ai = 0; ai < 2; ++ai)
#pragma unroll
            for (int m = 0; m < 4; ++m) { const float r = rs[ai][m]; bf16_t* rp = ACT + (size_t)(rowb + ai * HALF + m * 16) * 3584 + jt * 128 + wc * 32 + 8 * fq;
                const f32x4 g0 = acc[ai][0][m][0] * r, g1 = acc[ai][0][m][1] * r, u0 = acc[ai][1][m][0] * r, u1 = acc[ai][1][m][1] * r;
                *(u32x4*)rp = pack8(g0 * sig4(g0) * u0, g1 * sig4(g1) * u1);
                asm volatile("" ::: "memory"); }
    }
};
struct EpiScatter {
    static constexpr bool PERM = true, AFTER_DRAIN = false;
    const int* rowts; const float* rowg; bf16_t *D0, *D1;
    __device__ __forceinline__ void operator()(const f32x4 (&acc)[2][2][4][2], const Unit& u, int wr, int wc, int fr, int fq) const {
        const int rowb = u.pm * BM + wr * 64 + fr, jt = u.pn & 3;
#pragma unroll
        for (int ai = 0; ai < 2; ++ai)
#pragma unroll
            for (int m = 0; m < 4; ++m) { const int row = rowb + ai * HALF + m * 16; const int ts = rowts[row];
                if (ts >= 0) { const float g = rowg[row]; bf16_t* dp = ((ts & 1) ? D1 : D0) + (size_t)(ts >> 1) * 1024 + jt * 256 + wc * 32 + 8 * fq;
#pragma unroll
                    for (int bj = 0; bj < 2; ++bj) *(u32x4*)(dp + bj * HALF) = pack8(acc[ai][bj][m][0] * g, acc[ai][bj][m][1] * g); }
                asm volatile("" ::: "memory"); }
    }
};
struct EpiPart {
    static constexpr bool PERM = true, AFTER_DRAIN = false;
    float* PART;
    __device__ __forceinline__ void operator()(const f32x4 (&acc)[2][2][4][2], const Unit& u, int wr, int wc, int fr, int fq) const {
        float* base = PART + ((size_t)u.aux * 256 + wr * 64 + fr) * 1024 + (u.pn & 3) * 256 + wc * 32 + 8 * fq;
#pragma unroll
        for (int ai = 0; ai < 2; ++ai)
#pragma unroll
            for (int m = 0; m < 4; ++m) { float* rp = base + (size_t)(ai * HALF + m * 16) * 1024;
#pragma unroll
                for (int bj = 0; bj < 2; ++bj) { *(f32x4*)(rp + bj * HALF) = acc[ai][bj][m][0]; *(f32x4*)(rp + bj * HALF + 4) = acc[ai][bj][m][1]; }
                asm volatile("" ::: "memory"); }
    }
};
template <bool SPLIT> struct LeftOrder {
    const int* lt; int nl, G, c;
    __device__ __forceinline__ bool next(int i, Unit& u) const { const int L = i * G + c; if (L >= nl) return false; const int tl = L / 28, rem = L - 28 * tl;
        u.pm = __builtin_amdgcn_readfirstlane(lt[tl]); const int e = __builtin_amdgcn_readfirstlane(lt[16 + tl]);
        if (SPLIT) { const int j = rem / 7, kc = rem - 7 * j; u.pn = e * 4 + j; u.ko = kc * 512; u.aux = tl * 7 + kc; } else { u.pn = e * 28 + rem; u.ko = 0; u.aux = 0; }
        return true; }
    __device__ __forceinline__ void a_ready(const Unit&) const {}
    __device__ __forceinline__ void done(const Unit&) const {}
};
struct EpiStore {
    static constexpr bool PERM = true, AFTER_DRAIN = false;
    bf16_t* O; int ldc;
    __device__ __forceinline__ void operator()(const f32x4 (&acc)[2][2][4][2], const Unit& u, int wr, int wc, int fr, int fq) const {
        const int rowb = u.pm * BM + wr * 64 + fr, colb = u.pn * BM + wc * 32 + 8 * fq;
#pragma unroll
        for (int ai = 0; ai < 2; ++ai)
#pragma unroll
            for (int m = 0; m < 4; ++m) { bf16_t* rp = O + (size_t)(rowb + ai * HALF + m * 16) * ldc + colb;
#pragma unroll
                for (int bj = 0; bj < 2; ++bj) *(u32x4*)(rp + bj * HALF) = pack8(acc[ai][bj][m][0], acc[ai][bj][m][1]); }
    }
};
struct PoolOrder {
    int G, c;
    __device__ __forceinline__ bool next(int i, Unit& u) const { const int L = i * G + c; if (L >= 256) return false; const int g = L & 3; u.pm = g * 64 + (L >> 2); u.pn = g; return true; }
    __device__ __forceinline__ void a_ready(const Unit&) const {}
    __device__ __forceinline__ void done(const Unit&) const {}
};
struct MoeOrder {
    const int* tileE; const int* expb; const int* expn; int ntiles, ncol, G, c;
    __device__ __forceinline__ bool next(int i, Unit& u) const {
        if (G == 256) { const int e = c & 7, lu = i * 32 + (c >> 3), nrt = __builtin_amdgcn_readfirstlane(expn[e]); if (lu >= nrt * ncol) return false;
            const int per = 4 * nrt, cbk = lu / per, rem = lu - cbk * per; u.pm = __builtin_amdgcn_readfirstlane(expb[e]) + (rem >> 2); u.pn = e * ncol + cbk * 4 + (rem & 3); return true; }
        const int L = i * G + c; if (L >= ntiles * ncol) return false; const int rt = L / ncol, j = L - rt * ncol;
        u.pm = rt; u.pn = __builtin_amdgcn_readfirstlane(tileE[rt]) * ncol + j; return true; }
    __device__ __forceinline__ void a_ready(const Unit&) const {}
    __device__ __forceinline__ void done(const Unit&) const {}
};
template <class Epi, class Sched, bool ALIGN_EPI = false, bool SP2 = false>
__device__ __forceinline__ void gemm_phase(PG8_LAS unsigned char* lds, const Gemm g, const Sched& S, const Epi& E) {
    const int tid = threadIdx.x, wid = __builtin_amdgcn_readfirstlane(tid >> 6), lane = tid & 63, wr = wid >> 2, wc = wid & 3, fr = lane & 15, fq = lane >> 4;
    const int K = g.K, nt = K / BK, LD = g.ld ? g.ld : K;
    unsigned voffA[2], voffB[2];
#pragma unroll
    for (int i = 0; i < 2; ++i) { int R, C; stage_rc(tid * 16 + i * 8192, R, C); const int Rb = Epi::PERM ? ((R & ~31) + perm32(R & 31)) : R;
        voffA[i] = (unsigned)(R * LD + C) * 2u; voffB[i] = (unsigned)(Rb * LD + C) * 2u; }
    const size_t kstep = (size_t)(BK * 2);
    const size_t hstep = (size_t)HALF * LD * 2;
    const size_t tstep = 2 * hstep;
    const unsigned ldsw = (unsigned)wid * 1024u;
    const int aoff = lds_byte(wr * 64 + fr, fq * 8), boff = lds_byte(wc * 32 + fr, fq * 8);
#define PG8_SA(b, h) (((b) * 2 + (h)) * HTB)
#define PG8_SB(b, h) ((4 + (b) * 2 + (h)) * HTB)
#define PG8_STAGE(bufoff, gbase, voff) do { _Pragma("unroll") for (int _i = 0; _i < 2; ++_i) \
        __builtin_amdgcn_global_load_lds((const unsigned*)((const char*)(gbase) + (voff)[_i]), (PG8_LAS unsigned*)(lds + (bufoff) + ldsw + _i * 8192), 16, 0, 0); } while (0)
#define PG8_LDA(dst, b, h) do { _Pragma("unroll") for (int m = 0; m < 4; ++m) _Pragma("unroll") for (int k = 0; k < 2; ++k) dst[m][k] = *(const PG8_LAS bf16x8*)(lds + PG8_SA(b, h) + aoff + m * 2048 + k * 1024); } while (0)
#define PG8_LDB(dst, b, h) do { _Pragma("unroll") for (int n = 0; n < 2; ++n) _Pragma("unroll") for (int k = 0; k < 2; ++k) dst[n][k] = *(const PG8_LAS bf16x8*)(lds + PG8_SB(b, h) + boff + n * 2048 + k * 1024); } while (0)
#define PG8_MMA(ai, bj, At, Bt) do { __builtin_amdgcn_s_setprio(1); _Pragma("unroll") for (int m = 0; m < 4; ++m) _Pragma("unroll") for (int n = 0; n < 2; ++n) _Pragma("unroll") for (int k = 0; k < 2; ++k) \
        acc[ai][bj][m][n] = __builtin_amdgcn_mfma_f32_16x16x32_bf16(Bt[n][k], At[m][k], acc[ai][bj][m][n], 0, 0, 0); __builtin_amdgcn_s_setprio(0); } while (0)
#define PG8_WAIT_V(n) asm volatile("s_waitcnt vmcnt(" #n ")" ::: "memory")
#define PG8_WAIT_L(n) asm volatile("s_waitcnt lgkmcnt(" #n ")" ::: "memory")
#define PG8_BAR __builtin_amdgcn_s_barrier()
#define PG8_SCHED __builtin_amdgcn_sched_barrier(0)
    Unit cur{0, 0, 0, 0}, nxt{0, 0, 0, 0}; int ui = 0;
    if (!S.next(0, cur)) return;
    f32x4 acc[2][2][4][2];
#pragma unroll
    for (int a = 0; a < 2; ++a)
#pragma unroll
        for (int b = 0; b < 2; ++b)
#pragma unroll
            for (int m = 0; m < 4; ++m)
#pragma unroll
                for (int n = 0; n < 2; ++n) acc[a][b][m][n] = (f32x4){0.f, 0.f, 0.f, 0.f};
    bf16x8 At[4][2], B0[2][2], B1[2][2];
    const char* cA = (const char*)g.A + (size_t)cur.pm * tstep + (size_t)cur.ko * 2; const char* cB = (const char*)g.Bt + (size_t)cur.pn * tstep + (size_t)cur.ko * 2;
    S.a_ready(cur);
    if constexpr (SP2) {
        PG8_STAGE(PG8_SB(0, 0), cB, voffB); PG8_STAGE(PG8_SB(0, 1), cB + hstep, voffB); PG8_STAGE(PG8_SA(0, 0), cA, voffA); PG8_STAGE(PG8_SA(0, 1), cA + hstep, voffA);
        if (wr == 1) PG8_BAR;
        PG8_WAIT_V(2); PG8_BAR;
        PG8_STAGE(PG8_SB(1, 0), cB + kstep, voffB); PG8_STAGE(PG8_SA(1, 0), cA + kstep, voffA); PG8_STAGE(PG8_SB(1, 1), cB + hstep + kstep, voffB);
        PG8_WAIT_V(6); PG8_BAR;
    } else {
        PG8_STAGE(PG8_SB(0, 0), cB, voffB); PG8_STAGE(PG8_SA(0, 0), cA, voffA); PG8_STAGE(PG8_SB(0, 1), cB + hstep, voffB); PG8_STAGE(PG8_SA(0, 1), cA + hstep, voffA);
        if (wr == 1) PG8_BAR;
        PG8_WAIT_V(4); PG8_BAR;
        PG8_STAGE(PG8_SB(1, 0), cB + kstep, voffB); PG8_STAGE(PG8_SA(1, 0), cA + kstep, voffA); PG8_STAGE(PG8_SB(1, 1), cB + hstep + kstep, voffB);
        PG8_WAIT_V(6); PG8_BAR;
    }
    for (;;) {
        const bool has_next = S.next(ui + 1, nxt);
        const char* nA = has_next ? (const char*)g.A + (size_t)nxt.pm * tstep + (size_t)nxt.ko * 2 : cA; const char* nB = has_next ? (const char*)g.Bt + (size_t)nxt.pn * tstep + (size_t)nxt.ko * 2 : cB;
        for (int t = 0; t < nt; t += 2) {
            const bool last = (t == nt - 2);
            const char* a1 = cA + (size_t)(t + 1) * kstep;
            const char* a2 = last ? nA : cA + (size_t)(t + 2) * kstep; const char* b2 = last ? nB : cB + (size_t)(t + 2) * kstep;
            const char* a3 = a2 + kstep; const char* b3 = b2 + kstep;
            if (last && has_next) S.a_ready(nxt);
            if constexpr (SP2) {
            PG8_LDB(B0, 0, 0); PG8_LDB(B1, 0, 1); PG8_SCHED; PG8_LDA(At, 0, 0); PG8_STAGE(PG8_SA(1, 1), a1 + hstep, voffA);
            PG8_WAIT_V(8); PG8_WAIT_L(0); PG8_BAR; PG8_MMA(0, 0, At, B0); PG8_MMA(0, 1, At, B1); PG8_BAR; PG8_SCHED;
            PG8_LDA(At, 0, 1); PG8_STAGE(PG8_SB(0, 0), b2, voffB); PG8_STAGE(PG8_SB(0, 1), b2 + hstep, voffB); PG8_STAGE(PG8_SA(0, 0), a2, voffA);
            PG8_WAIT_V(8); PG8_WAIT_L(0); PG8_BAR; PG8_MMA(1, 0, At, B0); PG8_MMA(1, 1, At, B1); PG8_BAR; PG8_SCHED;
            PG8_LDB(B0, 1, 0); PG8_LDB(B1, 1, 1); PG8_SCHED; PG8_LDA(At, 1, 0); PG8_STAGE(PG8_SA(0, 1), a2 + hstep, voffA);
            PG8_WAIT_V(8); PG8_WAIT_L(0); PG8_BAR; PG8_MMA(0, 0, At, B0); PG8_MMA(0, 1, At, B1); PG8_BAR; PG8_SCHED;
            PG8_LDA(At, 1, 1); PG8_STAGE(PG8_SB(1, 0), b3, voffB); PG8_STAGE(PG8_SB(1, 1), b3 + hstep, voffB); PG8_STAGE(PG8_SA(1, 0), a3, voffA);
            PG8_WAIT_V(8); PG8_WAIT_L(0); PG8_BAR; PG8_MMA(1, 0, At, B0); PG8_MMA(1, 1, At, B1); PG8_BAR; PG8_SCHED;
            } else {
            PG8_LDB(B0, 0, 0); PG8_SCHED; PG8_LDA(At, 0, 0); PG8_STAGE(PG8_SA(1, 1), a1 + hstep, voffA);
            PG8_WAIT_L(8); PG8_BAR; PG8_WAIT_L(0); PG8_MMA(0, 0, At, B0); PG8_BAR; PG8_SCHED;
            PG8_LDB(B1, 0, 1); PG8_STAGE(PG8_SB(0, 0), b2, voffB);
            PG8_BAR; PG8_WAIT_L(0); PG8_MMA(0, 1, At, B1); PG8_BAR;
            PG8_LDA(At, 0, 1); PG8_STAGE(PG8_SA(0, 0), a2, voffA);
            PG8_BAR; PG8_WAIT_L(0); PG8_MMA(1, 0, At, B0); PG8_BAR; PG8_SCHED;
            PG8_STAGE(PG8_SB(0, 1), b2 + hstep, voffB);
            PG8_WAIT_V(6); PG8_BAR; PG8_MMA(1, 1, At, B1); PG8_BAR;
            PG8_LDB(B0, 1, 0); PG8_SCHED; PG8_LDA(At, 1, 0); PG8_STAGE(PG8_SA(0, 1), a2 + hstep, voffA);
            PG8_WAIT_L(8); PG8_BAR; PG8_WAIT_L(0); PG8_MMA(0, 0, At, B0); PG8_BAR; PG8_SCHED;
            PG8_LDB(B1, 1, 1); PG8_STAGE(PG8_SB(1, 0), b3, voffB);
            PG8_BAR; PG8_WAIT_L(0); PG8_MMA(0, 1, At, B1); PG8_BAR;
            PG8_LDA(At, 1, 1); PG8_STAGE(PG8_SA(1, 0), a3, voffA);
            PG8_BAR; PG8_WAIT_L(0); PG8_MMA(1, 0, At, B0); PG8_BAR; PG8_SCHED;
            PG8_STAGE(PG8_SB(1, 1), b3 + hstep, voffB);
            PG8_WAIT_V(6); PG8_BAR; PG8_MMA(1, 1, At, B1); PG8_BAR;
            }
        }
        if constexpr (ALIGN_EPI) { if (wr == 0) PG8_BAR; }
        if constexpr (!Epi::AFTER_DRAIN) { E(acc, cur, wr, wc, fr, fq); S.done(cur); }
        if (!has_next) break;
#pragma unroll
        for (int a = 0; a < 2; ++a)
#pragma unroll
            for (int b = 0; b < 2; ++b)
#pragma unroll
                for (int m = 0; m < 4; ++m)
#pragma unroll
                    for (int n = 0; n < 2; ++n) acc[a][b][m][n] = (f32x4){0.f, 0.f, 0.f, 0.f};
        cur = nxt; cA = nA; cB = nB; ++ui;
        if constexpr (ALIGN_EPI) { if (wr == 1) PG8_BAR; }
    }
    PG8_WAIT_V(0);
    if constexpr (!ALIGN_EPI) { if (wr == 0) PG8_BAR; }
    PG8_BAR;
    if constexpr (Epi::AFTER_DRAIN) { E.fused(acc, cur, wr, wc, fr, fq, lds, wid, lane); S.done(cur); }
#undef PG8_SA
#undef PG8_SB
#undef PG8_STAGE
#undef PG8_LDA
#undef PG8_LDB
#undef PG8_MMA
#undef PG8_WAIT_V
#undef PG8_WAIT_L
#undef PG8_BAR
#undef PG8_SCHED
}
}
constexpr int NWAVES = 8;
constexpr int BATCH = 8, SEQ = 2048, DM = 1024, M = BATCH * SEQ, DFF = 3584, NEXP = 8, PLED = 256, NINP = 3328, NCHUNK = 32;
constexpr float LOG2E = 1.4426950408889634f;
constexpr size_t MiB = 1u << 20;
constexpr size_t WS_CTL = 0, CTL_ZERO_BYTES = 1 * MiB;
constexpr size_t WS_SMALL = 1 * MiB;
constexpr size_t WS_W_IN = 2 * MiB, WS_W_OUT = 15 * MiB, WS_W_GU = 19 * MiB, WS_W_DN = 47 * MiB, WS_W_PG = 61 * MiB, WS_W_PL = 69 * MiB, WS_W_POOL = 71 * MiB;
constexpr size_t WS_W_MGU = 72 * MiB, WS_W_MDN = 184 * MiB;
constexpr size_t WS_HB0 = 240 * MiB, WS_HB1 = 272 * MiB, WS_STATS = 304 * MiB, WS_PB = 306 * MiB, WS_E = 338 * MiB;
constexpr size_t WS_OVL = 370 * MiB;
constexpr size_t WS_QK = WS_OVL, WS_VB = WS_OVL + 32 * MiB, WS_OG = WS_OVL + 48 * MiB, WS_BQ = WS_OVL + 64 * MiB, WS_BQI = WS_OVL + 80 * MiB, WS_MISC = WS_OVL + 96 * MiB, WS_MIX = WS_OVL + 112 * MiB;
constexpr size_t WS_KB = WS_OVL + 144 * MiB, WS_KIB = WS_OVL + 146 * MiB, WS_VT = WS_OVL + 148 * MiB, WS_MASK = WS_OVL + 164 * MiB, WS_CHS = WS_OVL + 168 * MiB;
constexpr size_t WS_ISC = WS_OVL + 169 * MiB, WS_U = WS_OVL + 297 * MiB, WS_CB = WS_OVL + 369 * MiB, WS_QKC = WS_OVL + 406 * MiB, WS_ACT = WS_ISC;
constexpr size_t WS_POOLED = WS_OVL, WS_YG = WS_OVL + 32 * MiB, WS_ACTM = WS_OVL + 100 * MiB, WS_D0 = WS_OVL + 338 * MiB, WS_D1 = WS_OVL + 370 * MiB, WS_ROUTE = WS_OVL + 402 * MiB, WS_PART = WS_OVL + 406 * MiB;
constexpr size_t WS_END = WS_OVL + 518 * MiB;
constexpr int MAXROWS = 34816;
constexpr size_t RT_TOKE = 0, RT_TOKG = 65536, RT_TOKR = 196608, RT_CNT = 262144, RT_ROWTS = 270336, RT_ROWG = 409600, RT_ROWR = 548864, RT_TILEE = 688128, RT_NT = 688128 + 1024, RT_TOKPOS = 1048576, RT_LT = 1048576 + 131072;
constexpr int CW_BAR = 4096;
constexpr int RING_BYTES = 131072, LDSCTL_OFF = RING_BYTES, MISC_OFF = LDSCTL_OFF + 320, LDS_BYTES = 147456;

#define GAS __attribute__((address_space(1)))
#define LAS __attribute__((address_space(3)))
typedef unsigned short bf16;
typedef unsigned v4u __attribute__((ext_vector_type(4)));
typedef unsigned v2u __attribute__((ext_vector_type(2)));
typedef float f32x4 __attribute__((ext_vector_type(4)));
typedef float f32x2 __attribute__((ext_vector_type(2)));
typedef short bf16x8 __attribute__((ext_vector_type(8)));
#define LDS_WAIT() asm volatile("s_waitcnt lgkmcnt(0)" ::: "memory")
typedef float f32x2c __attribute__((ext_vector_type(2))); typedef __bf16 bf16x2c __attribute__((ext_vector_type(2)));
__device__ __forceinline__ unsigned pk2(float lo, float hi) { const f32x2c v = {lo, hi}; return __builtin_bit_cast(unsigned, __builtin_convertvector(v, bf16x2c)); }
__device__ __forceinline__ unsigned f2bf(float f) { return pk2(f, 0.f) & 0xffffu; }
__device__ __forceinline__ float bflo(unsigned w) { return __uint_as_float(w << 16); }
__device__ __forceinline__ float bfhi(unsigned w) { return __uint_as_float(w & 0xffff0000u); }
__device__ __forceinline__ float bf2f(bf16 b) { return __uint_as_float(((unsigned)b) << 16); }
__device__ __forceinline__ float wave_sum(float v) {
#pragma unroll
    for (int o = 1; o < 64; o <<= 1) v += __shfl_xor(v, o);
    return v;
}
__device__ __forceinline__ float wave_max(float v) {
#pragma unroll
    for (int o = 1; o < 64; o <<= 1) v = fmaxf(v, __shfl_xor(v, o));
    return v;
}
__device__ __forceinline__ float fsig(float x) { return __builtin_amdgcn_rcpf(1.0f + __builtin_amdgcn_exp2f(-1.44269504f * x)); }
#define MFMA16(a, b, c) __builtin_amdgcn_mfma_f32_16x16x32_bf16((a), (b), (c), 0, 0, 0)
#define XB_TMO      128
#define XB_XCNT(j)  (256  + 64 * (j))
#define XB_XSUB(j)  (1280 + 64 * (j))
#define XB_XGEN(j)  (2304 + 64 * (j))
#define XB_TOP      3328
#define XB_TOPGEN   3392
#define XCD_BAR_WORDS 3456
#define XB_SPIN_CAP (1u << 18)

__device__ __forceinline__ unsigned xb_ld(unsigned* p)              { return __hip_atomic_load(p, __ATOMIC_RELAXED, __HIP_MEMORY_SCOPE_AGENT); }
__device__ __forceinline__ unsigned xb_add(unsigned* p, unsigned v) { return __hip_atomic_fetch_add(p, v, __ATOMIC_RELAXED, __HIP_MEMORY_SCOPE_AGENT); }
__device__ __forceinline__ unsigned xb_xcc_id() { return (unsigned)__builtin_amdgcn_s_getreg((3 << 11) | 20) & 0xFu; }
#define XB_SPIN(cond, bar) do { unsigned _sp = 0; while (cond) { __builtin_amdgcn_s_sleep(1); \
    if ((++_sp & 255u) == 0u) { if (xb_ld(&(bar)[XB_TMO])) break; if (_sp > XB_SPIN_CAP) { atomicAdd(&(bar)[XB_TMO], 1u); break; } } } } while (0)

struct XcdBarrier {
    unsigned* bar; unsigned x;
    volatile LAS unsigned* st;
};

__device__ __forceinline__ XcdBarrier xcd_barrier_post(unsigned* bar, volatile LAS unsigned* st) {
    XcdBarrier b; b.bar = bar; b.x = xb_xcc_id(); b.st = st;
    if (threadIdx.x == 0) (void)xb_add(&bar[XB_XCNT(b.x)], 1u);
    return b;
}
__device__ __forceinline__ void xcd_barrier_complete(unsigned* bar, unsigned x, unsigned& nloc, unsigned& nx) {
    const unsigned G = gridDim.x * gridDim.y * gridDim.z;
    unsigned sum, cnt, mine, sp = 0u;
    for (;;) {
        sum = 0u; cnt = 0u; mine = 0u;
#pragma unroll
        for (unsigned j = 0; j < 16; ++j) { const unsigned c = xb_ld(&bar[XB_XCNT(j)]); sum += c; cnt += (c > 0u) ? 1u : 0u; mine = (j == x) ? c : mine; }
        if (sum == G) break;
        __builtin_amdgcn_s_sleep(1);
        if ((++sp & 255u) == 0u) { if (xb_ld(&bar[XB_TMO])) break; if (sp > XB_SPIN_CAP) { atomicAdd(&bar[XB_TMO], 1u); break; } }
    }
    nloc = mine > 0u ? mine : 1u; nx = cnt > 0u ? cnt : 1u;
}

__device__ __forceinline__ void xcd_barrier(const XcdBarrier& b) {
    asm volatile("s_waitcnt vmcnt(0)" ::: "memory");
    __syncthreads();
    if (threadIdx.x == 0) {
        unsigned* bar = b.bar;
        __builtin_amdgcn_s_waitcnt(0);
        unsigned nloc = b.st[0], nx = b.st[1];
        if (nloc == 0u) { xcd_barrier_complete(bar, b.x, nloc, nx); b.st[0] = nloc; b.st[1] = nx; }
        const unsigned old = xb_add(&bar[XB_XSUB(b.x)], 1u);
        const unsigned gen = old / nloc;
        if (old + 1u == (gen + 1u) * nloc) {
            __builtin_amdgcn_fence(__ATOMIC_RELEASE, "agent");
            asm volatile("s_waitcnt vmcnt(0)" ::: "memory");
            const unsigned og = xb_add(&bar[XB_TOP], 1u);
            const unsigned tg = og / nx;
            if (og + 1u == (tg + 1u) * nx) xb_add(&bar[XB_TOPGEN], 1u);
            else XB_SPIN(xb_ld(&bar[XB_TOPGEN]) == tg, bar);
            __builtin_amdgcn_fence(__ATOMIC_ACQUIRE, "agent");
            xb_add(&bar[XB_XGEN(b.x)], 1u);
            asm volatile("s_waitcnt vmcnt(0)" ::: "memory");
        } else {
            XB_SPIN(xb_ld(&bar[XB_XGEN(b.x)]) == gen, bar);
            __builtin_amdgcn_fence(__ATOMIC_ACQUIRE, "agent");
            asm volatile("s_waitcnt vmcnt(0)" ::: "memory");
        }
    }
    __syncthreads();
}
struct Args { const float* in[28]; float* out; unsigned char* ws; int ph_lo, ph_hi; };
struct Frame {
    LAS unsigned char* lds; unsigned char* gl;
    volatile LAS unsigned* MISCW;
    int tid, lane, wave, G, bid, gw, NGW;
    float* out; unsigned char* ws;
    unsigned long long tacc, tprev;
};
#define INP(k) (args.in[k])
#define IN_X 0
#define IN_P 1
#define IN_NORM_MIX 2
#define IN_NORM_FFN 3
#define IN_W_IN 4
#define IN_B_GATE 5
#define IN_CONV 6
#define IN_NORM_H 7
#define IN_NORM_Q 8
#define IN_NORM_K 9
#define IN_NORM_KV 10
#define IN_W_UK 11
#define IN_W_UV 12
#define IN_W_OUT 13
#define IN_REL_BIAS 14
#define IN_W_POOL 15
#define IN_SCALE_POOL 16
#define IN_W_GATE_D 17
#define IN_W_UP_D 18
#define IN_W_DOWN_D 19
#define IN_W_ROUTER 20
#define IN_B_ROUTER 21
#define IN_W_GATE_M 22
#define IN_W_UP_M 23
#define IN_W_DOWN_M 24
#define IN_W_PLE 25
#define IN_W_PLE_GATE 26
#define IN_NORM_PLE 27

template <int MODE> __device__ __forceinline__ int dst_row(int n) {
    if (MODE == 0) return n;
    if (MODE == 1) return ((n >> 7) << 8) + (n & 127);
    if (MODE == 2) return ((n >> 7) << 8) + 128 + (n & 127);
    if (n < 2048) return n;
    if (n < 2052) return 3264 + (n - 2048);
    if (n < 2056) return 3268 + (n - 2052);
    if (n < 2568) return 2048 + (n - 2056);
    if (n < 2696) return 3072 + (n - 2568);
    if (n < 3208) return 2560 + (n - 2696);
    if (n < 3272) return 3200 + (n - 3208);
    return 3272 + (n - 3272);
}
template <int MODE> __device__ __forceinline__ void conv_mat(Frame& F, const float* W, int K, int N, bf16* WT, const float* gain, int wi, int nw) {
    LAS float* scr = (LAS float*)(F.lds + F.wave * 16384);
    const int nblk = (N + 31) >> 5, nitems = (K >> 6) * nblk, lane = F.lane, r = lane >> 3, c4 = lane & 7;
    for (int it = wi; it < nitems; it += nw) {
        const int kb = it / nblk, nb = it - kb * nblk, k0 = 64 * kb, n0 = 32 * nb, nn = n0 + 4 * c4; const bool okn = nn < N;
        f32x4 v[8];
#pragma unroll
        for (int i = 0; i < 8; ++i) v[i] = okn ? *(const f32x4*)(W + (size_t)(k0 + 8 * i + r) * N + nn) : (f32x4){0.f, 0.f, 0.f, 0.f};
        if (gain) {
#pragma unroll
            for (int i = 0; i < 8; ++i) v[i] = v[i] * gain[k0 + 8 * i + r]; }
#pragma unroll
        for (int i = 0; i < 8; ++i) { LAS float* d = scr + (8 * i + r) * 33 + 4 * c4; d[0] = v[i].x; d[1] = v[i].y; d[2] = v[i].z; d[3] = v[i].w; }
        LDS_WAIT(); asm volatile("" ::: "memory");
        const int c = lane & 7;
#pragma unroll
        for (int j = 0; j < 4; ++j) { const int n = (lane >> 3) + 8 * j; const LAS float* s = scr + (8 * c) * 33 + n;
            v4u o; o.x = pk2(s[0 * 33], s[1 * 33]); o.y = pk2(s[2 * 33], s[3 * 33]); o.z = pk2(s[4 * 33], s[5 * 33]); o.w = pk2(s[6 * 33], s[7 * 33]);
            if (n0 + n < N) *(v4u*)(WT + (size_t)dst_row<MODE>(n0 + n) * K + k0 + 8 * c) = o; }
        LDS_WAIT(); asm volatile("" ::: "memory");
    }
}
__device__ __forceinline__ void conv_moe(Frame& F, const Args& args, int o) {
    bf16* mgu = (bf16*)(F.ws + WS_W_MGU); bf16* mdn = (bf16*)(F.ws + WS_W_MDN);
    const float* gain = INP(IN_NORM_FFN) + (2 * o + 1) * DM;
    for (int e = 0; e < NEXP; ++e) {
        const size_t wo = ((size_t)o * NEXP + e) * DM * DFF;
        conv_mat<1>(F, INP(IN_W_GATE_M) + wo, DM, DFF, mgu + (size_t)e * 7168 * 1024, gain, F.gw, F.NGW);
        conv_mat<2>(F, INP(IN_W_UP_M) + wo, DM, DFF, mgu + (size_t)e * 7168 * 1024, gain, F.gw, F.NGW);
        conv_mat<0>(F, INP(IN_W_DOWN_M) + wo, DFF, DM, mdn + (size_t)e * 1024 * 3584, nullptr, F.gw, F.NGW);
    }
}
__device__ __forceinline__ void p0_prologue(Frame& F, const Args& args) {
    unsigned char* ws = F.ws;
    for (int e = 0; e < 2; ++e) {
        conv_mat<3>(F, INP(IN_W_IN) + (size_t)e * DM * 3280, DM, 3280, (bf16*)(ws + WS_W_IN) + (size_t)e * NINP * DM, INP(IN_NORM_MIX) + (2 * e) * DM, F.gw, F.NGW);
        conv_mat<0>(F, INP(IN_W_OUT) + (size_t)e * DM * DM, DM, DM, (bf16*)(ws + WS_W_OUT) + (size_t)e * DM * DM, nullptr, F.gw, F.NGW);
        conv_mat<1>(F, INP(IN_W_GATE_D) + (size_t)e * DM * DFF, DM, DFF, (bf16*)(ws + WS_W_GU) + (size_t)e * 7168 * DM, INP(IN_NORM_FFN) + (2 * e) * DM, F.gw, F.NGW);
        conv_mat<2>(F, INP(IN_W_UP_D) + (size_t)e * DM * DFF, DM, DFF, (bf16*)(ws + WS_W_GU) + (size_t)e * 7168 * DM, INP(IN_NORM_FFN) + (2 * e) * DM, F.gw, F.NGW);
        conv_mat<0>(F, INP(IN_W_DOWN_D) + (size_t)e * DFF * DM, DFF, DM, (bf16*)(ws + WS_W_DN) + (size_t)e * DM * DFF, nullptr, F.gw, F.NGW);
        conv_mat<0>(F, INP(IN_W_UK) + (size_t)e * 128 * 64, 128, 64, (bf16*)(ws + WS_SMALL + 8192) + (size_t)e * 64 * 128, nullptr, F.gw, F.NGW);
        for (int h = 0; h < 8; ++h)
            conv_mat<0>(F, INP(IN_W_UV) + ((size_t)e * 8 + h) * 128 * 64, 128, 64, (bf16*)(ws + WS_SMALL + 65536) + ((size_t)e * 512 + h * 64) * 128, nullptr, F.gw, F.NGW);
        for (int g = 0; g < 4; ++g)
            conv_mat<0>(F, INP(IN_W_POOL) + ((size_t)e * 4 + g) * 256 * 256, 256, 256, (bf16*)(ws + WS_W_POOL) + ((size_t)e * 4 + g) * 256 * 256, nullptr, F.gw, F.NGW);
    }
    for (int i = 0; i < 4; ++i) {
        conv_mat<0>(F, INP(IN_W_PLE_GATE) + (size_t)i * DM * DM, DM, DM, (bf16*)(ws + WS_W_PG) + (size_t)i * DM * DM, INP(IN_NORM_PLE) + i * DM, F.gw, F.NGW);
        conv_mat<0>(F, INP(IN_W_PLE) + (size_t)i * PLED * DM, PLED, DM, (bf16*)(ws + WS_W_PL) + (size_t)i * DM * PLED, nullptr, F.gw, F.NGW);
    }
    conv_moe(F, args, 0);
    const int gt = F.bid * 512 + F.tid, NT = F.G * 512;
    for (int i = gt; i < 2 * 48 * DM / 8; i += NT) { const int e = i / (48 * DM / 8), r = i - e * (48 * DM / 8); *(v4u*)((bf16*)(ws + WS_W_IN) + ((size_t)e * NINP + 3280) * DM + (size_t)r * 8) = (v4u){0u, 0u, 0u, 0u}; }
    if (F.bid == 0) for (int t = F.tid; t < 1024; t += 512) { const int hh = t >> 7, d = t & 127; int bk = d;
        if (d >= 16) { bk = 16 + (d >= 19) + (d >= 21) + (d >= 24) + (d >= 27) + (d >= 31) + (d >= 35) + (d >= 40) + (d >= 46) + (d >= 52) + (d >= 59) + (d >= 67) + (d >= 77) + (d >= 87) + (d >= 99) + (d >= 113); }
        ((float*)(ws + WS_SMALL))[t] = INP(IN_REL_BIAS)[bk * 8 + hh] * LOG2E; }
    { const f32x4* src = (const f32x4*)INP(IN_P); v4u* dst = (v4u*)(ws + WS_PB);
      for (int i = gt; i < 4 * M * PLED / 8; i += NT) { const f32x4 a = src[2 * i], b = src[2 * i + 1]; v4u o; o.x = pk2(a.x, a.y); o.y = pk2(a.z, a.w); o.z = pk2(b.x, b.y); o.w = pk2(b.z, b.w); dst[i] = o; } }
    { const float* x = INP(IN_X); bf16* hb = (bf16*)(ws + WS_HB0); float* st = (float*)(ws + WS_STATS);
      for (int m = F.gw; m < M; m += F.NGW) { const f32x4* xr = (const f32x4*)(x + (size_t)m * DM) + F.lane; f32x4 v[4]; float s = 0.f;
#pragma unroll
          for (int j = 0; j < 4; ++j) { v[j] = xr[64 * j]; s += (v[j].x * v[j].x + v[j].y * v[j].y) + (v[j].z * v[j].z + v[j].w * v[j].w); }
          s = wave_sum(s);
          v2u* o8 = (v2u*)(hb + (size_t)m * DM) + F.lane;
#pragma unroll
          for (int j = 0; j < 4; ++j) { v2u w; w.x = pk2(v[j].x, v[j].y); w.y = pk2(v[j].z, v[j].w); o8[64 * j] = w; }
          if (F.lane < 16) st[(size_t)m * 16 + F.lane] = (F.lane == 0) ? s : 0.f; } }
}

struct EvenPtrs {
    const bf16 *QK, *VB, *OG, *BQ, *BQI; const float* MISC; bf16 *MIX, *KB, *KIB, *VT, *QKC; unsigned* MASK; float* CHS; float* MST; float* ISC; float* U; bf16* CB;
    const float *bgate, *conv, *gh, *gq, *gk, *gkv; const bf16 *WukT, *WuvT; const float* bt;
};
__device__ __forceinline__ void conv8(const bf16* QK, const float* cw, int rowb, int tpos, int ch, float (&o)[8]) {
#pragma unroll
    for (int j = 0; j < 8; ++j) o[j] = 0.f;
#pragma unroll
    for (int tap = 0; tap < 4; ++tap) { const int tp = tpos - 3 + tap;
        if (tp >= 0) { const v4u w = *(const v4u*)(QK + (size_t)(rowb + tp) * 1024 + ch); const f32x4 c0 = *(const f32x4*)(cw + tap * 1024 + ch), c1 = *(const f32x4*)(cw + tap * 1024 + ch + 4);
            o[0] += bflo(w.x) * c0.x; o[1] += bfhi(w.x) * c0.y; o[2] += bflo(w.y) * c0.z; o[3] += bfhi(w.y) * c0.w;
            o[4] += bflo(w.z) * c1.x; o[5] += bfhi(w.z) * c1.y; o[6] += bflo(w.w) * c1.z; o[7] += bfhi(w.w) * c1.w; } }
#pragma unroll
    for (int j = 0; j < 8; ++j) o[j] = o[j] * fsig(o[j]);
}
__device__ __forceinline__ void chunk_gates(const EvenPtrs& P, int row, int hh, int lane, float& li, float& bc) {
    const float ai = P.MISC[(size_t)row * 256 + 192 + hh], af = P.MISC[(size_t)row * 256 + 196 + hh];
    li = ai + P.bgate[hh]; const float x = af + P.bgate[4 + hh]; const float lf = fminf(x, 0.f) - log1pf(__expf(-fabsf(x)));
    bc = lf;
#pragma unroll
    for (int o = 1; o < 64; o <<= 1) { const float t = __shfl_up(bc, o); if (lane >= o) bc += t; }
}
__device__ __forceinline__ void mlstm_a(Frame& F, const EvenPtrs& P) {
    bf16* KT = (bf16*)F.gl; bf16* VwT = (bf16*)(F.gl + 18432); float* wv = (float*)(F.gl + 18432 + 20736);
    const int tid = F.tid, lane = F.lane, w = F.wave, fr = lane & 15, fq = lane >> 4;
    for (int unit = F.bid; unit < BATCH * 4 * NCHUNK; unit += F.G) {
        const int b = unit >> 7, hh = (unit >> 5) & 3, c = unit & 31, rowb = b * SEQ, t0 = c * 64;
        if (w == 0) { float li, bc; chunk_gates(P, rowb + t0 + lane, hh, lane, li, bc); const float blast = __shfl(bc, 63), g = blast - bc + li, gmax = wave_max(g);
            wv[lane] = __expf(g - gmax); if (lane == 0) { P.CHS[unit * 2] = blast; P.CHS[unit * 2 + 1] = gmax; } }
        { const int cg = tid & 31, s0 = (tid >> 5) * 4, ch = (cg < 16 ? 0 : 512 - 128) + hh * 128 + cg * 8;
          float cw[4][8];
#pragma unroll
          for (int tap = 0; tap < 4; ++tap) { const f32x4 c0 = *(const f32x4*)(P.conv + tap * 1024 + ch), c1 = *(const f32x4*)(P.conv + tap * 1024 + ch + 4);
              cw[tap][0] = c0.x; cw[tap][1] = c0.y; cw[tap][2] = c0.z; cw[tap][3] = c0.w; cw[tap][4] = c1.x; cw[tap][5] = c1.y; cw[tap][6] = c1.z; cw[tap][7] = c1.w; }
          v4u xin[7];
#pragma unroll
          for (int i = 0; i < 7; ++i) { const int tp = t0 + s0 - 3 + i; xin[i] = (tp >= 0) ? *(const v4u*)(P.QK + (size_t)(rowb + tp) * 1024 + ch) : (v4u){0u, 0u, 0u, 0u}; }
          float o[4][8];
#pragma unroll
          for (int r = 0; r < 4; ++r) {
#pragma unroll
              for (int j = 0; j < 8; ++j) o[r][j] = 0.f;
#pragma unroll
              for (int tap = 0; tap < 4; ++tap) { const v4u xw = xin[r + tap];
                  o[r][0] += bflo(xw.x) * cw[tap][0]; o[r][1] += bfhi(xw.x) * cw[tap][1]; o[r][2] += bflo(xw.y) * cw[tap][2]; o[r][3] += bfhi(xw.y) * cw[tap][3];
                  o[r][4] += bflo(xw.z) * cw[tap][4]; o[r][5] += bfhi(xw.z) * cw[tap][5]; o[r][6] += bflo(xw.w) * cw[tap][6]; o[r][7] += bfhi(xw.w) * cw[tap][7]; }
              const float sc = (cg < 16) ? 1.0f : 0.08838834764831845f;
#pragma unroll
              for (int j = 0; j < 8; ++j) o[r][j] = o[r][j] * fsig(o[r][j]) * sc;
              v4u q; q.x = pk2(o[r][0], o[r][1]); q.y = pk2(o[r][2], o[r][3]); q.z = pk2(o[r][4], o[r][5]); q.w = pk2(o[r][6], o[r][7]);
              *(v4u*)(P.QKC + (size_t)(rowb + t0 + s0 + r) * 1024 + ch) = q; }
          if (cg >= 16) { const int d0 = (cg - 16) * 8;
#pragma unroll
              for (int j = 0; j < 8; ++j) { v2u pk; pk.x = pk2(o[0][j], o[1][j]); pk.y = pk2(o[2][j], o[3][j]); *(v2u*)(KT + (d0 + j) * 72 + s0) = pk; } } }
        __syncthreads();
        if (tid < 256) { const int vg = tid & 15, s0 = (tid >> 4) * 4; v4u vw[4]; float ws4[4];
#pragma unroll
            for (int r = 0; r < 4; ++r) { vw[r] = *(const v4u*)(P.VB + (size_t)(rowb + t0 + s0 + r) * 512 + hh * 128 + vg * 8); ws4[r] = wv[s0 + r]; }
#pragma unroll
            for (int j = 0; j < 4; ++j) { const unsigned w0 = j == 0 ? vw[0].x : j == 1 ? vw[0].y : j == 2 ? vw[0].z : vw[0].w, w1 = j == 0 ? vw[1].x : j == 1 ? vw[1].y : j == 2 ? vw[1].z : vw[1].w,
                                                    w2 = j == 0 ? vw[2].x : j == 1 ? vw[2].y : j == 2 ? vw[2].z : vw[2].w, w3 = j == 0 ? vw[3].x : j == 1 ? vw[3].y : j == 2 ? vw[3].z : vw[3].w;
                v2u lo, hi; lo.x = pk2(bflo(w0) * ws4[0], bflo(w1) * ws4[1]); lo.y = pk2(bflo(w2) * ws4[2], bflo(w3) * ws4[3]); hi.x = pk2(bfhi(w0) * ws4[0], bfhi(w1) * ws4[1]); hi.y = pk2(bfhi(w2) * ws4[2], bfhi(w3) * ws4[3]);
                *(v2u*)(VwT + (vg * 8 + 2 * j) * 72 + s0) = lo; *(v2u*)(VwT + (vg * 8 + 2 * j + 1) * 72 + s0) = hi; } }
        else if (tid < 320) VwT[128 * 72 + (tid - 256)] = (bf16)f2bf(wv[tid - 256]);
        else for (int i = tid - 320; i < 15 * 64; i += 192) VwT[(129 + (i >> 6)) * 72 + (i & 63)] = 0;
        __syncthreads();
        { bf16x8 bfr[2]; f32x4 acc[9];
#pragma unroll
          for (int ks = 0; ks < 2; ++ks) bfr[ks] = *(const bf16x8*)(KT + (16 * w + fr) * 72 + 8 * fq + 32 * ks);
#pragma unroll
          for (int rt = 0; rt < 9; ++rt) { acc[rt] = (f32x4){0.f, 0.f, 0.f, 0.f};
#pragma unroll
              for (int ks = 0; ks < 2; ++ks) { const bf16x8 a = *(const bf16x8*)(VwT + (16 * rt + fr) * 72 + 8 * fq + 32 * ks); acc[rt] = MFMA16(a, bfr[ks], acc[rt]); } }
          float* Uo = P.U + (size_t)unit * 144 * 128 + 16 * w + fr;
#pragma unroll
          for (int rt = 0; rt < 9; ++rt)
#pragma unroll
              for (int r = 0; r < 4; ++r) Uo[(size_t)(16 * rt + 4 * fq + r) * 128] = acc[rt][r]; }
        __syncthreads();
    }
}
__device__ __forceinline__ void mlstm_b(Frame& F, const EvenPtrs& P) {
    const int gt = F.bid * 512 + F.tid, NT = F.G * 512;
    for (int e = gt; e < BATCH * 4 * 129 * 128; e += NT) {
        const int d = e & 127, v = (e >> 7) % 129, bh = e / (129 * 128);
        float u[NCHUNK];
#pragma unroll
        for (int c = 0; c < NCHUNK; ++c) u[c] = P.U[((size_t)(bh * 32 + c) * 144 + v) * 128 + d];
        float C = 0.f, m = 0.f;
#pragma unroll
        for (int c = 0; c < NCHUNK; ++c) { const int unit = bh * 32 + c; const size_t idx = ((size_t)unit * 144 + v) * 128 + d;
            P.CB[idx] = (bf16)f2bf(C);
            if (v == 0 && d == 0) P.MST[unit] = m;
            const float blast = P.CHS[unit * 2], gmax = P.CHS[unit * 2 + 1], mn = fmaxf(blast + m, gmax);
            C = __expf(blast + m - mn) * C + __expf(gmax - mn) * u[c]; m = mn; }
    }
    for (int e = gt; e < BATCH * 4 * NCHUNK * 15 * 128; e += NT) { const int d = e & 127, r = (e >> 7) % 15, unit = e / (15 * 128); P.CB[((size_t)unit * 144 + 129 + r) * 128 + d] = 0; }
}
__device__ __forceinline__ void mlstm_c(Frame& F, const EvenPtrs& P) {
    bf16* Qs = (bf16*)F.gl; bf16* Ks = (bf16*)(F.gl + 17408); bf16* VTa = (bf16*)(F.gl + 34816); bf16* Ps = (bf16*)(F.gl + 55552);
    float* av = (float*)(F.gl + 64768); float* pmv = av + 64; float* bcv = av + 128; float* ssb = av + 192;
    const int tid = F.tid, lane = F.lane, w = F.wave, fr = lane & 15, fq = lane >> 4;
    for (int unit = F.bid; unit < BATCH * 4 * NCHUNK; unit += F.G) {
        const int b = unit >> 7, hh = (unit >> 5) & 3, c = unit & 31, rowb = b * SEQ, t0 = c * 64;
        const float mc = P.MST[unit];
        if (w == 0) { float li, bc; chunk_gates(P, rowb + t0 + lane, hh, lane, li, bc); const float a = li - bc; float p = a;
#pragma unroll
            for (int o = 1; o < 64; o <<= 1) { const float tt = __shfl_up(p, o); if (lane >= o) p = fmaxf(p, tt); }
            av[lane] = a; pmv[lane] = fmaxf(p, mc); bcv[lane] = bc; }
        {
#pragma unroll
          for (int i = 0; i < 2; ++i) { const int idx = tid + 512 * i, s = idx >> 4, ch = (idx & 15) * 8;
              *(v4u*)(Qs + s * 136 + ch) = *(const v4u*)(P.QKC + (size_t)(rowb + t0 + s) * 1024 + hh * 128 + ch);
              *(v4u*)(Ks + s * 136 + ch) = *(const v4u*)(P.QKC + (size_t)(rowb + t0 + s) * 1024 + 512 + hh * 128 + ch); }
          if (tid < 256) { const int vg = tid & 15, s0 = (tid >> 4) * 4; v4u vw[4];
#pragma unroll
              for (int r = 0; r < 4; ++r) vw[r] = *(const v4u*)(P.VB + (size_t)(rowb + t0 + s0 + r) * 512 + hh * 128 + vg * 8);
#pragma unroll
              for (int j = 0; j < 4; ++j) { const unsigned w0 = j == 0 ? vw[0].x : j == 1 ? vw[0].y : j == 2 ? vw[0].z : vw[0].w, w1 = j == 0 ? vw[1].x : j == 1 ? vw[1].y : j == 2 ? vw[1].z : vw[1].w,
                                                      w2 = j == 0 ? vw[2].x : j == 1 ? vw[2].y : j == 2 ? vw[2].z : vw[2].w, w3 = j == 0 ? vw[3].x : j == 1 ? vw[3].y : j == 2 ? vw[3].z : vw[3].w;
                  v2u lo, hi; lo.x = (w0 & 0xffffu) | (w1 << 16); lo.y = (w2 & 0xffffu) | (w3 << 16); hi.x = (w0 >> 16) | (w1 & 0xffff0000u); hi.y = (w2 >> 16) | (w3 & 0xffff0000u);
                  *(v2u*)(VTa + (vg * 8 + 2 * j) * 72 + s0) = lo; *(v2u*)(VTa + (vg * 8 + 2 * j + 1) * 72 + s0) = hi; } }
          else if (tid < 320) VTa[128 * 72 + (tid - 256)] = (bf16)0x3f80u;
          else for (int i = tid - 320; i < 15 * 64; i += 192) VTa[(129 + (i >> 6)) * 72 + (i & 63)] = 0; }
        __syncthreads();
        { const int rt = w >> 1;
#pragma unroll
          for (int c2 = 0; c2 < 2; ++c2) { const int ct = 2 * (w & 1) + c2; f32x4 acc = (f32x4){0.f, 0.f, 0.f, 0.f};
#pragma unroll
              for (int ks = 0; ks < 4; ++ks) { const bf16x8 a = *(const bf16x8*)(Qs + (16 * rt + fr) * 136 + 8 * fq + 32 * ks), bb = *(const bf16x8*)(Ks + (16 * ct + fr) * 136 + 8 * fq + 32 * ks); acc = MFMA16(a, bb, acc); }
              const int s = 16 * ct + fr; const float as = av[s];
#pragma unroll
              for (int r = 0; r < 4; ++r) { const int t = 16 * rt + 4 * fq + r; const float p = (s <= t) ? acc[r] * __expf(as - pmv[t]) : 0.f; Ps[t * 72 + s] = (bf16)f2bf(p); } } }
        __syncthreads();
        { const int tt = w & 3, hf = w >> 2, t = 16 * tt + fr; f32x4 ni[5], ne[5];
#pragma unroll
          for (int i = 0; i < 5; ++i) { const int vt = (i < 4) ? 4 * hf + i : 8; ni[i] = (f32x4){0.f, 0.f, 0.f, 0.f}; ne[i] = (f32x4){0.f, 0.f, 0.f, 0.f};
#pragma unroll
              for (int ks = 0; ks < 2; ++ks) { const bf16x8 a = *(const bf16x8*)(VTa + (16 * vt + fr) * 72 + 8 * fq + 32 * ks), bb = *(const bf16x8*)(Ps + (16 * tt + fr) * 72 + 8 * fq + 32 * ks); ni[i] = MFMA16(a, bb, ni[i]); }
#pragma unroll
              for (int ks = 0; ks < 4; ++ks) { const bf16x8 a = *(const bf16x8*)(P.CB + ((size_t)unit * 144 + 16 * vt + fr) * 128 + 8 * fq + 32 * ks), bb = *(const bf16x8*)(Qs + (16 * tt + fr) * 136 + 8 * fq + 32 * ks); ne[i] = MFMA16(a, bb, ne[i]); } }
          const float pm = pmv[t], wi = __expf(mc - pm), fl = __expf(-(bcv[t] + pm));
#pragma unroll
          for (int i = 0; i < 5; ++i) ni[i] = ni[i] + ne[i] * wi;
          const float den = __shfl(ni[4].x, fr), rinv = __builtin_amdgcn_rcpf(fmaxf(fabsf(den), fl)); float q = 0.f;
#pragma unroll
          for (int i = 0; i < 4; ++i) { ni[i] = ni[i] * rinv; q += (ni[i].x * ni[i].x + ni[i].y * ni[i].y) + (ni[i].z * ni[i].z + ni[i].w * ni[i].w); }
          q += __shfl_xor(q, 16); q += __shfl_xor(q, 32);
          if (fq == 0) ssb[w * 16 + fr] = q;
          __syncthreads();
          const float rs = rsqrtf((q + ssb[(w ^ 4) * 16 + fr]) * (1.0f / 128.0f) + 1e-6f);
          const size_t row = (size_t)(rowb + t0 + t);
#pragma unroll
          for (int i = 0; i < 4; ++i) { const int col = hh * 128 + 16 * (4 * hf + i) + 4 * fq; const f32x4 g = *(const f32x4*)(P.gh + col); const v2u og = *(const v2u*)(P.OG + row * 512 + col);
              v2u o; o.x = pk2(ni[i].x * rs * g.x * bflo(og.x), ni[i].y * rs * g.y * bfhi(og.x)); o.y = pk2(ni[i].z * rs * g.z * bflo(og.y), ni[i].w * rs * g.w * bfhi(og.y));
              *(v2u*)(P.MIX + row * 1024 + col) = o; } }
        __syncthreads();
    }
}
__device__ __forceinline__ void dsa_prep(Frame& F, const EvenPtrs& P) {
    bf16* LAT = (bf16*)F.gl;
    const int lane = F.lane, w = F.wave, fr = lane & 15, fq = lane >> 4;
    for (int tile = F.bid; tile < M / 64; tile += F.G) {
        const int row0 = tile * 64, b = row0 >> 11, s0 = row0 & 2047;
        bf16x8 wk[4][4], wv[4][4];
        if (w < 4) {
#pragma unroll
            for (int ct = 0; ct < 4; ++ct)
#pragma unroll
                for (int ks = 0; ks < 4; ++ks) wk[ct][ks] = *(const bf16x8*)(P.WukT + (16 * ct + fr) * 128 + 8 * fq + 32 * ks); }
#pragma unroll
        for (int i = 0; i < 4; ++i)
#pragma unroll
            for (int ks = 0; ks < 4; ++ks) wv[i][ks] = *(const bf16x8*)(P.WuvT + (size_t)(16 * (w + 8 * i) + fr) * 128 + 8 * fq + 32 * ks);
        { f32x2 x[8]; float ss[8];
          const f32x2 g = *(const f32x2*)(P.gkv + 2 * lane);
#pragma unroll
          for (int i = 0; i < 8; ++i) x[i] = *(const f32x2*)(P.MISC + (size_t)(row0 + w * 8 + i) * 256 + 2 * lane);
#pragma unroll
          for (int i = 0; i < 8; ++i) ss[i] = x[i].x * x[i].x + x[i].y * x[i].y;
#pragma unroll
          for (int o = 1; o < 64; o <<= 1)
#pragma unroll
              for (int i = 0; i < 8; ++i) ss[i] += __shfl_xor(ss[i], o);
#pragma unroll
          for (int i = 0; i < 8; ++i) { const float r = rsqrtf(ss[i] * (1.0f / 128.0f) + 1e-6f); *(unsigned*)(LAT + (w * 8 + i) * 136 + 2 * lane) = pk2(x[i].x * r * g.x, x[i].y * r * g.y); } }
        __syncthreads();
        if (w < 4) { const int rt = w; f32x4 acc[4]; float q[4] = {0.f, 0.f, 0.f, 0.f};
#pragma unroll
            for (int ct = 0; ct < 4; ++ct) { acc[ct] = (f32x4){0.f, 0.f, 0.f, 0.f};
#pragma unroll
                for (int ks = 0; ks < 4; ++ks) { const bf16x8 a = *(const bf16x8*)(LAT + (16 * rt + fr) * 136 + 8 * fq + 32 * ks); acc[ct] = MFMA16(a, wk[ct][ks], acc[ct]); }
#pragma unroll
                for (int r = 0; r < 4; ++r) q[r] += acc[ct][r] * acc[ct][r]; }
#pragma unroll
            for (int r = 0; r < 4; ++r) { float s = q[r]; s += __shfl_xor(s, 1); s += __shfl_xor(s, 2); s += __shfl_xor(s, 4); s += __shfl_xor(s, 8); q[r] = rsqrtf(s * (1.0f / 64.0f) + 1e-6f); }
#pragma unroll
            for (int ct = 0; ct < 4; ++ct) { const float g = P.gk[16 * ct + fr];
#pragma unroll
                for (int r = 0; r < 4; ++r) P.KB[(size_t)(row0 + 16 * rt + 4 * fq + r) * 64 + 16 * ct + fr] = (bf16)f2bf(acc[ct][r] * q[r] * g); } }
#pragma unroll
        for (int i = 0; i < 4; ++i) { const int rt = w + 8 * i;
#pragma unroll
            for (int ct = 0; ct < 4; ++ct) { f32x4 acc = (f32x4){0.f, 0.f, 0.f, 0.f};
#pragma unroll
                for (int ks = 0; ks < 4; ++ks) { const bf16x8 bb = *(const bf16x8*)(LAT + (16 * ct + fr) * 136 + 8 * fq + 32 * ks); acc = MFMA16(wv[i][ks], bb, acc); }
#pragma unroll
                for (int r = 0; r < 4; ++r) { const int hd = 16 * rt + 4 * fq + r; P.VT[((size_t)(b * 8 + (hd >> 6)) * 64 + (hd & 63)) * 2048 + s0 + 16 * ct + fr] = (bf16)f2bf(acc[r]); } } }
        __syncthreads();
    }
}
__device__ __forceinline__ void dsa_index(Frame& F, const EvenPtrs& P) {
    const int lane = F.lane, fr = lane & 15, fq = lane >> 4;
    for (int uid = F.gw; uid < BATCH * 576; uid += F.NGW) {
        const int b = uid / 576, rr0 = uid - b * 576; int gq = 0;
        while (gq < 7 && 8 * (gq + 1) * (gq + 2) <= rr0) ++gq;
        const int rr = rr0 - 8 * gq * (gq + 1), qt = gq * 16 + rr / (gq + 1), kc = rr % (gq + 1);
        const int t0 = qt * 16; int nkt = ((t0 + 15 - kc * 256) >> 4) + 1; if (nkt > 16) nkt = 16;
        const size_t rowq = (size_t)b * SEQ + t0 + fr;
        bf16x8 qf[8][2]; float wq[8];
#pragma unroll
        for (int hh = 0; hh < 8; ++hh)
#pragma unroll
            for (int ks = 0; ks < 2; ++ks) qf[hh][ks] = *(const bf16x8*)(P.BQI + rowq * 512 + hh * 64 + 32 * ks + 8 * fq);
        { const f32x4 w0 = *(const f32x4*)(P.MISC + rowq * 256 + 200), w1 = *(const f32x4*)(P.MISC + rowq * 256 + 204); wq[0] = w0.x; wq[1] = w0.y; wq[2] = w0.z; wq[3] = w0.w; wq[4] = w1.x; wq[5] = w1.y; wq[6] = w1.z; wq[7] = w1.w; }
        const bf16* kip = P.KIB + ((size_t)b * SEQ + kc * 256 + fr) * 64 + 8 * fq;
        bf16x8 a0 = *(const bf16x8*)kip, a1 = *(const bf16x8*)(kip + 32);
        for (int kt = 0; kt < nkt; ++kt) { const int sk = kc * 256 + kt * 16; const bf16x8 c0 = a0, c1 = a1;
            if (kt + 1 < nkt) { a0 = *(const bf16x8*)(kip + (size_t)(kt + 1) * 16 * 64); a1 = *(const bf16x8*)(kip + (size_t)(kt + 1) * 16 * 64 + 32); }
            f32x4 sc = (f32x4){0.f, 0.f, 0.f, 0.f};
#pragma unroll
            for (int hh = 0; hh < 8; ++hh) { f32x4 acc = MFMA16(c0, qf[hh][0], ((f32x4){0.f, 0.f, 0.f, 0.f})); acc = MFMA16(c1, qf[hh][1], acc);
                sc.x += wq[hh] * fmaxf(acc.x, 0.f); sc.y += wq[hh] * fmaxf(acc.y, 0.f); sc.z += wq[hh] * fmaxf(acc.z, 0.f); sc.w += wq[hh] * fmaxf(acc.w, 0.f); }
            *(f32x4*)(P.ISC + rowq * 2048 + sk + 4 * fq) = sc; }
    }
}
__device__ __forceinline__ unsigned fkey(float f) { const unsigned u = __float_as_uint(f); return (u & 0x80000000u) ? ~u : (u | 0x80000000u); }
template <int NJ> __device__ __forceinline__ void select_row(const float* isc, unsigned long long* mo, int t, int lane) {
    unsigned key[NJ];
#pragma unroll
    for (int j = 0; j < NJ; ++j) { const int s = 64 * j + lane; const float x = (s <= t) ? isc[s] : 0.f; key[j] = (s <= t) ? fkey(x) : 0u; }
    unsigned T = 0u;
    for (int bit = 31; bit >= 0; --bit) { const unsigned cand = T | (1u << bit); int cnt = 0;
#pragma unroll
        for (int j = 0; j < NJ; ++j) cnt += __popcll(__ballot(key[j] >= cand));
        if (cnt >= 256) T = cand; }
    int cgt = 0;
#pragma unroll
    for (int j = 0; j < NJ; ++j) cgt += __popcll(__ballot(key[j] > T));
    const int need = 256 - cgt; int run = 0; const unsigned long long lt = (lane == 0) ? 0ull : (~0ull >> (64 - lane));
#pragma unroll
    for (int j = 0; j < 32; ++j) { unsigned long long m = 0ull;
        if (j < NJ) { const unsigned long long eq = __ballot(key[j] == T); const int before = run + __popcll(eq & lt); const bool sel = (key[j] > T) || (key[j] == T && before < need); m = __ballot(sel); run += __popcll(eq); }
        if (lane == 0) mo[j] = m; }
}
template <int NJ> __device__ __forceinline__ void select_hist(const float* isc, unsigned long long* mo, int t, int lane, LAS unsigned* hist  , LAS float* cand  ) {
    float x[NJ]; int bn[NJ];
    float mn = INFINITY, mxv = -INFINITY;
#pragma unroll
    for (int j = 0; j < NJ; ++j) { const int s = 64 * j + lane; const bool v = s <= t; x[j] = v ? isc[s] : 0.f; mn = fminf(mn, v ? x[j] : INFINITY); mxv = fmaxf(mxv, v ? x[j] : -INFINITY); }
    mn = -wave_max(-mn); mxv = wave_max(mxv);
    const float range = mxv - mn; const bool ok = (range > 0.f) && (range < 3.0e38f);
    const float scale = ok ? 2047.0f / range : 0.f;
#pragma unroll
    for (int j = 0; j < NJ; ++j) { const int s = 64 * j + lane; const bool v = s <= t; int b = (int)((x[j] - mn) * scale); b = b > 2047 ? 2047 : b; b = v ? b : 0; bn[j] = v ? b : -1;
        __hip_atomic_fetch_add(hist + b + (b >> 5), v ? 1u : 0u, __ATOMIC_RELAXED, __HIP_MEMORY_SCOPE_WORKGROUP); }
    unsigned hb[32]; unsigned ls = 0u;
#pragma unroll
    for (int k = 0; k < 32; ++k) { hb[k] = hist[33 * lane + k]; ls += hb[k]; }
    unsigned suf = ls;
#pragma unroll
    for (int o = 1; o < 64; o <<= 1) { const unsigned tt = __shfl_down(suf, o); suf += (lane + o < 64) ? tt : 0u; }
    const unsigned long long lm = __ballot(suf >= 256u);
    const int L = 63 - __builtin_clzll(lm);
    unsigned c = suf - ls; int Bl = 0; unsigned cal = 0u, hB = 0u; bool found = false;
#pragma unroll
    for (int k = 31; k >= 0; --k) { const bool hit = !found && (c + hb[k] >= 256u); Bl = hit ? 32 * lane + k : Bl; cal = hit ? c : cal; hB = hit ? hb[k] : hB; found = found || hit; c += found ? 0u : hb[k]; }
    const int B = __shfl(Bl, L); const unsigned cab = __shfl(cal, L), nB = __shfl(hB, L); const int need = 256 - (int)cab;
#pragma unroll
    for (int j = 0; j < NJ; ++j) { const int b = bn[j] < 0 ? 0 : bn[j]; hist[b + (b >> 5)] = 0u; }
    if (!ok || nB > 64u) { select_row<NJ>(isc, mo, t, lane); return; }
    float Ts = -INFINITY; int Is = 0x7fffffff;
    if ((unsigned)need < nB) {
        int run = 0; const unsigned long long lt = (lane == 0) ? 0ull : (~0ull >> (64 - lane));
#pragma unroll
        for (int j = 0; j < NJ; ++j) { const unsigned long long m = __ballot(bn[j] == B); if (m) { if (bn[j] == B) { const int pos = run + __popcll(m & lt); cand[pos] = x[j]; cand[64 + pos] = __int_as_float(64 * j + lane); } run += __popcll(m); } }
        const float xi = (lane < (int)nB) ? cand[lane] : 0.f; const int si = (lane < (int)nB) ? __float_as_int(cand[64 + lane]) : 0; int rank = 0;
        for (int k = 0; k < (int)nB; ++k) { const float xk = cand[k]; const int sk = __float_as_int(cand[64 + k]); rank += (xk > xi || (xk == xi && sk < si)) ? 1 : 0; }
        const unsigned long long wm = __ballot(lane < (int)nB && rank == need - 1); const int src = __builtin_ctzll(wm);
        Ts = __shfl(xi, src); Is = __shfl(si, src);
    }
#pragma unroll
    for (int j = 0; j < 32; ++j) { unsigned long long m = 0ull;
        if (j < NJ) { const int s = 64 * j + lane; const bool sel = (bn[j] > B) || (bn[j] == B && (x[j] > Ts || (x[j] == Ts && s <= Is))); m = __ballot(sel); }
        if (lane == 0) mo[j] = m; }
}
__device__ __forceinline__ void dsa_select(Frame& F, const EvenPtrs& P) {
    const int lane = F.lane;
    LAS unsigned* hist = (LAS unsigned*)(F.lds + F.wave * 9216); LAS float* cand = (LAS float*)(F.lds + F.wave * 9216 + 8448);
    for (int i = lane; i < 2112; i += 64) hist[i] = 0u;
    for (int idx = F.gw; idx < M; idx += F.NGW) {
        const int k = idx >> 11, gwid = idx & 2047, t = (k & 1) ? 2047 - gwid : gwid; const size_t row = (size_t)k * SEQ + t; const int n = t + 1;
        unsigned long long* mo = (unsigned long long*)(P.MASK + row * 64); const float* isc = P.ISC + row * 2048;
        if (n <= 256) {
#pragma unroll
            for (int j = 0; j < 32; ++j) { const unsigned long long m = __ballot(64 * j + lane <= t); if (lane == 0) mo[j] = m; }
        } else if (n <= 512) select_hist<8>(isc, mo, t, lane, hist, cand);
        else if (n <= 1024) select_hist<16>(isc, mo, t, lane, hist, cand);
        else if (n <= 1536) select_hist<24>(isc, mo, t, lane, hist, cand);
        else select_hist<32>(isc, mo, t, lane, hist, cand);
    }
}
__device__ __forceinline__ void dsa_attn(Frame& F, const EvenPtrs& P) {
    bf16* Kl = (bf16*)F.gl; bf16* Vl = (bf16*)(F.gl + 18432); float* btl = (float*)(F.gl + 41472); float* mtl = (float*)(F.gl + 41984);
    const int tid = F.tid, lane = F.lane, w = F.wave, fr = lane & 15, fq = lane >> 4, lrow = tid >> 3, lch = tid & 7;
    for (int i = tid; i < 2 * 16 * 64; i += 512) { const int bufi = i >> 10, r = (i >> 6) & 15, cc = i & 63; Vl[bufi * 5760 + (64 + r) * 72 + cc] = (r == 0) ? (bf16)0x3f80u : (bf16)0; }
    if (tid < 64) mtl[tid] = ((tid >> 2) >> (tid & 3)) & 1 ? 1.0f : 0.0f;
    for (int vu = F.bid; vu < 256; vu += F.G) {
        const int bh = vu >> 2, s4 = vu & 3, b = bh >> 3, hh = bh & 7;
        for (int iu = 0; iu < 2; ++iu) {
            const int qb = (iu == 0) ? s4 : 7 - s4;
            const int t0 = qb * 256, tw = t0 + 32 * w;
            bf16x8 qf[2][2]; const v2u* mrow[2];
#pragma unroll
            for (int cb = 0; cb < 2; ++cb) { const size_t rowq = (size_t)b * SEQ + tw + 16 * cb + fr; mrow[cb] = (const v2u*)(P.MASK + rowq * 64);
              const v4u w0 = *(const v4u*)(P.BQ + rowq * 512 + hh * 64 + 8 * fq), w1 = *(const v4u*)(P.BQ + rowq * 512 + hh * 64 + 32 + 8 * fq);
              float x[16] = {bflo(w0.x), bfhi(w0.x), bflo(w0.y), bfhi(w0.y), bflo(w0.z), bfhi(w0.z), bflo(w0.w), bfhi(w0.w), bflo(w1.x), bfhi(w1.x), bflo(w1.y), bfhi(w1.y), bflo(w1.z), bfhi(w1.z), bflo(w1.w), bfhi(w1.w)};
              float ss = 0.f;
#pragma unroll
              for (int j = 0; j < 16; ++j) ss += x[j] * x[j];
              ss += __shfl_xor(ss, 16); ss += __shfl_xor(ss, 32);
              const float r = rsqrtf(ss * (1.0f / 64.0f) + 1e-6f) * (0.125f * LOG2E);
              const f32x4 g0 = *(const f32x4*)(P.gq + 8 * fq), g1 = *(const f32x4*)(P.gq + 8 * fq + 4), g2 = *(const f32x4*)(P.gq + 32 + 8 * fq), g3 = *(const f32x4*)(P.gq + 32 + 8 * fq + 4);
              v4u q0, q1; q0.x = pk2(x[0] * r * g0.x, x[1] * r * g0.y); q0.y = pk2(x[2] * r * g0.z, x[3] * r * g0.w); q0.z = pk2(x[4] * r * g1.x, x[5] * r * g1.y); q0.w = pk2(x[6] * r * g1.z, x[7] * r * g1.w);
              q1.x = pk2(x[8] * r * g2.x, x[9] * r * g2.y); q1.y = pk2(x[10] * r * g2.z, x[11] * r * g2.w); q1.z = pk2(x[12] * r * g3.x, x[13] * r * g3.y); q1.w = pk2(x[14] * r * g3.z, x[15] * r * g3.w);
              qf[cb][0] = __builtin_bit_cast(bf16x8, q0); qf[cb][1] = __builtin_bit_cast(bf16x8, q1); }
            if (tid < 128) btl[tid] = P.bt[hh * 128 + tid] - P.bt[hh * 128 + 127];
            const int nk = 4 * qb + 4;
            const bf16* kg = P.KB + ((size_t)b * SEQ + lrow) * 64 + lch * 8;
            const bf16* vg = P.VT + ((size_t)(b * 8 + hh) * 64 + lrow) * 2048 + lch * 8;
            v4u kreg = *(const v4u*)kg, vreg = *(const v4u*)vg; v2u mnext[2] = {mrow[0][0], mrow[1][0]};
            *(v4u*)(Kl + lrow * 72 + lch * 8) = kreg; *(v4u*)(Vl + lrow * 72 + lch * 8) = vreg;
            __syncthreads();
            f32x4 o[2][5];
#pragma unroll
            for (int cb = 0; cb < 2; ++cb)
#pragma unroll
                for (int dt = 0; dt < 5; ++dt) o[cb][dt] = (f32x4){0.f, 0.f, 0.f, 0.f};
            float mrun[2] = {0.f, 0.f}; bool first = true;
            for (int kt = 0; kt < nk; ++kt) {
                const int s0 = kt * 64; const bf16* Kb = Kl + (kt & 1) * 4608; const bf16* Vb = Vl + (kt & 1) * 5760; const v2u mw[2] = {mnext[0], mnext[1]};
                if (kt + 1 < nk) { kreg = *(const v4u*)(kg + (size_t)(s0 + 64) * 64); vreg = *(const v4u*)(vg + s0 + 64); mnext[0] = mrow[0][kt + 1]; mnext[1] = mrow[1][kt + 1]; }
                if (s0 <= tw + 31) {
                    f32x4 acc[2][4];
#pragma unroll
                    for (int cb = 0; cb < 2; ++cb) { const f32x4 cin = (f32x4){-mrun[cb], -mrun[cb], -mrun[cb], -mrun[cb]};
#pragma unroll
                        for (int st = 0; st < 4; ++st) acc[cb][st] = cin; }
#pragma unroll
                    for (int st = 0; st < 4; ++st) { const bf16x8 a0 = *(const bf16x8*)(Kb + (16 * st + fr) * 72 + 8 * fq), a1 = *(const bf16x8*)(Kb + (16 * st + fr) * 72 + 32 + 8 * fq);
#pragma unroll
                        for (int cb = 0; cb < 2; ++cb) { acc[cb][st] = MFMA16(a0, qf[cb][0], acc[cb][st]); acc[cb][st] = MFMA16(a1, qf[cb][1], acc[cb][st]); } }
                    bf16x8 pf[2][2]; bool resc = false; float mxs[2];
#pragma unroll
                    for (int cb = 0; cb < 2; ++cb) { const int tb = tw + 16 * cb, t = tb + fr;
                        if ((tb - (s0 + 63)) < 113) {
#pragma unroll
                            for (int st = 0; st < 4; ++st)
#pragma unroll
                                for (int r = 0; r < 4; ++r) { int dist = t - (s0 + 16 * st + 4 * fq + r); dist = dist < 0 ? 0 : (dist > 127 ? 127 : dist); acc[cb][st][r] += btl[dist]; } }
                        float mx = fmaxf(fmaxf(fmaxf(acc[cb][0].x, acc[cb][0].y), fmaxf(acc[cb][0].z, acc[cb][0].w)), fmaxf(fmaxf(acc[cb][1].x, acc[cb][1].y), fmaxf(acc[cb][1].z, acc[cb][1].w)));
                        mx = fmaxf(mx, fmaxf(fmaxf(fmaxf(acc[cb][2].x, acc[cb][2].y), fmaxf(acc[cb][2].z, acc[cb][2].w)), fmaxf(fmaxf(acc[cb][3].x, acc[cb][3].y), fmaxf(acc[cb][3].z, acc[cb][3].w))));
                        mx = fmaxf(mx, __shfl_xor(mx, 16)); mx = fmaxf(mx, __shfl_xor(mx, 32)); mxs[cb] = mx; resc = resc || (mx > 8.0f); }
                    if (first || __any(resc)) {
#pragma unroll
                        for (int cb = 0; cb < 2; ++cb) { const float dl = first ? mxs[cb] : fmaxf(mxs[cb], 0.f); mrun[cb] += dl; const float alpha = first ? 1.0f : __builtin_amdgcn_exp2f(-dl);
#pragma unroll
                            for (int st = 0; st < 4; ++st) acc[cb][st] = acc[cb][st] - dl;
#pragma unroll
                            for (int dt = 0; dt < 5; ++dt) o[cb][dt] = o[cb][dt] * alpha; }
                        first = false; }
#pragma unroll
                    for (int cb = 0; cb < 2; ++cb)
#pragma unroll
                        for (int kk = 0; kk < 2; ++kk) { const unsigned mword = (kk == 0) ? mw[cb].x : mw[cb].y;
                            const f32x4 m0 = *(const f32x4*)(mtl + 4 * ((mword >> (4 * fq)) & 15u)), m1 = *(const f32x4*)(mtl + 4 * ((mword >> (16 + 4 * fq)) & 15u));
                            const f32x4 a = acc[cb][2 * kk], c = acc[cb][2 * kk + 1];
                            v4u pw; pw.x = pk2(__builtin_amdgcn_exp2f(a.x) * m0.x, __builtin_amdgcn_exp2f(a.y) * m0.y); pw.y = pk2(__builtin_amdgcn_exp2f(a.z) * m0.z, __builtin_amdgcn_exp2f(a.w) * m0.w);
                            pw.z = pk2(__builtin_amdgcn_exp2f(c.x) * m1.x, __builtin_amdgcn_exp2f(c.y) * m1.y); pw.w = pk2(__builtin_amdgcn_exp2f(c.z) * m1.z, __builtin_amdgcn_exp2f(c.w) * m1.w);
                            pf[cb][kk] = __builtin_bit_cast(bf16x8, pw); }
#pragma unroll
                    for (int dt = 0; dt < 5; ++dt)
#pragma unroll
                        for (int kk = 0; kk < 2; ++kk) { const bf16* vp = Vb + (16 * dt + fr) * 72 + 32 * kk + 4 * fq; const v2u lo = *(const v2u*)vp, hi = *(const v2u*)(vp + 16);
                            v4u vv; vv.x = lo.x; vv.y = lo.y; vv.z = hi.x; vv.w = hi.y; const bf16x8 vf = __builtin_bit_cast(bf16x8, vv);
                            o[0][dt] = MFMA16(vf, pf[0][kk], o[0][dt]); o[1][dt] = MFMA16(vf, pf[1][kk], o[1][dt]); }
                }
                if (kt + 1 < nk) { *(v4u*)(Kl + ((kt + 1) & 1) * 4608 + lrow * 72 + lch * 8) = kreg; *(v4u*)(Vl + ((kt + 1) & 1) * 5760 + lrow * 72 + lch * 8) = vreg; }
                __syncthreads();
            }
#pragma unroll
            for (int cb = 0; cb < 2; ++cb) { const size_t rowq = (size_t)b * SEQ + tw + 16 * cb + fr; const float linv = 1.0f / __shfl(o[cb][4].x, fr);
#pragma unroll
                for (int dt = 0; dt < 4; ++dt) { v2u wv; wv.x = pk2(o[cb][dt].x * linv, o[cb][dt].y * linv); wv.y = pk2(o[cb][dt].z * linv, o[cb][dt].w * linv); *(v2u*)(P.MIX + rowq * 1024 + 512 + hh * 64 + 16 * dt + 4 * fq) = wv; } }
        }
    }
}
__device__ __forceinline__ void pool_fused(Frame& F, const bf16* HBi, bf16* HBo, const float* statsR, float* statsW, const float* gmix, const bf16* Wp  , const float* scale) {
    bf16* HT = (bf16*)F.gl; bf16* PT = (bf16*)(F.gl + 41712); float* rl = (float*)(F.gl + 75504); float* sq = (float*)(F.gl + 75824);
    const int tid = F.tid, lane = F.lane, w = F.wave, fr = lane & 15, fq = lane >> 4;
    for (int u = F.bid; u < (M / 64) * 4; u += F.G) {
        const int tile = u >> 2, g = ((u & 3) + (u >> 8)) & 3, row0 = tile * 64, tpos0 = row0 & 2047, win = 2 << g;
        for (int i = tid; i < 79 * 32; i += 512) { const int rr = i >> 5, ch = (i & 31) * 8; v4u v = (v4u){0u, 0u, 0u, 0u};
            if (tpos0 - 15 + rr >= 0) v = *(const v4u*)(HBi + (size_t)(row0 - 15 + rr) * DM + g * 256 + ch);
            *(v4u*)(HT + rr * 264 + ch) = v; }
        bf16x8 af[8][2];
#pragma unroll
        for (int ks = 0; ks < 8; ++ks)
#pragma unroll
            for (int oi = 0; oi < 2; ++oi) af[ks][oi] = *(const bf16x8*)(Wp + ((size_t)g * 256 + 16 * (2 * w + oi) + fr) * 256 + 8 * fq + 32 * ks);
        if (tid < 79) { float r = 0.f;
            if (tpos0 - 15 + tid >= 0) { const f32x4* p = (const f32x4*)(statsR + (size_t)(row0 - 15 + tid) * 16); const f32x4 a = p[0], b = p[1], c = p[2], d2 = p[3];
                const float s = (((a.x + a.y) + (a.z + a.w)) + ((b.x + b.y) + (b.z + b.w))) + (((c.x + c.y) + (c.z + c.w)) + ((d2.x + d2.y) + (d2.z + d2.w))); r = rsqrtf(s * (1.0f / 1024.0f) + 1e-6f); }
            rl[tid] = r; }
        __syncthreads();
        { const int cg = tid & 31, t4 = (tid >> 5) * 4, c0 = cg * 8; const f32x4 g0 = *(const f32x4*)(gmix + g * 256 + c0), g1 = *(const f32x4*)(gmix + g * 256 + c0 + 4);
          float S[8] = {0.f, 0.f, 0.f, 0.f, 0.f, 0.f, 0.f, 0.f};
          for (int j = 1; j < win; ++j) if (tpos0 + t4 - j >= 0) { f32x4 a, b; pg8::unpack8(*(const v4u*)(HT + (15 + t4 - j) * 264 + c0), a, b); const float r = rl[15 + t4 - j];
              S[0] += a.x * r; S[1] += a.y * r; S[2] += a.z * r; S[3] += a.w * r; S[4] += b.x * r; S[5] += b.y * r; S[6] += b.z * r; S[7] += b.w * r; }
#pragma unroll
          for (int i = 0; i < 4; ++i) { const int tok = t4 + i, tpos = tpos0 + tok, n = (tpos + 1 < win) ? tpos + 1 : win;
              f32x4 a, b; pg8::unpack8(*(const v4u*)(HT + (15 + tok) * 264 + c0), a, b); const float r = rl[15 + tok];
              const float y[8] = {a.x * r, a.y * r, a.z * r, a.w * r, b.x * r, b.y * r, b.z * r, b.w * r};
#pragma unroll
              for (int q = 0; q < 8; ++q) S[q] += y[q];
              const float inv = __builtin_amdgcn_rcpf((float)n);
              v4u o; o.x = pk2((S[0] * inv - y[0]) * g0.x, (S[1] * inv - y[1]) * g0.y); o.y = pk2((S[2] * inv - y[2]) * g0.z, (S[3] * inv - y[3]) * g0.w);
              o.z = pk2((S[4] * inv - y[4]) * g1.x, (S[5] * inv - y[5]) * g1.y); o.w = pk2((S[6] * inv - y[6]) * g1.z, (S[7] * inv - y[7]) * g1.w);
              *(v4u*)(PT + tok * 264 + c0) = o;
              const int dep = tok - (win - 1);
              if (tpos0 + dep >= 0) { f32x4 da, db; pg8::unpack8(*(const v4u*)(HT + (15 + dep) * 264 + c0), da, db); const float dr = rl[15 + dep];
                  S[0] -= da.x * dr; S[1] -= da.y * dr; S[2] -= da.z * dr; S[3] -= da.w * dr; S[4] -= db.x * dr; S[5] -= db.y * dr; S[6] -= db.z * dr; S[7] -= db.w * dr; } } }
        __syncthreads();
        { f32x4 acc[2][4]; float ssq[4] = {0.f, 0.f, 0.f, 0.f};
#pragma unroll
          for (int oi = 0; oi < 2; ++oi)
#pragma unroll
              for (int tt = 0; tt < 4; ++tt) acc[oi][tt] = (f32x4){0.f, 0.f, 0.f, 0.f};
#pragma unroll
          for (int ks = 0; ks < 8; ++ks) { bf16x8 bfv[4];
#pragma unroll
              for (int tt = 0; tt < 4; ++tt) bfv[tt] = *(const bf16x8*)(PT + (16 * tt + fr) * 264 + 8 * fq + 32 * ks);
#pragma unroll
              for (int oi = 0; oi < 2; ++oi)
#pragma unroll
                  for (int tt = 0; tt < 4; ++tt) acc[oi][tt] = MFMA16(af[ks][oi], bfv[tt], acc[oi][tt]); }
#pragma unroll
          for (int oi = 0; oi < 2; ++oi) { const int cl = 16 * (2 * w + oi) + 4 * fq; const f32x4 sc = *(const f32x4*)(scale + g * 256 + cl);
#pragma unroll
              for (int tt = 0; tt < 4; ++tt) { const int tok = 16 * tt + fr; const v2u hw = *(const v2u*)(HT + (15 + tok) * 264 + cl);
                  const float h0 = bflo(hw.x) + sc.x * acc[oi][tt].x, h1 = bfhi(hw.x) + sc.y * acc[oi][tt].y, h2 = bflo(hw.y) + sc.z * acc[oi][tt].z, h3 = bfhi(hw.y) + sc.w * acc[oi][tt].w;
                  ssq[tt] += (h0 * h0 + h1 * h1) + (h2 * h2 + h3 * h3);
                  v2u o; o.x = pk2(h0, h1); o.y = pk2(h2, h3); *(v2u*)(HBo + (size_t)(row0 + tok) * DM + g * 256 + cl) = o; } }
#pragma unroll
          for (int tt = 0; tt < 4; ++tt) { float s = ssq[tt]; s += __shfl_xor(s, 16); s += __shfl_xor(s, 32); if (fq == 0) sq[(16 * tt + fr) * 8 + w] = s; } }
        __syncthreads();
        if (tid < 64) { const f32x4 a = *(const f32x4*)(sq + tid * 8), b = *(const f32x4*)(sq + tid * 8 + 4); const float s = ((a.x + a.y) + (a.z + a.w)) + ((b.x + b.y) + (b.z + b.w));
            *(f32x4*)(statsW + (size_t)(row0 + tid) * 16 + 4 * g) = (f32x4){s, 0.f, 0.f, 0.f}; }
        __syncthreads();
    }
}
struct RoutePtrs { int* TOKE; float* TOKG; float* TOKR; int* CNT; int* ROWTS; float* ROWG; float* ROWR; int* TILEE; int* NT; int* EXPB; int* EXPN; int* TOKPOS; int* LT; int* TOKLT; };
__device__ __forceinline__ RoutePtrs route_ptrs(unsigned char* ws) { unsigned char* r = ws + WS_ROUTE; RoutePtrs p;
    p.TOKE = (int*)(r + RT_TOKE); p.TOKG = (float*)(r + RT_TOKG); p.TOKR = (float*)(r + RT_TOKR); p.CNT = (int*)(r + RT_CNT); p.ROWTS = (int*)(r + RT_ROWTS); p.ROWG = (float*)(r + RT_ROWG); p.ROWR = (float*)(r + RT_ROWR);
    p.TILEE = (int*)(r + RT_TILEE); p.NT = (int*)(r + RT_NT); p.EXPB = p.NT + 16; p.EXPN = p.NT + 32; p.TOKPOS = (int*)(r + RT_TOKPOS); p.LT = (int*)(r + RT_LT); p.TOKLT = (int*)(r + RT_LT + 4096); return p; }
__device__ __forceinline__ void moe_route(Frame& F, const RoutePtrs& R, const bf16* HB, const float* gffn, const float* wr, const float* br) {
    int* cnt = (int*)F.gl; const int lane = F.lane;
    float wreg[16][8];
#pragma unroll
    for (int j = 0; j < 4; ++j) { const int c0 = 4 * lane + 256 * j; const f32x4 g = *(const f32x4*)(gffn + c0); const float gg[4] = {g.x, g.y, g.z, g.w};
#pragma unroll
        for (int q = 0; q < 4; ++q) { const f32x4 w0 = *(const f32x4*)(wr + (size_t)(c0 + q) * 8), w1 = *(const f32x4*)(wr + (size_t)(c0 + q) * 8 + 4);
            wreg[4 * j + q][0] = w0.x * gg[q]; wreg[4 * j + q][1] = w0.y * gg[q]; wreg[4 * j + q][2] = w0.z * gg[q]; wreg[4 * j + q][3] = w0.w * gg[q];
            wreg[4 * j + q][4] = w1.x * gg[q]; wreg[4 * j + q][5] = w1.y * gg[q]; wreg[4 * j + q][6] = w1.z * gg[q]; wreg[4 * j + q][7] = w1.w * gg[q]; } }
    const int myexp = ((lane >> 5) & 1) * 4 + ((lane >> 4) & 1) * 2 + ((lane >> 3) & 1); const float mybias = br[myexp];
    for (int tile = F.bid; tile < M / 64; tile += F.G) {
        if (F.tid < 8) cnt[F.tid] = 0;
        __syncthreads();
        for (int ib = 0; ib < 2; ++ib) {
            f32x4 v[4][4];
#pragma unroll
            for (int i = 0; i < 4; ++i) { const v2u* hr = (const v2u*)(HB + (size_t)(tile * 64 + F.wave * 8 + ib * 4 + i) * DM) + lane;
#pragma unroll
                for (int j = 0; j < 4; ++j) { const v2u hw = hr[64 * j]; v[i][j] = (f32x4){bflo(hw.x), bfhi(hw.x), bflo(hw.y), bfhi(hw.y)}; } }
#pragma unroll
            for (int i = 0; i < 4; ++i) { const int row = tile * 64 + F.wave * 8 + ib * 4 + i; float ss = 0.f; float lg[8] = {0.f, 0.f, 0.f, 0.f, 0.f, 0.f, 0.f, 0.f};
#pragma unroll
                for (int j = 0; j < 4; ++j) { const float y[4] = {v[i][j].x, v[i][j].y, v[i][j].z, v[i][j].w};
#pragma unroll
                    for (int q = 0; q < 4; ++q) { ss += y[q] * y[q];
#pragma unroll
                        for (int e = 0; e < 8; ++e) lg[e] += y[q] * wreg[4 * j + q][e]; } }
                ss = wave_sum(ss); const float r = rsqrtf(ss * (1.0f / 1024.0f) + 1e-6f);
                float a4[4];
#pragma unroll
                for (int e = 0; e < 4; ++e) { const bool hi = (lane & 32) != 0; const float keep = hi ? lg[e + 4] : lg[e], send = hi ? lg[e] : lg[e + 4]; a4[e] = keep + __shfl_xor(send, 32); }
                float a2[2];
#pragma unroll
                for (int e = 0; e < 2; ++e) { const bool hi = (lane & 16) != 0; const float keep = hi ? a4[e + 2] : a4[e], send = hi ? a4[e] : a4[e + 2]; a2[e] = keep + __shfl_xor(send, 16); }
                float a1; { const bool hi = (lane & 8) != 0; const float keep = hi ? a2[1] : a2[0], send = hi ? a2[0] : a2[1]; a1 = keep + __shfl_xor(send, 8); }
                a1 += __shfl_xor(a1, 4); a1 += __shfl_xor(a1, 2); a1 += __shfl_xor(a1, 1);
                const float mylogit = a1 * r + mybias;
                float l8[8];
#pragma unroll
                for (int e = 0; e < 8; ++e) l8[e] = __shfl(mylogit, 32 * (e >> 2) + 16 * ((e >> 1) & 1) + 8 * (e & 1));
                int e1 = 0; float v1 = l8[0];
#pragma unroll
                for (int e = 1; e < 8; ++e) if (l8[e] > v1) { v1 = l8[e]; e1 = e; }
                int e2 = -1; float v2 = -INFINITY;
#pragma unroll
                for (int e = 0; e < 8; ++e) if (e != e1 && l8[e] > v2) { v2 = l8[e]; e2 = e; }
                const float ex = __expf(v2 - v1), g1 = 1.0f / (1.0f + ex), g2 = ex * g1;
                if (lane == 0) { R.TOKE[row] = e1 | (e2 << 8); R.TOKG[row * 2] = g1; R.TOKG[row * 2 + 1] = g2; R.TOKR[row] = r; atomicAdd(&cnt[e1], 1); atomicAdd(&cnt[e2], 1); } }
        }
        __syncthreads();
        if (F.tid < 8) R.CNT[tile * 8 + F.tid] = cnt[F.tid];
        __syncthreads();
    }
}
__device__ __forceinline__ void moe_scatter(Frame& F, const RoutePtrs& R, const bf16* HB, bf16* YG) {
    int* sm = (int*)F.gl;
    for (int tile = F.bid; tile < M / 64; tile += F.G) {
        if (F.tid < 16) sm[F.tid] = 0;
        __syncthreads();
        for (int i = F.tid; i < (M / 64) * 8; i += 512) { const int v = R.CNT[i]; atomicAdd(&sm[i & 7], v); if ((i >> 3) < tile) atomicAdd(&sm[8 + (i & 7)], v); }
        __syncthreads();
        if (F.tid == 0) { int base = 0; for (int e = 0; e < 8; ++e) { sm[16 + e] = base; base += (sm[e] + 255) & ~255; } sm[24] = base >> 8; }
        __syncthreads();
        if (F.wave == 0) { const int row = tile * 64 + F.lane, te = R.TOKE[row], e1 = te & 255, e2 = te >> 8; int p1 = 0, p2 = 0; const unsigned long long lt = (F.lane == 0) ? 0ull : (~0ull >> (64 - F.lane));
#pragma unroll
            for (int e = 0; e < 8; ++e) { const unsigned long long m1 = __ballot(e1 == e), m2 = __ballot(e2 == e); const int rk = __popcll(m1 & lt) + __popcll(m2 & lt), bs = sm[16 + e] + sm[8 + e];
                if (e1 == e) p1 = bs + rk; if (e2 == e) p2 = bs + rk; }
            const float r = R.TOKR[row]; R.ROWTS[p1] = row * 2; R.ROWTS[p2] = row * 2 + 1; R.ROWG[p1] = R.TOKG[row * 2]; R.ROWG[p2] = R.TOKG[row * 2 + 1]; R.ROWR[p1] = r; R.ROWR[p2] = r;
            sm[32 + 2 * F.lane] = p1; sm[33 + 2 * F.lane] = p2; R.TOKPOS[row * 2] = p1; R.TOKPOS[row * 2 + 1] = p2; }
        __syncthreads();
        for (int i = 0; i < 16; ++i) { const int cp = F.wave * 16 + i, tok = cp >> 1, pos = sm[32 + cp]; const v4u* src = (const v4u*)(HB + (size_t)(tile * 64 + tok) * DM); v4u* dst = (v4u*)(YG + (size_t)pos * DM);
            dst[F.lane] = src[F.lane]; dst[64 + F.lane] = src[64 + F.lane]; }
        if (tile == 0) {
            for (int e = 0; e < 8; ++e) { const int lo = sm[16 + e] + sm[e], hi = sm[16 + e] + ((sm[e] + 255) & ~255);
                for (int p = lo + F.tid; p < hi; p += 512) { R.ROWTS[p] = -1; R.ROWG[p] = 0.f; R.ROWR[p] = 0.f; }
                for (int t2 = (sm[16 + e] >> 8) + F.tid; t2 < (hi >> 8); t2 += 512) R.TILEE[t2] = e; }
            if (F.tid == 0) R.NT[0] = sm[24];
            if (F.tid < 8) { R.EXPB[F.tid] = sm[16 + F.tid] >> 8; R.EXPN[F.tid] = (sm[F.tid] + 255) >> 8; }
            for (int t2 = F.tid; t2 < 136; t2 += 512) R.LT[48 + t2] = -1;
            __syncthreads();
            if (F.tid == 0) { int nl = 0; for (int e = 0; e < 8; ++e) { const int nrt = (sm[e] + 255) >> 8; nl += nrt > 16 ? nrt - 16 : 0; } const bool use = (F.G == 256) && nl <= 16; int tl = 0;
                for (int e = 0; e < 8; ++e) { const int nrt = (sm[e] + 255) >> 8, nmain = (use && nrt > 16) ? 16 : nrt; R.LT[40 + e] = nmain;
                    for (int q = nmain; q < nrt; ++q) { const int rt = (sm[16 + e] >> 8) + q; R.LT[tl] = rt; R.LT[16 + tl] = e; R.LT[48 + rt] = tl; ++tl; } }
                R.LT[32] = tl; } }
        __syncthreads();
    }
}
__device__ __forceinline__ void moe_combine(Frame& F, const RoutePtrs& R, const bf16* D0, const bf16* D1, const float* PART, bf16* HB, float* stats) {
    for (int m = F.gw; m < M; m += F.NGW) { v2u* o8 = (v2u*)(HB + (size_t)m * DM) + F.lane; const v2u* a = (const v2u*)(D0 + (size_t)m * DM) + F.lane; const v2u* b = (const v2u*)(D1 + (size_t)m * DM) + F.lane;
        float s = 0.f; v2u hv[4], x[2][4]; f32x4 add[2][4];
        const int pos0 = R.TOKPOS[m * 2], pos1 = R.TOKPOS[m * 2 + 1];
#pragma unroll
        for (int j = 0; j < 4; ++j) { hv[j] = o8[64 * j]; x[0][j] = a[64 * j]; x[1][j] = b[64 * j]; }
        const int tl0 = __builtin_amdgcn_readfirstlane(R.LT[48 + (pos0 >> 8)]), tl1 = __builtin_amdgcn_readfirstlane(R.LT[48 + (pos1 >> 8)]);
#pragma unroll
        for (int sl = 0; sl < 2; ++sl) { const int tl = sl ? tl1 : tl0, pos = __builtin_amdgcn_readfirstlane(sl ? pos1 : pos0);
#pragma unroll
            for (int j = 0; j < 4; ++j) add[sl][j] = (f32x4){bflo(x[sl][j].x), bfhi(x[sl][j].x), bflo(x[sl][j].y), bfhi(x[sl][j].y)};
            if (tl >= 0) { const float g = R.TOKG[m * 2 + sl]; const f32x4* pp = (const f32x4*)(PART + ((size_t)(tl * 7) * 256 + (pos & 255)) * 1024) + F.lane;
#pragma unroll
                for (int j = 0; j < 4; ++j) { f32x4 acc = pp[64 * j];
#pragma unroll
                    for (int kc = 1; kc < 7; ++kc) acc = acc + pp[(size_t)kc * 256 * 256 + 64 * j];
                    add[sl][j] = acc * g; } } }
#pragma unroll
        for (int j = 0; j < 4; ++j) { f32x4 v; v.x = bflo(hv[j].x) + add[0][j].x + add[1][j].x; v.y = bfhi(hv[j].x) + add[0][j].y + add[1][j].y; v.z = bflo(hv[j].y) + add[0][j].z + add[1][j].z; v.w = bfhi(hv[j].y) + add[0][j].w + add[1][j].w;
            s += (v.x * v.x + v.y * v.y) + (v.z * v.z + v.w * v.w); v2u w; w.x = pk2(v.x, v.y); w.y = pk2(v.z, v.w); o8[64 * j] = w; }
        s = wave_sum(s);
        if (F.lane < 16) stats[(size_t)m * 16 + F.lane] = (F.lane == 0) ? s : 0.f; }
}
constexpr int N_PHASES = 35;
static_assert(WS_VB == WS_QK + 32 * MiB && WS_OG == WS_VB + 16 * MiB && WS_BQ == WS_OG + 16 * MiB && WS_BQI == WS_BQ + 16 * MiB, "EpiIn address arithmetic");
#ifndef PHASE_SEL
#define PHASE_SEL -1
#endif
#define PHEN(r) (PHASE_SEL < 0 || PHASE_SEL == (r))
#ifndef REP_MASK
#define REP_MASK 0
#endif
#define REPF(bit, call) do { call; if (REP_MASK & (1u << (bit))) { __syncthreads(); call; } } while (0)
#define IN(k) (lo <= (k) && (k) < hi)
#ifndef PROBE_SLOT
#define PROBE_SLOT -1
#endif
#ifndef PROBE_MULT
#define PROBE_MULT 8
#endif
#define SEAM(k) do { if ((k) + 1 < hi) { XcdBarrier b2_ = bar; asm volatile("" : "+s"(b2_.bar)); xcd_barrier(b2_); } \
    if (PROBE_SLOT >= 0) { const unsigned long long now_ = wall_clock64(); if ((((k) == 0) ? 100 : (((k) - 1) % 17)) == PROBE_SLOT) F.tacc += now_ - F.tprev; F.tprev = now_; } } while (0)
#define HBSEL(i) ((bf16*)(ws + ((i) ? WS_HB1 : WS_HB0)))
#define STSEL(i) ((float*)(ws + WS_STATS + ((i) ? MiB : (size_t)0)))
template <int lp> __device__ __forceinline__ void layer_pair(Frame& F, const Args& args, const XcdBarrier& bar, const int lo, const int hi, LAS unsigned char* ring, const int K256, const int K512) {
    unsigned char* ws = F.ws; bf16* Eb = (bf16*)(ws + WS_E);
        const int pb = 1 + 17 * lp;
        int hbi = lp & 1, si = 0;

        {
            const int e = lp, li = 2 * lp;
            EvenPtrs P;
            P.QK = (const bf16*)(ws + WS_QK); P.VB = (const bf16*)(ws + WS_VB); P.OG = (const bf16*)(ws + WS_OG); P.BQ = (const bf16*)(ws + WS_BQ); P.BQI = (const bf16*)(ws + WS_BQI); P.MISC = (const float*)(ws + WS_MISC);
            P.MIX = (bf16*)(ws + WS_MIX); P.QKC = (bf16*)(ws + WS_QKC); P.KB = (bf16*)(ws + WS_KB); P.KIB = (bf16*)(ws + WS_KIB); P.VT = (bf16*)(ws + WS_VT); P.MASK = (unsigned*)(ws + WS_MASK); P.CHS = (float*)(ws + WS_CHS); P.MST = (float*)(ws + WS_CHS + 65536);
            P.ISC = (float*)(ws + WS_ISC); P.U = (float*)(ws + WS_U); P.CB = (bf16*)(ws + WS_CB);
            P.bgate = INP(IN_B_GATE) + e * 8; P.conv = INP(IN_CONV) + e * 4 * 1024; P.gh = INP(IN_NORM_H) + e * 512; P.gq = INP(IN_NORM_Q) + e * 64; P.gk = INP(IN_NORM_K) + e * 64; P.gkv = INP(IN_NORM_KV) + e * 128;
            P.WukT = (const bf16*)(ws + WS_SMALL + 8192) + (size_t)e * 64 * 128; P.WuvT = (const bf16*)(ws + WS_SMALL + 65536) + (size_t)e * 512 * 128; P.bt = (const float*)(ws + WS_SMALL);
            if (PHEN(1) && IN(pb + 1)) {
                pg8::Gemm g{HBSEL(hbi), (const bf16*)(ws + WS_W_IN) + (size_t)e * NINP * DM, M, NINP, DM}; pg8::StaticOrder S; S.init(M, NINP, F.G, F.bid);
                pg8::EpiIn E{STSEL(si), (bf16*)(ws + WS_QK), (float*)(ws + WS_MISC), (bf16*)(ws + WS_KIB)};
                pg8::gemm_phase<pg8::EpiIn, pg8::StaticOrder, true, true>(ring, g, S, E);
                {
                  int c0 = (((M / 256) * (NINP / 256)) % F.G + 7) & ~7; if (c0 >= F.G) c0 = 0;
                  if (F.bid >= c0) { pg8::Gemm g2{(const bf16*)(ws + WS_PB) + (size_t)li * M * PLED, (const bf16*)(ws + WS_W_PL) + (size_t)li * DM * PLED, M, DM, K256}; pg8::StaticOrder S2; S2.init(M, DM, F.G - c0, F.bid - c0);
                    pg8::EpiStore E2{Eb, DM};
                    pg8::gemm_phase<pg8::EpiStore, pg8::StaticOrder, true, true>(ring, g2, S2, E2); } }
                  SEAM(pb + 1); }
            if (PHEN(2) && IN(pb + 2)) { REPF(1, mlstm_a(F, P)); REPF(2, dsa_prep(F, P)); REPF(3, dsa_index(F, P)); SEAM(pb + 2); }
            if (PHEN(3) && IN(pb + 3)) { REPF(4, mlstm_b(F, P)); REPF(5, dsa_select(F, P)); SEAM(pb + 3); }
            if (PHEN(4) && IN(pb + 4)) { REPF(6, mlstm_c(F, P)); REPF(7, dsa_attn(F, P)); SEAM(pb + 4); }
            if (PHEN(5) && IN(pb + 5)) {
                { pg8::Gemm g{(const bf16*)(ws + WS_MIX), (const bf16*)(ws + WS_W_OUT) + (size_t)e * DM * DM, M, DM, DM}; pg8::StaticOrder S; S.init(M, DM, F.G, F.bid);
                  pg8::EpiResid<0> E{HBSEL(hbi), HBSEL(hbi), nullptr, STSEL(si ^ 1), nullptr, nullptr, nullptr};
                  pg8::gemm_phase<pg8::EpiResid<0>, pg8::StaticOrder, true, true>(ring, g, S, E); }
                SEAM(pb + 5); }
            si ^= 1;
            if (PHEN(6) && IN(pb + 6)) {
                pg8::Gemm g{HBSEL(hbi), (const bf16*)(ws + WS_W_GU) + (size_t)e * 7168 * DM, M, 7168, DM}; pg8::StaticOrder S; S.init(M, 7168, F.G, F.bid);
                pg8::EpiGLU<false> E{STSEL(si), nullptr, (bf16*)(ws + WS_ACT)};
                pg8::gemm_phase<pg8::EpiGLU<false>, pg8::StaticOrder, true, true>(ring, g, S, E);
                  SEAM(pb + 6); }
            if (PHEN(7) && IN(pb + 7)) {
                pg8::Gemm g{(const bf16*)(ws + WS_ACT), (const bf16*)(ws + WS_W_DN) + (size_t)e * DM * DFF, M, DM, DFF}; pg8::StaticOrder S; S.init(M, DM, F.G, F.bid);
                pg8::EpiResid<0> E{HBSEL(hbi), HBSEL(hbi), nullptr, STSEL(si ^ 1), nullptr, nullptr, nullptr};
                pg8::gemm_phase<pg8::EpiResid<0>, pg8::StaticOrder, true, true>(ring, g, S, E);
                SEAM(pb + 7); }
            si ^= 1;
            if (PHEN(8) && IN(pb + 8)) {
                pg8::Gemm g{HBSEL(hbi), (const bf16*)(ws + WS_W_PG) + (size_t)li * DM * DM, M, DM, DM}; pg8::StaticOrder S; S.init(M, DM, F.G, F.bid);
                pg8::EpiResid<2> E{HBSEL(hbi), HBSEL(hbi ^ 1), nullptr, STSEL(si ^ 1), STSEL(si), Eb, nullptr};
                pg8::gemm_phase<pg8::EpiResid<2>, pg8::StaticOrder, true, true>(ring, g, S, E);
                SEAM(pb + 8); }
            si ^= 1; hbi ^= 1;
        }
        {
            const int o = lp, li = 2 * lp + 1;
            const RoutePtrs R = route_ptrs(ws);
            if (PHEN(9) && IN(pb + 9)) {
                REPF(13, pool_fused(F, HBSEL(hbi), HBSEL(hbi ^ 1), STSEL(si), STSEL(si ^ 1), INP(IN_NORM_MIX) + li * DM, (const bf16*)(ws + WS_W_POOL) + (size_t)o * 4 * 256 * 256, INP(IN_SCALE_POOL) + o * DM));
                SEAM(pb + 9); }
            si ^= 1; hbi ^= 1;
            if (PHEN(11) && IN(pb + 11)) {   moe_route(F, R, HBSEL(hbi), INP(IN_NORM_FFN) + li * DM, INP(IN_W_ROUTER) + (size_t)o * DM * 8, INP(IN_B_ROUTER) + o * 8);   SEAM(pb + 11); }
            if (PHEN(12) && IN(pb + 12)) {   moe_scatter(F, R, HBSEL(hbi), (bf16*)(ws + WS_YG));   SEAM(pb + 12); }
            if (PHEN(13) && IN(pb + 13)) {
                const int nt = __builtin_amdgcn_readfirstlane(R.NT[0]);
                pg8::Gemm g{(const bf16*)(ws + WS_YG), (const bf16*)(ws + WS_W_MGU), MAXROWS, 8 * 7168, DM}; pg8::MoeOrder S{R.TILEE, R.EXPB, R.LT + 40, nt, 28, F.G, F.bid};
                pg8::EpiGLU<true> E{nullptr, R.ROWR, (bf16*)(ws + WS_ACTM)};
                pg8::gemm_phase<pg8::EpiGLU<true>, pg8::MoeOrder, true, true>(ring, g, S, E);
                { const int nlt = __builtin_amdgcn_readfirstlane(R.LT[32]); pg8::LeftOrder<false> S2{R.LT, nlt * 28, F.G, F.bid};
                  pg8::gemm_phase<pg8::EpiGLU<true>, pg8::LeftOrder<false>, true, true>(ring, g, S2, E); }
                  SEAM(pb + 13); }
            if (PHEN(14) && IN(pb + 14)) {
                const int nt = __builtin_amdgcn_readfirstlane(R.NT[0]);
                pg8::Gemm g{(const bf16*)(ws + WS_ACTM), (const bf16*)(ws + WS_W_MDN), MAXROWS, 8 * 1024, DFF}; pg8::MoeOrder S{R.TILEE, R.EXPB, R.LT + 40, nt, 4, F.G, F.bid};
                pg8::EpiScatter E{R.ROWTS, R.ROWG, (bf16*)(ws + WS_D0), (bf16*)(ws + WS_D1)};
                pg8::gemm_phase<pg8::EpiScatter, pg8::MoeOrder, true, true>(ring, g, S, E);
                {
                  const int nlt = __builtin_amdgcn_readfirstlane(R.LT[32]);
                  pg8::Gemm g3{(const bf16*)(ws + WS_ACTM), (const bf16*)(ws + WS_W_MDN), MAXROWS, 8 * 1024, K512, DFF}; pg8::LeftOrder<true> S3{R.LT, nlt * 28, F.G, F.bid};
                  pg8::EpiPart E3{(float*)(ws + WS_PART)};
                  pg8::gemm_phase<pg8::EpiPart, pg8::LeftOrder<true>, true, true>(ring, g3, S3, E3); }
                {
                  const int c0 = 0;
                  if (F.bid >= c0) { pg8::Gemm g2{(const bf16*)(ws + WS_PB) + (size_t)li * M * PLED, (const bf16*)(ws + WS_W_PL) + (size_t)li * DM * PLED, M, DM, K256}; pg8::StaticOrder S2; S2.init(M, DM, F.G - c0, F.bid - c0);
                    pg8::EpiStore E2{Eb, DM};
                    pg8::gemm_phase<pg8::EpiStore, pg8::StaticOrder, true, true>(ring, g2, S2, E2); } }
                  SEAM(pb + 14); }
            if (PHEN(15) && IN(pb + 15)) { moe_combine(F, R, (const bf16*)(ws + WS_D0), (const bf16*)(ws + WS_D1), (const float*)(ws + WS_PART), HBSEL(hbi), STSEL(si ^ 1)); if (lp == 0) REPF(16, conv_moe(F, args, 1));     SEAM(pb + 15); }
            si ^= 1;
            if (PHEN(16) && IN(pb + 16)) {
                pg8::Gemm g{HBSEL(hbi), (const bf16*)(ws + WS_W_PG) + (size_t)li * DM * DM, M, DM, DM}; pg8::StaticOrder S; S.init(M, DM, F.G, F.bid);
                if (lp == 1) { pg8::EpiResid<2, true> E{HBSEL(hbi), nullptr, F.out, nullptr, STSEL(si), Eb, nullptr};
                    pg8::gemm_phase<pg8::EpiResid<2, true>, pg8::StaticOrder, true, true>(ring, g, S, E); }
                else { pg8::EpiResid<2> E{HBSEL(hbi), HBSEL(hbi ^ 1), nullptr, STSEL(si ^ 1), STSEL(si), Eb, nullptr};
                    pg8::gemm_phase<pg8::EpiResid<2>, pg8::StaticOrder, true, true>(ring, g, S, E); }
                SEAM(pb + 16); }
            si ^= 1; hbi ^= 1;
        }

}
__global__ void __launch_bounds__(NWAVES * 64, 2) fwd(Args args) {
    extern __shared__ __attribute__((aligned(16))) unsigned char lds[];
    Frame F;
    F.lds = (LAS unsigned char*)lds; F.gl = lds; F.MISCW = (volatile LAS unsigned*)(F.lds + MISC_OFF);
    F.tid = threadIdx.x; F.lane = F.tid & 63; F.wave = __builtin_amdgcn_readfirstlane(F.tid >> 6); F.G = gridDim.x; F.bid = blockIdx.x; F.gw = F.bid * NWAVES + F.wave; F.NGW = F.G * NWAVES;
    F.out = args.out; F.ws = args.ws;
    unsigned char* ws = args.ws;
    for (int u = F.tid; u < (LDS_BYTES - LDSCTL_OFF) / 4; u += NWAVES * 64) ((LAS unsigned*)(F.lds + LDSCTL_OFF))[u] = 0u;
    __syncthreads();
    XcdBarrier bar = xcd_barrier_post((unsigned*)(ws + WS_CTL) + CW_BAR, F.MISCW + 8);
    const int lo = args.ph_lo, hi = args.ph_hi;
    F.tacc = 0ull; F.tprev = (PROBE_SLOT >= 0) ? wall_clock64() : 0ull;
    LAS unsigned char* ring = F.lds;
    int K512 = 512; asm volatile("" : "+s"(K512));
    int K256 = 256; asm volatile("" : "+s"(K256));

    if (PHEN(100) && IN(0)) { REPF(8, p0_prologue(F, args)); SEAM(0); }

    layer_pair<0>(F, args, bar, lo, hi, ring, K256, K512);
    layer_pair<1>(F, args, bar, lo, hi, ring, K256, K512);
    if (PROBE_SLOT >= 0 && F.bid == 0 && F.tid == 0) { const unsigned long long t0_ = wall_clock64(), dl_ = (unsigned long long)PROBE_MULT * F.tacc; while (wall_clock64() - t0_ < dl_) __builtin_amdgcn_s_sleep(8); }
#undef IN
#undef SEAM
}

extern "C" void kernel_launch(void* const* d_in, const int* in_sizes, int n_in, void* d_out, int out_size, void* d_ws, size_t ws_size, hipStream_t stream) {
    static int grid = 0;
    if (grid == 0) {
        if (n_in != 28 || in_sizes[0] != M * DM || out_size != M * DM || ws_size < WS_END) { fprintf(stderr, "kernel_launch: unexpected shapes (n_in %d, in0 %d, out %d, ws %zu < %zu); nothing launched\n", n_in, n_in > 0 ? in_sizes[0] : -1, out_size, ws_size, (size_t)WS_END); grid = -1; return; }
        int dev = 0, cus = 0, per_cu = 0;
        if (hipGetDevice(&dev) != hipSuccess || hipDeviceGetAttribute(&cus, hipDeviceAttributeMultiprocessorCount, dev) != hipSuccess) { grid = -1; return; }
        if (hipFuncSetAttribute((const void*)fwd, hipFuncAttributeMaxDynamicSharedMemorySize, LDS_BYTES) != hipSuccess) { fprintf(stderr, "kernel_launch: hipFuncSetAttribute failed\n"); grid = -1; return; }
        if (hipOccupancyMaxActiveBlocksPerMultiprocessor(&per_cu, (const void*)fwd, NWAVES * 64, LDS_BYTES) != hipSuccess || per_cu < 1) fprintf(stderr, "kernel_launch: occupancy query reports %d workgroups per CU\n", per_cu);
        (void)hipGetLastError();
        grid = cus;
    }
    if (grid < 0) return;
    if (hipMemsetAsync((char*)d_ws + WS_CTL, 0, CTL_ZERO_BYTES, stream) != hipSuccess) return;
    Args a{};
    for (int i = 0; i < 28; ++i) a.in[i] = (const float*)d_in[i];
    a.out = (float*)d_out; a.ws = (unsigned char*)d_ws;
#if MK_ONE_LAUNCH
    a.ph_lo = 0; a.ph_hi = N_PHASES;
    hipLaunchKernelGGL(fwd, dim3(grid), dim3(NWAVES * 64), LDS_BYTES, stream, a);
#else
    for (int ph = 0; ph < N_PHASES; ++ph) { if (ph == 1) continue; a.ph_lo = ph; a.ph_hi = ph + 1;
        hipLaunchKernelGGL(fwd, dim3(grid), dim3(NWAVES * 64), LDS_BYTES, stream, a); }
#endif
}
```

```cpp
#include <hip/hip_runtime.h>
#include <cstdio>
#include <cstdint>
#ifndef MK_ONE_LAUNCH
#define MK_ONE_LAUNCH 1
#endif
namespace pg8 {
#define PG8_LAS __attribute__((address_space(3)))
typedef unsigned short bf16_t;
typedef short bf16x8 __attribute__((ext_vector_type(8)));
typedef float f32x4 __attribute__((ext_vector_type(4)));
typedef unsigned u32x4 __attribute__((ext_vector_type(4)));
constexpr int BM = 256, BK = 64, HALF = 128, HTB = HALF * BK * 2  , STAGE_BYTES = 8 * HTB, NXCD = 8, WGM = 8;

__host__ __device__ __forceinline__ int lds_byte(int r, int c) { const int st = (r >> 4) * 2 + (c >> 5), rr = r & 15, cc = c & 31, ob = rr * 64 + cc * 2; return st * 1024 + (ob ^ (((ob >> 9) & 1) << 5)); }
__host__ __device__ __forceinline__ void stage_rc(int b, int& R, int& C) { const int st = b / 1024, sb = b % 1024, swz = sb ^ (((sb >> 9) & 1) << 5); R = (st >> 1) * 16 + swz / 64; C = (st & 1) * 32 + (swz % 64) / 2; }
__host__ __device__ __forceinline__ int perm32(int rho) { const int n = rho >> 4, i = rho & 15; return 8 * (i >> 2) + 4 * n + (i & 3); }

struct Unit { int pm, pn, ko, aux; };
struct Gemm { const bf16_t* A; const bf16_t* Bt; int M, N, K, ld; };

struct StaticOrder {
    int nM, nN, nwg, G, c;
    __host__ __device__ void init(int M, int N, int G_, int c_) { nM = M / BM; nN = N / BM; nwg = nM * nN; G = G_; c = c_; }
    __host__ __device__ bool next(int i, Unit& u) const {
        const long L = (long)i * G + c; if (L >= nwg) return false;
        int wgid = (int)L; { const int q = nwg / NXCD, r = nwg % NXCD, xcd = wgid % NXCD, off = wgid / NXCD; wgid = (xcd < r ? xcd * (q + 1) : r * (q + 1) + (xcd - r) * q) + off; }
        const int nig = WGM * nN, gid = wgid / nig, fm = gid * WGM, gsz = (nM - fm) < WGM ? (nM - fm) : WGM;
        u.pm = fm + ((wgid % nig) % gsz); u.pn = (wgid % nig) / gsz; return true;
    }
    __device__ __forceinline__ void a_ready(const Unit&) const {}
    __device__ __forceinline__ void done(const Unit&) const {}
};
__device__ __forceinline__ unsigned cvt_pk_bf16(float lo, float hi) { unsigned r; asm volatile("v_cvt_pk_bf16_f32 %0, %1, %2" : "=v"(r) : "v"(lo), "v"(hi)); return r; }
typedef float f32x2 __attribute__((ext_vector_type(2)));
constexpr float RMS_EPS = 1e-6f;
__device__ __forceinline__ float fsigmoid(float x) { return __builtin_amdgcn_rcpf(1.0f + __builtin_amdgcn_exp2f(-1.44269504f * x)); }
__device__ __forceinline__ f32x4 sig4(f32x4 v) { f32x4 o; o.x = fsigmoid(v.x); o.y = fsigmoid(v.y); o.z = fsigmoid(v.z); o.w = fsigmoid(v.w); return o; }
__device__ __forceinline__ u32x4 pack8(f32x4 v0, f32x4 v1) { u32x4 w; w.x = cvt_pk_bf16(v0[0], v0[1]); w.y = cvt_pk_bf16(v0[2], v0[3]); w.z = cvt_pk_bf16(v1[0], v1[1]); w.w = cvt_pk_bf16(v1[2], v1[3]); return w; }
__device__ __forceinline__ void unpack8(u32x4 w, f32x4& a, f32x4& b) {
    a.x = __uint_as_float(w.x << 16); a.y = __uint_as_float(w.x & 0xffff0000u); a.z = __uint_as_float(w.y << 16); a.w = __uint_as_float(w.y & 0xffff0000u);
    b.x = __uint_as_float(w.z << 16); b.y = __uint_as_float(w.z & 0xffff0000u); b.z = __uint_as_float(w.w << 16); b.w = __uint_as_float(w.w & 0xffff0000u); }
__device__ __forceinline__ void load_rstd(const float* stats, int rowb, int fr, int fq, float (&rs)[2][4]) {
    float mine[2];
#pragma unroll
    for (int ai = 0; ai < 2; ++ai) { const f32x4* p = (const f32x4*)(stats + (size_t)(rowb + ai * HALF + fq * 16) * 16); const f32x4 a = p[0], b = p[1], c = p[2], d = p[3];
        const float s = (((a.x + a.y) + (a.z + a.w)) + ((b.x + b.y) + (b.z + b.w))) + (((c.x + c.y) + (c.z + c.w)) + ((d.x + d.y) + (d.z + d.w)));
        mine[ai] = rsqrtf(s * (1.0f / 1024.0f) + RMS_EPS); }
#pragma unroll
    for (int ai = 0; ai < 2; ++ai)
#pragma unroll
        for (int m = 0; m < 4; ++m) rs[ai][m] = __shfl(mine[ai], fr + 16 * m);
}
struct EpiIn {
    static constexpr bool PERM = true, AFTER_DRAIN = false;
    const float* stats; bf16_t* QK; float* MISC; bf16_t* KIB;
    __device__ __forceinline__ void operator()(const f32x4 (&acc)[2][2][4][2], const Unit& u, int wr, int wc, int fr, int fq) const {
        const int rowb = u.pm * BM + wr * 64 + fr, cl = wc * 32 + 8 * fq, pn = u.pn;
        float rs[2][4]; load_rstd(stats, rowb, fr, fq, rs);
        if (pn < 12) {
            bf16_t* base; int ld, colt; bool sig = false;
            if (pn < 4) { base = QK; ld = 1024; colt = pn * 256; }
            else { const int t = (pn - 4) >> 1; base = QK + (size_t)16777216 + (size_t)t * 8388608; ld = 512; colt = ((pn - 4) & 1) * 256; sig = (t == 1); }
#pragma unroll
            for (int ai = 0; ai < 2; ++ai)
#pragma unroll
                for (int m = 0; m < 4; ++m) { const float r = rs[ai][m]; bf16_t* rp = base + (size_t)(rowb + ai * HALF + m * 16) * ld + colt + cl;
#pragma unroll
                    for (int bj = 0; bj < 2; ++bj) { f32x4 v0 = acc[ai][bj][m][0] * r, v1 = acc[ai][bj][m][1] * r; if (sig) { v0 = sig4(v0); v1 = sig4(v1); }
                        *(u32x4*)(rp + bj * HALF) = pack8(v0, v1); }
                    asm volatile("" ::: "memory"); }
        } else {
#pragma unroll
            for (int ai = 0; ai < 2; ++ai)
#pragma unroll
                for (int m = 0; m < 4; ++m) { const float r = rs[ai][m]; float* rp = MISC + (size_t)(rowb + ai * HALF + m * 16) * 256 + cl;
#pragma unroll
                    for (int bj = 0; bj < 2; ++bj)
#pragma unroll
                        for (int n = 0; n < 2; ++n) *(f32x4*)(rp + bj * HALF + 4 * n) = acc[ai][bj][m][n] * r;
                    if (wc < 2) *(u32x4*)(KIB + (size_t)(rowb + ai * HALF + m * 16) * 64 + cl) = pack8(acc[ai][1][m][0] * r, acc[ai][1][m][1] * r);
                    asm volatile("" ::: "memory"); }
        }
    }
};
template <int MODE, bool FINAL = false> struct EpiResid {
    static constexpr bool PERM = true, AFTER_DRAIN = false;
    const bf16_t* HBi; bf16_t* HBo; float* OUT; float* statsW; const float* statsR; const bf16_t* E; const float* scale;
    __device__ __forceinline__ void operator()(const f32x4 (&acc)[2][2][4][2], const Unit& u, int wr, int wc, int fr, int fq) const {
        int pm = u.pm; const int pn = u.pn; if (MODE == 1) pm -= 64 * pn;
        const int rowb = pm * BM + wr * 64 + fr, colb = pn * BM + wc * 32 + 8 * fq;
        float rs[2][4]; if (MODE == 2) load_rstd(statsR, rowb, fr, fq, rs);
        f32x4 sc[2][2];
        if (MODE == 1) {
#pragma unroll
            for (int bj = 0; bj < 2; ++bj)
#pragma unroll
                for (int n = 0; n < 2; ++n) sc[bj][n] = *(const f32x4*)(scale + colb + bj * HALF + 4 * n); }
#pragma unroll
        for (int ai = 0; ai < 2; ++ai)
#pragma unroll
            for (int m = 0; m < 4; ++m) { const size_t off = (size_t)(rowb + ai * HALF + m * 16) * 1024 + colb; float ssq = 0.f;
#pragma unroll
                for (int bj = 0; bj < 2; ++bj) { f32x4 h0, h1; unpack8(*(const u32x4*)(HBi + off + bj * HALF), h0, h1);
                    f32x4 v0 = acc[ai][bj][m][0], v1 = acc[ai][bj][m][1];
                    if (MODE == 1) { v0 = v0 * sc[bj][0]; v1 = v1 * sc[bj][1]; }
                    if (MODE == 2) { const u32x4 ew = *(const u32x4*)(E + off + bj * HALF); f32x4 e0, e1; unpack8(ew, e0, e1); const float r = rs[ai][m]; v0 = e0 * sig4(v0 * r); v1 = e1 * sig4(v1 * r); }
                    h0 = h0 + v0; h1 = h1 + v1;
                    if (FINAL) { float* hp = OUT + off + bj * HALF; ((f32x4*)hp)[0] = h0; ((f32x4*)hp)[1] = h1; }
                    else { ssq += ((h0.x * h0.x + h0.y * h0.y) + (h0.z * h0.z + h0.w * h0.w)) + ((h1.x * h1.x + h1.y * h1.y) + (h1.z * h1.z + h1.w * h1.w));
                           *(u32x4*)(HBo + off + bj * HALF) = pack8(h0, h1); } }
                if (!FINAL) { ssq += __shfl_xor(ssq, 16); ssq += __shfl_xor(ssq, 32);
                    if (fq == 0) statsW[(size_t)(rowb + ai * HALF + m * 16) * 16 + pn * 4 + wc] = ssq; }
                asm volatile("" ::: "memory"); }
    }
};
template <bool MOE> struct EpiGLU {
    static constexpr bool PERM = true, AFTER_DRAIN = false;
    const float* stats; const float* rowr; bf16_t* ACT;
    __device__ __forceinline__ void operator()(const f32x4 (&acc)[2][2][4][2], const Unit& u, int wr, int wc, int fr, int fq) const {
        const int rowb = u.pm * BM + wr * 64 + fr, jt = MOE ? (u.pn % 28) : u.pn;
        float rs[2][4];
        if (MOE) {
#pragma unroll
            for (int ai = 0; ai < 2; ++ai)
#pragma unroll
                for (int m = 0; m < 4; ++m) rs[ai][m] = rowr[rowb + ai * HALF + m * 16];
        } else load_rstd(stats, rowb, fr, fq, rs);
#pragma unroll
        for (int ai = 0; ai < 2; ++ai)
#pragma unroll
            for (int m = 0; m < 4; ++m) { const float r = rs[ai][m]; bf16_t* rp = ACT + (size_t)(rowb + ai * HALF + m * 16) * 3584 + jt * 128 + wc * 32 + 8 * fq;
                const f32x4 g0 = acc[ai][0][m][0] * r, g1 = acc[ai][0][m][1] * r, u0 = acc[ai][1][m][0] * r, u1 = acc[ai][1][m][1] * r;
                *(u32x4*)rp = pack8(g0 * sig4(g0) * u0, g1 * sig4(g1) * u1);
                asm volatile("" ::: "memory"); }
    }
};
struct EpiScatter {
    static constexpr bool PERM = true, AFTER_DRAIN = false;
    const int* rowts; const float* rowg; bf16_t *D0, *D1;
    __device__ __forceinline__ void operator()(const f32x4 (&acc)[2][2][4][2], const Unit& u, int wr, int wc, int fr, int fq) const {
        const int rowb = u.pm * BM + wr * 64 + fr, jt = u.pn & 3;
#pragma unroll
        for (int ai = 0; ai < 2; ++ai)
#pragma unroll
            for (int m = 0; m < 4; ++m) { const int row = rowb + ai * HALF + m * 16; const int ts = rowts[row];
                if (ts >= 0) { const float g = rowg[row]; bf16_t* dp = ((ts & 1) ? D1 : D0) + (size_t)(ts >> 1) * 1024 + jt * 256 + wc * 32 + 8 * fq;
#pragma unroll
                    for (int bj = 0; bj < 2; ++bj) *(u32x4*)(dp + bj * HALF) = pack8(acc[ai][bj][m][0] * g, acc[ai][bj][m][1] * g); }
                asm volatile("" ::: "memory"); }
    }
};
struct EpiPart {
    static constexpr bool PERM = true, AFTER_DRAIN = false;
    float* PART;
    __device__ __forceinline__ void operator()(const f32x4 (&acc)[2][2][4][2], const Unit& u, int wr, int wc, int fr, int fq) const {
        float* base = PART + ((size_t)u.aux * 256 + wr * 64 + fr) * 1024 + (u.pn & 3) * 256 + wc * 32 + 8 * fq;
#pragma unroll
        for (int ai = 0; ai < 2; ++ai)
#pragma unroll
            for (int m = 0; m < 4; ++m) { float* rp = base + (size_t)(ai * HALF + m * 16) * 1024;
#pragma unroll
                for (int bj = 0; bj < 2; ++bj) { *(f32x4*)(rp + bj * HALF) = acc[ai][bj][m][0]; *(f32x4*)(rp + bj * HALF + 4) = acc[ai][bj][m][1]; }
                asm volatile("" ::: "memory"); }
    }
};
template <bool SPLIT> struct LeftOrder {
    const int* lt; int nl, G, c;
    __device__ __forceinline__ bool next(int i, Unit& u) const { const int L = i * G + c; if (L >= nl) return false; const int tl = L / 28, rem = L - 28 * tl;
        u.pm = __builtin_amdgcn_readfirstlane(lt[tl]); const int e = __builtin_amdgcn_readfirstlane(lt[16 + tl]);
        if (SPLIT) { const int j = rem / 7, kc = rem - 7 * j; u.pn = e * 4 + j; u.ko = kc * 512; u.aux = tl * 7 + kc; } else { u.pn = e * 28 + rem; u.ko = 0; u.aux = 0; }
        return true; }
    __device__ __forceinline__ void a_ready(const Unit&) const {}
    __device__ __forceinline__ void done(const Unit&) const {}
};
struct EpiStore {
    static constexpr bool PERM = true, AFTER_DRAIN = false;
    bf16_t* O; int ldc;
    __device__ __forceinline__ void operator()(const f32x4 (&acc)[2][2][4][2], const Unit& u, int wr, int wc, int fr, int fq) const {
        const int rowb = u.pm * BM + wr * 64 + fr, colb = u.pn * BM + wc * 32 + 8 * fq;
#pragma unroll
        for (int ai = 0; ai < 2; ++ai)
#pragma unroll
            for (int m = 0; m < 4; ++m) { bf16_t* rp = O + (size_t)(rowb + ai * HALF + m * 16) * ldc + colb;
#pragma unroll
                for (int bj = 0; bj < 2; ++bj) *(u32x4*)(rp + bj * HALF) = pack8(acc[ai][bj][m][0], acc[ai][bj][m][1]); }
    }
};
struct PoolOrder {
    int G, c;
    __device__ __forceinline__ bool next(int i, Unit& u) const { const int L = i * G + c; if (L >= 256) return false; const int g = L & 3; u.pm = g * 64 + (L >> 2); u.pn = g; return true; }
    __device__ __forceinline__ void a_ready(const Unit&) const {}
    __device__ __forceinline__ void done(const Unit&) const {}
};
struct MoeOrder {
    const int* tileE; const int* expb; const int* expn; int ntiles, ncol, G, c;
    __device__ __forceinline__ bool next(int i, Unit& u) const {
        if (G == 256) { const int e = c & 7, lu = i * 32 + (c >> 3), nrt = __builtin_amdgcn_readfirstlane(expn[e]); if (lu >= nrt * ncol) return false;
            const int per = 4 * nrt, cbk = lu / per, rem = lu - cbk * per; u.pm = __builtin_amdgcn_readfirstlane(expb[e]) + (rem >> 2); u.pn = e * ncol + cbk * 4 + (rem & 3); return true; }
        const int L = i * G + c; if (L >= ntiles * ncol) return false; const int rt = L / ncol, j = L - rt * ncol;
        u.pm = rt; u.pn = __builtin_amdgcn_readfirstlane(tileE[rt]) * ncol + j; return true; }
    __device__ __forceinline__ void a_ready(const Unit&) const {}
    __device__ __forceinline__ void done(const Unit&) const {}
};
template <class Epi, class Sched, bool ALIGN_EPI = false, bool SP2 = false>
__device__ __forceinline__ void gemm_phase(PG8_LAS unsigned char* lds, const Gemm g, const Sched& S, const Epi& E) {
    const int tid = threadIdx.x, wid = __builtin_amdgcn_readfirstlane(tid >> 6), lane = tid & 63, wr = wid >> 2, wc = wid & 3, fr = lane & 15, fq = lane >> 4;
    const int K = g.K, nt = K / BK, LD = g.ld ? g.ld : K;
    unsigned voffA[2], voffB[2];
#pragma unroll
    for (int i = 0; i < 2; ++i) { int R, C; stage_rc(tid * 16 + i * 8192, R, C); const int Rb = Epi::PERM ? ((R & ~31) + perm32(R & 31)) : R;
        voffA[i] = (unsigned)(R * LD + C) * 2u; voffB[i] = (unsigned)(Rb * LD + C) * 2u; }
    const size_t kstep = (size_t)(BK * 2);
    const size_t hstep = (size_t)HALF * LD * 2;
    const size_t tstep = 2 * hstep;
    const unsigned ldsw = (unsigned)wid * 1024u;
    const int aoff = lds_byte(wr * 64 + fr, fq * 8), boff = lds_byte(wc * 32 + fr, fq * 8);
#define PG8_SA(b, h) (((b) * 2 + (h)) * HTB)
#define PG8_SB(b, h) ((4 + (b) * 2 + (h)) * HTB)
#define PG8_STAGE(bufoff, gbase, voff) do { _Pragma("unroll") for (int _i = 0; _i < 2; ++_i) \
        __builtin_amdgcn_global_load_lds((const unsigned*)((const char*)(gbase) + (voff)[_i]), (PG8_LAS unsigned*)(lds + (bufoff) + ldsw + _i * 8192), 16, 0, 0); } while (0)
#define PG8_LDA(dst, b, h) do { _Pragma("unroll") for (int m = 0; m < 4; ++m) _Pragma("unroll") for (int k = 0; k < 2; ++k) dst[m][k] = *(const PG8_LAS bf16x8*)(lds + PG8_SA(b, h) + aoff + m * 2048 + k * 1024); } while (0)
#define PG8_LDB(dst, b, h) do { _Pragma("unroll") for (int n = 0; n < 2; ++n) _Pragma("unroll") for (int k = 0; k < 2; ++k) dst[n][k] = *(const PG8_LAS bf16x8*)(lds + PG8_SB(b, h) + boff + n * 2048 + k * 1024); } while (0)
#define PG8_MMA(ai, bj, At, Bt) do { __builtin_amdgcn_s_setprio(1); _Pragma("unroll") for (int m = 0; m < 4; ++m) _Pragma("unroll") for (int n = 0; n < 2; ++n) _Pragma("unroll") for (int k = 0; k < 2; ++k) \
        acc[ai][bj][m][n] = __builtin_amdgcn_mfma_f32_16x16x32_bf16(Bt[n][k], At[m][k], acc[ai][bj][m][n], 0, 0, 0); __builtin_amdgcn_s_setprio(0); } while (0)
#define PG8_WAIT_V(n) asm volatile("s_waitcnt vmcnt(" #n ")" ::: "memory")
#define PG8_WAIT_L(n) asm volatile("s_waitcnt lgkmcnt(" #n ")" ::: "memory")
#define PG8_BAR __builtin_amdgcn_s_barrier()
#define PG8_SCHED __builtin_amdgcn_sched_barrier(0)
    Unit cur{0, 0, 0, 0}, nxt{0, 0, 0, 0}; int ui = 0;
    if (!S.next(0, cur)) return;
    f32x4 acc[2][2][4][2];
#pragma unroll
    for (int a = 0; a < 2; ++a)
#pragma unroll
        for (int b = 0; b < 2; ++b)
#pragma unroll
            for (int m = 0; m < 4; ++m)
#pragma unroll
                for (int n = 0; n < 2; ++n) acc[a][b][m][n] = (f32x4){0.f, 0.f, 0.f, 0.f};
    bf16x8 At[4][2], B0[2][2], B1[2][2];
    const char* cA = (const char*)g.A + (size_t)cur.pm * tstep + (size_t)cur.ko * 2; const char* cB = (const char*)g.Bt + (size_t)cur.pn * tstep + (size_t)cur.ko * 2;
    S.a_ready(cur);
    if constexpr (SP2) {
        PG8_STAGE(PG8_SB(0, 0), cB, voffB); PG8_STAGE(PG8_SB(0, 1), cB + hstep, voffB); PG8_STAGE(PG8_SA(0, 0), cA, voffA); PG8_STAGE(PG8_SA(0, 1), cA + hstep, voffA);
        if (wr == 1) PG8_BAR;
        PG8_WAIT_V(2); PG8_BAR;
        PG8_STAGE(PG8_SB(1, 0), cB + kstep, voffB); PG8_STAGE(PG8_SA(1, 0), cA + kstep, voffA); PG8_STAGE(PG8_SB(1, 1), cB + hstep + kstep, voffB);
        PG8_WAIT_V(6); PG8_BAR;
    } else {
        PG8_STAGE(PG8_SB(0, 0), cB, voffB); PG8_STAGE(PG8_SA(0, 0), cA, voffA); PG8_STAGE(PG8_SB(0, 1), cB + hstep, voffB); PG8_STAGE(PG8_SA(0, 1), cA + hstep, voffA);
        if (wr == 1) PG8_BAR;
        PG8_WAIT_V(4); PG8_BAR;
        PG8_STAGE(PG8_SB(1, 0), cB + kstep, voffB); PG8_STAGE(PG8_SA(1, 0), cA + kstep, voffA); PG8_STAGE(PG8_SB(1, 1), cB + hstep + kstep, voffB);
        PG8_WAIT_V(6); PG8_BAR;
    }
    for (;;) {
        const bool has_next = S.next(ui + 1, nxt);
        const char* nA = has_next ? (const char*)g.A + (size_t)nxt.pm * tstep + (size_t)nxt.ko * 2 : cA; const char* nB = has_next ? (const char*)g.Bt + (size_t)nxt.pn * tstep + (size_t)nxt.ko * 2 : cB;
        for (int t = 0; t < nt; t += 2) {
            const bool last = (t == nt - 2);
            const char* a1 = cA + (size_t)(t + 1) * kstep;
            const char* a2 = last ? nA : cA + (size_t)(t + 2) * kstep; const char* b2 = last ? nB : cB + (size_t)(t + 2) * kstep;
            const char* a3 = a2 + kstep; const char* b3 = b2 + kstep;
            if (last && has_next) S.a_ready(nxt);
            if constexpr (SP2) {
            PG8_LDB(B0, 0, 0); PG8_LDB(B1, 0, 1); PG8_SCHED; PG8_LDA(At, 0, 0); PG8_STAGE(PG8_SA(1, 1), a1 + hstep, voffA);
            PG8_WAIT_V(8); PG8_WAIT_L(0); PG8_BAR; PG8_MMA(0, 0, At, B0); PG8_MMA(0, 1, At, B1); PG8_BAR; PG8_SCHED;
            PG8_LDA(At, 0, 1); PG8_STAGE(PG8_SB(0, 0), b2, voffB); PG8_STAGE(PG8_SB(0, 1), b2 + hstep, voffB); PG8_STAGE(PG8_SA(0, 0), a2, voffA);
            PG8_WAIT_V(8); PG8_WAIT_L(0); PG8_BAR; PG8_MMA(1, 0, At, B0); PG8_MMA(1, 1, At, B1); PG8_BAR; PG8_SCHED;
            PG8_LDB(B0, 1, 0); PG8_LDB(B1, 1, 1); PG8_SCHED; PG8_LDA(At, 1, 0); PG8_STAGE(PG8_SA(0, 1), a2 + hstep, voffA);
            PG8_WAIT_V(8); PG8_WAIT_L(0); PG8_BAR; PG8_MMA(0, 0, At, B0); PG8_MMA(0, 1, At, B1); PG8_BAR; PG8_SCHED;
            PG8_LDA(At, 1, 1); PG8_STAGE(PG8_SB(1, 0), b3, voffB); PG8_STAGE(PG8_SB(1, 1), b3 + hstep, voffB); PG8_STAGE(PG8_SA(1, 0), a3, voffA);
            PG8_WAIT_V(8); PG8_WAIT_L(0); PG8_BAR; PG8_MMA(1, 0, At, B0); PG8_MMA(1, 1, At, B1); PG8_BAR; PG8_SCHED;
            } else {
            PG8_LDB(B0, 0, 0); PG8_SCHED; PG8_LDA(At, 0, 0); PG8_STAGE(PG8_SA(1, 1), a1 + hstep, voffA);
            PG8_WAIT_L(8); PG8_BAR; PG8_WAIT_L(0); PG8_MMA(0, 0, At, B0); PG8_BAR; PG8_SCHED;
            PG8_LDB(B1, 0, 1); PG8_STAGE(PG8_SB(0, 0), b2, voffB);
            PG8_BAR; PG8_WAIT_L(0); PG8_MMA(0, 1, At, B1); PG8_BAR;
            PG8_LDA(At, 0, 1); PG8_STAGE(PG8_SA(0, 0), a2, voffA);
            PG8_BAR; PG8_WAIT_L(0); PG8_MMA(1, 0, At, B0); PG8_BAR; PG8_SCHED;
            PG8_STAGE(PG8_SB(0, 1), b2 + hstep, voffB);
            PG8_WAIT_V(6); PG8_BAR; PG8_MMA(1, 1, At, B1); PG8_BAR;
            PG8_LDB(B0, 1, 0); PG8_SCHED; PG8_LDA(At, 1, 0); PG8_STAGE(PG8_SA(0, 1), a2 + hstep, voffA);
            PG8_WAIT_L(8); PG8_BAR; PG8_WAIT_L(0); PG8_MMA(0, 0, At, B0); PG8_BAR; PG8_SCHED;
            PG8_LDB(B1, 1, 1); PG8_STAGE(PG8_SB(1, 0), b3, voffB);
            PG8_BAR; PG8_WAIT_L(0); PG8_MMA(0, 1, At, B1); PG8_BAR;
            PG8_LDA(At, 1, 1); PG8_STAGE(PG8_SA(1, 0), a3, voffA);
            PG8_BAR; PG8_WAIT_L(0); PG8_MMA(1, 0, At, B0); PG8_BAR; PG8_SCHED;
            PG8_STAGE(PG8_SB(1, 1), b3 + hstep, voffB);
            PG8_WAIT_V(6); PG8_BAR; PG8_MMA(1, 1, At, B1); PG8_BAR;
            }
        }
        if constexpr (ALIGN_EPI) { if (wr == 0) PG8_BAR; }
        if constexpr (!Epi::AFTER_DRAIN) { E(acc, cur, wr, wc, fr, fq); S.done(cur); }
        if (!has_next) break;
#pragma unroll
        for (int a = 0; a < 2; ++a)
#pragma unroll
            for (int b = 0; b < 2; ++b)
#pragma unroll
                for (int m = 0; m < 4; ++m)
#pragma unroll
                    for (int n = 0; n < 2; ++n) acc[a][b][m][n] = (f32x4){0.f, 0.f, 0.f, 0.f};
        cur = nxt; cA = nA; cB = nB; ++ui;
        if constexpr (ALIGN_EPI) { if (wr == 1) PG8_BAR; }
    }
    PG8_WAIT_V(0);
    if constexpr (!ALIGN_EPI) { if (wr == 0) PG8_BAR; }
    PG8_BAR;
    if constexpr (Epi::AFTER_DRAIN) { E.fused(acc, cur, wr, wc, fr, fq, lds, wid, lane); S.done(cur); }
#undef PG8_SA
#undef PG8_SB
#undef PG8_STAGE
#undef PG8_LDA
#undef PG8_LDB
#undef PG8_MMA
#undef PG8_WAIT_V
#undef PG8_WAIT_L
#undef PG8_BAR
#undef PG8_SCHED
}
}
constexpr int NWAVES = 8;
constexpr int BATCH = 8, SEQ = 2048, DM = 1024, M = BATCH * SEQ, DFF = 3584, NEXP = 8, PLED = 256, NINP = 3328, NCHUNK = 32;
constexpr float LOG2E = 1.4426950408889634f;
constexpr size_t MiB = 1u << 20;
constexpr size_t WS_CTL = 0, CTL_ZERO_BYTES = 1 * MiB;
constexpr size_t WS_SMALL = 1 * MiB;
constexpr size_t WS_W_IN = 2 * MiB, WS_W_OUT = 15 * MiB, WS_W_GU = 19 * MiB, WS_W_DN = 47 * MiB, WS_W_PG = 61 * MiB, WS_W_PL = 69 * MiB, WS_W_POOL = 71 * MiB;
constexpr size_t WS_W_MGU = 72 * MiB, WS_W_MDN = 184 * MiB;
constexpr size_t WS_HB0 = 240 * MiB, WS_HB1 = 272 * MiB, WS_STATS = 304 * MiB, WS_PB = 306 * MiB, WS_E = 338 * MiB;
constexpr size_t WS_OVL = 370 * MiB;
constexpr size_t WS_QK = WS_OVL, WS_VB = WS_OVL + 32 * MiB, WS_OG = WS_OVL + 48 * MiB, WS_BQ = WS_OVL + 64 * MiB, WS_BQI = WS_OVL + 80 * MiB, WS_MISC = WS_OVL + 96 * MiB, WS_MIX = WS_OVL + 112 * MiB;
constexpr size_t WS_KB = WS_OVL + 144 * MiB, WS_KIB = WS_OVL + 146 * MiB, WS_VT = WS_OVL + 148 * MiB, WS_MASK = WS_OVL + 164 * MiB, WS_CHS = WS_OVL + 168 * MiB;
constexpr size_t WS_ISC = WS_OVL + 169 * MiB, WS_U = WS_OVL + 297 * MiB, WS_CB = WS_OVL + 369 * MiB, WS_QKC = WS_OVL + 406 * MiB, WS_ACT = WS_ISC;
constexpr size_t WS_POOLED = WS_OVL, WS_YG = WS_OVL + 32 * MiB, WS_ACTM = WS_OVL + 100 * MiB, WS_D0 = WS_OVL + 338 * MiB, WS_D1 = WS_OVL + 370 * MiB, WS_ROUTE = WS_OVL + 402 * MiB, WS_PART = WS_OVL + 406 * MiB;
constexpr size_t WS_END = WS_OVL + 518 * MiB;
constexpr int MAXROWS = 34816;
constexpr size_t RT_TOKE = 0, RT_TOKG = 65536, RT_TOKR = 196608, RT_CNT = 262144, RT_ROWTS = 270336, RT_ROWG = 409600, RT_ROWR = 548864, RT_TILEE = 688128, RT_NT = 688128 + 1024, RT_TOKPOS = 1048576, RT_LT = 1048576 + 131072;
constexpr int CW_BAR = 4096;
constexpr int RING_BYTES = 131072, LDSCTL_OFF = RING_BYTES, MISC_OFF = LDSCTL_OFF + 320, LDS_BYTES = 147456;

#define GAS __attribute__((address_space(1)))
#define LAS __attribute__((address_space(3)))
typedef unsigned short bf16;
typedef unsigned v4u __attribute__((ext_vector_type(4)));
typedef unsigned v2u __attribute__((ext_vector_type(2)));
typedef float f32x4 __attribute__((ext_vector_type(4)));
typedef float f32x2 __attribute__((ext_vector_type(2)));
typedef short bf16x8 __attribute__((ext_vector_type(8)));
#define LDS_WAIT() asm volatile("s_waitcnt lgkmcnt(0)" ::: "memory")
typedef float f32x2c __attribute__((ext_vector_type(2))); typedef __bf16 bf16x2c __attribute__((ext_vector_type(2)));
__device__ __forceinline__ unsigned pk2(float lo, float hi) { const f32x2c v = {lo, hi}; return __builtin_bit_cast(unsigned, __builtin_convertvector(v, bf16x2c)); }
__device__ __forceinline__ unsigned f2bf(float f) { return pk2(f, 0.f) & 0xffffu; }
__device__ __forceinline__ float bflo(unsigned w) { return __uint_as_float(w << 16); }
__device__ __forceinline__ float bfhi(unsigned w) { return __uint_as_float(w & 0xffff0000u); }
__device__ __forceinline__ float bf2f(bf16 b) { return __uint_as_float(((unsigned)b) << 16); }
__device__ __forceinline__ float wave_sum(float v) {
#pragma unroll
    for (int o = 1; o < 64; o <<= 1) v += __shfl_xor(v, o);
    return v;
}
__device__ __forceinline__ float wave_max(float v) {
#pragma unroll
    for (int o = 1; o < 64; o <<= 1) v = fmaxf(v, __shfl_xor(v, o));
    return v;
}
__device__ __forceinline__ float fsig(float x) { return __builtin_amdgcn_rcpf(1.0f + __builtin_amdgcn_exp2f(-1.44269504f * x)); }
#define MFMA16(a, b, c) __builtin_amdgcn_mfma_f32_16x16x32_bf16((a), (b), (c), 0, 0, 0)
#define XB_TMO      128
#define XB_XCNT(j)  (256  + 64 * (j))
#define XB_XSUB(j)  (1280 + 64 * (j))
#define XB_XGEN(j)  (2304 + 64 * (j))
#define XB_TOP      3328
#define XB_TOPGEN   3392
#define XCD_BAR_WORDS 3456
#define XB_SPIN_CAP (1u << 18)

__device__ __forceinline__ unsigned xb_ld(unsigned* p)              { return __hip_atomic_load(p, __ATOMIC_RELAXED, __HIP_MEMORY_SCOPE_AGENT); }
__device__ __forceinline__ unsigned xb_add(unsigned* p, unsigned v) { return __hip_atomic_fetch_add(p, v, __ATOMIC_RELAXED, __HIP_MEMORY_SCOPE_AGENT); }
__device__ __forceinline__ unsigned xb_xcc_id() { return (unsigned)__builtin_amdgcn_s_getreg((3 << 11) | 20) & 0xFu; }
#define XB_SPIN(cond, bar) do { unsigned _sp = 0; while (cond) { __builtin_amdgcn_s_sleep(1); \
    if ((++_sp & 255u) == 0u) { if (xb_ld(&(bar)[XB_TMO])) break; if (_sp > XB_SPIN_CAP) { atomicAdd(&(bar)[XB_TMO], 1u); break; } } } } while (0)

struct XcdBarrier {
    unsigned* bar; unsigned x;
    volatile LAS unsigned* st;
};

__device__ __forceinline__ XcdBarrier xcd_barrier_post(unsigned* bar, volatile LAS unsigned* st) {
    XcdBarrier b; b.bar = bar; b.x = xb_xcc_id(); b.st = st;
    if (threadIdx.x == 0) (void)xb_add(&bar[XB_XCNT(b.x)], 1u);
    return b;
}
__device__ __forceinline__ void xcd_barrier_complete(unsigned* bar, unsigned x, unsigned& nloc, unsigned& nx) {
    const unsigned G = gridDim.x * gridDim.y * gridDim.z;
    unsigned sum, cnt, mine, sp = 0u;
    for (;;) {
        sum = 0u; cnt = 0u; mine = 0u;
#pragma unroll
        for (unsigned j = 0; j < 16; ++j) { const unsigned c = xb_ld(&bar[XB_XCNT(j)]); sum += c; cnt += (c > 0u) ? 1u : 0u; mine = (j == x) ? c : mine; }
        if (sum == G) break;
        __builtin_amdgcn_s_sleep(1);
        if ((++sp & 255u) == 0u) { if (xb_ld(&bar[XB_TMO])) break; if (sp > XB_SPIN_CAP) { atomicAdd(&bar[XB_TMO], 1u); break; } }
    }
    nloc = mine > 0u ? mine : 1u; nx = cnt > 0u ? cnt : 1u;
}

__device__ __forceinline__ void xcd_barrier(const XcdBarrier& b) {
    asm volatile("s_waitcnt vmcnt(0)" ::: "memory");
    __syncthreads();
    if (threadIdx.x == 0) {
        unsigned* bar = b.bar;
        __builtin_amdgcn_s_waitcnt(0);
        unsigned nloc = b.st[0], nx = b.st[1];
        if (nloc == 0u) { xcd_barrier_complete(bar, b.x, nloc, nx); b.st[0] = nloc; b.st[1] = nx; }
        const unsigned old = xb_add(&bar[XB_XSUB(b.x)], 1u);
        const unsigned gen = old / nloc;
        if (old + 1u == (gen + 1u) * nloc) {
            __builtin_amdgcn_fence(__ATOMIC_RELEASE, "agent");
            asm volatile("s_waitcnt vmcnt(0)" ::: "memory");
            const unsigned og = xb_add(&bar[XB_TOP], 1u);
            const unsigned tg = og / nx;
            if (og + 1u == (tg + 1u) * nx) xb_add(&bar[XB_TOPGEN], 1u);
            else XB_SPIN(xb_ld(&bar[XB_TOPGEN]) == tg, bar);
            __builtin_amdgcn_fence(__ATOMIC_ACQUIRE, "agent");
            xb_add(&bar[XB_XGEN(b.x)], 1u);
            asm volatile("s_waitcnt vmcnt(0)" ::: "memory");
        } else {
            XB_SPIN(xb_ld(&bar[XB_XGEN(b.x)]) == gen, bar);
            __builtin_amdgcn_fence(__ATOMIC_ACQUIRE, "agent");
            asm volatile("s_waitcnt vmcnt(0)" ::: "memory");
        }
    }
    __syncthreads();
}
struct Args { const float* in[28]; float* out; unsigned char* ws; int ph_lo, ph_hi; };
struct Frame {
    LAS unsigned char* lds; unsigned char* gl;
    volatile LAS unsigned* MISCW;
    int tid, lane, wave, G, bid, gw, NGW;
    float* out; unsigned char* ws;
    unsigned long long tacc, tprev;
};
#define INP(k) (args.in[k])
#define IN_X 0
#define IN_P 1
#define IN_NORM_MIX 2
#define IN_NORM_FFN 3
#define IN_W_IN 4
#define IN_B_GATE 5
#define IN_CONV 6
#define IN_NORM_H 7
#define IN_NORM_Q 8
#define IN_NORM_K 9
#define IN_NORM_KV 10
#define IN_W_UK 11
#define IN_W_UV 12
#define IN_W_OUT 13
#define IN_REL_BIAS 14
#define IN_W_POOL 15
#define IN_SCALE_POOL 16
#define IN_W_GATE_D 17
#define IN_W_UP_D 18
#define IN_W_DOWN_D 19
#define IN_W_ROUTER 20
#define IN_B_ROUTER 21
#define IN_W_GATE_M 22
#define IN_W_UP_M 23
#define IN_W_DOWN_M 24
#define IN_W_PLE 25
#define IN_W_PLE_GATE 26
#define IN_NORM_PLE 27

template <int MODE> __device__ __forceinline__ int dst_row(int n) {
    if (MODE == 0) return n;
    if (MODE == 1) return ((n >> 7) << 8) + (n & 127);
    if (MODE == 2) return ((n >> 7) << 8) + 128 + (n & 127);
    if (n < 2048) return n;
    if (n < 2052) return 3264 + (n - 2048);
    if (n < 2056) return 3268 + (n - 2052);
    if (n < 2568) return 2048 + (n - 2056);
    if (n < 2696) return 3072 + (n - 2568);
    if (n < 3208) return 2560 + (n - 2696);
    if (n < 3272) return 3200 + (n - 3208);
    return 3272 + (n - 3272);
}
template <int MODE> __device__ __forceinline__ void conv_item(Frame& F, const float* W, int K, int N, bf16* WT, const float* gain, int it) {
    LAS float* scr = (LAS float*)(F.lds + F.wave * 16384);
    const int nblk = (N + 31) >> 5, lane = F.lane, r = lane >> 3, c4 = lane & 7;
    {
        const int kb = it / nblk, nb = it - kb * nblk, k0 = 64 * kb, n0 = 32 * nb, nn = n0 + 4 * c4; const bool okn = nn < N;
        f32x4 v[8];
#pragma unroll
        for (int i = 0; i < 8; ++i) v[i] = okn ? *(const f32x4*)(W + (size_t)(k0 + 8 * i + r) * N + nn) : (f32x4){0.f, 0.f, 0.f, 0.f};
        if (gain) {
#pragma unroll
            for (int i = 0; i < 8; ++i) v[i] = v[i] * gain[k0 + 8 * i + r]; }
#pragma unroll
        for (int i = 0; i < 8; ++i) { LAS float* d = scr + (8 * i + r) * 33 + 4 * c4; d[0] = v[i].x; d[1] = v[i].y; d[2] = v[i].z; d[3] = v[i].w; }
        LDS_WAIT(); asm volatile("" ::: "memory");
        const int c = lane & 7;
#pragma unroll
        for (int j = 0; j < 4; ++j) { const int n = (lane >> 3) + 8 * j; const LAS float* s = scr + (8 * c) * 33 + n;
            v4u o; o.x = pk2(s[0 * 33], s[1 * 33]); o.y = pk2(s[2 * 33], s[3 * 33]); o.z = pk2(s[4 * 33], s[5 * 33]); o.w = pk2(s[6 * 33], s[7 * 33]);
            if (n0 + n < N) *(v4u*)(WT + (size_t)dst_row<MODE>(n0 + n) * K + k0 + 8 * c) = o; }
        LDS_WAIT(); asm volatile("" ::: "memory");
    }
}
template <int MODE> __device__ __forceinline__ void conv_mat(Frame& F, const float* W, int K, int N, bf16* WT, const float* gain, int wi, int nw) {
    const int nitems = (K >> 6) * ((N + 31) >> 5);
    for (int it = wi; it < nitems; it += nw) conv_item<MODE>(F, W, K, N, WT, gain, it);
}
constexpr int CQ_CH = 4, CQ_ITEMS = 24 * 1792, CQ_NCH = CQ_ITEMS / CQ_CH, CW_CQ = 65536, CQ_LIM1 = 16 * 896;
struct ConvMat { const float* W; bf16* WT; const float* gain; int K, N, nblk, rsel; };
#define CQ_LOAD(v, it_) do { const int kb_ = (it_) / cm.nblk, nb_ = (it_) - kb_ * cm.nblk; const float* p_ = cm.W + (size_t)(64 * kb_ + r) * cm.N + 32 * nb_ + 4 * c4; \
    _Pragma("unroll") for (int i_ = 0; i_ < 8; ++i_) (v)[i_] = *(const f32x4*)(p_ + (size_t)(8 * i_) * cm.N); } while (0)
#define CQ_FIN(v, it_) do { const int kb_ = (it_) / cm.nblk, nb_ = (it_) - kb_ * cm.nblk, k0_ = 64 * kb_, n0_ = 32 * nb_; \
    if (cm.gain) { _Pragma("unroll") for (int i_ = 0; i_ < 8; ++i_) (v)[i_] = (v)[i_] * cm.gain[k0_ + 8 * i_ + r]; } \
    _Pragma("unroll") for (int i_ = 0; i_ < 8; ++i_) { LAS float* d_ = scr + (8 * i_ + r) * 33 + 4 * c4; d_[0] = (v)[i_].x; d_[1] = (v)[i_].y; d_[2] = (v)[i_].z; d_[3] = (v)[i_].w; } \
    LDS_WAIT(); asm volatile("" ::: "memory"); \
    _Pragma("unroll") for (int j_ = 0; j_ < 4; ++j_) { const int n_ = r + 8 * j_; const LAS float* s_ = scr + (8 * c4) * 33 + n_; \
        v4u o_; o_.x = pk2(s_[0 * 33], s_[1 * 33]); o_.y = pk2(s_[2 * 33], s_[3 * 33]); o_.z = pk2(s_[4 * 33], s_[5 * 33]); o_.w = pk2(s_[6 * 33], s_[7 * 33]); \
        const int nn_ = n0_ + n_, row_ = cm.rsel ? (((nn_ >> 7) << 8) + (nn_ & 127) + ((cm.rsel == 2) ? 128 : 0)) : nn_; \
        *(v4u*)(cm.WT + (size_t)row_ * cm.K + k0_ + 8 * c4) = o_; } \
    LDS_WAIT(); asm volatile("" ::: "memory"); } while (0)
#define CQ_SETUP(c_) const int t0 = (int)(c_) * 2, mi = t0 / 1792, it0 = t0 - mi * 1792, e = (mi < 16) ? (mi >> 1) : (mi - 16), kind = (mi < 16) ? (mi & 1) : 2;     const size_t wo = ((size_t)o * NEXP + e) * DM * DFF; ConvMat cm; \
        if (kind == 2) { cm.W = INP(IN_W_DOWN_M) + wo; cm.WT = (bf16*)(F.ws + WS_W_MDN) + (size_t)e * 1024 * 3584; cm.gain = nullptr; cm.K = DFF; cm.N = DM; cm.nblk = DM / 32; cm.rsel = 0; } \
        else { cm.W = (kind == 0 ? INP(IN_W_GATE_M) : INP(IN_W_UP_M)) + wo; cm.WT = (bf16*)(F.ws + WS_W_MGU) + (size_t)e * 7168 * 1024; cm.gain = gain; cm.K = DM; cm.N = DFF; cm.nblk = DFF / 32; cm.rsel = 1 + kind; }
__device__ __forceinline__ void conv_queue(Frame& F, const Args& args, int o, unsigned* q, const unsigned* done, const bool until_done) {
    LAS float* scr = (LAS float*)(F.lds + F.wave * 16384);
    const int r = F.lane >> 3, c4 = F.lane & 7;
    const float* gain = INP(IN_NORM_FFN) + (2 * o + 1) * DM;
    f32x4 b0[8], b1[8], b2[8], b3[8];
    if (!until_done) {
        const unsigned q0 = __hip_atomic_load(q, __ATOMIC_RELAXED, __HIP_MEMORY_SCOPE_AGENT);
        for (unsigned c = q0 + (unsigned)F.gw; c < (unsigned)CQ_LIM1; c += (unsigned)F.NGW) { CQ_SETUP(c); CQ_LOAD(b0, it0 + 0); CQ_LOAD(b1, it0 + 1); CQ_FIN(b0, it0 + 0); CQ_FIN(b1, it0 + 1); }
        return;
    }
    for (;;) {
        if (__hip_atomic_load(done, __ATOMIC_RELAXED, __HIP_MEMORY_SCOPE_AGENT) != 0u) break;
        unsigned c = 0; if (F.lane == 0) c = atomicAdd(q, (unsigned)(CQ_CH / 2));
        c = __builtin_amdgcn_readfirstlane(c);
        if (c >= (unsigned)(CQ_ITEMS / 2)) break;
        CQ_SETUP(c);
        CQ_LOAD(b0, it0 + 0); CQ_LOAD(b1, it0 + 1); CQ_LOAD(b2, it0 + 2); CQ_LOAD(b3, it0 + 3);
#pragma unroll 1
        for (int j = 0; j < CQ_CH; j += 4) { const bool more = j + 4 < CQ_CH;
            CQ_FIN(b0, it0 + j + 0); if (more) CQ_LOAD(b0, it0 + j + 4);
            CQ_FIN(b1, it0 + j + 1); if (more) CQ_LOAD(b1, it0 + j + 5);
            CQ_FIN(b2, it0 + j + 2); if (more) CQ_LOAD(b2, it0 + j + 6);
            CQ_FIN(b3, it0 + j + 3); if (more) CQ_LOAD(b3, it0 + j + 7); }
    }
}
__device__ __forceinline__ void conv_drain2(Frame& F, const Args& args, int o, const unsigned* q, unsigned* q2) {
    LAS float* scr = (LAS float*)(F.lds + F.wave * 16384);
    volatile LAS unsigned* slot = (volatile LAS unsigned*)(F.lds + LDSCTL_OFF + 12288);
    const int r = F.lane >> 3, c4 = F.lane & 7;
    const float* gain = INP(IN_NORM_FFN) + (2 * o + 1) * DM;
    f32x4 b0[8], b1[8];
    unsigned base = __hip_atomic_load(q, __ATOMIC_RELAXED, __HIP_MEMORY_SCOPE_AGENT); if (base < (unsigned)CQ_LIM1) base = (unsigned)CQ_LIM1;
    for (;;) {
        __syncthreads();
        if (F.tid == 0) *slot = atomicAdd(q2, 8u);
        __syncthreads();
        const unsigned g = __builtin_amdgcn_readfirstlane(*slot);
        if (base + g >= (unsigned)(CQ_ITEMS / 2)) break;
        const unsigned c = base + g + (unsigned)F.wave;
        if (c < (unsigned)(CQ_ITEMS / 2)) { CQ_SETUP(c); CQ_LOAD(b0, it0 + 0); CQ_LOAD(b1, it0 + 1); CQ_FIN(b0, it0 + 0); CQ_FIN(b1, it0 + 1); }
    }
}
__device__ __forceinline__ void conv_moe(Frame& F, const Args& args, int o) {
    bf16* mgu = (bf16*)(F.ws + WS_W_MGU); bf16* mdn = (bf16*)(F.ws + WS_W_MDN);
    const float* gain = INP(IN_NORM_FFN) + (2 * o + 1) * DM;
    for (int e = 0; e < NEXP; ++e) {
        const size_t wo = ((size_t)o * NEXP + e) * DM * DFF;
        conv_mat<1>(F, INP(IN_W_GATE_M) + wo, DM, DFF, mgu + (size_t)e * 7168 * 1024, gain, F.gw, F.NGW);
        conv_mat<2>(F, INP(IN_W_UP_M) + wo, DM, DFF, mgu + (size_t)e * 7168 * 1024, gain, F.gw, F.NGW);
        conv_mat<0>(F, INP(IN_W_DOWN_M) + wo, DFF, DM, mdn + (size_t)e * 1024 * 3584, nullptr, F.gw, F.NGW);
    }
}
__device__ __forceinline__ void p0_prologue(Frame& F, const Args& args) {
    unsigned char* ws = F.ws;
    int off = 0;
#define CONV_BAL(MODE, W_, K_, N_, WT_, gain_) do { const int ni_ = ((K_) >> 6) * (((N_) + 31) >> 5); int wi_ = (F.gw - off) % F.NGW; if (wi_ < 0) wi_ += F.NGW; conv_mat<MODE>(F, W_, K_, N_, WT_, gain_, wi_, F.NGW); off = (off + ni_) % F.NGW; } while (0)
    for (int e = 0; e < 2; ++e) {
        CONV_BAL(3, INP(IN_W_IN) + (size_t)e * DM * 3280, DM, 3280, (bf16*)(ws + WS_W_IN) + (size_t)e * NINP * DM, INP(IN_NORM_MIX) + (2 * e) * DM);
        CONV_BAL(0, INP(IN_W_OUT) + (size_t)e * DM * DM, DM, DM, (bf16*)(ws + WS_W_OUT) + (size_t)e * DM * DM, nullptr);
        CONV_BAL(1, INP(IN_W_GATE_D) + (size_t)e * DM * DFF, DM, DFF, (bf16*)(ws + WS_W_GU) + (size_t)e * 7168 * DM, INP(IN_NORM_FFN) + (2 * e) * DM);
        CONV_BAL(2, INP(IN_W_UP_D) + (size_t)e * DM * DFF, DM, DFF, (bf16*)(ws + WS_W_GU) + (size_t)e * 7168 * DM, INP(IN_NORM_FFN) + (2 * e) * DM);
        CONV_BAL(0, INP(IN_W_DOWN_D) + (size_t)e * DFF * DM, DFF, DM, (bf16*)(ws + WS_W_DN) + (size_t)e * DM * DFF, nullptr);
        CONV_BAL(0, INP(IN_W_UK) + (size_t)e * 128 * 64, 128, 64, (bf16*)(ws + WS_SMALL + 8192) + (size_t)e * 64 * 128, nullptr);
        for (int h = 0; h < 8; ++h)
            CONV_BAL(0, INP(IN_W_UV) + ((size_t)e * 8 + h) * 128 * 64, 128, 64, (bf16*)(ws + WS_SMALL + 65536) + ((size_t)e * 512 + h * 64) * 128, nullptr);
        for (int g = 0; g < 4; ++g)
            CONV_BAL(0, INP(IN_W_POOL) + ((size_t)e * 4 + g) * 256 * 256, 256, 256, (bf16*)(ws + WS_W_POOL) + ((size_t)e * 4 + g) * 256 * 256, nullptr);
    }
    for (int i = 0; i < 4; ++i) {
        CONV_BAL(0, INP(IN_W_PLE_GATE) + (size_t)i * DM * DM, DM, DM, (bf16*)(ws + WS_W_PG) + (size_t)i * DM * DM, INP(IN_NORM_PLE) + i * DM);
        CONV_BAL(0, INP(IN_W_PLE) + (size_t)i * PLED * DM, PLED, DM, (bf16*)(ws + WS_W_PL) + (size_t)i * DM * PLED, nullptr);
    }
    const int gt = F.bid * 512 + F.tid, NT = F.G * 512;
    for (int i = gt; i < 2 * 48 * DM / 8; i += NT) { const int e = i / (48 * DM / 8), r = i - e * (48 * DM / 8); *(v4u*)((bf16*)(ws + WS_W_IN) + ((size_t)e * NINP + 3280) * DM + (size_t)r * 8) = (v4u){0u, 0u, 0u, 0u}; }
    if (F.bid == 0) for (int t = F.tid; t < 1024; t += 512) { const int hh = t >> 7, d = t & 127; int bk = d;
        if (d >= 16) { bk = 16 + (d >= 19) + (d >= 21) + (d >= 24) + (d >= 27) + (d >= 31) + (d >= 35) + (d >= 40) + (d >= 46) + (d >= 52) + (d >= 59) + (d >= 67) + (d >= 77) + (d >= 87) + (d >= 99) + (d >= 113); }
        ((float*)(ws + WS_SMALL))[t] = INP(IN_REL_BIAS)[bk * 8 + hh] * LOG2E; }
    { const f32x4* src = (const f32x4*)INP(IN_P); v4u* dst = (v4u*)(ws + WS_PB);
      constexpr int TOT = 4 * M * PLED / 8;
      for (int i = gt; i < TOT; i += 4 * NT) {
          f32x4 a[4], b[4];
#pragma unroll
          for (int k = 0; k < 4; ++k) { const int ii = i + k * NT; if (ii < TOT) { a[k] = src[2 * ii]; b[k] = src[2 * ii + 1]; } }
#pragma unroll
          for (int k = 0; k < 4; ++k) { const int ii = i + k * NT; if (ii < TOT) { v4u o; o.x = pk2(a[k].x, a[k].y); o.y = pk2(a[k].z, a[k].w); o.z = pk2(b[k].x, b[k].y); o.w = pk2(b[k].z, b[k].w); dst[ii] = o; } } } }
    { const float* x = INP(IN_X); bf16* hb = (bf16*)(ws + WS_HB0); float* st = (float*)(ws + WS_STATS);
      for (int m0 = F.gw; m0 < M; m0 += 2 * F.NGW) {
          f32x4 v[2][4];
#pragma unroll
          for (int k = 0; k < 2; ++k) { const int m = m0 + k * F.NGW; if (m < M) { const f32x4* xr = (const f32x4*)(x + (size_t)m * DM) + F.lane;
#pragma unroll
              for (int j = 0; j < 4; ++j) v[k][j] = xr[64 * j]; } }
#pragma unroll
          for (int k = 0; k < 2; ++k) { const int m = m0 + k * F.NGW; if (m < M) { float s = 0.f;
#pragma unroll
              for (int j = 0; j < 4; ++j) s += (v[k][j].x * v[k][j].x + v[k][j].y * v[k][j].y) + (v[k][j].z * v[k][j].z + v[k][j].w * v[k][j].w);
              s = wave_sum(s);
              v2u* o8 = (v2u*)(hb + (size_t)m * DM) + F.lane;
#pragma unroll
              for (int j = 0; j < 4; ++j) { v2u w; w.x = pk2(v[k][j].x, v[k][j].y); w.y = pk2(v[k][j].z, v[k][j].w); o8[64 * j] = w; }
              if (F.lane < 16) st[(size_t)m * 16 + F.lane] = (F.lane == 0) ? s : 0.f; } } } }
}

struct EvenPtrs {
    const bf16 *QK, *VB, *OG, *BQ, *BQI; const float* MISC; bf16 *MIX, *KB, *KIB, *VT, *QKC; unsigned* MASK; float* CHS; float* MST; float* ISC; float* U; bf16* CB;
    const float *bgate, *conv, *gh, *gq, *gk, *gkv; const bf16 *WukT, *WuvT; const float* bt;
};
__device__ __forceinline__ void conv8(const bf16* QK, const float* cw, int rowb, int tpos, int ch, float (&o)[8]) {
#pragma unroll
    for (int j = 0; j < 8; ++j) o[j] = 0.f;
#pragma unroll
    for (int tap = 0; tap < 4; ++tap) { const int tp = tpos - 3 + tap;
        if (tp >= 0) { const v4u w = *(const v4u*)(QK + (size_t)(rowb + tp) * 1024 + ch); const f32x4 c0 = *(const f32x4*)(cw + tap * 1024 + ch), c1 = *(const f32x4*)(cw + tap * 1024 + ch + 4);
            o[0] += bflo(w.x) * c0.x; o[1] += bfhi(w.x) * c0.y; o[2] += bflo(w.y) * c0.z; o[3] += bfhi(w.y) * c0.w;
            o[4] += bflo(w.z) * c1.x; o[5] += bfhi(w.z) * c1.y; o[6] += bflo(w.w) * c1.z; o[7] += bfhi(w.w) * c1.w; } }
#pragma unroll
    for (int j = 0; j < 8; ++j) o[j] = o[j] * fsig(o[j]);
}
__device__ __forceinline__ void chunk_gates(const EvenPtrs& P, int row, int hh, int lane, float& li, float& bc) {
    const float ai = P.MISC[(size_t)row * 256 + 192 + hh], af = P.MISC[(size_t)row * 256 + 196 + hh];
    li = ai + P.bgate[hh]; const float x = af + P.bgate[4 + hh]; const float lf = fminf(x, 0.f) - log1pf(__expf(-fabsf(x)));
    bc = lf;
#pragma unroll
    for (int o = 1; o < 64; o <<= 1) { const float t = __shfl_up(bc, o); if (lane >= o) bc += t; }
}
__device__ __forceinline__ void chunk_gates_pre(const EvenPtrs& P, float ai, float af, int hh, int lane, float& li, float& bc) {
    li = ai + P.bgate[hh]; const float x = af + P.bgate[4 + hh]; const float lf = fminf(x, 0.f) - log1pf(__expf(-fabsf(x)));
    bc = lf;
#pragma unroll
    for (int o = 1; o < 64; o <<= 1) { const float t = __shfl_up(bc, o); if (lane >= o) bc += t; }
}
#define MLA_BAR() asm volatile("s_waitcnt lgkmcnt(0)\n\ts_barrier" ::: "memory")
__device__ __forceinline__ void mlstm_a(Frame& F, const EvenPtrs& P) {
    bf16* KT = (bf16*)F.gl; bf16* VwT = (bf16*)(F.gl + 18432); float* wv = (float*)(F.gl + 18432 + 20736);
    const int tid = F.tid, lane = F.lane, w = F.wave, fr = lane & 15, fq = lane >> 4;
    const int NU = BATCH * 4 * NCHUNK;
    const int cg = tid & 31, s0c = (tid >> 5) * 4, vg = tid & 15, s0v = ((tid & 255) >> 4) * 4;
    v4u xin[7], vw[4]; float gai = 0.f, gaf = 0.f;
#define MLA_LOAD(u_) do { const int u2_ = (u_); const int b_ = u2_ >> 7, h_ = (u2_ >> 5) & 3, c_ = u2_ & 31; const size_t rb_ = (size_t)b_ * SEQ; const int t0_ = c_ * 64; \
        const int ch_ = (cg < 16 ? 0 : 512 - 128) + h_ * 128 + cg * 8; \
        _Pragma("unroll") for (int i = 0; i < 7; ++i) { const int tp = t0_ + s0c - 3 + i; xin[i] = (tp >= 0) ? *(const v4u*)(P.QK + (rb_ + tp) * 1024 + ch_) : (v4u){0u, 0u, 0u, 0u}; } \
        if (tid < 256) { _Pragma("unroll") for (int r = 0; r < 4; ++r) vw[r] = *(const v4u*)(P.VB + (rb_ + t0_ + s0v + r) * 512 + h_ * 128 + vg * 8); } \
        if (tid < 64) { gai = P.MISC[(rb_ + t0_ + tid) * 256 + 192 + h_]; gaf = P.MISC[(rb_ + t0_ + tid) * 256 + 196 + h_]; } } while (0)
    if (F.bid < NU) MLA_LOAD(F.bid);
    for (int unit = F.bid; unit < NU; unit += F.G) {
        const int b = unit >> 7, hh = (unit >> 5) & 3, c = unit & 31, rowb = b * SEQ, t0 = c * 64;
        if (w == 0) { float li, bc; chunk_gates_pre(P, gai, gaf, hh, lane, li, bc); const float blast = __shfl(bc, 63), g = blast - bc + li, gmax = wave_max(g);
            wv[lane] = __expf(g - gmax); if (lane == 0) { P.CHS[unit * 2] = blast; P.CHS[unit * 2 + 1] = gmax; } }
        { const int ch = (cg < 16 ? 0 : 512 - 128) + hh * 128 + cg * 8;
          float cw[4][8];
#pragma unroll
          for (int tap = 0; tap < 4; ++tap) { const f32x4 c0 = *(const f32x4*)(P.conv + tap * 1024 + ch), c1 = *(const f32x4*)(P.conv + tap * 1024 + ch + 4);
              cw[tap][0] = c0.x; cw[tap][1] = c0.y; cw[tap][2] = c0.z; cw[tap][3] = c0.w; cw[tap][4] = c1.x; cw[tap][5] = c1.y; cw[tap][6] = c1.z; cw[tap][7] = c1.w; }
          float o[4][8];
#pragma unroll
          for (int r = 0; r < 4; ++r) {
#pragma unroll
              for (int j = 0; j < 8; ++j) o[r][j] = 0.f;
#pragma unroll
              for (int tap = 0; tap < 4; ++tap) { const v4u xw = xin[r + tap];
                  o[r][0] += bflo(xw.x) * cw[tap][0]; o[r][1] += bfhi(xw.x) * cw[tap][1]; o[r][2] += bflo(xw.y) * cw[tap][2]; o[r][3] += bfhi(xw.y) * cw[tap][3];
                  o[r][4] += bflo(xw.z) * cw[tap][4]; o[r][5] += bfhi(xw.z) * cw[tap][5]; o[r][6] += bflo(xw.w) * cw[tap][6]; o[r][7] += bfhi(xw.w) * cw[tap][7]; }
              const float sc = (cg < 16) ? 1.0f : 0.08838834764831845f;
#pragma unroll
              for (int j = 0; j < 8; ++j) o[r][j] = o[r][j] * fsig(o[r][j]) * sc;
              v4u q; q.x = pk2(o[r][0], o[r][1]); q.y = pk2(o[r][2], o[r][3]); q.z = pk2(o[r][4], o[r][5]); q.w = pk2(o[r][6], o[r][7]);
              *(v4u*)(P.QKC + (size_t)(rowb + t0 + s0c + r) * 1024 + ch) = q; }
          if (cg >= 16) { const int d0 = (cg - 16) * 8;
#pragma unroll
              for (int j = 0; j < 8; ++j) { v2u pk; pk.x = pk2(o[0][j], o[1][j]); pk.y = pk2(o[2][j], o[3][j]); *(v2u*)(KT + (d0 + j) * 72 + s0c) = pk; } } }
        MLA_BAR();
        if (tid < 256) { float ws4[4];
#pragma unroll
            for (int r = 0; r < 4; ++r) ws4[r] = wv[s0v + r];
#pragma unroll
            for (int j = 0; j < 4; ++j) { const unsigned w0 = j == 0 ? vw[0].x : j == 1 ? vw[0].y : j == 2 ? vw[0].z : vw[0].w, w1 = j == 0 ? vw[1].x : j == 1 ? vw[1].y : j == 2 ? vw[1].z : vw[1].w,
                                                    w2 = j == 0 ? vw[2].x : j == 1 ? vw[2].y : j == 2 ? vw[2].z : vw[2].w, w3 = j == 0 ? vw[3].x : j == 1 ? vw[3].y : j == 2 ? vw[3].z : vw[3].w;
                v2u lo, hi; lo.x = pk2(bflo(w0) * ws4[0], bflo(w1) * ws4[1]); lo.y = pk2(bflo(w2) * ws4[2], bflo(w3) * ws4[3]); hi.x = pk2(bfhi(w0) * ws4[0], bfhi(w1) * ws4[1]); hi.y = pk2(bfhi(w2) * ws4[2], bfhi(w3) * ws4[3]);
                *(v2u*)(VwT + (vg * 8 + 2 * j) * 72 + s0v) = lo; *(v2u*)(VwT + (vg * 8 + 2 * j + 1) * 72 + s0v) = hi; } }
        else if (tid < 320) VwT[128 * 72 + (tid - 256)] = (bf16)f2bf(wv[tid - 256]);
        else for (int i = tid - 320; i < 15 * 64; i += 192) VwT[(129 + (i >> 6)) * 72 + (i & 63)] = 0;
        if (unit + F.G < NU) MLA_LOAD(unit + F.G);
        MLA_BAR();
        { bf16x8 bfr[2]; f32x4 acc[9];
#pragma unroll
          for (int ks = 0; ks < 2; ++ks) bfr[ks] = *(const bf16x8*)(KT + (16 * w + fr) * 72 + 8 * fq + 32 * ks);
#pragma unroll
          for (int rt = 0; rt < 9; ++rt) { acc[rt] = (f32x4){0.f, 0.f, 0.f, 0.f};
#pragma unroll
              for (int ks = 0; ks < 2; ++ks) { const bf16x8 a = *(const bf16x8*)(VwT + (16 * rt + fr) * 72 + 8 * fq + 32 * ks); acc[rt] = MFMA16(a, bfr[ks], acc[rt]); } }
          float* Uo = P.U + (size_t)unit * 144 * 128 + 16 * w + fr;
#pragma unroll
          for (int rt = 0; rt < 9; ++rt)
#pragma unroll
              for (int r = 0; r < 4; ++r) Uo[(size_t)(16 * rt + 4 * fq + r) * 128] = acc[rt][r]; }
        MLA_BAR();
    }
#undef MLA_LOAD
    asm volatile("s_waitcnt vmcnt(0)" ::: "memory"); __syncthreads();
}
#undef MLA_BAR
__device__ __forceinline__ void mlstm_b(Frame& F, const EvenPtrs& P) {
    const int gt = F.bid * 512 + F.tid, NT = F.G * 512;
    for (int e = gt; e < BATCH * 4 * 129 * 128; e += NT) {
        const int d = e & 127, v = (e >> 7) % 129, bh = e / (129 * 128);
        float u[NCHUNK];
#pragma unroll
        for (int c = 0; c < NCHUNK; ++c) u[c] = P.U[((size_t)(bh * 32 + c) * 144 + v) * 128 + d];
        float C = 0.f, m = 0.f;
#pragma unroll
        for (int c = 0; c < NCHUNK; ++c) { const int unit = bh * 32 + c; const size_t idx = ((size_t)unit * 144 + v) * 128 + d;
            P.CB[idx] = (bf16)f2bf(C);
            if (v == 0 && d == 0) P.MST[unit] = m;
            const float blast = P.CHS[unit * 2], gmax = P.CHS[unit * 2 + 1], mn = fmaxf(blast + m, gmax);
            C = __expf(blast + m - mn) * C + __expf(gmax - mn) * u[c]; m = mn; }
    }
    for (int e = gt; e < BATCH * 4 * NCHUNK * 15 * 128; e += NT) { const int d = e & 127, r = (e >> 7) % 15, unit = e / (15 * 128); P.CB[((size_t)unit * 144 + 129 + r) * 128 + d] = 0; }
}
#define MLC_BAR() asm volatile("s_waitcnt lgkmcnt(0)\n\ts_barrier" ::: "memory")
__device__ __forceinline__ void mlstm_c(Frame& F, const EvenPtrs& P) {
    bf16* Qs = (bf16*)F.gl; bf16* Ks = (bf16*)(F.gl + 17408); bf16* VTa = (bf16*)(F.gl + 34816); bf16* Ps = (bf16*)(F.gl + 55552);
    float* av = (float*)(F.gl + 64768); float* pmv = av + 64; float* bcv = av + 128; float* ssb = av + 192;
    const int tid = F.tid, lane = F.lane, w = F.wave, fr = lane & 15, fq = lane >> 4;
    const int NU = BATCH * 4 * NCHUNK;
    v4u qv[2], kv[2], vw[4]; float mc = 0.f;
#define MLC_LOAD(u_) do { const int u2_ = (u_); const int b_ = u2_ >> 7, h_ = (u2_ >> 5) & 3, c_ = u2_ & 31; const size_t r0_ = (size_t)b_ * SEQ + c_ * 64; \
        _Pragma("unroll") for (int i = 0; i < 2; ++i) { const int idx = tid + 512 * i, s = idx >> 4, ch = (idx & 15) * 8; \
            qv[i] = *(const v4u*)(P.QKC + (r0_ + s) * 1024 + h_ * 128 + ch); kv[i] = *(const v4u*)(P.QKC + (r0_ + s) * 1024 + 512 + h_ * 128 + ch); } \
        if (tid < 256) { const int vg = tid & 15, s0 = (tid >> 4) * 4; _Pragma("unroll") for (int r = 0; r < 4; ++r) vw[r] = *(const v4u*)(P.VB + (r0_ + s0 + r) * 512 + h_ * 128 + vg * 8); } \
        mc = P.MST[u2_]; } while (0)
    if (F.bid < NU) MLC_LOAD(F.bid);
    for (int unit = F.bid; unit < NU; unit += F.G) {
        const int b = unit >> 7, hh = (unit >> 5) & 3, c = unit & 31, rowb = b * SEQ, t0 = c * 64;
        const int tt = w & 3, hf = w >> 2, t = 16 * tt + fr; const size_t row = (size_t)(rowb + t0 + t);
        bf16x8 cbf[5][4]; v2u ogw[4];
#pragma unroll
        for (int i = 0; i < 5; ++i) { const int vt = (i < 4) ? 4 * hf + i : 8;
#pragma unroll
            for (int ks = 0; ks < 4; ++ks) cbf[i][ks] = *(const bf16x8*)(P.CB + ((size_t)unit * 144 + 16 * vt + fr) * 128 + 8 * fq + 32 * ks); }
#pragma unroll
        for (int i = 0; i < 4; ++i) ogw[i] = *(const v2u*)(P.OG + row * 512 + hh * 128 + 16 * (4 * hf + i) + 4 * fq);
        const float mcu = mc;
        if (w == 0) { float li, bc; chunk_gates(P, rowb + t0 + lane, hh, lane, li, bc); const float a = li - bc; float p = a;
#pragma unroll
            for (int o = 1; o < 64; o <<= 1) { const float t2 = __shfl_up(p, o); if (lane >= o) p = fmaxf(p, t2); }
            av[lane] = a; pmv[lane] = fmaxf(p, mcu); bcv[lane] = bc; }
        {
#pragma unroll
          for (int i = 0; i < 2; ++i) { const int idx = tid + 512 * i, s = idx >> 4, ch = (idx & 15) * 8; *(v4u*)(Qs + s * 136 + ch) = qv[i]; *(v4u*)(Ks + s * 136 + ch) = kv[i]; }
          if (tid < 256) { const int vg = tid & 15, s0 = (tid >> 4) * 4;
#pragma unroll
              for (int j = 0; j < 4; ++j) { const unsigned w0 = j == 0 ? vw[0].x : j == 1 ? vw[0].y : j == 2 ? vw[0].z : vw[0].w, w1 = j == 0 ? vw[1].x : j == 1 ? vw[1].y : j == 2 ? vw[1].z : vw[1].w,
                                                      w2 = j == 0 ? vw[2].x : j == 1 ? vw[2].y : j == 2 ? vw[2].z : vw[2].w, w3 = j == 0 ? vw[3].x : j == 1 ? vw[3].y : j == 2 ? vw[3].z : vw[3].w;
                  v2u lo, hi; lo.x = (w0 & 0xffffu) | (w1 << 16); lo.y = (w2 & 0xffffu) | (w3 << 16); hi.x = (w0 >> 16) | (w1 & 0xffff0000u); hi.y = (w2 >> 16) | (w3 & 0xffff0000u);
                  *(v2u*)(VTa + (vg * 8 + 2 * j) * 72 + s0) = lo; *(v2u*)(VTa + (vg * 8 + 2 * j + 1) * 72 + s0) = hi; } }
          else if (tid < 320) VTa[128 * 72 + (tid - 256)] = (bf16)0x3f80u;
          else for (int i = tid - 320; i < 15 * 64; i += 192) VTa[(129 + (i >> 6)) * 72 + (i & 63)] = 0; }
        if (unit + F.G < NU) MLC_LOAD(unit + F.G);
        MLC_BAR();
        { const int rt = w >> 1;
#pragma unroll
          for (int c2 = 0; c2 < 2; ++c2) { const int ct = 2 * (w & 1) + c2; f32x4 acc = (f32x4){0.f, 0.f, 0.f, 0.f};
#pragma unroll
              for (int ks = 0; ks < 4; ++ks) { const bf16x8 a = *(const bf16x8*)(Qs + (16 * rt + fr) * 136 + 8 * fq + 32 * ks), bb = *(const bf16x8*)(Ks + (16 * ct + fr) * 136 + 8 * fq + 32 * ks); acc = MFMA16(a, bb, acc); }
              const int s = 16 * ct + fr; const float as = av[s];
#pragma unroll
              for (int r = 0; r < 4; ++r) { const int t3 = 16 * rt + 4 * fq + r; const float p = (s <= t3) ? acc[r] * __expf(as - pmv[t3]) : 0.f; Ps[t3 * 72 + s] = (bf16)f2bf(p); } } }
        MLC_BAR();
        { f32x4 ni[5], ne[5];
#pragma unroll
          for (int i = 0; i < 5; ++i) { const int vt = (i < 4) ? 4 * hf + i : 8; ni[i] = (f32x4){0.f, 0.f, 0.f, 0.f}; ne[i] = (f32x4){0.f, 0.f, 0.f, 0.f};
#pragma unroll
              for (int ks = 0; ks < 2; ++ks) { const bf16x8 a = *(const bf16x8*)(VTa + (16 * vt + fr) * 72 + 8 * fq + 32 * ks), bb = *(const bf16x8*)(Ps + (16 * tt + fr) * 72 + 8 * fq + 32 * ks); ni[i] = MFMA16(a, bb, ni[i]); }
#pragma unroll
              for (int ks = 0; ks < 4; ++ks) { const bf16x8 bb = *(const bf16x8*)(Qs + (16 * tt + fr) * 136 + 8 * fq + 32 * ks); ne[i] = MFMA16(cbf[i][ks], bb, ne[i]); } }
          const float pm = pmv[t], wi = __expf(mcu - pm), fl = __expf(-(bcv[t] + pm));
#pragma unroll
          for (int i = 0; i < 5; ++i) ni[i] = ni[i] + ne[i] * wi;
          const float den = __shfl(ni[4].x, fr), rinv = __builtin_amdgcn_rcpf(fmaxf(fabsf(den), fl)); float q = 0.f;
#pragma unroll
          for (int i = 0; i < 4; ++i) { ni[i] = ni[i] * rinv; q += (ni[i].x * ni[i].x + ni[i].y * ni[i].y) + (ni[i].z * ni[i].z + ni[i].w * ni[i].w); }
          q += __shfl_xor(q, 16); q += __shfl_xor(q, 32);
          if (fq == 0) ssb[w * 16 + fr] = q;
          MLC_BAR();
          const float rs = rsqrtf((q + ssb[(w ^ 4) * 16 + fr]) * (1.0f / 128.0f) + 1e-6f);
#pragma unroll
          for (int i = 0; i < 4; ++i) { const int col = hh * 128 + 16 * (4 * hf + i) + 4 * fq; const f32x4 g = *(const f32x4*)(P.gh + col); const v2u og = ogw[i];
              v2u o; o.x = pk2(ni[i].x * rs * g.x * bflo(og.x), ni[i].y * rs * g.y * bfhi(og.x)); o.y = pk2(ni[i].z * rs * g.z * bflo(og.y), ni[i].w * rs * g.w * bfhi(og.y));
              *(v2u*)(P.MIX + row * 1024 + col) = o; } }
        MLC_BAR();
    }
#undef MLC_LOAD
    asm volatile("s_waitcnt vmcnt(0)" ::: "memory"); __syncthreads();
}
#undef MLC_BAR
__device__ __forceinline__ void dsa_prep(Frame& F, const EvenPtrs& P) {
    bf16* LAT = (bf16*)F.gl;
    const int lane = F.lane, w = F.wave, fr = lane & 15, fq = lane >> 4;
    for (int tile = F.bid; tile < M / 64; tile += F.G) {
        const int row0 = tile * 64, b = row0 >> 11, s0 = row0 & 2047;
        bf16x8 wk[4][4], wv[4][4];
        if (w < 4) {
#pragma unroll
            for (int ct = 0; ct < 4; ++ct)
#pragma unroll
                for (int ks = 0; ks < 4; ++ks) wk[ct][ks] = *(const bf16x8*)(P.WukT + (16 * ct + fr) * 128 + 8 * fq + 32 * ks); }
#pragma unroll
        for (int i = 0; i < 4; ++i)
#pragma unroll
            for (int ks = 0; ks < 4; ++ks) wv[i][ks] = *(const bf16x8*)(P.WuvT + (size_t)(16 * (w + 8 * i) + fr) * 128 + 8 * fq + 32 * ks);
        { f32x2 x[8]; float ss[8];
          const f32x2 g = *(const f32x2*)(P.gkv + 2 * lane);
#pragma unroll
          for (int i = 0; i < 8; ++i) x[i] = *(const f32x2*)(P.MISC + (size_t)(row0 + w * 8 + i) * 256 + 2 * lane);
#pragma unroll
          for (int i = 0; i < 8; ++i) ss[i] = x[i].x * x[i].x + x[i].y * x[i].y;
#pragma unroll
          for (int o = 1; o < 64; o <<= 1)
#pragma unroll
              for (int i = 0; i < 8; ++i) ss[i] += __shfl_xor(ss[i], o);
#pragma unroll
          for (int i = 0; i < 8; ++i) { const float r = rsqrtf(ss[i] * (1.0f / 128.0f) + 1e-6f); *(unsigned*)(LAT + (w * 8 + i) * 136 + 2 * lane) = pk2(x[i].x * r * g.x, x[i].y * r * g.y); } }
        __syncthreads();
        if (w < 4) { const int rt = w; f32x4 acc[4]; float q[4] = {0.f, 0.f, 0.f, 0.f};
#pragma unroll
            for (int ct = 0; ct < 4; ++ct) { acc[ct] = (f32x4){0.f, 0.f, 0.f, 0.f};
#pragma unroll
                for (int ks = 0; ks < 4; ++ks) { const bf16x8 a = *(const bf16x8*)(LAT + (16 * rt + fr) * 136 + 8 * fq + 32 * ks); acc[ct] = MFMA16(a, wk[ct][ks], acc[ct]); }
#pragma unroll
                for (int r = 0; r < 4; ++r) q[r] += acc[ct][r] * acc[ct][r]; }
#pragma unroll
            for (int r = 0; r < 4; ++r) { float s = q[r]; s += __shfl_xor(s, 1); s += __shfl_xor(s, 2); s += __shfl_xor(s, 4); s += __shfl_xor(s, 8); q[r] = rsqrtf(s * (1.0f / 64.0f) + 1e-6f); }
#pragma unroll
            for (int ct = 0; ct < 4; ++ct) { const float g = P.gk[16 * ct + fr];
#pragma unroll
                for (int r = 0; r < 4; ++r) P.KB[(size_t)(row0 + 16 * rt + 4 * fq + r) * 64 + 16 * ct + fr] = (bf16)f2bf(acc[ct][r] * q[r] * g); } }
#pragma unroll
        for (int i = 0; i < 4; ++i) { const int rt = w + 8 * i;
#pragma unroll
            for (int ct = 0; ct < 4; ++ct) { f32x4 acc = (f32x4){0.f, 0.f, 0.f, 0.f};
#pragma unroll
                for (int ks = 0; ks < 4; ++ks) { const bf16x8 bb = *(const bf16x8*)(LAT + (16 * ct + fr) * 136 + 8 * fq + 32 * ks); acc = MFMA16(wv[i][ks], bb, acc); }
#pragma unroll
                for (int r = 0; r < 4; ++r) { const int hd = 16 * rt + 4 * fq + r; P.VT[((size_t)(b * 8 + (hd >> 6)) * 64 + (hd & 63)) * 2048 + s0 + 16 * ct + fr] = (bf16)f2bf(acc[r]); } } }
        __syncthreads();
    }
}
__device__ __forceinline__ void dsa_index(Frame& F, const EvenPtrs& P) {
    const int lane = F.lane, fr = lane & 15, fq = lane >> 4;
    constexpr int TPB = 128 * 129 / 2, TOT = BATCH * TPB;
    const int per = (TOT + F.NGW - 1) / F.NGW;
    int idx = F.gw * per; const int end = (idx + per < TOT) ? idx + per : TOT;
    if (idx >= end) return;
    int b = idx / TPB; const int r0 = idx - b * TPB;
    int qt = (int)((sqrtf(8.f * (float)r0 + 1.f) - 1.f) * 0.5f); while ((qt + 1) * (qt + 2) / 2 <= r0) ++qt; while (qt * (qt + 1) / 2 > r0) --qt;
    int kt = r0 - qt * (qt + 1) / 2;
    while (idx < end) {
        const int left = end - idx, avail = qt + 1 - kt, nseg = left < avail ? left : avail;
        const size_t rowq = (size_t)b * SEQ + qt * 16 + fr;
        bf16x8 qf[8][2]; float wq[8];
#pragma unroll
        for (int hh = 0; hh < 8; ++hh)
#pragma unroll
            for (int ks = 0; ks < 2; ++ks) qf[hh][ks] = *(const bf16x8*)(P.BQI + rowq * 512 + hh * 64 + 32 * ks + 8 * fq);
        { const f32x4 w0 = *(const f32x4*)(P.MISC + rowq * 256 + 200), w1 = *(const f32x4*)(P.MISC + rowq * 256 + 204); wq[0] = w0.x; wq[1] = w0.y; wq[2] = w0.z; wq[3] = w0.w; wq[4] = w1.x; wq[5] = w1.y; wq[6] = w1.z; wq[7] = w1.w; }
        const bf16* kip = P.KIB + ((size_t)b * SEQ + kt * 16 + fr) * 64 + 8 * fq;
        bf16x8 a0 = *(const bf16x8*)kip, a1 = *(const bf16x8*)(kip + 32);
        for (int i = 0; i < nseg; ++i) { const int sk = (kt + i) * 16; const bf16x8 c0 = a0, c1 = a1;
            if (i + 1 < nseg) { a0 = *(const bf16x8*)(kip + (size_t)(i + 1) * 16 * 64); a1 = *(const bf16x8*)(kip + (size_t)(i + 1) * 16 * 64 + 32); }
            f32x4 sc = (f32x4){0.f, 0.f, 0.f, 0.f};
#pragma unroll
            for (int hh = 0; hh < 8; ++hh) { f32x4 acc = MFMA16(c0, qf[hh][0], ((f32x4){0.f, 0.f, 0.f, 0.f})); acc = MFMA16(c1, qf[hh][1], acc);
                sc.x += wq[hh] * fmaxf(acc.x, 0.f); sc.y += wq[hh] * fmaxf(acc.y, 0.f); sc.z += wq[hh] * fmaxf(acc.z, 0.f); sc.w += wq[hh] * fmaxf(acc.w, 0.f); }
            *(f32x4*)(P.ISC + rowq * 2048 + sk + 4 * fq) = sc; }
        idx += nseg; kt += nseg;
        if (kt > qt) { kt = 0; if (++qt == 128) { qt = 0; ++b; } }
    }
}
__device__ __forceinline__ unsigned fkey(float f) { const unsigned u = __float_as_uint(f); return (u & 0x80000000u) ? ~u : (u | 0x80000000u); }
template <int NJ> __device__ __forceinline__ void select_row(const float* isc, unsigned long long* mo, int t, int lane) {
    unsigned key[NJ];
#pragma unroll
    for (int j = 0; j < NJ; ++j) { const int s = 64 * j + lane; const float x = (s <= t) ? isc[s] : 0.f; key[j] = (s <= t) ? fkey(x) : 0u; }
    unsigned T = 0u;
    for (int bit = 31; bit >= 0; --bit) { const unsigned cand = T | (1u << bit); int cnt = 0;
#pragma unroll
        for (int j = 0; j < NJ; ++j) cnt += __popcll(__ballot(key[j] >= cand));
        if (cnt >= 256) T = cand; }
    int cgt = 0;
#pragma unroll
    for (int j = 0; j < NJ; ++j) cgt += __popcll(__ballot(key[j] > T));
    const int need = 256 - cgt; int run = 0; const unsigned long long lt = (lane == 0) ? 0ull : (~0ull >> (64 - lane));
#pragma unroll
    for (int j = 0; j < 32; ++j) { unsigned long long m = 0ull;
        if (j < NJ) { const unsigned long long eq = __ballot(key[j] == T); const int before = run + __popcll(eq & lt); const bool sel = (key[j] > T) || (key[j] == T && before < need); m = __ballot(sel); run += __popcll(eq); }
        if (lane == 0) mo[j] = m; }
}
template <int NJ> __device__ __forceinline__ void select_hist(const float* isc, unsigned long long* mo, int t, int lane, LAS unsigned* hist  , LAS float* cand  ) {
    float x[NJ]; int bn[NJ];
    float mn = INFINITY, mxv = -INFINITY;
#pragma unroll
    for (int j = 0; j < NJ; ++j) { const int s = 64 * j + lane; const bool v = s <= t; x[j] = v ? isc[s] : 0.f; mn = fminf(mn, v ? x[j] : INFINITY); mxv = fmaxf(mxv, v ? x[j] : -INFINITY); }
    mn = -wave_max(-mn); mxv = wave_max(mxv);
    const float range = mxv - mn; const bool ok = (range > 0.f) && (range < 3.0e38f);
    const float scale = ok ? 2047.0f / range : 0.f;
#pragma unroll
    for (int j = 0; j < NJ; ++j) { const int s = 64 * j + lane; const bool v = s <= t; int b = (int)((x[j] - mn) * scale); b = b > 2047 ? 2047 : b; b = v ? b : 0; bn[j] = v ? b : -1;
        __hip_atomic_fetch_add(hist + b + (b >> 5), v ? 1u : 0u, __ATOMIC_RELAXED, __HIP_MEMORY_SCOPE_WORKGROUP); }
    unsigned hb[32]; unsigned ls = 0u;
#pragma unroll
    for (int k = 0; k < 32; ++k) { hb[k] = hist[33 * lane + k]; ls += hb[k]; }
    unsigned suf = ls;
#pragma unroll
    for (int o = 1; o < 64; o <<= 1) { const unsigned tt = __shfl_down(suf, o); suf += (lane + o < 64) ? tt : 0u; }
    const unsigned long long lm = __ballot(suf >= 256u);
    const int L = 63 - __builtin_clzll(lm);
    unsigned c = suf - ls; int Bl = 0; unsigned cal = 0u, hB = 0u; bool found = false;
#pragma unroll
    for (int k = 31; k >= 0; --k) { const bool hit = !found && (c + hb[k] >= 256u); Bl = hit ? 32 * lane + k : Bl; cal = hit ? c : cal; hB = hit ? hb[k] : hB; found = found || hit; c += found ? 0u : hb[k]; }
    const int B = __shfl(Bl, L); const unsigned cab = __shfl(cal, L), nB = __shfl(hB, L); const int need = 256 - (int)cab;
#pragma unroll
    for (int j = 0; j < NJ; ++j) { const int b = bn[j] < 0 ? 0 : bn[j]; hist[b + (b >> 5)] = 0u; }
    if (!ok || nB > 64u) { select_row<NJ>(isc, mo, t, lane); return; }
    float Ts = -INFINITY; int Is = 0x7fffffff;
    if ((unsigned)need < nB) {
        int run = 0; const unsigned long long lt = (lane == 0) ? 0ull : (~0ull >> (64 - lane));
#pragma unroll
        for (int j = 0; j < NJ; ++j) { const unsigned long long m = __ballot(bn[j] == B); if (m) { if (bn[j] == B) { const int pos = run + __popcll(m & lt); cand[pos] = x[j]; cand[64 + pos] = __int_as_float(64 * j + lane); } run += __popcll(m); } }
        const float xi = (lane < (int)nB) ? cand[lane] : 0.f; const int si = (lane < (int)nB) ? __float_as_int(cand[64 + lane]) : 0; int rank = 0;
        for (int k = 0; k < (int)nB; ++k) { const float xk = cand[k]; const int sk = __float_as_int(cand[64 + k]); rank += (xk > xi || (xk == xi && sk < si)) ? 1 : 0; }
        const unsigned long long wm = __ballot(lane < (int)nB && rank == need - 1); const int src = __builtin_ctzll(wm);
        Ts = __shfl(xi, src); Is = __shfl(si, src);
    }
#pragma unroll
    for (int j = 0; j < 32; ++j) { unsigned long long m = 0ull;
        if (j < NJ) { const int s = 64 * j + lane; const bool sel = (bn[j] > B) || (bn[j] == B && (x[j] > Ts || (x[j] == Ts && s <= Is))); m = __ballot(sel); }
        if (lane == 0) mo[j] = m; }
}
__device__ __forceinline__ void dsa_select(Frame& F, const EvenPtrs& P) {
    const int lane = F.lane;
    LAS unsigned* hist = (LAS unsigned*)(F.lds + F.wave * 9216); LAS float* cand = (LAS float*)(F.lds + F.wave * 9216 + 8448);
    for (int i = lane; i < 2112; i += 64) hist[i] = 0u;
    for (int idx = F.gw; idx < M; idx += F.NGW) {
        const int k = idx >> 11, gwid = idx & 2047, t = (k & 1) ? 2047 - gwid : gwid; const size_t row = (size_t)k * SEQ + t; const int n = t + 1;
        unsigned long long* mo = (unsigned long long*)(P.MASK + row * 64); const float* isc = P.ISC + row * 2048;
        if (n <= 256) {
#pragma unroll
            for (int j = 0; j < 32; ++j) { const unsigned long long m = __ballot(64 * j + lane <= t); if (lane == 0) mo[j] = m; }
        } else if (n <= 512) select_hist<8>(isc, mo, t, lane, hist, cand);
        else if (n <= 1024) select_hist<16>(isc, mo, t, lane, hist, cand);
        else if (n <= 1536) select_hist<24>(isc, mo, t, lane, hist, cand);
        else select_hist<32>(isc, mo, t, lane, hist, cand);
    }
}
__device__ __forceinline__ void dsa_attn(Frame& F, const EvenPtrs& P) {
    bf16* Kl = (bf16*)F.gl; bf16* Vl = (bf16*)(F.gl + 18432); float* btl = (float*)(F.gl + 41472); float* mtl = (float*)(F.gl + 41984);
    const int tid = F.tid, lane = F.lane, w = F.wave, fr = lane & 15, fq = lane >> 4, lrow = tid >> 3, lch = tid & 7;
    for (int i = tid; i < 2 * 16 * 64; i += 512) { const int bufi = i >> 10, r = (i >> 6) & 15, cc = i & 63; Vl[bufi * 5760 + (64 + r) * 72 + cc] = (r == 0) ? (bf16)0x3f80u : (bf16)0; }
    if (tid < 64) ((unsigned*)mtl)[tid] = ((tid >> 2) >> (tid & 3)) & 1 ? 0xffffffffu : 0u;
    for (int vu = F.bid; vu < 256; vu += F.G) {
        const int bh = vu >> 2, s4 = vu & 3, b = bh >> 3, hh = bh & 7;
        for (int iu = 0; iu < 2; ++iu) {
            const int qb = (iu == 0) ? s4 : 7 - s4;
            const int t0 = qb * 256, tw = t0 + 32 * w;
            bf16x8 qf[2][2]; const v2u* mrow[2];
#pragma unroll
            for (int cb = 0; cb < 2; ++cb) { const size_t rowq = (size_t)b * SEQ + tw + 16 * cb + fr; mrow[cb] = (const v2u*)(P.MASK + rowq * 64);
              const v4u w0 = *(const v4u*)(P.BQ + rowq * 512 + hh * 64 + 8 * fq), w1 = *(const v4u*)(P.BQ + rowq * 512 + hh * 64 + 32 + 8 * fq);
              float x[16] = {bflo(w0.x), bfhi(w0.x), bflo(w0.y), bfhi(w0.y), bflo(w0.z), bfhi(w0.z), bflo(w0.w), bfhi(w0.w), bflo(w1.x), bfhi(w1.x), bflo(w1.y), bfhi(w1.y), bflo(w1.z), bfhi(w1.z), bflo(w1.w), bfhi(w1.w)};
              float ss = 0.f;
#pragma unroll
              for (int j = 0; j < 16; ++j) ss += x[j] * x[j];
              ss += __shfl_xor(ss, 16); ss += __shfl_xor(ss, 32);
              const float r = rsqrtf(ss * (1.0f / 64.0f) + 1e-6f) * (0.125f * LOG2E);
              const f32x4 g0 = *(const f32x4*)(P.gq + 8 * fq), g1 = *(const f32x4*)(P.gq + 8 * fq + 4), g2 = *(const f32x4*)(P.gq + 32 + 8 * fq), g3 = *(const f32x4*)(P.gq + 32 + 8 * fq + 4);
              v4u q0, q1; q0.x = pk2(x[0] * r * g0.x, x[1] * r * g0.y); q0.y = pk2(x[2] * r * g0.z, x[3] * r * g0.w); q0.z = pk2(x[4] * r * g1.x, x[5] * r * g1.y); q0.w = pk2(x[6] * r * g1.z, x[7] * r * g1.w);
              q1.x = pk2(x[8] * r * g2.x, x[9] * r * g2.y); q1.y = pk2(x[10] * r * g2.z, x[11] * r * g2.w); q1.z = pk2(x[12] * r * g3.x, x[13] * r * g3.y); q1.w = pk2(x[14] * r * g3.z, x[15] * r * g3.w);
              qf[cb][0] = __builtin_bit_cast(bf16x8, q0); qf[cb][1] = __builtin_bit_cast(bf16x8, q1); }
            if (tid < 128) btl[tid] = P.bt[hh * 128 + tid] - P.bt[hh * 128 + 127];
            const int nk = 4 * qb + 4;
            const bf16* kg = P.KB + ((size_t)b * SEQ + lrow) * 64 + lch * 8;
            const bf16* vg = P.VT + ((size_t)(b * 8 + hh) * 64 + lrow) * 2048 + lch * 8;
            v4u kreg = *(const v4u*)kg, vreg = *(const v4u*)vg; v2u mnext[2] = {mrow[0][0], mrow[1][0]};
            *(v4u*)(Kl + lrow * 72 + lch * 8) = kreg; *(v4u*)(Vl + lrow * 72 + lch * 8) = vreg;
            __syncthreads();
            f32x4 o[2][5];
#pragma unroll
            for (int cb = 0; cb < 2; ++cb)
#pragma unroll
                for (int dt = 0; dt < 5; ++dt) o[cb][dt] = (f32x4){0.f, 0.f, 0.f, 0.f};
            float mrun[2] = {0.f, 0.f}; bool first = true;
            for (int kt = 0; kt < nk; ++kt) {
                const int s0 = kt * 64; const bf16* Kb = Kl + (kt & 1) * 4608; const bf16* Vb = Vl + (kt & 1) * 5760; const v2u mw[2] = {mnext[0], mnext[1]};
                if (kt + 1 < nk) { kreg = *(const v4u*)(kg + (size_t)(s0 + 64) * 64); vreg = *(const v4u*)(vg + s0 + 64); mnext[0] = mrow[0][kt + 1]; mnext[1] = mrow[1][kt + 1]; }
                if (s0 <= tw + 31) {
                    f32x4 acc[2][4];
#pragma unroll
                    for (int cb = 0; cb < 2; ++cb) { const f32x4 cin = (f32x4){-mrun[cb], -mrun[cb], -mrun[cb], -mrun[cb]};
#pragma unroll
                        for (int st = 0; st < 4; ++st) acc[cb][st] = cin; }
#pragma unroll
                    for (int st = 0; st < 4; ++st) { const bf16x8 a0 = *(const bf16x8*)(Kb + (16 * st + fr) * 72 + 8 * fq), a1 = *(const bf16x8*)(Kb + (16 * st + fr) * 72 + 32 + 8 * fq);
#pragma unroll
                        for (int cb = 0; cb < 2; ++cb) { acc[cb][st] = MFMA16(a0, qf[cb][0], acc[cb][st]); acc[cb][st] = MFMA16(a1, qf[cb][1], acc[cb][st]); } }
                    bf16x8 pf[2][2]; bool resc = false; float mxs[2];
#pragma unroll
                    for (int cb = 0; cb < 2; ++cb) { const int tb = tw + 16 * cb, t = tb + fr;
                        if ((tb - (s0 + 63)) < 113) {
#pragma unroll
                            for (int st = 0; st < 4; ++st)
#pragma unroll
                                for (int r = 0; r < 4; ++r) { int dist = t - (s0 + 16 * st + 4 * fq + r); dist = dist < 0 ? 0 : (dist > 127 ? 127 : dist); acc[cb][st][r] += btl[dist]; } }
                        float mx = fmaxf(fmaxf(fmaxf(acc[cb][0].x, acc[cb][0].y), fmaxf(acc[cb][0].z, acc[cb][0].w)), fmaxf(fmaxf(acc[cb][1].x, acc[cb][1].y), fmaxf(acc[cb][1].z, acc[cb][1].w)));
                        mx = fmaxf(mx, fmaxf(fmaxf(fmaxf(acc[cb][2].x, acc[cb][2].y), fmaxf(acc[cb][2].z, acc[cb][2].w)), fmaxf(fmaxf(acc[cb][3].x, acc[cb][3].y), fmaxf(acc[cb][3].z, acc[cb][3].w))));
                        mx = fmaxf(mx, __shfl_xor(mx, 16)); mx = fmaxf(mx, __shfl_xor(mx, 32)); mxs[cb] = mx; resc = resc || (mx > 8.0f); }
                    if (first || __any(resc)) {
#pragma unroll
                        for (int cb = 0; cb < 2; ++cb) { const float dl = first ? mxs[cb] : fmaxf(mxs[cb], 0.f); mrun[cb] += dl; const float alpha = first ? 1.0f : __builtin_amdgcn_exp2f(-dl);
#pragma unroll
                            for (int st = 0; st < 4; ++st) acc[cb][st] = acc[cb][st] - dl;
#pragma unroll
                            for (int dt = 0; dt < 5; ++dt) o[cb][dt] = o[cb][dt] * alpha; }
                        first = false; }
#pragma unroll
                    for (int cb = 0; cb < 2; ++cb)
#pragma unroll
                        for (int kk = 0; kk < 2; ++kk) { const unsigned mword = (kk == 0) ? mw[cb].x : mw[cb].y;
                            const v4u m0 = *(const v4u*)((const unsigned*)mtl + 4 * ((mword >> (4 * fq)) & 15u)), m1 = *(const v4u*)((const unsigned*)mtl + 4 * ((mword >> (16 + 4 * fq)) & 15u));
                            const f32x4 a = acc[cb][2 * kk], c = acc[cb][2 * kk + 1];
#define EXM(v, m) __uint_as_float(__float_as_uint(__builtin_amdgcn_exp2f(v)) & (m))
                            v4u pw; pw.x = pk2(EXM(a.x, m0.x), EXM(a.y, m0.y)); pw.y = pk2(EXM(a.z, m0.z), EXM(a.w, m0.w));
                            pw.z = pk2(EXM(c.x, m1.x), EXM(c.y, m1.y)); pw.w = pk2(EXM(c.z, m1.z), EXM(c.w, m1.w));
#undef EXM
                            pf[cb][kk] = __builtin_bit_cast(bf16x8, pw); }
#pragma unroll
                    for (int dt = 0; dt < 5; ++dt)
#pragma unroll
                        for (int kk = 0; kk < 2; ++kk) { const bf16* vp = Vb + (16 * dt + fr) * 72 + 32 * kk + 4 * fq; const v2u lo = *(const v2u*)vp, hi = *(const v2u*)(vp + 16);
                            v4u vv; vv.x = lo.x; vv.y = lo.y; vv.z = hi.x; vv.w = hi.y; const bf16x8 vf = __builtin_bit_cast(bf16x8, vv);
                            o[0][dt] = MFMA16(vf, pf[0][kk], o[0][dt]); o[1][dt] = MFMA16(vf, pf[1][kk], o[1][dt]); }
                }
                if (kt + 1 < nk) { *(v4u*)(Kl + ((kt + 1) & 1) * 4608 + lrow * 72 + lch * 8) = kreg; *(v4u*)(Vl + ((kt + 1) & 1) * 5760 + lrow * 72 + lch * 8) = vreg; }
                __syncthreads();
            }
#pragma unroll
            for (int cb = 0; cb < 2; ++cb) { const size_t rowq = (size_t)b * SEQ + tw + 16 * cb + fr; const float linv = 1.0f / __shfl(o[cb][4].x, fr);
#pragma unroll
                for (int dt = 0; dt < 4; ++dt) { v2u wv; wv.x = pk2(o[cb][dt].x * linv, o[cb][dt].y * linv); wv.y = pk2(o[cb][dt].z * linv, o[cb][dt].w * linv); *(v2u*)(P.MIX + rowq * 1024 + 512 + hh * 64 + 16 * dt + 4 * fq) = wv; } }
        }
    }
}
#define PF_BAR() asm volatile("s_waitcnt lgkmcnt(0)\n\ts_barrier" ::: "memory")
__device__ __forceinline__ void pool_fused(Frame& F, const bf16* HBi, bf16* HBo, const float* statsR, float* statsW, const float* gmix, const bf16* Wp  , const float* scale) {
    bf16* HT = (bf16*)F.gl; bf16* PT = (bf16*)(F.gl + 41712); float* rl = (float*)(F.gl + 75504); float* sq = (float*)(F.gl + 75824);
    const int tid = F.tid, lane = F.lane, w = F.wave, fr = lane & 15, fq = lane >> 4;
    const int NU = (M / 64) * 4;
    v4u hin[5]; f32x4 stin[4];
#define PF_LOAD(u_) do { const int u2_ = (u_); const int tile_ = u2_ & 255, g_ = ((u2_ & 3) + (u2_ >> 8)) & 3, r0_ = tile_ * 64, tp0_ = r0_ & 2047; \
        _Pragma("unroll") for (int q = 0; q < 5; ++q) { const int i = tid + 512 * q; const int rr = i >> 5, ch = (i & 31) * 8; hin[q] = (v4u){0u, 0u, 0u, 0u}; \
            if (i < 79 * 32 && tp0_ - 15 + rr >= 0) hin[q] = *(const v4u*)(HBi + (size_t)(r0_ - 15 + rr) * DM + g_ * 256 + ch); } \
        if (tid < 79 && tp0_ - 15 + tid >= 0) { const f32x4* p = (const f32x4*)(statsR + (size_t)(r0_ - 15 + tid) * 16); stin[0] = p[0]; stin[1] = p[1]; stin[2] = p[2]; stin[3] = p[3]; } } while (0)
    if (F.bid < NU) PF_LOAD(F.bid);
    for (int u = F.bid; u < NU; u += F.G) {
        const int tile = u & 255, g = ((u & 3) + (u >> 8)) & 3, row0 = tile * 64, tpos0 = row0 & 2047, win = 2 << g;
        bf16x8 af[8][2];
#pragma unroll
        for (int ks = 0; ks < 8; ++ks)
#pragma unroll
            for (int oi = 0; oi < 2; ++oi) af[ks][oi] = *(const bf16x8*)(Wp + ((size_t)g * 256 + 16 * (2 * w + oi) + fr) * 256 + 8 * fq + 32 * ks);
#pragma unroll
        for (int q = 0; q < 5; ++q) { const int i = tid + 512 * q; if (i < 79 * 32) *(v4u*)(HT + (i >> 5) * 264 + (i & 31) * 8) = hin[q]; }
        if (tid < 79) { float r = 0.f;
            if (tpos0 - 15 + tid >= 0) { const f32x4 a = stin[0], b = stin[1], c = stin[2], d2 = stin[3];
                const float s = (((a.x + a.y) + (a.z + a.w)) + ((b.x + b.y) + (b.z + b.w))) + (((c.x + c.y) + (c.z + c.w)) + ((d2.x + d2.y) + (d2.z + d2.w))); r = rsqrtf(s * (1.0f / 1024.0f) + 1e-6f); }
            rl[tid] = r; }
        if (u + F.G < NU) PF_LOAD(u + F.G);
        PF_BAR();
        { const int cg = tid & 31, t4 = (tid >> 5) * 4, c0 = cg * 8; const f32x4 g0 = *(const f32x4*)(gmix + g * 256 + c0), g1 = *(const f32x4*)(gmix + g * 256 + c0 + 4);
          float S[8] = {0.f, 0.f, 0.f, 0.f, 0.f, 0.f, 0.f, 0.f};
          for (int j = 1; j < win; ++j) if (tpos0 + t4 - j >= 0) { f32x4 a, b; pg8::unpack8(*(const v4u*)(HT + (15 + t4 - j) * 264 + c0), a, b); const float r = rl[15 + t4 - j];
              S[0] += a.x * r; S[1] += a.y * r; S[2] += a.z * r; S[3] += a.w * r; S[4] += b.x * r; S[5] += b.y * r; S[6] += b.z * r; S[7] += b.w * r; }
#pragma unroll
          for (int i = 0; i < 4; ++i) { const int tok = t4 + i, tpos = tpos0 + tok, n = (tpos + 1 < win) ? tpos + 1 : win;
              f32x4 a, b; pg8::unpack8(*(const v4u*)(HT + (15 + tok) * 264 + c0), a, b); const float r = rl[15 + tok];
              const float y[8] = {a.x * r, a.y * r, a.z * r, a.w * r, b.x * r, b.y * r, b.z * r, b.w * r};
#pragma unroll
              for (int q = 0; q < 8; ++q) S[q] += y[q];
              const float inv = __builtin_amdgcn_rcpf((float)n);
              v4u o; o.x = pk2((S[0] * inv - y[0]) * g0.x, (S[1] * inv - y[1]) * g0.y); o.y = pk2((S[2] * inv - y[2]) * g0.z, (S[3] * inv - y[3]) * g0.w);
              o.z = pk2((S[4] * inv - y[4]) * g1.x, (S[5] * inv - y[5]) * g1.y); o.w = pk2((S[6] * inv - y[6]) * g1.z, (S[7] * inv - y[7]) * g1.w);
              *(v4u*)(PT + tok * 264 + c0) = o;
              const int dep = tok - (win - 1);
              if (tpos0 + dep >= 0) { f32x4 da, db; pg8::unpack8(*(const v4u*)(HT + (15 + dep) * 264 + c0), da, db); const float dr = rl[15 + dep];
                  S[0] -= da.x * dr; S[1] -= da.y * dr; S[2] -= da.z * dr; S[3] -= da.w * dr; S[4] -= db.x * dr; S[5] -= db.y * dr; S[6] -= db.z * dr; S[7] -= db.w * dr; } } }
        PF_BAR();
        { f32x4 acc[2][4]; float ssq[4] = {0.f, 0.f, 0.f, 0.f};
#pragma unroll
          for (int oi = 0; oi < 2; ++oi)
#pragma unroll
              for (int tt = 0; tt < 4; ++tt) acc[oi][tt] = (f32x4){0.f, 0.f, 0.f, 0.f};
#pragma unroll
          for (int ks = 0; ks < 8; ++ks) { bf16x8 bfv[4];
#pragma unroll
              for (int tt = 0; tt < 4; ++tt) bfv[tt] = *(const bf16x8*)(PT + (16 * tt + fr) * 264 + 8 * fq + 32 * ks);
#pragma unroll
              for (int oi = 0; oi < 2; ++oi)
#pragma unroll
                  for (int tt = 0; tt < 4; ++tt) acc[oi][tt] = MFMA16(af[ks][oi], bfv[tt], acc[oi][tt]); }
#pragma unroll
          for (int oi = 0; oi < 2; ++oi) { const int cl = 16 * (2 * w + oi) + 4 * fq; const f32x4 sc = *(const f32x4*)(scale + g * 256 + cl);
#pragma unroll
              for (int tt = 0; tt < 4; ++tt) { const int tok = 16 * tt + fr; const v2u hw = *(const v2u*)(HT + (15 + tok) * 264 + cl);
                  const float h0 = bflo(hw.x) + sc.x * acc[oi][tt].x, h1 = bfhi(hw.x) + sc.y * acc[oi][tt].y, h2 = bflo(hw.y) + sc.z * acc[oi][tt].z, h3 = bfhi(hw.y) + sc.w * acc[oi][tt].w;
                  ssq[tt] += (h0 * h0 + h1 * h1) + (h2 * h2 + h3 * h3);
                  v2u o; o.x = pk2(h0, h1); o.y = pk2(h2, h3); *(v2u*)(HBo + (size_t)(row0 + tok) * DM + g * 256 + cl) = o; } }
#pragma unroll
          for (int tt = 0; tt < 4; ++tt) { float s = ssq[tt]; s += __shfl_xor(s, 16); s += __shfl_xor(s, 32); if (fq == 0) sq[(16 * tt + fr) * 8 + w] = s; } }
        PF_BAR();
        if (tid < 64) { const f32x4 a = *(const f32x4*)(sq + tid * 8), b = *(const f32x4*)(sq + tid * 8 + 4); const float s = ((a.x + a.y) + (a.z + a.w)) + ((b.x + b.y) + (b.z + b.w));
            *(f32x4*)(statsW + (size_t)(row0 + tid) * 16 + 4 * g) = (f32x4){s, 0.f, 0.f, 0.f}; }
        PF_BAR();
    }
#undef PF_LOAD
    asm volatile("s_waitcnt vmcnt(0)" ::: "memory"); __syncthreads();
}
#undef PF_BAR
struct RoutePtrs { int* TOKE; float* TOKG; float* TOKR; int* CNT; int* ROWTS; float* ROWG; float* ROWR; int* TILEE; int* NT; int* EXPB; int* EXPN; int* TOKPOS; int* LT; int* TOKLT; };
__device__ __forceinline__ RoutePtrs route_ptrs(unsigned char* ws) { unsigned char* r = ws + WS_ROUTE; RoutePtrs p;
    p.TOKE = (int*)(r + RT_TOKE); p.TOKG = (float*)(r + RT_TOKG); p.TOKR = (float*)(r + RT_TOKR); p.CNT = (int*)(r + RT_CNT); p.ROWTS = (int*)(r + RT_ROWTS); p.ROWG = (float*)(r + RT_ROWG); p.ROWR = (float*)(r + RT_ROWR);
    p.TILEE = (int*)(r + RT_TILEE); p.NT = (int*)(r + RT_NT); p.EXPB = p.NT + 16; p.EXPN = p.NT + 32; p.TOKPOS = (int*)(r + RT_TOKPOS); p.LT = (int*)(r + RT_LT); p.TOKLT = (int*)(r + RT_LT + 4096); return p; }
__device__ __forceinline__ void moe_route(Frame& F, const RoutePtrs& R, const bf16* HB, const float* gffn, const float* wr, const float* br) {
    int* cnt = (int*)F.gl; const int lane = F.lane;
    float wreg[16][8];
#pragma unroll
    for (int j = 0; j < 4; ++j) { const int c0 = 4 * lane + 256 * j; const f32x4 g = *(const f32x4*)(gffn + c0); const float gg[4] = {g.x, g.y, g.z, g.w};
#pragma unroll
        for (int q = 0; q < 4; ++q) { const f32x4 w0 = *(const f32x4*)(wr + (size_t)(c0 + q) * 8), w1 = *(const f32x4*)(wr + (size_t)(c0 + q) * 8 + 4);
            wreg[4 * j + q][0] = w0.x * gg[q]; wreg[4 * j + q][1] = w0.y * gg[q]; wreg[4 * j + q][2] = w0.z * gg[q]; wreg[4 * j + q][3] = w0.w * gg[q];
            wreg[4 * j + q][4] = w1.x * gg[q]; wreg[4 * j + q][5] = w1.y * gg[q]; wreg[4 * j + q][6] = w1.z * gg[q]; wreg[4 * j + q][7] = w1.w * gg[q]; } }
    const int myexp = ((lane >> 5) & 1) * 4 + ((lane >> 4) & 1) * 2 + ((lane >> 3) & 1); const float mybias = br[myexp];
    for (int tile = F.bid; tile < M / 64; tile += F.G) {
        if (F.tid < 8) cnt[F.tid] = 0;
        __syncthreads();
        for (int ib = 0; ib < 2; ++ib) {
            f32x4 v[4][4];
#pragma unroll
            for (int i = 0; i < 4; ++i) { const v2u* hr = (const v2u*)(HB + (size_t)(tile * 64 + F.wave * 8 + ib * 4 + i) * DM) + lane;
#pragma unroll
                for (int j = 0; j < 4; ++j) { const v2u hw = hr[64 * j]; v[i][j] = (f32x4){bflo(hw.x), bfhi(hw.x), bflo(hw.y), bfhi(hw.y)}; } }
#pragma unroll
            for (int i = 0; i < 4; ++i) { const int row = tile * 64 + F.wave * 8 + ib * 4 + i; float ss = 0.f; float lg[8] = {0.f, 0.f, 0.f, 0.f, 0.f, 0.f, 0.f, 0.f};
#pragma unroll
                for (int j = 0; j < 4; ++j) { const float y[4] = {v[i][j].x, v[i][j].y, v[i][j].z, v[i][j].w};
#pragma unroll
                    for (int q = 0; q < 4; ++q) { ss += y[q] * y[q];
#pragma unroll
                        for (int e = 0; e < 8; ++e) lg[e] += y[q] * wreg[4 * j + q][e]; } }
                ss = wave_sum(ss); const float r = rsqrtf(ss * (1.0f / 1024.0f) + 1e-6f);
                float a4[4];
#pragma unroll
                for (int e = 0; e < 4; ++e) { const bool hi = (lane & 32) != 0; const float keep = hi ? lg[e + 4] : lg[e], send = hi ? lg[e] : lg[e + 4]; a4[e] = keep + __shfl_xor(send, 32); }
                float a2[2];
#pragma unroll
                for (int e = 0; e < 2; ++e) { const bool hi = (lane & 16) != 0; const float keep = hi ? a4[e + 2] : a4[e], send = hi ? a4[e] : a4[e + 2]; a2[e] = keep + __shfl_xor(send, 16); }
                float a1; { const bool hi = (lane & 8) != 0; const float keep = hi ? a2[1] : a2[0], send = hi ? a2[0] : a2[1]; a1 = keep + __shfl_xor(send, 8); }
                a1 += __shfl_xor(a1, 4); a1 += __shfl_xor(a1, 2); a1 += __shfl_xor(a1, 1);
                const float mylogit = a1 * r + mybias;
                float l8[8];
#pragma unroll
                for (int e = 0; e < 8; ++e) l8[e] = __shfl(mylogit, 32 * (e >> 2) + 16 * ((e >> 1) & 1) + 8 * (e & 1));
                int e1 = 0; float v1 = l8[0];
#pragma unroll
                for (int e = 1; e < 8; ++e) if (l8[e] > v1) { v1 = l8[e]; e1 = e; }
                int e2 = -1; float v2 = -INFINITY;
#pragma unroll
                for (int e = 0; e < 8; ++e) if (e != e1 && l8[e] > v2) { v2 = l8[e]; e2 = e; }
                const float ex = __expf(v2 - v1), g1 = 1.0f / (1.0f + ex), g2 = ex * g1;
                if (lane == 0) { R.TOKE[row] = e1 | (e2 << 8); R.TOKG[row * 2] = g1; R.TOKG[row * 2 + 1] = g2; R.TOKR[row] = r; atomicAdd(&cnt[e1], 1); atomicAdd(&cnt[e2], 1); } }
        }
        __syncthreads();
        if (F.tid < 8) R.CNT[tile * 8 + F.tid] = cnt[F.tid];
        __syncthreads();
    }
}
__device__ __forceinline__ void moe_scatter(Frame& F, const RoutePtrs& R, const bf16* HB, bf16* YG) {
    int* sm = (int*)F.gl;
    for (int tile = F.bid; tile < M / 64; tile += F.G) {
        if (F.tid < 16) sm[F.tid] = 0;
        __syncthreads();
        for (int i = F.tid; i < (M / 64) * 8; i += 512) { const int v = R.CNT[i]; atomicAdd(&sm[i & 7], v); if ((i >> 3) < tile) atomicAdd(&sm[8 + (i & 7)], v); }
        __syncthreads();
        if (F.tid == 0) { int base = 0; for (int e = 0; e < 8; ++e) { sm[16 + e] = base; base += (sm[e] + 255) & ~255; } sm[24] = base >> 8; }
        __syncthreads();
        if (F.wave == 0) { const int row = tile * 64 + F.lane, te = R.TOKE[row], e1 = te & 255, e2 = te >> 8; int p1 = 0, p2 = 0; const unsigned long long lt = (F.lane == 0) ? 0ull : (~0ull >> (64 - F.lane));
#pragma unroll
            for (int e = 0; e < 8; ++e) { const unsigned long long m1 = __ballot(e1 == e), m2 = __ballot(e2 == e); const int rk = __popcll(m1 & lt) + __popcll(m2 & lt), bs = sm[16 + e] + sm[8 + e];
                if (e1 == e) p1 = bs + rk; if (e2 == e) p2 = bs + rk; }
            const float r = R.TOKR[row]; R.ROWTS[p1] = row * 2; R.ROWTS[p2] = row * 2 + 1; R.ROWG[p1] = R.TOKG[row * 2]; R.ROWG[p2] = R.TOKG[row * 2 + 1]; R.ROWR[p1] = r; R.ROWR[p2] = r;
            sm[32 + 2 * F.lane] = p1; sm[33 + 2 * F.lane] = p2; R.TOKPOS[row * 2] = p1; R.TOKPOS[row * 2 + 1] = p2; }
        __syncthreads();
        for (int i = 0; i < 16; ++i) { const int cp = F.wave * 16 + i, tok = cp >> 1, pos = sm[32 + cp]; const v4u* src = (const v4u*)(HB + (size_t)(tile * 64 + tok) * DM); v4u* dst = (v4u*)(YG + (size_t)pos * DM);
            dst[F.lane] = src[F.lane]; dst[64 + F.lane] = src[64 + F.lane]; }
        if (tile == 0) {
            for (int e = 0; e < 8; ++e) { const int lo = sm[16 + e] + sm[e], hi = sm[16 + e] + ((sm[e] + 255) & ~255);
                for (int p = lo + F.tid; p < hi; p += 512) { R.ROWTS[p] = -1; R.ROWG[p] = 0.f; R.ROWR[p] = 0.f; }
                for (int t2 = (sm[16 + e] >> 8) + F.tid; t2 < (hi >> 8); t2 += 512) R.TILEE[t2] = e; }
            if (F.tid == 0) R.NT[0] = sm[24];
            if (F.tid < 8) { R.EXPB[F.tid] = sm[16 + F.tid] >> 8; R.EXPN[F.tid] = (sm[F.tid] + 255) >> 8; }
            for (int t2 = F.tid; t2 < 136; t2 += 512) R.LT[48 + t2] = -1;
            __syncthreads();
            if (F.tid == 0) { int nl = 0; for (int e = 0; e < 8; ++e) { const int nrt = (sm[e] + 255) >> 8; nl += nrt > 16 ? nrt - 16 : 0; } const bool use = (F.G == 256) && nl <= 16; int tl = 0;
                for (int e = 0; e < 8; ++e) { const int nrt = (sm[e] + 255) >> 8, nmain = (use && nrt > 16) ? 16 : nrt; R.LT[40 + e] = nmain;
                    for (int q = nmain; q < nrt; ++q) { const int rt = (sm[16 + e] >> 8) + q; R.LT[tl] = rt; R.LT[16 + tl] = e; R.LT[48 + rt] = tl; ++tl; } }
                R.LT[32] = tl; } }
        __syncthreads();
    }
}
__device__ __forceinline__ void moe_combine(Frame& F, const RoutePtrs& R, const bf16* D0, const bf16* D1, const float* PART, bf16* HB, float* stats) {
    for (int m = F.gw; m < M; m += F.NGW) { v2u* o8 = (v2u*)(HB + (size_t)m * DM) + F.lane; const v2u* a = (const v2u*)(D0 + (size_t)m * DM) + F.lane; const v2u* b = (const v2u*)(D1 + (size_t)m * DM) + F.lane;
        float s = 0.f; v2u hv[4], x[2][4]; f32x4 add[2][4];
        const int pos0 = R.TOKPOS[m * 2], pos1 = R.TOKPOS[m * 2 + 1];
#pragma unroll
        for (int j = 0; j < 4; ++j) { hv[j] = o8[64 * j]; x[0][j] = a[64 * j]; x[1][j] = b[64 * j]; }
        const int tl0 = __builtin_amdgcn_readfirstlane(R.LT[48 + (pos0 >> 8)]), tl1 = __builtin_amdgcn_readfirstlane(R.LT[48 + (pos1 >> 8)]);
#pragma unroll
        for (int sl = 0; sl < 2; ++sl) { const int tl = sl ? tl1 : tl0, pos = __builtin_amdgcn_readfirstlane(sl ? pos1 : pos0);
#pragma unroll
            for (int j = 0; j < 4; ++j) add[sl][j] = (f32x4){bflo(x[sl][j].x), bfhi(x[sl][j].x), bflo(x[sl][j].y), bfhi(x[sl][j].y)};
            if (tl >= 0) { const float g = R.TOKG[m * 2 + sl]; const f32x4* pp = (const f32x4*)(PART + ((size_t)(tl * 7) * 256 + (pos & 255)) * 1024) + F.lane;
#pragma unroll
                for (int j = 0; j < 4; ++j) { f32x4 acc = pp[64 * j];
#pragma unroll
                    for (int kc = 1; kc < 7; ++kc) acc = acc + pp[(size_t)kc * 256 * 256 + 64 * j];
                    add[sl][j] = acc * g; } } }
#pragma unroll
        for (int j = 0; j < 4; ++j) { f32x4 v; v.x = bflo(hv[j].x) + add[0][j].x + add[1][j].x; v.y = bfhi(hv[j].x) + add[0][j].y + add[1][j].y; v.z = bflo(hv[j].y) + add[0][j].z + add[1][j].z; v.w = bfhi(hv[j].y) + add[0][j].w + add[1][j].w;
            s += (v.x * v.x + v.y * v.y) + (v.z * v.z + v.w * v.w); v2u w; w.x = pk2(v.x, v.y); w.y = pk2(v.z, v.w); o8[64 * j] = w; }
        s = wave_sum(s);
        if (F.lane < 16) stats[(size_t)m * 16 + F.lane] = (F.lane == 0) ? s : 0.f; }
}
constexpr int N_PHASES = 35;
static_assert(WS_VB == WS_QK + 32 * MiB && WS_OG == WS_VB + 16 * MiB && WS_BQ == WS_OG + 16 * MiB && WS_BQI == WS_BQ + 16 * MiB, "EpiIn address arithmetic");
#ifndef PHASE_SEL
#define PHASE_SEL -1
#endif
#define PHEN(r) (PHASE_SEL < 0 || PHASE_SEL == (r))
#ifndef REP_MASK
#define REP_MASK 0
#endif
#define REPF(bit, call) do { call; if (REP_MASK & (1u << (bit))) { __syncthreads(); call; } } while (0)
#define IN(k) (lo <= (k) && (k) < hi)
#ifndef PROBE_SLOT
#define PROBE_SLOT -1
#endif
#ifndef PROBE_MULT
#define PROBE_MULT 8
#endif
#define SEAM(k) do { if ((k) + 1 < hi) { XcdBarrier b2_ = bar; asm volatile("" : "+s"(b2_.bar)); xcd_barrier(b2_); } \
    if (PROBE_SLOT >= 0) { const unsigned long long now_ = wall_clock64(); if ((((k) == 0) ? 100 : (((k) - 1) % 17)) == PROBE_SLOT) F.tacc += now_ - F.tprev; F.tprev = now_; } } while (0)
#define HBSEL(i) ((bf16*)(ws + ((i) ? WS_HB1 : WS_HB0)))
#define STSEL(i) ((float*)(ws + WS_STATS + ((i) ? MiB : (size_t)0)))
template <int lp> __device__ __forceinline__ void layer_pair(Frame& F, const Args& args, const XcdBarrier& bar, const int lo, const int hi, LAS unsigned char* ring, const int K256, const int K512) {
    unsigned char* ws = F.ws; bf16* Eb = (bf16*)(ws + WS_E);
        const int pb = 1 + 17 * lp;
        int hbi = lp & 1, si = 0;

        {
            const int e = lp, li = 2 * lp;
            EvenPtrs P;
            P.QK = (const bf16*)(ws + WS_QK); P.VB = (const bf16*)(ws + WS_VB); P.OG = (const bf16*)(ws + WS_OG); P.BQ = (const bf16*)(ws + WS_BQ); P.BQI = (const bf16*)(ws + WS_BQI); P.MISC = (const float*)(ws + WS_MISC);
            P.MIX = (bf16*)(ws + WS_MIX); P.QKC = (bf16*)(ws + WS_QKC); P.KB = (bf16*)(ws + WS_KB); P.KIB = (bf16*)(ws + WS_KIB); P.VT = (bf16*)(ws + WS_VT); P.MASK = (unsigned*)(ws + WS_MASK); P.CHS = (float*)(ws + WS_CHS); P.MST = (float*)(ws + WS_CHS + 65536);
            P.ISC = (float*)(ws + WS_ISC); P.U = (float*)(ws + WS_U); P.CB = (bf16*)(ws + WS_CB);
            P.bgate = INP(IN_B_GATE) + e * 8; P.conv = INP(IN_CONV) + e * 4 * 1024; P.gh = INP(IN_NORM_H) + e * 512; P.gq = INP(IN_NORM_Q) + e * 64; P.gk = INP(IN_NORM_K) + e * 64; P.gkv = INP(IN_NORM_KV) + e * 128;
            P.WukT = (const bf16*)(ws + WS_SMALL + 8192) + (size_t)e * 64 * 128; P.WuvT = (const bf16*)(ws + WS_SMALL + 65536) + (size_t)e * 512 * 128; P.bt = (const float*)(ws + WS_SMALL);
            if (PHEN(1) && IN(pb + 1)) {
                const int GG = (F.G == 256) ? 208 : F.G;
                unsigned* cq = (unsigned*)(ws + WS_CTL) + CW_CQ + 64 * lp; unsigned* cdone = cq + 256;
#define E_UNITS() do { pg8::Gemm g2{(const bf16*)(ws + WS_PB) + (size_t)li * M * PLED, (const bf16*)(ws + WS_W_PL) + (size_t)li * DM * PLED, M, DM, K256}; pg8::StaticOrder S2; S2.init(M, DM, F.G, F.bid); \
                    pg8::EpiStore E2{Eb, DM}; pg8::gemm_phase<pg8::EpiStore, pg8::StaticOrder, true, true>(ring, g2, S2, E2); } while (0)
                if (F.bid < GG) {
                    pg8::Gemm g{HBSEL(hbi), (const bf16*)(ws + WS_W_IN) + (size_t)e * NINP * DM, M, NINP, DM}; pg8::StaticOrder S; S.init(M, NINP, GG, F.bid);
                    pg8::EpiIn E{STSEL(si), (bf16*)(ws + WS_QK), (float*)(ws + WS_MISC), (bf16*)(ws + WS_KIB)};
                    pg8::gemm_phase<pg8::EpiIn, pg8::StaticOrder, true, true>(ring, g, S, E);
                    if (F.tid == 0) atomicAdd(cdone, 1u);
                    E_UNITS();
                } else { E_UNITS(); __syncthreads(); conv_queue(F, args, lp, cq, cdone, true); }
#undef E_UNITS
                  SEAM(pb + 1); }
            if (PROBE_SLOT == 201 && F.bid == 0 && F.tid == 0) F.tacc += __hip_atomic_load((unsigned*)(ws + WS_CTL) + CW_CQ + 64 * lp, __ATOMIC_RELAXED, __HIP_MEMORY_SCOPE_AGENT);
            if (PHEN(2) && IN(pb + 2)) { REPF(1, mlstm_a(F, P)); REPF(2, dsa_prep(F, P)); REPF(3, dsa_index(F, P)); SEAM(pb + 2); }
            if (PHEN(3) && IN(pb + 3)) { REPF(4, mlstm_b(F, P)); REPF(5, dsa_select(F, P)); SEAM(pb + 3); }
            if (PHEN(4) && IN(pb + 4)) { REPF(6, mlstm_c(F, P)); REPF(7, dsa_attn(F, P)); SEAM(pb + 4); }
            if (PHEN(5) && IN(pb + 5)) {
                { pg8::Gemm g{(const bf16*)(ws + WS_MIX), (const bf16*)(ws + WS_W_OUT) + (size_t)e * DM * DM, M, DM, DM}; pg8::StaticOrder S; S.init(M, DM, F.G, F.bid);
                  pg8::EpiResid<0> E{HBSEL(hbi), HBSEL(hbi), nullptr, STSEL(si ^ 1), nullptr, nullptr, nullptr};
                  pg8::gemm_phase<pg8::EpiResid<0>, pg8::StaticOrder, true, true>(ring, g, S, E); }
                SEAM(pb + 5); }
            si ^= 1;
            if (PHEN(6) && IN(pb + 6)) {
                const int GF = (F.G == 256) ? 224 : F.G;
                unsigned* cq = (unsigned*)(ws + WS_CTL) + CW_CQ + 64 * lp; unsigned* cdone = cq + 512;
                if (F.bid < GF) {
                pg8::Gemm g{HBSEL(hbi), (const bf16*)(ws + WS_W_GU) + (size_t)e * 7168 * DM, M, 7168, DM}; pg8::StaticOrder S; S.init(M, 7168, GF, F.bid);
                pg8::EpiGLU<false> E{STSEL(si), nullptr, (bf16*)(ws + WS_ACT)};
                pg8::gemm_phase<pg8::EpiGLU<false>, pg8::StaticOrder, true, true>(ring, g, S, E);
                if (F.tid == 0) atomicAdd(cdone, 1u);
                } else conv_queue(F, args, lp, cq, cdone, true);
                  SEAM(pb + 6); }
            if (PHEN(7) && IN(pb + 7)) {
                pg8::Gemm g{(const bf16*)(ws + WS_ACT), (const bf16*)(ws + WS_W_DN) + (size_t)e * DM * DFF, M, DM, DFF}; pg8::StaticOrder S; S.init(M, DM, F.G, F.bid);
                pg8::EpiResid<0> E{HBSEL(hbi), HBSEL(hbi), nullptr, STSEL(si ^ 1), nullptr, nullptr, nullptr};
                pg8::gemm_phase<pg8::EpiResid<0>, pg8::StaticOrder, true, true>(ring, g, S, E);
                SEAM(pb + 7); }
            si ^= 1;
            if (PHEN(8) && IN(pb + 8)) {
                pg8::Gemm g{HBSEL(hbi), (const bf16*)(ws + WS_W_PG) + (size_t)li * DM * DM, M, DM, DM}; pg8::StaticOrder S; S.init(M, DM, F.G, F.bid);
                pg8::EpiResid<2> E{HBSEL(hbi), HBSEL(hbi ^ 1), nullptr, STSEL(si ^ 1), STSEL(si), Eb, nullptr};
                pg8::gemm_phase<pg8::EpiResid<2>, pg8::StaticOrder, true, true>(ring, g, S, E);
                SEAM(pb + 8); }
            si ^= 1; hbi ^= 1;
        }
        {
            const int o = lp, li = 2 * lp + 1;
            const RoutePtrs R = route_ptrs(ws);
            if (PROBE_SLOT == 202 && F.bid == 0 && F.tid == 0) F.tacc += __hip_atomic_load((unsigned*)(ws + WS_CTL) + CW_CQ + 64 * lp, __ATOMIC_RELAXED, __HIP_MEMORY_SCOPE_AGENT);
            if (PHEN(9) && IN(pb + 9)) {
                REPF(13, pool_fused(F, HBSEL(hbi), HBSEL(hbi ^ 1), STSEL(si), STSEL(si ^ 1), INP(IN_NORM_MIX) + li * DM, (const bf16*)(ws + WS_W_POOL) + (size_t)o * 4 * 256 * 256, INP(IN_SCALE_POOL) + o * DM));
                if (F.G == 256) moe_route(F, R, HBSEL(hbi ^ 1), INP(IN_NORM_FFN) + li * DM, INP(IN_W_ROUTER) + (size_t)o * DM * 8, INP(IN_B_ROUTER) + o * 8);
                __syncthreads(); conv_queue(F, args, lp, (unsigned*)(ws + WS_CTL) + CW_CQ + 64 * lp, nullptr, false);
                SEAM(pb + 9); }
            si ^= 1; hbi ^= 1;
            if (PHEN(11) && IN(pb + 11)) { if (F.G != 256) {   moe_route(F, R, HBSEL(hbi), INP(IN_NORM_FFN) + li * DM, INP(IN_W_ROUTER) + (size_t)o * DM * 8, INP(IN_B_ROUTER) + o * 8);   SEAM(pb + 11); } }
            if (PHEN(12) && IN(pb + 12)) {   moe_scatter(F, R, HBSEL(hbi), (bf16*)(ws + WS_YG));   SEAM(pb + 12); }
            if (PHEN(13) && IN(pb + 13)) {
                const int nt = __builtin_amdgcn_readfirstlane(R.NT[0]);
                pg8::Gemm g{(const bf16*)(ws + WS_YG), (const bf16*)(ws + WS_W_MGU), MAXROWS, 8 * 7168, DM}; pg8::MoeOrder S{R.TILEE, R.EXPB, R.LT + 40, nt, 28, F.G, F.bid};
                pg8::EpiGLU<true> E{nullptr, R.ROWR, (bf16*)(ws + WS_ACTM)};
                pg8::gemm_phase<pg8::EpiGLU<true>, pg8::MoeOrder, true, true>(ring, g, S, E);
                { const int nlt = __builtin_amdgcn_readfirstlane(R.LT[32]); pg8::LeftOrder<false> S2{R.LT, nlt * 28, F.G, F.bid};
                  pg8::gemm_phase<pg8::EpiGLU<true>, pg8::LeftOrder<false>, true, true>(ring, g, S2, E); }
                { unsigned* cq = (unsigned*)(ws + WS_CTL) + CW_CQ + 64 * lp; __syncthreads(); conv_drain2(F, args, lp, cq, cq + 768); }
                  SEAM(pb + 13); }
            if (PHEN(14) && IN(pb + 14)) {
                const int nt = __builtin_amdgcn_readfirstlane(R.NT[0]);
                pg8::Gemm g{(const bf16*)(ws + WS_ACTM), (const bf16*)(ws + WS_W_MDN), MAXROWS, 8 * 1024, DFF}; pg8::MoeOrder S{R.TILEE, R.EXPB, R.LT + 40, nt, 4, F.G, F.bid};
                pg8::EpiScatter E{R.ROWTS, R.ROWG, (bf16*)(ws + WS_D0), (bf16*)(ws + WS_D1)};
                pg8::gemm_phase<pg8::EpiScatter, pg8::MoeOrder, true, true>(ring, g, S, E);
                {
                  const int nlt = __builtin_amdgcn_readfirstlane(R.LT[32]);
                  pg8::Gemm g3{(const bf16*)(ws + WS_ACTM), (const bf16*)(ws + WS_W_MDN), MAXROWS, 8 * 1024, K512, DFF}; pg8::LeftOrder<true> S3{R.LT, nlt * 28, F.G, F.bid};
                  pg8::EpiPart E3{(float*)(ws + WS_PART)};
                  pg8::gemm_phase<pg8::EpiPart, pg8::LeftOrder<true>, true, true>(ring, g3, S3, E3); }
                {
                  const int c0 = 0;
                  if (F.bid >= c0) { pg8::Gemm g2{(const bf16*)(ws + WS_PB) + (size_t)li * M * PLED, (const bf16*)(ws + WS_W_PL) + (size_t)li * DM * PLED, M, DM, K256}; pg8::StaticOrder S2; S2.init(M, DM, F.G - c0, F.bid - c0);
                    pg8::EpiStore E2{Eb, DM};
                    pg8::gemm_phase<pg8::EpiStore, pg8::StaticOrder, true, true>(ring, g2, S2, E2); } }
                  SEAM(pb + 14); }
            if (PHEN(15) && IN(pb + 15)) { moe_combine(F, R, (const bf16*)(ws + WS_D0), (const bf16*)(ws + WS_D1), (const float*)(ws + WS_PART), HBSEL(hbi), STSEL(si ^ 1)); SEAM(pb + 15); }
            si ^= 1;
            if (PHEN(16) && IN(pb + 16)) {
                pg8::Gemm g{HBSEL(hbi), (const bf16*)(ws + WS_W_PG) + (size_t)li * DM * DM, M, DM, DM}; pg8::StaticOrder S; S.init(M, DM, F.G, F.bid);
                if (lp == 1) { pg8::EpiResid<2, true> E{HBSEL(hbi), nullptr, F.out, nullptr, STSEL(si), Eb, nullptr};
                    pg8::gemm_phase<pg8::EpiResid<2, true>, pg8::StaticOrder, true, true>(ring, g, S, E); }
                else { pg8::EpiResid<2> E{HBSEL(hbi), HBSEL(hbi ^ 1), nullptr, STSEL(si ^ 1), STSEL(si), Eb, nullptr};
                    pg8::gemm_phase<pg8::EpiResid<2>, pg8::StaticOrder, true, true>(ring, g, S, E); }
                SEAM(pb + 16); }
            si ^= 1; hbi ^= 1;
        }

}
__global__ void __launch_bounds__(NWAVES * 64, 2) fwd(Args args) {
    extern __shared__ __attribute__((aligned(16))) unsigned char lds[];
    Frame F;
    F.lds = (LAS unsigned char*)lds; F.gl = lds; F.MISCW = (volatile LAS unsigned*)(F.lds + MISC_OFF);
    F.tid = threadIdx.x; F.lane = F.tid & 63; F.wave = __builtin_amdgcn_readfirstlane(F.tid >> 6); F.G = gridDim.x; F.bid = blockIdx.x; F.gw = F.bid * NWAVES + F.wave; F.NGW = F.G * NWAVES;
    F.out = args.out; F.ws = args.ws;
    unsigned char* ws = args.ws;
    for (int u = F.tid; u < (LDS_BYTES - LDSCTL_OFF) / 4; u += NWAVES * 64) ((LAS unsigned*)(F.lds + LDSCTL_OFF))[u] = 0u;
    __syncthreads();
    XcdBarrier bar = xcd_barrier_post((unsigned*)(ws + WS_CTL) + CW_BAR, F.MISCW + 8);
    const int lo = args.ph_lo, hi = args.ph_hi;
    F.tacc = 0ull; F.tprev = (PROBE_SLOT >= 0) ? wall_clock64() : 0ull;
    LAS unsigned char* ring = F.lds;
    int K512 = 512; asm volatile("" : "+s"(K512));
    int K256 = 256; asm volatile("" : "+s"(K256));

    if (PHEN(100) && IN(0)) { REPF(8, p0_prologue(F, args)); SEAM(0); }

    layer_pair<0>(F, args, bar, lo, hi, ring, K256, K512);
    layer_pair<1>(F, args, bar, lo, hi, ring, K256, K512);
    if (PROBE_SLOT >= 0 && F.bid == 0 && F.tid == 0) { const unsigned long long t0_ = wall_clock64(), dl_ = (unsigned long long)PROBE_MULT * F.tacc; while (wall_clock64() - t0_ < dl_) __builtin_amdgcn_s_sleep(8); }
#undef IN
#undef SEAM
}

extern "C" void kernel_launch(void* const* d_in, const int* in_sizes, int n_in, void* d_out, int out_size, void* d_ws, size_t ws_size, hipStream_t stream) {
    static int grid = 0;
    if (grid == 0) {
        if (n_in != 28 || in_sizes[0] != M * DM || out_size != M * DM || ws_size < WS_END) { fprintf(stderr, "kernel_launch: unexpected shapes (n_in %d, in0 %d, out %d, ws %zu < %zu); nothing launched\n", n_in, n_in > 0 ? in_sizes[0] : -1, out_size, ws_size, (size_t)WS_END); grid = -1; return; }
        int dev = 0, cus = 0, per_cu = 0;
        if (hipGetDevice(&dev) != hipSuccess || hipDeviceGetAttribute(&cus, hipDeviceAttributeMultiprocessorCount, dev) != hipSuccess) { grid = -1; return; }
        if (hipFuncSetAttribute((const void*)fwd, hipFuncAttributeMaxDynamicSharedMemorySize, LDS_BYTES) != hipSuccess) { fprintf(stderr, "kernel_launch: hipFuncSetAttribute failed\n"); grid = -1; return; }
        if (hipOccupancyMaxActiveBlocksPerMultiprocessor(&per_cu, (const void*)fwd, NWAVES * 64, LDS_BYTES) != hipSuccess || per_cu < 1) fprintf(stderr, "kernel_launch: occupancy query reports %d workgroups per CU\n", per_cu);
        (void)hipGetLastError();
        grid = cus;
    }
    if (grid < 0) return;
    if (hipMemsetAsync((char*)d_ws + WS_CTL, 0, CTL_ZERO_BYTES, stream) != hipSuccess) return;
    Args a{};
    for (int i = 0; i < 28; ++i) a.in[i] = (const float*)d_in[i];
    a.out = (float*)d_out; a.ws = (unsigned char*)d_ws;
#if MK_ONE_LAUNCH
    a.ph_lo = 0; a.ph_hi = N_PHASES;
    hipLaunchKernelGGL(fwd, dim3(grid), dim3(NWAVES * 64), LDS_BYTES, stream, a);
#else
    for (int ph = 0; ph < N_PHASES; ++ph) { if (ph == 1) continue; a.ph_lo = ph; a.ph_hi = ph + 1;
        hipLaunchKernelGGL(fwd, dim3(grid), dim3(NWAVES * 64), LDS_BYTES, stream, a); }
#endif
}
```
